# Optimizing an MI355X kernel written in HIP

```python
import jax, jax.numpy as jnp
from jax import lax
import numpy as np

D_MODEL = 1024
BATCH = 8
SEQ = 8192
DEPTH = 1

N_HEADS = 8
HEAD_DIM = 64
N_KV_HEADS = 2
CMP_LEN = 32
CMP_STRIDE = 16
CMP_HID = 256
SEL_BLK = 64
SEL_TOPN = 16
WINDOW = 512
QBLK = 128
CONV_WIDTH = 512
CONV_K = 3
N_EXPERTS = 32
TOP_K = 4
D_FF = 1024
SWIGLU_LIMIT = 7.0
SWIGLU_ALPHA = 1.702
MOE_CHUNK = 512
EPS = 1e-6
NEG = -1e30
POS = 1e30

ATTN_WIDTH = N_HEADS * HEAD_DIM
KV_WIDTH = N_KV_HEADS * HEAD_DIM
IN_SPLITS = (ATTN_WIDTH,
             KV_WIDTH, KV_WIDTH,
             KV_WIDTH, KV_WIDTH,
             KV_WIDTH, KV_WIDTH,
             3 * N_HEADS,
             CONV_WIDTH, CONV_WIDTH, CONV_WIDTH,
             2 * D_MODEL)
IN_COLS = int(sum(IN_SPLITS))
IN_OFFSETS = tuple(int(o) for o in np.cumsum(IN_SPLITS)[:-1])

kernel_name = 'hybrid_nsa_shortconv_moe_block'


def rmsnorm(x, g):
    xf = x.astype(jnp.float32)
    y = xf * lax.rsqrt(jnp.mean(xf * xf, axis=-1, keepdims=True) + EPS)
    return (y * g.astype(jnp.float32)).astype(x.dtype)


def masked_softmax(s, mask):
    p = jax.nn.softmax(jnp.where(mask, s, NEG), axis=-1)
    return jnp.where(mask, p, 0.0)


def alibi_slopes(n_heads):
    return jnp.asarray(2.0 ** (-8.0 * np.arange(1, n_heads + 1) / n_heads), jnp.float32)


def selection_map(n_cmp, n_blk):
    ratio = SEL_BLK // CMP_STRIDE
    span = CMP_LEN // CMP_STRIDE
    j = np.arange(n_blk)[:, None, None]
    i = (ratio * j + np.arange(ratio)[None, :, None] - np.arange(span)[None, None, :]).reshape(n_blk, -1)
    jj = np.broadcast_to(np.arange(n_blk)[:, None], i.shape)
    ok = (i >= 0) & (i < n_cmp)
    m = np.zeros((n_cmp, n_blk), np.float32)
    np.add.at(m, (i[ok], jj[ok]), 1.0)
    return jnp.asarray(m)


def compress(k, pe, w1, b1, w2, b2):
    B, S, G, hd = k.shape
    kk = k.reshape(B, S // CMP_STRIDE, CMP_STRIDE, G, hd)
    blocks = jnp.concatenate([kk[:, :-1], kk[:, 1:]], axis=2) + pe[None, None, :, None, :]
    n_cmp = blocks.shape[1]
    flat = blocks.transpose(0, 1, 3, 2, 4).reshape(B, n_cmp, G, CMP_LEN * hd)
    return jax.nn.gelu(flat @ w1 + b1) @ w2 + b2


def nsa_attention(q, kc, vc, ks, vs, kw, vw, gates):
    B, S, H, hd = q.shape
    G = kc.shape[2]
    hpg = H // G
    n_cmp = kc.shape[1]
    n_blk = S // SEL_BLK
    n_sel = min(SEL_TOPN, n_blk)
    scale = hd ** -0.5
    f32 = jnp.float32
    slopes = alibi_slopes(H).reshape(1, G, hpg, 1, 1)
    sel_map = selection_map(n_cmp, n_blk)
    cmp_end = jnp.arange(n_cmp) * CMP_STRIDE + CMP_LEN - 1
    ksb = ks.reshape(B, n_blk, SEL_BLK, G, hd).transpose(0, 3, 1, 2, 4)
    vsb = vs.reshape(B, n_blk, SEL_BLK, G, hd).transpose(0, 3, 1, 2, 4)
    pad = ((0, 0), (WINDOW, 0), (0, 0), (0, 0))
    kwp = jnp.pad(kw, pad)
    vwp = jnp.pad(vw, pad)
    bi = jnp.arange(B)[:, None, None, None]
    gi = jnp.arange(G)[None, :, None, None]

    def block(i):
        q0 = i * QBLK
        t = q0 + jnp.arange(QBLK)
        qb = lax.dynamic_slice_in_dim(q, q0, QBLK, axis=1).reshape(B, QBLK, G, hpg, hd)
        gb = lax.dynamic_slice_in_dim(gates, q0, QBLK, axis=1).reshape(B, QBLK, G, hpg, 3)
        dist_c = (t[:, None] - cmp_end[None, :]).astype(f32)
        s_c = jnp.einsum('bqghd,bngd->bghqn', qb, kc, preferred_element_type=f32) * scale - slopes * dist_c
        p_c = masked_softmax(s_c, dist_c >= 0)
        o_c = jnp.einsum('bghqn,bngd->bqghd', p_c.astype(vc.dtype), vc)
        imp = jnp.einsum('bghqn,nj->bgqj', p_c, sel_map)
        jb = jnp.arange(n_blk)[None, :]
        cur = (t // SEL_BLK)[:, None]
        forced = (jb == 0) | (jb == cur) | (jb == cur - 1)
        score = jnp.where(jb > cur, NEG, jnp.where(forced, POS, imp))
        _, idx = lax.top_k(score, n_sel)
        k_sel = ksb[bi, gi, idx].reshape(B, G, QBLK, n_sel * SEL_BLK, hd)
        v_sel = vsb[bi, gi, idx].reshape(B, G, QBLK, n_sel * SEL_BLK, hd)
        pos = (idx[..., None] * SEL_BLK + jnp.arange(SEL_BLK)).reshape(B, G, QBLK, n_sel * SEL_BLK)
        dist_s = (t[None, None, :, None] - pos).astype(f32)[:, :, None]
        s_s = jnp.einsum('bqghd,bgqkd->bghqk', qb, k_sel, preferred_element_type=f32) * scale - slopes * dist_s
        p_s = masked_softmax(s_s, dist_s >= 0)
        o_s = jnp.einsum('bghqk,bgqkd->bqghd', p_s.astype(v_sel.dtype), v_sel)
        k_w = lax.dynamic_slice_in_dim(kwp, q0, WINDOW + QBLK, axis=1)
        v_w = lax.dynamic_slice_in_dim(vwp, q0, WINDOW + QBLK, axis=1)
        spos = q0 - WINDOW + jnp.arange(WINDOW + QBLK)
        dist_w = t[:, None] - spos[None, :]
        valid_w = (dist_w >= 0) & (dist_w < WINDOW) & (spos[None, :] >= 0)
        s_w = jnp.einsum('bqghd,bkgd->bghqk', qb, k_w, preferred_element_type=f32) * scale - slopes * dist_w.astype(f32)
        p_w = masked_softmax(s_w, valid_w)
        o_w = jnp.einsum('bghqk,bkgd->bqghd', p_w.astype(v_w.dtype), v_w)
        o = gb[..., 0:1] * o_c + gb[..., 1:2] * o_s + gb[..., 2:3] * o_w
        return o.reshape(B, QBLK, H * hd)

    out = lax.map(block, jnp.arange(S // QBLK))
    return out.transpose(1, 0, 2, 3).reshape(B, S, H * hd)


def short_conv(b_gate, c_gate, u, w):
    v = c_gate * u
    y = lax.conv_general_dilated(v, w[:, None, :].astype(v.dtype), window_strides=(1,),
                                 padding=[(CONV_K - 1, 0)], dimension_numbers=('NWC', 'WIO', 'NWC'),
                                 feature_group_count=v.shape[-1])
    return b_gate * y


def hybrid_mixer(h, w_in, g_q, g_kc, g_ks, g_kw, pe_k, ck_w1, ck_b1, ck_w2, ck_b2,
                 pe_v, cv_w1, cv_b1, cv_w2, cv_b2, conv_w, w_pa, w_pb, w_o):
    B, S, _ = h.shape
    proj = h @ w_in
    (q, kc, vc, ks, vs, kw, vw, ng, cb, cc, cu, mg) = jnp.split(proj, IN_OFFSETS, axis=-1)
    kv_shape = (B, S, N_KV_HEADS, HEAD_DIM)
    q = rmsnorm(q.reshape(B, S, N_HEADS, HEAD_DIM), g_q)
    kc = rmsnorm(compress(kc.reshape(kv_shape), pe_k, ck_w1, ck_b1, ck_w2, ck_b2), g_kc)
    vc = compress(vc.reshape(kv_shape), pe_v, cv_w1, cv_b1, cv_w2, cv_b2)
    ks = rmsnorm(ks.reshape(kv_shape), g_ks)
    kw = rmsnorm(kw.reshape(kv_shape), g_kw)
    nsa_gates = jax.nn.sigmoid(ng).reshape(B, S, N_HEADS, 3)
    o_a = nsa_attention(q, kc, vc, ks, vs.reshape(kv_shape), kw, vw.reshape(kv_shape), nsa_gates)
    y_a = o_a @ w_pa
    y_b = short_conv(cb, cc, cu, conv_w) @ w_pb
    g_a, g_b = jnp.split(jax.nn.sigmoid(mg), 2, axis=-1)
    return (g_a * y_a + g_b * y_b) @ w_o


def moe(h, w_r, b_r, w_gu, b_gu, w_dn, b_dn):
    B, S, D = h.shape
    T = B * S
    hf = h.reshape(T, D)
    logits = (hf @ w_r + b_r).astype(jnp.float32)
    top_v, top_e = lax.top_k(logits, TOP_K)
    gate_w = jax.nn.softmax(top_v, axis=-1).astype(h.dtype)
    e_flat = top_e.reshape(-1)
    tok_flat = jnp.repeat(jnp.arange(T, dtype=jnp.int32), TOP_K)
    w_flat = gate_w.reshape(-1)
    order = jnp.argsort(e_flat, stable=True)
    e_s, tok_s, w_s = e_flat[order], tok_flat[order], w_flat[order]
    counts = jnp.bincount(e_flat, length=N_EXPERTS)
    padded = (counts + MOE_CHUNK - 1) // MOE_CHUNK * MOE_CHUNK
    offs = jnp.cumsum(counts) - counts
    pend = jnp.cumsum(padded)
    poffs = pend - padded
    dest = poffs[e_s] + jnp.arange(T * TOP_K) - offs[e_s]
    n_chunks = (T * TOP_K + MOE_CHUNK - 1) // MOE_CHUNK + N_EXPERTS
    P = n_chunks * MOE_CHUNK
    row_tok = jnp.full((P,), T, jnp.int32).at[dest].set(tok_s)
    row_w = jnp.zeros((P,), h.dtype).at[dest].set(w_s)
    chunk_e = jnp.minimum(jnp.searchsorted(pend, jnp.arange(n_chunks) * MOE_CHUNK, side='right'), N_EXPERTS - 1)
    hpad = jnp.concatenate([hf, jnp.zeros((1, D), hf.dtype)], axis=0)

    def run(args):
        toks, wts, e = args
        gu = hpad[toks] @ w_gu[e] + b_gu[e]
        g, u = jnp.split(gu, 2, axis=-1)
        g = jnp.minimum(g, SWIGLU_LIMIT)
        u = jnp.clip(u, -SWIGLU_LIMIT, SWIGLU_LIMIT)
        y = ((u + 1.0) * (g * jax.nn.sigmoid(SWIGLU_ALPHA * g))) @ w_dn[e] + b_dn[e]
        return y * wts[:, None]

    ys = lax.map(run, (row_tok.reshape(n_chunks, MOE_CHUNK), row_w.reshape(n_chunks, MOE_CHUNK), chunk_e))
    out = jax.ops.segment_sum(ys.reshape(P, D), row_tok, num_segments=T + 1)[:T]
    return out.reshape(B, S, D)


def setup_inputs(seed: int = 0) -> dict:
    key = jax.random.key(seed)
    ks = iter(jax.random.split(key, 40))
    f32 = jnp.float32

    def nrm(shape, fan_in):
        return jax.random.normal(next(ks), shape, f32) * (fan_in ** -0.5)

    def gain(shape):
        return 1.0 + 0.02 * jax.random.normal(next(ks), shape, f32)

    def small(shape, s=0.02):
        return s * jax.random.normal(next(ks), shape, f32)

    L = DEPTH
    return {
        'x': jax.random.normal(next(ks), (BATCH, SEQ, D_MODEL), f32),
        'g_norm1': gain((L, D_MODEL)),
        'w_in': nrm((L, D_MODEL, IN_COLS), D_MODEL),
        'g_q': gain((L, HEAD_DIM)),
        'g_kc': gain((L, HEAD_DIM)),
        'g_ks': gain((L, HEAD_DIM)),
        'g_kw': gain((L, HEAD_DIM)),
        'pe_k': small((L, CMP_LEN, HEAD_DIM)),
        'ck_w1': nrm((L, CMP_LEN * HEAD_DIM, CMP_HID), CMP_LEN * HEAD_DIM),
        'ck_b1': small((L, CMP_HID)),
        'ck_w2': nrm((L, CMP_HID, HEAD_DIM), CMP_HID),
        'ck_b2': small((L, HEAD_DIM)),
        'pe_v': small((L, CMP_LEN, HEAD_DIM)),
        'cv_w1': nrm((L, CMP_LEN * HEAD_DIM, CMP_HID), CMP_LEN * HEAD_DIM),
        'cv_b1': small((L, CMP_HID)),
        'cv_w2': nrm((L, CMP_HID, HEAD_DIM), CMP_HID),
        'cv_b2': small((L, HEAD_DIM)),
        'conv_w': nrm((L, CONV_K, CONV_WIDTH), CONV_K),
        'w_pa': nrm((L, ATTN_WIDTH, D_MODEL), ATTN_WIDTH),
        'w_pb': nrm((L, CONV_WIDTH, D_MODEL), CONV_WIDTH),
        'w_o': nrm((L, D_MODEL, D_MODEL), D_MODEL),
        'g_norm2': gain((L, D_MODEL)),
        'w_r': nrm((L, D_MODEL, N_EXPERTS), D_MODEL),
        'b_r': small((L, N_EXPERTS), 0.01),
        'w_gu': nrm((L, N_EXPERTS, D_MODEL, 2 * D_FF), D_MODEL),
        'b_gu': small((L, N_EXPERTS, 2 * D_FF)),
        'w_dn': nrm((L, N_EXPERTS, D_FF, D_MODEL), D_FF),
        'b_dn': small((L, N_EXPERTS, D_MODEL)),
    }


def reference(x, g_norm1, w_in, g_q, g_kc, g_ks, g_kw, pe_k, ck_w1, ck_b1, ck_w2, ck_b2,
              pe_v, cv_w1, cv_b1, cv_w2, cv_b2, conv_w, w_pa, w_pb, w_o, g_norm2,
              w_r, b_r, w_gu, b_gu, w_dn, b_dn):
    for l in range(DEPTH):
        h = rmsnorm(x, g_norm1[l])
        x = x + hybrid_mixer(h, w_in[l], g_q[l], g_kc[l], g_ks[l], g_kw[l], pe_k[l], ck_w1[l], ck_b1[l],
                             ck_w2[l], ck_b2[l], pe_v[l], cv_w1[l], cv_b1[l], cv_w2[l], cv_b2[l],
                             conv_w[l], w_pa[l], w_pb[l], w_o[l])
        h = rmsnorm(x, g_norm2[l])
        x = x + moe(h, w_r[l], b_r[l], w_gu[l], b_gu[l], w_dn[l], b_dn[l])
    return x
```

```cpp
#include <hip/hip_runtime.h>
#include <cstdio>
#include <cstdint>

#define LAS __attribute__((address_space(3)))
#define GAS __attribute__((address_space(1)))
typedef unsigned short bf16_t;
typedef short bf16x8 __attribute__((ext_vector_type(8)));
typedef float f32x4 __attribute__((ext_vector_type(4)));
typedef float f32x2 __attribute__((ext_vector_type(2)));
typedef unsigned u32x4 __attribute__((ext_vector_type(4)));
typedef unsigned u32x2 __attribute__((ext_vector_type(2)));

#ifndef MK_N_LAUNCHES
#define MK_N_LAUNCHES 1
#endif

constexpr int BATCH = 8, SEQ = 8192, DM = 1024, T = BATCH * SEQ;
constexpr int NH = 8, HD = 64, NGRP = 2, AW = 512;
constexpr int CMP_HID = 256, NBLK = 128, NSEL = 16, WIN = 512;
constexpr int CONVW = 512, NEXP = 32, DFF = 1024;
constexpr int NPROJ = 5120;
constexpr int IN_COLS = 4888;
constexpr float EPS = 1e-6f, LOG2E = 1.4426950408889634f;
constexpr float QSCALE = 0.125f * LOG2E;
constexpr int NCH = 2;
constexpr int TCH = T / NCH;
constexpr int SLOTS_CH = TCH * 4 + NEXP * 256;
constexpr int WPC = 256 / NCH;
constexpr int NPH = 14;

constexpr size_t MiB = 1u << 20;
constexpr size_t WS_CTL = 0, CTL_ZERO_BYTES = 64 * 1024;
constexpr size_t WS_B1P = 1 * MiB;
constexpr size_t WS_TSTART = 1 * MiB + 4096;
constexpr size_t WS_CNT = 1 * MiB + 8192;
constexpr size_t WS_WIN_T = 8 * MiB, WS_WPA_T = 18 * MiB, WS_WPB_T = 19 * MiB, WS_WO_T = 20 * MiB, WS_CKW1_T = 22 * MiB, WS_CVW1_T = 23 * MiB;
constexpr size_t WS_WGU_T = 24 * MiB, WS_WDN_T = 152 * MiB;
constexpr size_t WS_H1 = 216 * MiB, WS_YB = 216 * MiB, WS_Q = 344 * MiB, WS_KV6 = 408 * MiB, WS_CONV3 = 504 * MiB, WS_MG = 696 * MiB;
constexpr size_t WS_NG = 952 * MiB, WS_HID = 956 * MiB, WS_KC = 964 * MiB, WS_VC = 965 * MiB, WS_Z = 408 * MiB;
constexpr size_t WS_H2 = 216 * MiB, WS_ACT = 344 * MiB, WS_YBUF = 616 * MiB, WS_TOPE = 888 * MiB, WS_TOPW = 889 * MiB, WS_INV = 890 * MiB, WS_ROWTOK = 891 * MiB, WS_ROWW = 893 * MiB;
constexpr size_t WS_END = 966 * MiB;
static_assert((size_t)SLOTS_CH * 2048 <= 272 * MiB, "act chunk");
static_assert((size_t)NCH * SLOTS_CH * 4 <= 2 * MiB, "rowtok");

constexpr int RING_BYTES = 131072;
constexpr int GTAB_OFF = RING_BYTES, GTAB_UNITS = 20, GTAB_BYTES = GTAB_UNITS * 1024;
constexpr int MISC_OFF = GTAB_OFF + GTAB_BYTES;
constexpr int LDS_BYTES = MISC_OFF + 1024;
static_assert(LDS_BYTES <= 160 * 1024, "LDS");

__device__ __forceinline__ unsigned f2bf(float f) { unsigned u = __builtin_bit_cast(unsigned, f); return (u + 0x7fffu + ((u >> 16) & 1u)) >> 16; }
__device__ __forceinline__ unsigned pk2(float lo, float hi) { return f2bf(lo) | (f2bf(hi) << 16); }
__device__ __forceinline__ float bflo(unsigned w) { return __builtin_bit_cast(float, w << 16); }
__device__ __forceinline__ float bfhi(unsigned w) { return __builtin_bit_cast(float, w & 0xffff0000u); }
__device__ __forceinline__ float bf2f(bf16_t h) { return __builtin_bit_cast(float, (unsigned)h << 16); }
__device__ __forceinline__ float wave_sum(float v) {
#pragma unroll
    for (int o = 1; o < 64; o <<= 1) v += __shfl_xor(v, o);
    return v;
}
__device__ __forceinline__ float wave_max(float v) {
#pragma unroll
    for (int o = 1; o < 64; o <<= 1) v = fmaxf(v, __shfl_xor(v, o));
    return v;
}
__device__ __forceinline__ float sigmoidf_(float x) { return 1.0f / (1.0f + __expf(-x)); }
#define LDS_WAIT() asm volatile("s_waitcnt lgkmcnt(0)" ::: "memory")
#define VM_WAIT() asm volatile("s_waitcnt vmcnt(0)" ::: "memory")

namespace pg8 {
constexpr int BM = 256, BK = 64, HALF = 128, HTB = HALF * BK * 2, STAGE_BYTES = 8 * HTB, NXCD = 8, WGM = 8;
__host__ __device__ __forceinline__ int lds_byte(int r, int c) { const int st = (r >> 4) * 2 + (c >> 5), rr = r & 15, cc = c & 31, ob = rr * 64 + cc * 2; return st * 1024 + (ob ^ (((ob >> 9) & 1) << 5)); }
__host__ __device__ __forceinline__ void stage_rc(int b, int& R, int& C) { const int st = b / 1024, sb = b % 1024, swz = sb ^ (((sb >> 9) & 1) << 5); R = (st >> 1) * 16 + swz / 64; C = (st & 1) * 32 + (swz % 64) / 2; }
__host__ __device__ __forceinline__ int perm32(int rho) { const int n = rho >> 4, i = rho & 15; return 8 * (i >> 2) + 4 * n + (i & 3); }

struct Unit { const char* a; const char* b; int pm, pn, e; };

__device__ __forceinline__ bool tile_map(long L, int nM, int nN, int& pm, int& pn) {
    const int nwg = nM * nN; if (L >= nwg) return false;
    int wgid = (int)L; { const int q = nwg / NXCD, r = nwg % NXCD, xcd = wgid % NXCD, off = wgid / NXCD; wgid = (xcd < r ? xcd * (q + 1) : r * (q + 1) + (xcd - r) * q) + off; }
    const int nig = WGM * nN, gid = wgid / nig, fm = gid * WGM, gsz = (nM - fm) < WGM ? (nM - fm) : WGM;
    pm = fm + ((wgid % nig) % gsz); pn = (wgid % nig) / gsz; return true;
}

__device__ __forceinline__ unsigned cvt_pk_bf16(float lo, float hi) { unsigned r; asm volatile("v_cvt_pk_bf16_f32 %0, %1, %2" : "=v"(r) : "v"(lo), "v"(hi)); return r; }

template <class Epi, class Sched, bool GATHER>
__device__ __forceinline__ void gemm_phase(LAS unsigned char* lds, const int K, const unsigned a_pitch, const unsigned a_kstep, const Sched& S, const Epi& E, const LAS unsigned* gtab) {
    const int tid = threadIdx.x, wid = __builtin_amdgcn_readfirstlane(tid >> 6), lane = tid & 63, wr = wid >> 2, wc = wid & 3, fr = lane & 15, fq = lane >> 4;
    const int nt = K / BK;
    unsigned voffA[2][2], voffB[2];
#pragma unroll
    for (int i = 0; i < 2; ++i) { int R, C; stage_rc(tid * 16 + i * 8192, R, C); const int Rb = Epi::PERM ? ((R & ~31) + perm32(R & 31)) : R;
        voffB[i] = (unsigned)(Rb * K + C) * 2u; voffA[0][i] = (unsigned)R * a_pitch + (unsigned)C * 2u; voffA[1][i] = voffA[0][i]; }
    const size_t kstepA = a_kstep, kstepB = (size_t)(BK * 2);
    const size_t hstepA = GATHER ? (size_t)0 : (size_t)HALF * a_pitch, hstepB = (size_t)HALF * K * 2;
    const unsigned ldsw = (unsigned)wid * 1024u;
    const int aoff = lds_byte(wr * 64 + fr, fq * 8), boff = lds_byte(wc * 32 + fr, fq * 8);
#define PG8_SA(b, h) (((b) * 2 + (h)) * HTB)
#define PG8_SB(b, h) ((4 + (b) * 2 + (h)) * HTB)
#define PG8_STAGE(bufoff, gbase, voff) do { _Pragma("unroll") for (int _i = 0; _i < 2; ++_i) \
        __builtin_amdgcn_global_load_lds((const unsigned*)((const char*)(gbase) + (voff)[_i]), (LAS unsigned*)(lds + (bufoff) + ldsw + _i * 8192), 16, 0, 0); } while (0)
#define PG8_STA(bufoff, gbase, h) do { if constexpr (GATHER) { PG8_STAGE(bufoff, gbase, voffA[h]); } else { PG8_STAGE(bufoff, (gbase) + (h) * hstepA, voffA[0]); } } while (0)
#define PG8_GLOAD(ui_) do { _Pragma("unroll") for (int _i = 0; _i < 2; ++_i) { int R_, C_; stage_rc(tid * 16 + _i * 8192, R_, C_); \
        voffA[0][_i] = gtab[(ui_) * 256 + R_] + (unsigned)C_ * 2u; voffA[1][_i] = gtab[(ui_) * 256 + 128 + R_] + (unsigned)C_ * 2u; } } while (0)
#define PG8_LDA(dst, b, h) do { _Pragma("unroll") for (int m = 0; m < 4; ++m) _Pragma("unroll") for (int k = 0; k < 2; ++k) dst[m][k] = *(const LAS bf16x8*)(lds + PG8_SA(b, h) + aoff + m * 2048 + k * 1024); } while (0)
#define PG8_LDB(dst, b, h) do { _Pragma("unroll") for (int n = 0; n < 2; ++n) _Pragma("unroll") for (int k = 0; k < 2; ++k) dst[n][k] = *(const LAS bf16x8*)(lds + PG8_SB(b, h) + boff + n * 2048 + k * 1024); } while (0)
#define PG8_MMA(ai, bj, At, Bt) do { __builtin_amdgcn_s_setprio(1); _Pragma("unroll") for (int m = 0; m < 4; ++m) _Pragma("unroll") for (int n = 0; n < 2; ++n) _Pragma("unroll") for (int k = 0; k < 2; ++k) \
        acc[ai][bj][m][n] = __builtin_amdgcn_mfma_f32_16x16x32_bf16(Bt[n][k], At[m][k], acc[ai][bj][m][n], 0, 0, 0); __builtin_amdgcn_s_setprio(0); } while (0)
#define PG8_WAIT_V(n) asm volatile("s_waitcnt vmcnt(" #n ")" ::: "memory")
#define PG8_WAIT_L(n) asm volatile("s_waitcnt lgkmcnt(" #n ")" ::: "memory")
#define PG8_BAR __builtin_amdgcn_s_barrier()
#define PG8_SCHED __builtin_amdgcn_sched_barrier(0)
    Unit cur, nxt; int ui = 0;
    if (!S.next(0, cur)) return;
    f32x4 acc[2][2][4][2];
#pragma unroll
    for (int a = 0; a < 2; ++a)
#pragma unroll
        for (int b = 0; b < 2; ++b)
#pragma unroll
            for (int m = 0; m < 4; ++m)
#pragma unroll
                for (int n = 0; n < 2; ++n) acc[a][b][m][n] = (f32x4){0.f, 0.f, 0.f, 0.f};
    bf16x8 At[4][2], B0[2][2], B1[2][2];
    const char* cA = cur.a; const char* cB = cur.b;
    if constexpr (GATHER) { PG8_GLOAD(0); }
    PG8_STAGE(PG8_SB(0, 0), cB, voffB); PG8_STAGE(PG8_SB(0, 1), cB + hstepB, voffB); PG8_STA(PG8_SA(0, 0), cA, 0); PG8_STA(PG8_SA(0, 1), cA, 1);
    if (wr == 1) PG8_BAR;
    PG8_WAIT_V(2); PG8_BAR;
    PG8_STAGE(PG8_SB(1, 0), cB + kstepB, voffB); PG8_STA(PG8_SA(1, 0), cA + kstepA, 0); PG8_STAGE(PG8_SB(1, 1), cB + hstepB + kstepB, voffB);
    PG8_WAIT_V(6); PG8_BAR;
    for (;;) {
        const bool has_next = S.next(ui + 1, nxt);
        const char* nA = has_next ? nxt.a : cA; const char* nB = has_next ? nxt.b : cB;
        for (int t = 0; t < nt; t += 2) {
            const bool last = (t == nt - 2);
            const char* a1 = cA + (size_t)(t + 1) * kstepA;
            const char* a2 = last ? nA : cA + (size_t)(t + 2) * kstepA; const char* b2 = last ? nB : cB + (size_t)(t + 2) * kstepB;
            const char* a3 = a2 + kstepA; const char* b3 = b2 + kstepB;
            PG8_LDB(B0, 0, 0); PG8_LDB(B1, 0, 1); PG8_SCHED; PG8_LDA(At, 0, 0); PG8_STA(PG8_SA(1, 1), a1, 1);
            if constexpr (GATHER) { if (last && has_next) { PG8_GLOAD(ui + 1); } }
            PG8_WAIT_V(8); PG8_WAIT_L(0); PG8_BAR; PG8_MMA(0, 0, At, B0); PG8_MMA(0, 1, At, B1); PG8_BAR; PG8_SCHED;
            PG8_LDA(At, 0, 1); PG8_STAGE(PG8_SB(0, 0), b2, voffB); PG8_STAGE(PG8_SB(0, 1), b2 + hstepB, voffB); PG8_STA(PG8_SA(0, 0), a2, 0);
            PG8_WAIT_V(8); PG8_WAIT_L(0); PG8_BAR; PG8_MMA(1, 0, At, B0); PG8_MMA(1, 1, At, B1); PG8_BAR; PG8_SCHED;
            PG8_LDB(B0, 1, 0); PG8_LDB(B1, 1, 1); PG8_SCHED; PG8_LDA(At, 1, 0); PG8_STA(PG8_SA(0, 1), a2, 1);
            PG8_WAIT_V(8); PG8_WAIT_L(0); PG8_BAR; PG8_MMA(0, 0, At, B0); PG8_MMA(0, 1, At, B1); PG8_BAR; PG8_SCHED;
            PG8_LDA(At, 1, 1); PG8_STAGE(PG8_SB(1, 0), b3, voffB); PG8_STAGE(PG8_SB(1, 1), b3 + hstepB, voffB); PG8_STA(PG8_SA(1, 0), a3, 0);
            PG8_WAIT_V(8); PG8_WAIT_L(0); PG8_BAR; PG8_MMA(1, 0, At, B0); PG8_MMA(1, 1, At, B1); PG8_BAR; PG8_SCHED;
        }
        if (wr == 0) PG8_BAR;
        E(acc, cur, wr, wc, fr, fq);
        if (!has_next) break;
#pragma unroll
        for (int a = 0; a < 2; ++a)
#pragma unroll
            for (int b = 0; b < 2; ++b)
#pragma unroll
                for (int m = 0; m < 4; ++m)
#pragma unroll
                    for (int n = 0; n < 2; ++n) acc[a][b][m][n] = (f32x4){0.f, 0.f, 0.f, 0.f};
        cur = nxt; cA = nA; cB = nB; ++ui;
        if (wr == 1) PG8_BAR;
    }
    PG8_WAIT_V(0);
    PG8_BAR;
#undef PG8_SA
#undef PG8_SB
#undef PG8_STAGE
#undef PG8_STA
#undef PG8_GLOAD
#undef PG8_LDA
#undef PG8_LDB
#undef PG8_MMA
#undef PG8_WAIT_V
#undef PG8_WAIT_L
#undef PG8_BAR
#undef PG8_SCHED
}

struct OrdPlain {
    const char* A; const char* Bt; int nM, nN, G, c; size_t a_tile, b_tile;
    __device__ __forceinline__ bool next(int i, Unit& u) const { int pm, pn; if (!tile_map((long)i * G + c, nM, nN, pm, pn)) return false;
        u.pm = pm; u.pn = pn; u.e = 0; u.a = A + (size_t)pm * a_tile; u.b = Bt + (size_t)pn * b_tile; return true; }
};
struct OrdCmp {
    const char* KV6; const char* Wk; const char* Wv; int G, c;
    __device__ __forceinline__ bool next(int i, Unit& u) const { const long L = (long)i * G + c; if (L >= 64) return false;
        const int kv = (int)L >> 5, b = ((int)L >> 2) & 7, g = ((int)L >> 1) & 1, nh = (int)L & 1;
        u.pm = (int)L; u.pn = 0; u.e = kv; u.a = KV6 + ((size_t)(b * SEQ + nh * 4096) * 768 + kv * 128 + g * 64) * 2; u.b = kv ? Wv : Wk; return true; }
};
struct OrdGrp {
    const char* A; const char* Bt; const LAS int* tstart; int nM, nN, G, c; size_t a_tile, b_tile, b_grp;
    __device__ __forceinline__ bool next(int i, Unit& u) const { int pm, pn; if (!tile_map((long)i * G + c, nM, nN, pm, pn)) return false;
        int e = 0;
#pragma unroll 1
        for (int k = 1; k < NEXP; ++k) e += (pm >= tstart[k]) ? 1 : 0;
        u.pm = pm; u.pn = pn; u.e = e; u.a = A + (size_t)pm * a_tile; u.b = Bt + (size_t)e * b_grp + (size_t)pn * b_tile; return true; }
};

struct EpiIn {
    static constexpr bool PERM = true;
    bf16_t *Q, *KV6, *CONV3, *MG, *NG;
    __device__ __forceinline__ void operator()(const f32x4 (&acc)[2][2][4][2], const Unit& u, int wr, int wc, int fr, int fq) const {
        const int pn = u.pn; bf16_t* base; int ld, ct; bool sig = false;
        if (pn < 2) { base = Q; ld = 512; ct = pn * 256; } else if (pn < 5) { base = KV6; ld = 768; ct = (pn - 2) * 256; }
        else if (pn < 11) { base = CONV3; ld = 1536; ct = (pn - 5) * 256; } else if (pn < 19) { base = MG; ld = 2048; ct = (pn - 11) * 256; sig = true; }
        else { base = NG; ld = 32; ct = 0; sig = true; }
        const int row0 = u.pm * BM + wr * 64 + fr;
#pragma unroll
        for (int ai = 0; ai < 2; ++ai)
#pragma unroll
            for (int m = 0; m < 4; ++m) { bf16_t* rowp = base + (size_t)(row0 + ai * HALF + m * 16) * ld + ct + wc * 32 + 8 * fq;
#pragma unroll
                for (int bj = 0; bj < 2; ++bj) { if (pn == 19 && (bj != 0 || wc != 0)) continue;
                    f32x4 v0 = acc[ai][bj][m][0], v1 = acc[ai][bj][m][1];
                    if (sig) {
#pragma unroll
                        for (int k = 0; k < 4; ++k) { v0[k] = sigmoidf_(v0[k]); v1[k] = sigmoidf_(v1[k]); } }
                    u32x4 w; w.x = cvt_pk_bf16(v0[0], v0[1]); w.y = cvt_pk_bf16(v0[2], v0[3]); w.z = cvt_pk_bf16(v1[0], v1[1]); w.w = cvt_pk_bf16(v1[2], v1[3]);
                    *(u32x4*)(rowp + bj * HALF) = w; } }
    }
};
__device__ __forceinline__ float gelu_tanh(float x) { const float y = 1.5957691216057308f * (x + 0.044715f * x * x * x); return x / (1.0f + __expf(-y)); }
struct EpiCmp {
    static constexpr bool PERM = true;
    bf16_t* HID; const float* B1P;
    __device__ __forceinline__ void operator()(const f32x4 (&acc)[2][2][4][2], const Unit& u, int wr, int wc, int fr, int fq) const {
        const int row0 = u.pm * BM + wr * 64 + fr; const float* bp = B1P + u.e * 256 + wc * 32 + 8 * fq;
        f32x4 bv[2][2];
#pragma unroll
        for (int bj = 0; bj < 2; ++bj)
#pragma unroll
            for (int n = 0; n < 2; ++n) bv[bj][n] = *(const f32x4*)(bp + bj * HALF + 4 * n);
#pragma unroll
        for (int ai = 0; ai < 2; ++ai)
#pragma unroll
            for (int m = 0; m < 4; ++m) { bf16_t* rowp = HID + (size_t)(row0 + ai * HALF + m * 16) * 256 + wc * 32 + 8 * fq;
#pragma unroll
                for (int bj = 0; bj < 2; ++bj) { f32x4 v0 = acc[ai][bj][m][0] + bv[bj][0], v1 = acc[ai][bj][m][1] + bv[bj][1];
#pragma unroll
                    for (int k = 0; k < 4; ++k) { v0[k] = gelu_tanh(v0[k]); v1[k] = gelu_tanh(v1[k]); }
                    u32x4 w; w.x = cvt_pk_bf16(v0[0], v0[1]); w.y = cvt_pk_bf16(v0[2], v0[3]); w.z = cvt_pk_bf16(v1[0], v1[1]); w.w = cvt_pk_bf16(v1[2], v1[3]);
                    *(u32x4*)(rowp + bj * HALF) = w; } }
    }
};
template <bool ADD> struct EpiGate {
    static constexpr bool PERM = true;
    bf16_t* Z; const bf16_t* MG; int goff;
    __device__ __forceinline__ void operator()(const f32x4 (&acc)[2][2][4][2], const Unit& u, int wr, int wc, int fr, int fq) const {
        const int row0 = u.pm * BM + wr * 64 + fr, col0 = u.pn * BM + wc * 32 + 8 * fq;
#pragma unroll
        for (int ai = 0; ai < 2; ++ai)
#pragma unroll
            for (int m = 0; m < 4; ++m) { const size_t row = (size_t)(row0 + ai * HALF + m * 16);
#pragma unroll
                for (int bj = 0; bj < 2; ++bj) { const int col = col0 + bj * HALF;
                    const u32x4 gw = *(const u32x4*)(MG + row * 2048 + goff + col);
                    f32x4 v0 = acc[ai][bj][m][0], v1 = acc[ai][bj][m][1];
                    v0[0] *= bflo(gw.x); v0[1] *= bfhi(gw.x); v0[2] *= bflo(gw.y); v0[3] *= bfhi(gw.y); v1[0] *= bflo(gw.z); v1[1] *= bfhi(gw.z); v1[2] *= bflo(gw.w); v1[3] *= bfhi(gw.w);
                    if (ADD) { const u32x4 zw = *(const u32x4*)(Z + row * 1024 + col);
                        v0[0] += bflo(zw.x); v0[1] += bfhi(zw.x); v0[2] += bflo(zw.y); v0[3] += bfhi(zw.y); v1[0] += bflo(zw.z); v1[1] += bfhi(zw.z); v1[2] += bflo(zw.w); v1[3] += bfhi(zw.w); }
                    u32x4 w; w.x = cvt_pk_bf16(v0[0], v0[1]); w.y = cvt_pk_bf16(v0[2], v0[3]); w.z = cvt_pk_bf16(v1[0], v1[1]); w.w = cvt_pk_bf16(v1[2], v1[3]);
                    *(u32x4*)(Z + row * 1024 + col) = w; } }
    }
};
struct EpiRes {
    static constexpr bool PERM = false;
    const float* X; float* O;
    __device__ __forceinline__ void operator()(const f32x4 (&acc)[2][2][4][2], const Unit& u, int wr, int wc, int fr, int fq) const {
        const int row0 = u.pm * BM + wr * 64 + fr, col0 = u.pn * BM + wc * 32 + 4 * fq;
#pragma unroll
        for (int ai = 0; ai < 2; ++ai)
#pragma unroll
            for (int m = 0; m < 4; ++m) { const size_t off = (size_t)(row0 + ai * HALF + m * 16) * DM + col0;
#pragma unroll
                for (int bj = 0; bj < 2; ++bj)
#pragma unroll
                    for (int n = 0; n < 2; ++n) { const f32x4 xv = *(const f32x4*)(X + off + bj * HALF + n * 16); *(f32x4*)(O + off + bj * HALF + n * 16) = xv + acc[ai][bj][m][n]; } }
    }
};
struct EpiGU {
    static constexpr bool PERM = true;
    bf16_t* ACT; const float* BGU;
    __device__ __forceinline__ void operator()(const f32x4 (&acc)[2][2][4][2], const Unit& u, int wr, int wc, int fr, int fq) const {
        const int row0 = u.pm * BM + wr * 64 + fr, col0 = u.pn * HALF + wc * 32 + 8 * fq; const float* bp = BGU + (size_t)u.e * 2048 + col0;
        f32x4 bg[2], bu[2];
#pragma unroll
        for (int n = 0; n < 2; ++n) { bg[n] = *(const f32x4*)(bp + 4 * n); bu[n] = *(const f32x4*)(bp + 1024 + 4 * n); }
#pragma unroll
        for (int ai = 0; ai < 2; ++ai)
#pragma unroll
            for (int m = 0; m < 4; ++m) { bf16_t* rowp = ACT + (size_t)(row0 + ai * HALF + m * 16) * 1024 + col0; float o[8];
#pragma unroll
                for (int n = 0; n < 2; ++n)
#pragma unroll
                    for (int k = 0; k < 4; ++k) { float g = fminf(acc[ai][0][m][n][k] + bg[n][k], 7.0f); float uu = fminf(fmaxf(acc[ai][1][m][n][k] + bu[n][k], -7.0f), 7.0f);
                        o[n * 4 + k] = (uu + 1.0f) * (g / (1.0f + __expf(-1.702f * g))); }
                u32x4 w; w.x = cvt_pk_bf16(o[0], o[1]); w.y = cvt_pk_bf16(o[2], o[3]); w.z = cvt_pk_bf16(o[4], o[5]); w.w = cvt_pk_bf16(o[6], o[7]);
                *(u32x4*)rowp = w; }
    }
};
struct EpiDN {
    static constexpr bool PERM = true;
    bf16_t* Y; const float* BDN; const float* ROWW;
    __device__ __forceinline__ void operator()(const f32x4 (&acc)[2][2][4][2], const Unit& u, int wr, int wc, int fr, int fq) const {
        const int row0 = u.pm * BM + wr * 64 + fr, col0 = u.pn * BM + wc * 32 + 8 * fq; const float* bp = BDN + (size_t)u.e * 1024 + col0;
        f32x4 bv[2][2];
#pragma unroll
        for (int bj = 0; bj < 2; ++bj)
#pragma unroll
            for (int n = 0; n < 2; ++n) bv[bj][n] = *(const f32x4*)(bp + bj * HALF + 4 * n);
#pragma unroll
        for (int ai = 0; ai < 2; ++ai)
#pragma unroll
            for (int m = 0; m < 4; ++m) { const int row = row0 + ai * HALF + m * 16; const float rw = ROWW[row]; bf16_t* rowp = Y + (size_t)row * 1024 + col0;
#pragma unroll
                for (int bj = 0; bj < 2; ++bj) { const f32x4 v0 = (acc[ai][bj][m][0] + bv[bj][0]) * rw, v1 = (acc[ai][bj][m][1] + bv[bj][1]) * rw;
                    u32x4 w; w.x = cvt_pk_bf16(v0[0], v0[1]); w.y = cvt_pk_bf16(v0[2], v0[3]); w.z = cvt_pk_bf16(v1[0], v1[1]); w.w = cvt_pk_bf16(v1[2], v1[3]);
                    *(u32x4*)(rowp + bj * HALF) = w; } }
    }
};
}

#define XB_TMO      128
#define XB_XCNT(j)  (256  + 64 * (j))
#define XB_XSUB(j)  (1280 + 64 * (j))
#define XB_XGEN(j)  (2304 + 64 * (j))
#define XB_TOP      3328
#define XB_TOPGEN   3392
#define XCD_BAR_WORDS 3456
#define XB_SPIN_CAP (1u << 18)
__device__ __forceinline__ unsigned xb_ld(unsigned* p)              { return __hip_atomic_load(p, __ATOMIC_RELAXED, __HIP_MEMORY_SCOPE_AGENT); }
__device__ __forceinline__ unsigned xb_add(unsigned* p, unsigned v) { return __hip_atomic_fetch_add(p, v, __ATOMIC_RELAXED, __HIP_MEMORY_SCOPE_AGENT); }
__device__ __forceinline__ unsigned xb_xcc_id() { return (unsigned)__builtin_amdgcn_s_getreg((3 << 11) | 20) & 0xFu; }
#define XB_SPIN(cond, bar) do { unsigned _sp = 0; while (cond) { __builtin_amdgcn_s_sleep(1); \
    if ((++_sp & 255u) == 0u) { if (xb_ld(&(bar)[XB_TMO])) break; if (_sp > XB_SPIN_CAP) { atomicAdd(&(bar)[XB_TMO], 1u); break; } } } } while (0)
struct XcdBarrier { unsigned* bar; unsigned x; volatile LAS unsigned* st; };
__device__ __forceinline__ XcdBarrier xcd_barrier_post(unsigned* bar, volatile LAS unsigned* st) {
    XcdBarrier b; b.bar = bar; b.x = xb_xcc_id(); b.st = st;
    if (threadIdx.x == 0) (void)xb_add(&bar[XB_XCNT(b.x)], 1u);
    return b;
}
__device__ __forceinline__ void xcd_barrier_complete(unsigned* bar, unsigned x, unsigned& nloc, unsigned& nx) {
    const unsigned G = gridDim.x * gridDim.y * gridDim.z;
    unsigned sum, cnt, mine, sp = 0u;
    for (;;) {
        sum = 0u; cnt = 0u; mine = 0u;
#pragma unroll
        for (unsigned j = 0; j < 16; ++j) { const unsigned c = xb_ld(&bar[XB_XCNT(j)]); sum += c; cnt += (c > 0u) ? 1u : 0u; mine = (j == x) ? c : mine; }
        if (sum == G) break;
        __builtin_amdgcn_s_sleep(1);
        if ((++sp & 255u) == 0u) { if (xb_ld(&bar[XB_TMO])) break; if (sp > XB_SPIN_CAP) { atomicAdd(&bar[XB_TMO], 1u); break; } }
    }
    nloc = mine > 0u ? mine : 1u; nx = cnt > 0u ? cnt : 1u;
}
__device__ __forceinline__ void xcd_barrier(const XcdBarrier& b) {
    asm volatile("s_waitcnt vmcnt(0)" ::: "memory");
    __syncthreads();
    if (threadIdx.x == 0) {
        unsigned* bar = b.bar;
        __builtin_amdgcn_s_waitcnt(0);
        unsigned nloc = b.st[0], nx = b.st[1];
        if (nloc == 0u) { xcd_barrier_complete(bar, b.x, nloc, nx); b.st[0] = nloc; b.st[1] = nx; }
        const unsigned old = xb_add(&bar[XB_XSUB(b.x)], 1u);
        const unsigned gen = old / nloc;
        if (old + 1u == (gen + 1u) * nloc) {
            __builtin_amdgcn_fence(__ATOMIC_RELEASE, "agent");
            asm volatile("s_waitcnt vmcnt(0)" ::: "memory");
            const unsigned og = xb_add(&bar[XB_TOP], 1u);
            const unsigned tg = og / nx;
            if (og + 1u == (tg + 1u) * nx) xb_add(&bar[XB_TOPGEN], 1u);
            else XB_SPIN(xb_ld(&bar[XB_TOPGEN]) == tg, bar);
            __builtin_amdgcn_fence(__ATOMIC_ACQUIRE, "agent");
            xb_add(&bar[XB_XGEN(b.x)], 1u);
            asm volatile("s_waitcnt vmcnt(0)" ::: "memory");
        } else {
            XB_SPIN(xb_ld(&bar[XB_XGEN(b.x)]) == gen, bar);
            __builtin_amdgcn_fence(__ATOMIC_ACQUIRE, "agent");
            asm volatile("s_waitcnt vmcnt(0)" ::: "memory");
        }
    }
    __syncthreads();
}

struct Args { const float* in[28]; float* out; unsigned char* ws; int ph_lo, ph_hi; };
enum { I_X = 0, I_GN1, I_WIN, I_GQ, I_GKC, I_GKS, I_GKW, I_PEK, I_CKW1, I_CKB1, I_CKW2, I_CKB2, I_PEV, I_CVW1, I_CVB1, I_CVW2, I_CVB2, I_CONVW, I_WPA, I_WPB, I_WO, I_GN2, I_WR, I_BR, I_WGU, I_BGU, I_WDN, I_BDN };

struct Frame {
    LAS unsigned char* lds; int tid, lane, wave, G, vcu; unsigned char* ws; const float* in[28]; float* out;
};

__device__ __forceinline__ int colmap(int mode, int n) {
    if (mode == 1) { if (n < 1280) return n; if (n < 4864) return n + 24; if (n < 4888) return n - 4864 + 1280; return -1; }
    if (mode == 2) { const int p = n >> 8, r = n & 255; return r < 128 ? 128 * p + r : 1024 + 128 * p + (r - 128); }
    return n;
}
__device__ __forceinline__ void tr_item(const float* W, int Nsrc, int K, bf16_t* WT, int mode, LAS float* scr, int kb, int nb, int lane) {
    const int k0 = 64 * kb, n0 = 32 * nb; const int col = colmap(mode, n0 + (lane & 31));
#pragma unroll 8
    for (int i = 0; i < 32; ++i) { const int kk = 2 * i + (lane >> 5); scr[kk * 33 + (lane & 31)] = col >= 0 ? W[(size_t)(k0 + kk) * Nsrc + col] : 0.f; }
    LDS_WAIT(); asm volatile("" ::: "memory");
    const int c = lane & 7;
#pragma unroll
    for (int j = 0; j < 4; ++j) { const int n = (lane >> 3) + 8 * j; const LAS float* s = scr + (8 * c) * 33 + n;
        u32x4 o; o.x = pk2(s[0 * 33], s[1 * 33]); o.y = pk2(s[2 * 33], s[3 * 33]); o.z = pk2(s[4 * 33], s[5 * 33]); o.w = pk2(s[6 * 33], s[7 * 33]);
        *(u32x4*)(WT + (size_t)(n0 + n) * K + k0 + 8 * c) = o; }
    LDS_WAIT(); asm volatile("" ::: "memory");
}
__device__ __forceinline__ void p0_prologue(Frame& F) {
    unsigned char* ws = F.ws;
    LAS float* scr = (LAS float*)(F.lds + F.wave * 16384);
    const int gw = F.vcu * 8 + F.wave, NGW = F.G * 8;
    constexpr int I_IN = 16 * 160, I_PA = 8 * 32, I_PO = 16 * 32, I_C1 = 32 * 8, I_GU = 16 * 64, I_DN = 16 * 32;
    constexpr int NTR = I_IN + 2 * I_PA + I_PO + 2 * I_C1 + NEXP * I_GU + NEXP * I_DN;
    for (int it = gw; it < NTR + T; it += NGW) {
        int r = it;
        if (r >= NTR) {
            const int m = r - NTR; const f32x4* xr = (const f32x4*)(F.in[I_X] + (size_t)m * DM) + F.lane; const f32x4* gr = (const f32x4*)F.in[I_GN1] + F.lane;
            f32x4 v[4]; float s = 0.f;
#pragma unroll
            for (int j = 0; j < 4; ++j) { v[j] = xr[64 * j]; s += (v[j].x * v[j].x + v[j].y * v[j].y) + (v[j].z * v[j].z + v[j].w * v[j].w); }
            const float rs = 1.0f / sqrtf(wave_sum(s) * (1.f / DM) + EPS);
            u32x2* o8 = (u32x2*)((bf16_t*)(ws + WS_H1) + (size_t)m * DM) + F.lane;
#pragma unroll
            for (int j = 0; j < 4; ++j) { const f32x4 g = gr[64 * j]; u32x2 o; o.x = pk2(v[j].x * rs * g.x, v[j].y * rs * g.y); o.y = pk2(v[j].z * rs * g.z, v[j].w * rs * g.w); o8[64 * j] = o; }
            continue;
        }
        if (r < I_IN) { tr_item(F.in[I_WIN], IN_COLS, DM, (bf16_t*)(ws + WS_WIN_T), 1, scr, r / 160, r % 160, F.lane); continue; } r -= I_IN;
        if (r < I_PA) { tr_item(F.in[I_WPA], DM, AW, (bf16_t*)(ws + WS_WPA_T), 0, scr, r / 32, r % 32, F.lane); continue; } r -= I_PA;
        if (r < I_PA) { tr_item(F.in[I_WPB], DM, CONVW, (bf16_t*)(ws + WS_WPB_T), 0, scr, r / 32, r % 32, F.lane); continue; } r -= I_PA;
        if (r < I_PO) { tr_item(F.in[I_WO], DM, DM, (bf16_t*)(ws + WS_WO_T), 0, scr, r / 32, r % 32, F.lane); continue; } r -= I_PO;
        if (r < I_C1) { tr_item(F.in[I_CKW1], CMP_HID, 2048, (bf16_t*)(ws + WS_CKW1_T), 0, scr, r / 8, r % 8, F.lane); continue; } r -= I_C1;
        if (r < I_C1) { tr_item(F.in[I_CVW1], CMP_HID, 2048, (bf16_t*)(ws + WS_CVW1_T), 0, scr, r / 8, r % 8, F.lane); continue; } r -= I_C1;
        if (r < NEXP * I_GU) { const int e = r / I_GU, q = r % I_GU; tr_item(F.in[I_WGU] + (size_t)e * DM * 2048, 2048, DM, (bf16_t*)(ws + WS_WGU_T) + (size_t)e * 2048 * DM, 2, scr, q / 64, q % 64, F.lane); continue; } r -= NEXP * I_GU;
        { const int e = r / I_DN, q = r % I_DN; tr_item(F.in[I_WDN] + (size_t)e * DFF * DM, DM, DFF, (bf16_t*)(ws + WS_WDN_T) + (size_t)e * DM * DFF, 0, scr, q / 32, q % 32, F.lane); }
    }
    __syncthreads();
    for (int it = blockIdx.x; it < 8; it += F.G) {
        const int kv = it >> 2, jb = it & 3, j = jb * 64 + F.lane;
        const float* pe = kv ? F.in[I_PEV] : F.in[I_PEK]; const float* w1 = kv ? F.in[I_CVW1] : F.in[I_CKW1];
        float a = 0.f;
#pragma unroll 8
        for (int i = 0; i < 256; ++i) { const int ii = F.wave * 256 + i; a += pe[ii] * w1[(size_t)ii * CMP_HID + j]; }
        LAS float* red = (LAS float*)F.lds;
        red[F.wave * 64 + F.lane] = a; __syncthreads();
        if (F.wave == 0) { float s = (kv ? F.in[I_CVB1] : F.in[I_CKB1])[j];
#pragma unroll
            for (int w = 0; w < 8; ++w) s += red[w * 64 + F.lane];
            ((float*)(ws + WS_B1P))[kv * 256 + j] = s; }
        __syncthreads();
    }
}

__device__ __forceinline__ void p2_elementwise(Frame& F) {
    unsigned char* ws = F.ws; const int lane = F.lane;
    bf16_t* Q = (bf16_t*)(ws + WS_Q); bf16_t* KV6 = (bf16_t*)(ws + WS_KV6); const bf16_t* C3 = (const bf16_t*)(ws + WS_CONV3); bf16_t* YB = (bf16_t*)(ws + WS_YB);
    const int gw = F.vcu * 8 + F.wave, NGW = F.G * 8;
    float gq[8], gk[8], cw[3][8];
    { const float* g = F.in[I_GQ] + (lane & 7) * 8; const float* g2 = (((lane >> 4) & 1) ? F.in[I_GKW] : F.in[I_GKS]) + (lane & 7) * 8;
#pragma unroll
      for (int k = 0; k < 8; ++k) { gq[k] = g[k] * QSCALE; gk[k] = g2[k]; }
#pragma unroll
      for (int j = 0; j < 3; ++j)
#pragma unroll
          for (int k = 0; k < 8; ++k) cw[j][k] = F.in[I_CONVW][j * CONVW + lane * 8 + k]; }
    for (int run = gw; run < T / 32; run += NGW) {
        const int t0 = run * 32;
        float v1[8], v2[8];
        if ((t0 & (SEQ - 1)) == 0) {
#pragma unroll
            for (int k = 0; k < 8; ++k) { v1[k] = 0.f; v2[k] = 0.f; }
        } else {
            const u32x4 c1 = *(const u32x4*)(C3 + (size_t)(t0 - 1) * 1536 + 512 + lane * 8), u1 = *(const u32x4*)(C3 + (size_t)(t0 - 1) * 1536 + 1024 + lane * 8);
            const u32x4 c2 = *(const u32x4*)(C3 + (size_t)(t0 - 2) * 1536 + 512 + lane * 8), u2 = *(const u32x4*)(C3 + (size_t)(t0 - 2) * 1536 + 1024 + lane * 8);
#pragma unroll
            for (int k = 0; k < 4; ++k) { v1[2 * k] = bflo(c1[k]) * bflo(u1[k]); v1[2 * k + 1] = bfhi(c1[k]) * bfhi(u1[k]); v2[2 * k] = bflo(c2[k]) * bflo(u2[k]); v2[2 * k + 1] = bfhi(c2[k]) * bfhi(u2[k]); }
        }
        for (int tt = 0; tt < 32; ++tt) {
            const size_t tok = (size_t)(t0 + tt);
            { u32x4 w = *(const u32x4*)(Q + tok * 512 + lane * 8); float x[8];
#pragma unroll
              for (int k = 0; k < 4; ++k) { x[2 * k] = bflo(w[k]); x[2 * k + 1] = bfhi(w[k]); }
              float s = 0.f;
#pragma unroll
              for (int k = 0; k < 8; ++k) s += x[k] * x[k];
              s += __shfl_xor(s, 1); s += __shfl_xor(s, 2); s += __shfl_xor(s, 4);
              const float rs = 1.0f / sqrtf(s * (1.f / 64.f) + EPS);
              u32x4 o; o.x = pk2(x[0] * rs * gq[0], x[1] * rs * gq[1]); o.y = pk2(x[2] * rs * gq[2], x[3] * rs * gq[3]); o.z = pk2(x[4] * rs * gq[4], x[5] * rs * gq[5]); o.w = pk2(x[6] * rs * gq[6], x[7] * rs * gq[7]);
              *(u32x4*)(Q + tok * 512 + lane * 8) = o; }
            { const int col = 256 + ((lane >> 4) & 1) * 256 + (lane & 15) * 8; u32x4 w = (u32x4){0u, 0u, 0u, 0u};
              if (lane < 32) w = *(const u32x4*)(KV6 + tok * 768 + col);
              float x[8];
#pragma unroll
              for (int k = 0; k < 4; ++k) { x[2 * k] = bflo(w[k]); x[2 * k + 1] = bfhi(w[k]); }
              float s = 0.f;
#pragma unroll
              for (int k = 0; k < 8; ++k) s += x[k] * x[k];
              s += __shfl_xor(s, 1); s += __shfl_xor(s, 2); s += __shfl_xor(s, 4);
              const float rs = 1.0f / sqrtf(s * (1.f / 64.f) + EPS);
              u32x4 o; o.x = pk2(x[0] * rs * gk[0], x[1] * rs * gk[1]); o.y = pk2(x[2] * rs * gk[2], x[3] * rs * gk[3]); o.z = pk2(x[4] * rs * gk[4], x[5] * rs * gk[5]); o.w = pk2(x[6] * rs * gk[6], x[7] * rs * gk[7]);
              if (lane < 32) *(u32x4*)(KV6 + tok * 768 + col) = o; }
            { const u32x4 b = *(const u32x4*)(C3 + tok * 1536 + lane * 8), c = *(const u32x4*)(C3 + tok * 1536 + 512 + lane * 8), u = *(const u32x4*)(C3 + tok * 1536 + 1024 + lane * 8);
              float v0[8], bb[8], y[8];
#pragma unroll
              for (int k = 0; k < 4; ++k) { v0[2 * k] = bflo(c[k]) * bflo(u[k]); v0[2 * k + 1] = bfhi(c[k]) * bfhi(u[k]); bb[2 * k] = bflo(b[k]); bb[2 * k + 1] = bfhi(b[k]); }
#pragma unroll
              for (int k = 0; k < 8; ++k) { y[k] = bb[k] * (cw[0][k] * v2[k] + cw[1][k] * v1[k] + cw[2][k] * v0[k]); v2[k] = v1[k]; v1[k] = v0[k]; }
              u32x4 o; o.x = pk2(y[0], y[1]); o.y = pk2(y[2], y[3]); o.z = pk2(y[4], y[5]); o.w = pk2(y[6], y[7]);
              *(u32x4*)(YB + tok * 512 + lane * 8) = o; }
        }
    }
}

__device__ __forceinline__ void p3_compress2(Frame& F) {
    unsigned char* ws = F.ws; const int lane = F.lane;
    const bf16_t* HID = (const bf16_t*)(ws + WS_HID);
    LAS float* hr = (LAS float*)(F.lds + F.wave * 1024);
    const int gw = F.vcu * 8 + F.wave, NGW = F.G * 8;
    for (int row = gw; row < 16384; row += NGW) {
        const int kv = row >> 13, n = row & 511;
        if (n == 511) continue;
        { const u32x2 w = *(const u32x2*)(HID + (size_t)row * 256 + lane * 4); hr[lane * 4 + 0] = bflo(w.x); hr[lane * 4 + 1] = bfhi(w.x); hr[lane * 4 + 2] = bflo(w.y); hr[lane * 4 + 3] = bfhi(w.y); }
        LDS_WAIT(); asm volatile("" ::: "memory");
        const float* w2 = kv ? F.in[I_CVW2] : F.in[I_CKW2];
        float a = (kv ? F.in[I_CVB2] : F.in[I_CKB2])[lane];
#pragma unroll 8
        for (int k = 0; k < 256; ++k) a += hr[k] * w2[k * 64 + lane];
        if (kv == 0) { const float ss = wave_sum(a * a); a = a * (1.0f / sqrtf(ss * (1.f / 64.f) + EPS)) * F.in[I_GKC][lane]; }
        ((bf16_t*)(ws + (kv ? WS_VC : WS_KC)))[(size_t)(row & 8191) * 64 + lane] = (bf16_t)f2bf(a);
        LDS_WAIT(); asm volatile("" ::: "memory");
    }
}

__device__ __forceinline__ float dot64(const bf16_t* krow, const f32x4 (&q4)[16]) {
    float s = 0.f;
#pragma unroll
    for (int c = 0; c < 8; ++c) { const u32x4 w = *(const u32x4*)(krow + 8 * c);
        s += q4[2 * c].x * bflo(w.x) + q4[2 * c].y * bfhi(w.x) + q4[2 * c].z * bflo(w.y) + q4[2 * c].w * bfhi(w.y)
           + q4[2 * c + 1].x * bflo(w.z) + q4[2 * c + 1].y * bfhi(w.z) + q4[2 * c + 1].z * bflo(w.w) + q4[2 * c + 1].w * bfhi(w.w); }
    return s;
}
__device__ __forceinline__ void p4_attn_naive(Frame& F) {
    unsigned char* ws = F.ws; const int lane = F.lane, h = F.wave, g = h >> 2;
    LAS float* SC = (LAS float*)F.lds + h * 1024;
    LAS float* PC = (LAS float*)F.lds + 8192 + h * 512;
    LAS float* PCg = (LAS float*)F.lds + 8192;
    LAS float* QS = (LAS float*)F.lds + 12288 + h * 64;
    LAS float* SCORE = (LAS float*)F.lds + 12800;
    LAS int* SEL = (LAS int*)((LAS float*)F.lds + 13056);
    bf16_t* Q = (bf16_t*)(ws + WS_Q); const bf16_t* KV6 = (const bf16_t*)(ws + WS_KV6);
    const bf16_t* KC = (const bf16_t*)(ws + WS_KC); const bf16_t* VC = (const bf16_t*)(ws + WS_VC); const bf16_t* NG = (const bf16_t*)(ws + WS_NG);
    const float slope2 = exp2f(-(float)(h + 1)) * LOG2E;
    const float NEGB = -1e30f;
    for (int tok = blockIdx.x; tok < T; tok += F.G) {
        const int b = tok >> 13, t = tok & (SEQ - 1), cur = t >> 6;
        QS[lane] = bf2f(Q[(size_t)tok * 512 + h * 64 + lane]);
        LDS_WAIT(); asm volatile("" ::: "memory");
        f32x4 q4[16];
#pragma unroll
        for (int i = 0; i < 16; ++i) q4[i] = *(const LAS f32x4*)(QS + 4 * i);
        const int nvalid = t >= 31 ? ((t - 31) >> 4) + 1 : 0;
        const bf16_t* kcb = KC + (size_t)((b * 2 + g) * 512) * 64; const bf16_t* vcb = VC + (size_t)((b * 2 + g) * 512) * 64;
        float oc = 0.f;
        {
            float mx = NEGB;
            for (int n = lane; n < nvalid; n += 64) { const float x = dot64(kcb + (size_t)n * 64, q4) - slope2 * (float)(t - (16 * n + 31)); SC[n] = x; mx = fmaxf(mx, x); }
            mx = wave_max(mx);
            float sum = 0.f;
            for (int n = lane; n < nvalid; n += 64) { const float p = exp2f(SC[n] - mx); SC[n] = p; sum += p; }
            sum = wave_sum(sum); const float il = nvalid > 0 ? 1.0f / sum : 0.f;
            for (int n = lane; n < 512; n += 64) PC[n] = n < nvalid ? SC[n] * il : 0.f;
            LDS_WAIT(); asm volatile("" ::: "memory");
            for (int n = 0; n < nvalid; ++n) oc += PC[n] * bf2f(vcb[(size_t)n * 64 + lane]);
        }
        __syncthreads();
        if (F.tid < 256) { const int gg = F.tid >> 7, j = F.tid & 127, a = 4 * j; float s = 0.f;
#pragma unroll
            for (int hh = 0; hh < 4; ++hh) { const LAS float* P = PCg + (gg * 4 + hh) * 512; s += (a > 0 ? P[a - 1] : 0.f) + 2.f * (P[a] + P[a + 1] + P[a + 2]) + P[a + 3]; }
            SCORE[gg * 128 + j] = j > cur ? -1e30f : ((j == 0 || j == cur || j == cur - 1) ? 1e30f : s); }
        __syncthreads();
        if (h < 2) { float a = SCORE[h * 128 + lane], bb = SCORE[h * 128 + 64 + lane];
            for (int r = 0; r < NSEL; ++r) { const float m = wave_max(fmaxf(a, bb));
                const unsigned long long ba = __ballot(a == m); int idx;
                if (ba) { idx = __ffsll((long long)ba) - 1; if (lane == idx) a = -3e38f; }
                else { const unsigned long long b2 = __ballot(bb == m); idx = __ffsll((long long)b2) - 1; if (lane == idx) bb = -3e38f; idx += 64; }
                if (lane == 0) SEL[h * 16 + r] = idx; } }
        __syncthreads();
        float os = 0.f;
        {
            float mx = NEGB;
            for (int r = 0; r < NSEL; ++r) { const int j = SEL[g * 16 + r]; float x = NEGB;
                if (j <= cur) { const int pos = 64 * j + lane; if (pos <= t) x = dot64(KV6 + (size_t)(b * SEQ + pos) * 768 + 256 + g * 64, q4) - slope2 * (float)(t - pos); }
                SC[r * 64 + lane] = x; mx = fmaxf(mx, x); }
            mx = wave_max(mx); float sum = 0.f;
            for (int r = 0; r < NSEL; ++r) { const float p = exp2f(SC[r * 64 + lane] - mx); SC[r * 64 + lane] = p; sum += p; }
            sum = wave_sum(sum); const float il = 1.0f / sum;
            LDS_WAIT(); asm volatile("" ::: "memory");
            for (int r = 0; r < NSEL; ++r) { const int j = SEL[g * 16 + r]; if (j > cur) continue;
                const bf16_t* vb = KV6 + (size_t)(b * SEQ + 64 * j) * 768 + 384 + g * 64 + lane; const int kmax = (64 * j + 63 <= t) ? 64 : (t - 64 * j + 1);
                for (int kk = 0; kk < kmax; ++kk) os += SC[r * 64 + kk] * bf2f(vb[(size_t)kk * 768]); }
            os *= il;
        }
        float ow = 0.f;
        {
            float mx = NEGB;
            for (int i = lane; i < WIN; i += 64) { const int pos = t - (WIN - 1) + i; float x = NEGB;
                if (pos >= 0) x = dot64(KV6 + (size_t)(b * SEQ + pos) * 768 + 512 + g * 64, q4) - slope2 * (float)(t - pos);
                SC[i] = x; mx = fmaxf(mx, x); }
            mx = wave_max(mx); float sum = 0.f;
            for (int i = lane; i < WIN; i += 64) { const float p = exp2f(SC[i] - mx); SC[i] = p; sum += p; }
            sum = wave_sum(sum); const float il = 1.0f / sum;
            LDS_WAIT(); asm volatile("" ::: "memory");
            const int i0 = t >= WIN - 1 ? 0 : (WIN - 1 - t);
            for (int i = i0; i < WIN; ++i) { const int pos = t - (WIN - 1) + i; ow += SC[i] * bf2f(KV6[(size_t)(b * SEQ + pos) * 768 + 640 + g * 64 + lane]); }
            ow *= il;
        }
        const float g0 = bf2f(NG[(size_t)tok * 32 + h * 3 + 0]), g1 = bf2f(NG[(size_t)tok * 32 + h * 3 + 1]), g2 = bf2f(NG[(size_t)tok * 32 + h * 3 + 2]);
        Q[(size_t)tok * 512 + h * 64 + lane] = (bf16_t)f2bf(g0 * oc + g1 * os + g2 * ow);
        __syncthreads();
    }
}

__device__ __forceinline__ void p7_route(Frame& F) {
    unsigned char* ws = F.ws; const int lane = F.lane;
    LAS float* WR = (LAS float*)F.lds;
    LAS int* CNT = (LAS int*)(F.lds + MISC_OFF + 256);
    for (int i = F.tid; i < DM * NEXP; i += 512) WR[i] = F.in[I_WR][(i & 1023) * NEXP + (i >> 10)];
    __syncthreads();
    int* TOPE = (int*)(ws + WS_TOPE); float* TOPW = (float*)(ws + WS_TOPW); int* CNTG = (int*)(ws + WS_CNT);
    bf16_t* H2 = (bf16_t*)(ws + WS_H2);
    const float* X1 = F.out;
    for (int vw = blockIdx.x; vw < 256; vw += F.G) {
        if (F.tid < 32) CNT[F.tid] = 0;
        __syncthreads();
        for (int rr = 0; rr < 32; ++rr) {
            const int tok = vw * 256 + F.wave * 32 + rr;
            const f32x4* xr = (const f32x4*)(X1 + (size_t)tok * DM) + lane; const f32x4* gr = (const f32x4*)F.in[I_GN2] + lane;
            f32x4 v[4]; float s = 0.f;
#pragma unroll
            for (int j = 0; j < 4; ++j) { v[j] = xr[64 * j]; s += (v[j].x * v[j].x + v[j].y * v[j].y) + (v[j].z * v[j].z + v[j].w * v[j].w); }
            const float rs = 1.0f / sqrtf(wave_sum(s) * (1.f / DM) + EPS);
            u32x2* o8 = (u32x2*)(H2 + (size_t)tok * DM) + lane;
#pragma unroll
            for (int j = 0; j < 4; ++j) { const f32x4 gg = gr[64 * j]; v[j].x *= rs * gg.x; v[j].y *= rs * gg.y; v[j].z *= rs * gg.z; v[j].w *= rs * gg.w;
                u32x2 o; o.x = pk2(v[j].x, v[j].y); o.y = pk2(v[j].z, v[j].w); o8[64 * j] = o; }
            float pe[32];
#pragma unroll
            for (int e = 0; e < 32; ++e) { float a = 0.f;
#pragma unroll
                for (int j = 0; j < 4; ++j) { const f32x4 w = *(const LAS f32x4*)(WR + e * 1024 + 4 * lane + 256 * j); a += v[j].x * w.x + v[j].y * w.y + v[j].z * w.z + v[j].w * w.w; }
                pe[e] = a; }
#pragma unroll
            for (int e = 0; e < 16; ++e) { const bool up = (lane & 16) != 0; const float send = up ? pe[e] : pe[e + 16], keep = up ? pe[e + 16] : pe[e]; pe[e] = keep + __shfl_xor(send, 16); }
#pragma unroll
            for (int e = 0; e < 8; ++e) { const bool up = (lane & 8) != 0; const float send = up ? pe[e] : pe[e + 8], keep = up ? pe[e + 8] : pe[e]; pe[e] = keep + __shfl_xor(send, 8); }
#pragma unroll
            for (int e = 0; e < 4; ++e) { const bool up = (lane & 4) != 0; const float send = up ? pe[e] : pe[e + 4], keep = up ? pe[e + 4] : pe[e]; pe[e] = keep + __shfl_xor(send, 4); }
#pragma unroll
            for (int e = 0; e < 2; ++e) { const bool up = (lane & 2) != 0; const float send = up ? pe[e] : pe[e + 2], keep = up ? pe[e + 2] : pe[e]; pe[e] = keep + __shfl_xor(send, 2); }
            { const bool up = (lane & 1) != 0; const float send = up ? pe[0] : pe[1], keep = up ? pe[1] : pe[0]; pe[0] = keep + __shfl_xor(send, 1); }
            float lg = pe[0] + __shfl_xor(pe[0], 32);
            lg += F.in[I_BR][lane & 31];
            float tv[4]; int te[4];
#pragma unroll
            for (int r = 0; r < 4; ++r) { const float m = wave_max(lg); const unsigned long long bm = __ballot(lg == m) & 0xffffffffull; const int idx = __ffsll((long long)bm) - 1;
                tv[r] = m; te[r] = idx; if ((lane & 31) == idx) lg = -3e38f; }
            const float e1 = __expf(tv[1] - tv[0]), e2 = __expf(tv[2] - tv[0]), e3 = __expf(tv[3] - tv[0]); const float inv = 1.0f / (1.0f + e1 + e2 + e3);
            if (lane == 0) { *(int4*)(TOPE + (size_t)tok * 4) = make_int4(te[0], te[1], te[2], te[3]); *(float4*)(TOPW + (size_t)tok * 4) = make_float4(inv, e1 * inv, e2 * inv, e3 * inv); }
            if (lane < 4) { const int e = lane == 0 ? te[0] : lane == 1 ? te[1] : lane == 2 ? te[2] : te[3]; __hip_atomic_fetch_add(&CNT[e], 1, __ATOMIC_RELAXED, __HIP_MEMORY_SCOPE_WORKGROUP); }
        }
        __syncthreads();
        if (F.tid < 32) CNTG[vw * 32 + F.tid] = CNT[F.tid];
        __syncthreads();
    }
}

__device__ __forceinline__ void p8_scatter(Frame& F) {
    unsigned char* ws = F.ws;
    LAS int* CN = (LAS int*)F.lds;
    LAS int* BASE = (LAS int*)(F.lds + 32768);
    LAS int* TS = (LAS int*)(F.lds + 32768 + 256);
    LAS int* TOT = (LAS int*)(F.lds + 32768 + 512);
    LAS int* LE = (LAS int*)(F.lds + 36864);
    LAS int* LS = (LAS int*)(F.lds + 36864 + 4096);
    const int* CNTG = (const int*)(ws + WS_CNT); const int* TOPE = (const int*)(ws + WS_TOPE); const float* TOPW = (const float*)(ws + WS_TOPW);
    int* INV = (int*)(ws + WS_INV);
    for (int vw = blockIdx.x; vw < 256; vw += F.G) {
        const int ch = vw / WPC, wl = vw % WPC;
        unsigned* ROWTOK = (unsigned*)(ws + WS_ROWTOK) + (size_t)ch * SLOTS_CH; float* ROWW = (float*)(ws + WS_ROWW) + (size_t)ch * SLOTS_CH;
        for (int i = F.tid; i < WPC * 32; i += 512) CN[i] = CNTG[ch * WPC * 32 + i];
        for (int i = F.tid; i < 1024; i += 512) LE[i] = TOPE[(size_t)vw * 1024 + i];
        __syncthreads();
        if (F.tid < 32) { int tot = 0, pre = 0; for (int w = 0; w < WPC; ++w) { const int c = CN[w * 32 + F.tid]; if (w < wl) pre += c; tot += c; } TOT[F.tid] = tot; BASE[F.tid] = pre; }
        __syncthreads();
        if (F.tid == 0) { int ts = 0; for (int e = 0; e < 32; ++e) { TS[e] = ts; ts += (TOT[e] + 255) >> 8; } TS[32] = ts; }
        __syncthreads();
        if (F.tid < 32) { const int e = F.tid; int pos = TS[e] * 256 + BASE[e]; for (int i = 0; i < 1024; ++i) if (LE[i] == e) LS[i] = pos++; }
        __syncthreads();
        for (int i = F.tid; i < 1024; i += 512) { const int slot = LS[i]; const int tok = vw * 256 + (i >> 2); ROWTOK[slot] = (unsigned)tok * 2048u; ROWW[slot] = TOPW[(size_t)vw * 1024 + i]; INV[(size_t)vw * 1024 + i] = slot; }
        if (wl < 32) { const int e = wl; const int lo = TS[e] * 256 + TOT[e], hi = TS[e + 1] * 256; for (int s = lo + F.tid; s < hi; s += 512) { ROWTOK[s] = (unsigned)(ch * TCH) * 2048u; ROWW[s] = 0.f; } }
        if (wl == 0 && F.tid < 33) ((int*)(ws + WS_TSTART))[ch * 64 + F.tid] = TS[F.tid];
        __syncthreads();
    }
}

__device__ __forceinline__ void p_combine(Frame& F, int ch) {
    unsigned char* ws = F.ws; const int lane = F.lane;
    const bf16_t* Y = (const bf16_t*)(ws + WS_YBUF); const int* INV = (const int*)(ws + WS_INV);
    const int gw = F.vcu * 8 + F.wave, NGW = F.G * 8;
    for (int i = gw; i < TCH; i += NGW) {
        const int tok = ch * TCH + i; const int4 sl = *(const int4*)(INV + (size_t)tok * 4);
        float* o = F.out + (size_t)tok * DM;
#pragma unroll
        for (int hh = 0; hh < 2; ++hh) { const int col = hh * 512 + lane * 8;
            f32x4 a0 = *(const f32x4*)(o + col), a1 = *(const f32x4*)(o + col + 4);
            const int ss[4] = {sl.x, sl.y, sl.z, sl.w};
#pragma unroll
            for (int k = 0; k < 4; ++k) { const u32x4 w = *(const u32x4*)(Y + (size_t)ss[k] * 1024 + col);
                a0.x += bflo(w.x); a0.y += bfhi(w.x); a0.z += bflo(w.y); a0.w += bfhi(w.y); a1.x += bflo(w.z); a1.y += bfhi(w.z); a1.z += bflo(w.w); a1.w += bfhi(w.w); }
            *(f32x4*)(o + col) = a0; *(f32x4*)(o + col + 4) = a1; }
    }
}

__global__ void __launch_bounds__(512, 2) mk_fwd(Args args) {
    extern __shared__ __attribute__((aligned(16))) unsigned char lds_raw[];
    Frame F;
    F.lds = (LAS unsigned char*)lds_raw;
    F.tid = threadIdx.x; F.lane = F.tid & 63; F.wave = __builtin_amdgcn_readfirstlane(F.tid >> 6);
    F.G = gridDim.x; { const int bx = blockIdx.x; F.vcu = (F.G % 8 == 0) ? (bx % 8) * (F.G / 8) + bx / 8 : bx; }
    F.ws = args.ws; F.out = args.out;
#pragma unroll
    for (int i = 0; i < 28; ++i) F.in[i] = args.in[i];
    unsigned char* ws = args.ws;
    volatile LAS unsigned* MISC = (volatile LAS unsigned*)(F.lds + MISC_OFF);
    for (int u = F.tid; u < 256; u += 512) MISC[u] = 0u;
    __syncthreads();
    XcdBarrier bar; bar.bar = (unsigned*)(ws + WS_CTL) + 1024; bar.x = 0; bar.st = nullptr;
    const int lo = args.ph_lo, hi = args.ph_hi;
    if (hi - lo > 1) bar = xcd_barrier_post((unsigned*)(ws + WS_CTL) + 1024, MISC + 8);
#define IN(k) (lo <= (k) && (k) < hi)
#define SEAM(k) do { if (IN(k) && IN((k) + 1)) xcd_barrier(bar); } while (0)
    LAS unsigned char* ring = F.lds;
    const int cid = (int)blockIdx.x;

    if (IN(0)) { p0_prologue(F); } SEAM(0);

    if (IN(1)) {
        pg8::OrdPlain S{(const char*)(ws + WS_H1), (const char*)(ws + WS_WIN_T), T / 256, NPROJ / 256, F.G, cid, (size_t)256 * DM * 2, (size_t)256 * DM * 2};
        pg8::EpiIn E{(bf16_t*)(ws + WS_Q), (bf16_t*)(ws + WS_KV6), (bf16_t*)(ws + WS_CONV3), (bf16_t*)(ws + WS_MG), (bf16_t*)(ws + WS_NG)};
        pg8::gemm_phase<pg8::EpiIn, pg8::OrdPlain, false>(ring, DM, DM * 2, 128, S, E, nullptr);
    } SEAM(1);

    if (IN(2)) {
        pg8::OrdCmp S{(const char*)(ws + WS_KV6), (const char*)(ws + WS_CKW1_T), (const char*)(ws + WS_CVW1_T), F.G, cid};
        pg8::EpiCmp E{(bf16_t*)(ws + WS_HID), (const float*)(ws + WS_B1P)};
        pg8::gemm_phase<pg8::EpiCmp, pg8::OrdCmp, false>(ring, 2048, 16 * 768 * 2, 768 * 2, S, E, nullptr);
    }
    SEAM(2);
    if (IN(3)) { p2_elementwise(F); p3_compress2(F); } SEAM(3);

    if (IN(4)) { p4_attn_naive(F); } SEAM(4);

    if (IN(5)) {
        { pg8::OrdPlain S{(const char*)(ws + WS_Q), (const char*)(ws + WS_WPA_T), T / 256, DM / 256, F.G, cid, (size_t)256 * AW * 2, (size_t)256 * AW * 2};
          pg8::EpiGate<false> E{(bf16_t*)(ws + WS_Z), (const bf16_t*)(ws + WS_MG), 0};
          pg8::gemm_phase<pg8::EpiGate<false>, pg8::OrdPlain, false>(ring, AW, AW * 2, 128, S, E, nullptr); }
        VM_WAIT(); __syncthreads();
        { pg8::OrdPlain S{(const char*)(ws + WS_YB), (const char*)(ws + WS_WPB_T), T / 256, DM / 256, F.G, cid, (size_t)256 * CONVW * 2, (size_t)256 * CONVW * 2};
          pg8::EpiGate<true> E{(bf16_t*)(ws + WS_Z), (const bf16_t*)(ws + WS_MG), 1024};
          pg8::gemm_phase<pg8::EpiGate<true>, pg8::OrdPlain, false>(ring, CONVW, CONVW * 2, 128, S, E, nullptr); }
    } SEAM(5);

    if (IN(6)) {
        pg8::OrdPlain S{(const char*)(ws + WS_Z), (const char*)(ws + WS_WO_T), T / 256, DM / 256, F.G, cid, (size_t)256 * DM * 2, (size_t)256 * DM * 2};
        pg8::EpiRes E{F.in[I_X], F.out};
        pg8::gemm_phase<pg8::EpiRes, pg8::OrdPlain, false>(ring, DM, DM * 2, 128, S, E, nullptr);
    } SEAM(6);

    if (IN(7)) { p7_route(F); } SEAM(7);
    if (IN(8)) { p8_scatter(F); } SEAM(8);

#pragma unroll
    for (int ch = 0; ch < NCH; ++ch) {
        const int pgu = 9 + 2 * ch, pdn = 10 + 2 * ch;
        if (IN(pgu)) {
            LAS int* TS = (LAS int*)(F.lds + MISC_OFF + 512);
            if (F.tid < 33) TS[F.tid] = ((const int*)(ws + WS_TSTART))[ch * 64 + F.tid];
            __syncthreads();
            const int ntile = TS[32];
            pg8::OrdGrp S{(const char*)(ws + WS_H2), (const char*)(ws + WS_WGU_T), TS, ntile, 8, F.G, cid, (size_t)0, (size_t)256 * DM * 2, (size_t)2048 * DM * 2};
            LAS unsigned* gtab = (LAS unsigned*)(F.lds + GTAB_OFF);
            { const unsigned* ROWTOK = (const unsigned*)(ws + WS_ROWTOK) + (size_t)ch * SLOTS_CH;
              for (int i = 0; i < GTAB_UNITS; ++i) { int pm, pn; if (!pg8::tile_map((long)i * F.G + cid, ntile, 8, pm, pn)) break;
                  if (F.tid < 256) gtab[i * 256 + F.tid] = ROWTOK[pm * 256 + F.tid]; } }
            __syncthreads();
            pg8::EpiGU E{(bf16_t*)(ws + WS_ACT), F.in[I_BGU]};
            pg8::gemm_phase<pg8::EpiGU, pg8::OrdGrp, true>(ring, DM, 0, 128, S, E, gtab);
            if (ch > 0) p_combine(F, ch - 1);
        } SEAM(pgu);
        if (IN(pdn)) {
            LAS int* TS = (LAS int*)(F.lds + MISC_OFF + 512);
            if (F.tid < 33) TS[F.tid] = ((const int*)(ws + WS_TSTART))[ch * 64 + F.tid];
            __syncthreads();
            const int ntile = TS[32];
            pg8::OrdGrp S{(const char*)(ws + WS_ACT), (const char*)(ws + WS_WDN_T), TS, ntile, 4, F.G, cid, (size_t)256 * DFF * 2, (size_t)256 * DFF * 2, (size_t)DM * DFF * 2};
            pg8::EpiDN E{(bf16_t*)(ws + WS_YBUF), F.in[I_BDN], (const float*)(ws + WS_ROWW) + (size_t)ch * SLOTS_CH};
            pg8::gemm_phase<pg8::EpiDN, pg8::OrdGrp, false>(ring, DFF, DFF * 2, 128, S, E, nullptr);
        } SEAM(pdn);
    }
    if (IN(NPH - 1)) { p_combine(F, NCH - 1); }
#undef IN
#undef SEAM
}

extern "C" void kernel_launch(void* const* d_in, const int* in_sizes, int n_in, void* d_out, int out_size, void* d_ws, size_t ws_size, hipStream_t stream) {
    static int grid = 0;
    if (grid == 0) {
        if (n_in != 28 || out_size != T * DM || ws_size < WS_END) { fprintf(stderr, "kernel_launch: unexpected shapes (n_in %d, out %d, ws %zu)\n", n_in, out_size, ws_size); grid = -1; return; }
        int dev = 0, cus = 0;
        if (hipGetDevice(&dev) != hipSuccess || hipDeviceGetAttribute(&cus, hipDeviceAttributeMultiprocessorCount, dev) != hipSuccess) { grid = -1; return; }
        if (hipFuncSetAttribute((const void*)mk_fwd, hipFuncAttributeMaxDynamicSharedMemorySize, LDS_BYTES) != hipSuccess) { fprintf(stderr, "kernel_launch: hipFuncSetAttribute failed\n"); grid = -1; return; }
        int per_cu = 0;
        if (hipOccupancyMaxActiveBlocksPerMultiprocessor(&per_cu, (const void*)mk_fwd, 512, LDS_BYTES) != hipSuccess || per_cu < 1) fprintf(stderr, "kernel_launch: occupancy query says %d\n", per_cu);
        (void)hipGetLastError();
        grid = cus;
    }
    if (grid < 0) return;
    (void)hipMemsetAsync((char*)d_ws + WS_CTL, 0, CTL_ZERO_BYTES, stream);
    Args a{};
    for (int i = 0; i < 28; ++i) a.in[i] = (const float*)d_in[i];
    a.out = (float*)d_out; a.ws = (unsigned char*)d_ws;
#if MK_N_LAUNCHES == 1
    a.ph_lo = 0; a.ph_hi = NPH;
    hipLaunchKernelGGL(mk_fwd, dim3(grid), dim3(512), LDS_BYTES, stream, a);
#else
    for (int p = 0; p < NPH; ++p) { a.ph_lo = p; a.ph_hi = p + 1; hipLaunchKernelGGL(mk_fwd, dim3(grid), dim3(512), LDS_BYTES, stream, a); }
#endif
}
```

```cpp
#include <hip/hip_runtime.h>
#include <cstdio>
#include <cstdint>

#define LAS __attribute__((address_space(3)))
#define GAS __attribute__((address_space(1)))
typedef unsigned short bf16_t;
typedef short bf16x8 __attribute__((ext_vector_type(8)));
typedef float f32x4 __attribute__((ext_vector_type(4)));
typedef float f32x2 __attribute__((ext_vector_type(2)));
typedef unsigned u32x4 __attribute__((ext_vector_type(4)));
typedef unsigned u32x2 __attribute__((ext_vector_type(2)));

#ifndef MK_N_LAUNCHES
#define MK_N_LAUNCHES 1
#endif

constexpr int BATCH = 8, SEQ = 8192, DM = 1024, T = BATCH * SEQ;
constexpr int NH = 8, HD = 64, NGRP = 2, AW = 512;
constexpr int CMP_HID = 256, NBLK = 128, NSEL = 16, WIN = 512;
constexpr int CONVW = 512, NEXP = 32, DFF = 1024;
constexpr int NPROJ = 5120;
constexpr int IN_COLS = 4888;
constexpr float EPS = 1e-6f, LOG2E = 1.4426950408889634f;
constexpr float QSCALE = 0.125f * LOG2E;
constexpr int NCH = 2;
constexpr int TCH = T / NCH;
constexpr int SLOTS_CH = TCH * 4 + NEXP * 256;
constexpr int WPC = 256 / NCH;
constexpr int NPH = 14;

constexpr size_t MiB = 1u << 20;
constexpr size_t WS_CTL = 0, CTL_ZERO_BYTES = 64 * 1024;
constexpr size_t WS_B1P = 1 * MiB;
constexpr size_t WS_TSTART = 1 * MiB + 4096;
constexpr size_t WS_CNT = 1 * MiB + 8192;
constexpr size_t WS_WIN_T = 8 * MiB, WS_WPA_T = 18 * MiB, WS_WPB_T = 19 * MiB, WS_WO_T = 20 * MiB, WS_CKW1_T = 22 * MiB, WS_CVW1_T = 23 * MiB;
constexpr size_t WS_WGU_T = 24 * MiB, WS_WDN_T = 152 * MiB;
constexpr size_t WS_H1 = 216 * MiB, WS_YB = 216 * MiB, WS_Q = 344 * MiB, WS_KV6 = 408 * MiB, WS_CONV3 = 504 * MiB, WS_MG = 696 * MiB;
constexpr size_t WS_NG = 952 * MiB, WS_HID = 956 * MiB, WS_KC = 964 * MiB, WS_VC = 965 * MiB, WS_Z = 408 * MiB;
constexpr size_t WS_H2 = 216 * MiB, WS_ACT = 344 * MiB, WS_YBUF = 616 * MiB, WS_TOPE = 888 * MiB, WS_TOPW = 889 * MiB, WS_INV = 890 * MiB, WS_ROWTOK = 891 * MiB, WS_ROWW = 893 * MiB;
constexpr size_t WS_END = 966 * MiB;
static_assert((size_t)SLOTS_CH * 2048 <= 272 * MiB, "act chunk");
static_assert((size_t)NCH * SLOTS_CH * 4 <= 2 * MiB, "rowtok");

constexpr int RING_BYTES = 131072;
constexpr int GTAB_OFF = RING_BYTES, GTAB_UNITS = 20, GTAB_BYTES = GTAB_UNITS * 1024;
constexpr int MISC_OFF = GTAB_OFF + GTAB_BYTES;
constexpr int LDS_BYTES = MISC_OFF + 1024;
static_assert(LDS_BYTES <= 160 * 1024, "LDS");

__device__ __forceinline__ unsigned f2bf(float f) { unsigned u = __builtin_bit_cast(unsigned, f); return (u + 0x7fffu + ((u >> 16) & 1u)) >> 16; }
__device__ __forceinline__ unsigned pk2(float lo, float hi) { return f2bf(lo) | (f2bf(hi) << 16); }
__device__ __forceinline__ float bflo(unsigned w) { return __builtin_bit_cast(float, w << 16); }
__device__ __forceinline__ float bfhi(unsigned w) { return __builtin_bit_cast(float, w & 0xffff0000u); }
__device__ __forceinline__ float bf2f(bf16_t h) { return __builtin_bit_cast(float, (unsigned)h << 16); }
__device__ __forceinline__ float wave_sum(float v) {
#pragma unroll
    for (int o = 1; o < 64; o <<= 1) v += __shfl_xor(v, o);
    return v;
}
__device__ __forceinline__ float wave_max(float v) {
#pragma unroll
    for (int o = 1; o < 64; o <<= 1) v = fmaxf(v, __shfl_xor(v, o));
    return v;
}
__device__ __forceinline__ float sigmoidf_(float x) { return 1.0f / (1.0f + __expf(-x)); }
#define LDS_WAIT() asm volatile("s_waitcnt lgkmcnt(0)" ::: "memory")
#define VM_WAIT() asm volatile("s_waitcnt vmcnt(0)" ::: "memory")

namespace pg8 {
constexpr int BM = 256, BK = 64, HALF = 128, HTB = HALF * BK * 2, STAGE_BYTES = 8 * HTB, NXCD = 8, WGM = 8;
__host__ __device__ __forceinline__ int lds_byte(int r, int c) { const int st = (r >> 4) * 2 + (c >> 5), rr = r & 15, cc = c & 31, ob = rr * 64 + cc * 2; return st * 1024 + (ob ^ (((ob >> 9) & 1) << 5)); }
__host__ __device__ __forceinline__ void stage_rc(int b, int& R, int& C) { const int st = b / 1024, sb = b % 1024, swz = sb ^ (((sb >> 9) & 1) << 5); R = (st >> 1) * 16 + swz / 64; C = (st & 1) * 32 + (swz % 64) / 2; }
__host__ __device__ __forceinline__ int perm32(int rho) { const int n = rho >> 4, i = rho & 15; return 8 * (i >> 2) + 4 * n + (i & 3); }

struct Unit { const char* a; const char* b; int pm, pn, e; };

__device__ __forceinline__ bool tile_map(long L, int nM, int nN, int& pm, int& pn) {
    const int nwg = nM * nN; if (L >= nwg) return false;
    int wgid = (int)L; { const int q = nwg / NXCD, r = nwg % NXCD, xcd = wgid % NXCD, off = wgid / NXCD; wgid = (xcd < r ? xcd * (q + 1) : r * (q + 1) + (xcd - r) * q) + off; }
    const int nig = WGM * nN, gid = wgid / nig, fm = gid * WGM, gsz = (nM - fm) < WGM ? (nM - fm) : WGM;
    pm = fm + ((wgid % nig) % gsz); pn = (wgid % nig) / gsz; return true;
}

__device__ __forceinline__ unsigned cvt_pk_bf16(float lo, float hi) { unsigned r; asm volatile("v_cvt_pk_bf16_f32 %0, %1, %2" : "=v"(r) : "v"(lo), "v"(hi)); return r; }

template <class Epi, class Sched, bool GATHER>
__device__ __forceinline__ void gemm_phase(LAS unsigned char* lds, const int K, const unsigned a_pitch, const unsigned a_kstep, const Sched& S, const Epi& E, const LAS unsigned* gtab) {
    const int tid = threadIdx.x, wid = __builtin_amdgcn_readfirstlane(tid >> 6), lane = tid & 63, wr = wid >> 2, wc = wid & 3, fr = lane & 15, fq = lane >> 4;
    const int nt = K / BK;
    unsigned voffA[2][2], voffB[2];
#pragma unroll
    for (int i = 0; i < 2; ++i) { int R, C; stage_rc(tid * 16 + i * 8192, R, C); const int Rb = Epi::PERM ? ((R & ~31) + perm32(R & 31)) : R;
        voffB[i] = (unsigned)(Rb * K + C) * 2u; voffA[0][i] = (unsigned)R * a_pitch + (unsigned)C * 2u; voffA[1][i] = voffA[0][i]; }
    const size_t kstepA = a_kstep, kstepB = (size_t)(BK * 2);
    const size_t hstepA = GATHER ? (size_t)0 : (size_t)HALF * a_pitch, hstepB = (size_t)HALF * K * 2;
    const unsigned ldsw = (unsigned)wid * 1024u;
    const int aoff = lds_byte(wr * 64 + fr, fq * 8), boff = lds_byte(wc * 32 + fr, fq * 8);
#define PG8_SA(b, h) (((b) * 2 + (h)) * HTB)
#define PG8_SB(b, h) ((4 + (b) * 2 + (h)) * HTB)
#define PG8_STAGE(bufoff, gbase, voff) do { _Pragma("unroll") for (int _i = 0; _i < 2; ++_i) \
        __builtin_amdgcn_global_load_lds((const unsigned*)((const char*)(gbase) + (voff)[_i]), (LAS unsigned*)(lds + (bufoff) + ldsw + _i * 8192), 16, 0, 0); } while (0)
#define PG8_STA(bufoff, gbase, h) do { if constexpr (GATHER) { PG8_STAGE(bufoff, gbase, voffA[h]); } else { PG8_STAGE(bufoff, (gbase) + (h) * hstepA, voffA[0]); } } while (0)
#define PG8_GLOAD(ui_) do { _Pragma("unroll") for (int _i = 0; _i < 2; ++_i) { int R_, C_; stage_rc(tid * 16 + _i * 8192, R_, C_); \
        voffA[0][_i] = gtab[(ui_) * 256 + R_] + (unsigned)C_ * 2u; voffA[1][_i] = gtab[(ui_) * 256 + 128 + R_] + (unsigned)C_ * 2u; } } while (0)
#define PG8_LDA(dst, b, h) do { _Pragma("unroll") for (int m = 0; m < 4; ++m) _Pragma("unroll") for (int k = 0; k < 2; ++k) dst[m][k] = *(const LAS bf16x8*)(lds + PG8_SA(b, h) + aoff + m * 2048 + k * 1024); } while (0)
#define PG8_LDB(dst, b, h) do { _Pragma("unroll") for (int n = 0; n < 2; ++n) _Pragma("unroll") for (int k = 0; k < 2; ++k) dst[n][k] = *(const LAS bf16x8*)(lds + PG8_SB(b, h) + boff + n * 2048 + k * 1024); } while (0)
#define PG8_MMA(ai, bj, At, Bt) do { __builtin_amdgcn_s_setprio(1); _Pragma("unroll") for (int m = 0; m < 4; ++m) _Pragma("unroll") for (int n = 0; n < 2; ++n) _Pragma("unroll") for (int k = 0; k < 2; ++k) \
        acc[ai][bj][m][n] = __builtin_amdgcn_mfma_f32_16x16x32_bf16(Bt[n][k], At[m][k], acc[ai][bj][m][n], 0, 0, 0); __builtin_amdgcn_s_setprio(0); } while (0)
#define PG8_WAIT_V(n) asm volatile("s_waitcnt vmcnt(" #n ")" ::: "memory")
#define PG8_WAIT_L(n) asm volatile("s_waitcnt lgkmcnt(" #n ")" ::: "memory")
#define PG8_BAR __builtin_amdgcn_s_barrier()
#define PG8_SCHED __builtin_amdgcn_sched_barrier(0)
    Unit cur, nxt; int ui = 0;
    if (!S.next(0, cur)) return;
    f32x4 acc[2][2][4][2];
#pragma unroll
    for (int a = 0; a < 2; ++a)
#pragma unroll
        for (int b = 0; b < 2; ++b)
#pragma unroll
            for (int m = 0; m < 4; ++m)
#pragma unroll
                for (int n = 0; n < 2; ++n) acc[a][b][m][n] = (f32x4){0.f, 0.f, 0.f, 0.f};
    bf16x8 At[4][2], B0[2][2], B1[2][2];
    const char* cA = cur.a; const char* cB = cur.b;
    if constexpr (GATHER) { PG8_GLOAD(0); }
    PG8_STAGE(PG8_SB(0, 0), cB, voffB); PG8_STAGE(PG8_SB(0, 1), cB + hstepB, voffB); PG8_STA(PG8_SA(0, 0), cA, 0); PG8_STA(PG8_SA(0, 1), cA, 1);
    if (wr == 1) PG8_BAR;
    PG8_WAIT_V(2); PG8_BAR;
    PG8_STAGE(PG8_SB(1, 0), cB + kstepB, voffB); PG8_STA(PG8_SA(1, 0), cA + kstepA, 0); PG8_STAGE(PG8_SB(1, 1), cB + hstepB + kstepB, voffB);
    PG8_WAIT_V(6); PG8_BAR;
    for (;;) {
        const bool has_next = S.next(ui + 1, nxt);
        const char* nA = has_next ? nxt.a : cA; const char* nB = has_next ? nxt.b : cB;
        for (int t = 0; t < nt; t += 2) {
            const bool last = (t == nt - 2);
            const char* a1 = cA + (size_t)(t + 1) * kstepA;
            const char* a2 = last ? nA : cA + (size_t)(t + 2) * kstepA; const char* b2 = last ? nB : cB + (size_t)(t + 2) * kstepB;
            const char* a3 = a2 + kstepA; const char* b3 = b2 + kstepB;
            PG8_LDB(B0, 0, 0); PG8_LDB(B1, 0, 1); PG8_SCHED; PG8_LDA(At, 0, 0); PG8_STA(PG8_SA(1, 1), a1, 1);
            if constexpr (GATHER) { if (last && has_next) { PG8_GLOAD(ui + 1); } }
            PG8_WAIT_V(8); PG8_WAIT_L(0); PG8_BAR; PG8_MMA(0, 0, At, B0); PG8_MMA(0, 1, At, B1); PG8_BAR; PG8_SCHED;
            PG8_LDA(At, 0, 1); PG8_STAGE(PG8_SB(0, 0), b2, voffB); PG8_STAGE(PG8_SB(0, 1), b2 + hstepB, voffB); PG8_STA(PG8_SA(0, 0), a2, 0);
            PG8_WAIT_V(8); PG8_WAIT_L(0); PG8_BAR; PG8_MMA(1, 0, At, B0); PG8_MMA(1, 1, At, B1); PG8_BAR; PG8_SCHED;
            PG8_LDB(B0, 1, 0); PG8_LDB(B1, 1, 1); PG8_SCHED; PG8_LDA(At, 1, 0); PG8_STA(PG8_SA(0, 1), a2, 1);
            PG8_WAIT_V(8); PG8_WAIT_L(0); PG8_BAR; PG8_MMA(0, 0, At, B0); PG8_MMA(0, 1, At, B1); PG8_BAR; PG8_SCHED;
            PG8_LDA(At, 1, 1); PG8_STAGE(PG8_SB(1, 0), b3, voffB); PG8_STAGE(PG8_SB(1, 1), b3 + hstepB, voffB); PG8_STA(PG8_SA(1, 0), a3, 0);
            PG8_WAIT_V(8); PG8_WAIT_L(0); PG8_BAR; PG8_MMA(1, 0, At, B0); PG8_MMA(1, 1, At, B1); PG8_BAR; PG8_SCHED;
        }
        if (wr == 0) PG8_BAR;
        E(acc, cur, wr, wc, fr, fq);
        if (!has_next) break;
#pragma unroll
        for (int a = 0; a < 2; ++a)
#pragma unroll
            for (int b = 0; b < 2; ++b)
#pragma unroll
                for (int m = 0; m < 4; ++m)
#pragma unroll
                    for (int n = 0; n < 2; ++n) acc[a][b][m][n] = (f32x4){0.f, 0.f, 0.f, 0.f};
        cur = nxt; cA = nA; cB = nB; ++ui;
        if (wr == 1) PG8_BAR;
    }
    PG8_WAIT_V(0);
    PG8_BAR;
#undef PG8_SA
#undef PG8_SB
#undef PG8_STAGE
#undef PG8_STA
#undef PG8_GLOAD
#undef PG8_LDA
#undef PG8_LDB
#undef PG8_MMA
#undef PG8_WAIT_V
#undef PG8_WAIT_L
#undef PG8_BAR
#undef PG8_SCHED
}

struct OrdPlain {
    const char* A; const char* Bt; int nM, nN, G, c; size_t a_tile, b_tile;
    __device__ __forceinline__ bool next(int i, Unit& u) const { int pm, pn; if (!tile_map((long)i * G + c, nM, nN, pm, pn)) return false;
        u.pm = pm; u.pn = pn; u.e = 0; u.a = A + (size_t)pm * a_tile; u.b = Bt + (size_t)pn * b_tile; return true; }
};
struct OrdCmp {
    const char* KV6; const char* Wk; const char* Wv; int G, c;
    __device__ __forceinline__ bool next(int i, Unit& u) const { const long L = (long)i * G + c; if (L >= 64) return false;
        const int kv = (int)L >> 5, b = ((int)L >> 2) & 7, g = ((int)L >> 1) & 1, nh = (int)L & 1;
        u.pm = (int)L; u.pn = 0; u.e = kv; u.a = KV6 + ((size_t)(b * SEQ + nh * 4096) * 768 + kv * 128 + g * 64) * 2; u.b = kv ? Wv : Wk; return true; }
};
struct OrdGrp {
    const char* A; const char* Bt; const LAS int* tstart; int nM, nN, G, c; size_t a_tile, b_tile, b_grp;
    __device__ __forceinline__ bool next(int i, Unit& u) const { int pm, pn; if (!tile_map((long)i * G + c, nM, nN, pm, pn)) return false;
        int e = 0;
#pragma unroll 1
        for (int k = 1; k < NEXP; ++k) e += (pm >= tstart[k]) ? 1 : 0;
        u.pm = pm; u.pn = pn; u.e = e; u.a = A + (size_t)pm * a_tile; u.b = Bt + (size_t)e * b_grp + (size_t)pn * b_tile; return true; }
};

struct EpiIn {
    static constexpr bool PERM = true;
    bf16_t *Q, *KV6, *CONV3, *MG, *NG;
    __device__ __forceinline__ void operator()(const f32x4 (&acc)[2][2][4][2], const Unit& u, int wr, int wc, int fr, int fq) const {
        const int pn = u.pn; bf16_t* base; int ld, ct; bool sig = false;
        if (pn < 2) { base = Q; ld = 512; ct = pn * 256; } else if (pn < 5) { base = KV6; ld = 768; ct = (pn - 2) * 256; }
        else if (pn < 11) { base = CONV3; ld = 1536; ct = (pn - 5) * 256; } else if (pn < 19) { base = MG; ld = 2048; ct = (pn - 11) * 256; sig = true; }
        else { base = NG; ld = 32; ct = 0; sig = true; }
        const int row0 = u.pm * BM + wr * 64 + fr;
#pragma unroll
        for (int ai = 0; ai < 2; ++ai)
#pragma unroll
            for (int m = 0; m < 4; ++m) { bf16_t* rowp = base + (size_t)(row0 + ai * HALF + m * 16) * ld + ct + wc * 32 + 8 * fq;
#pragma unroll
                for (int bj = 0; bj < 2; ++bj) { if (pn == 19 && (bj != 0 || wc != 0)) continue;
                    f32x4 v0 = acc[ai][bj][m][0], v1 = acc[ai][bj][m][1];
                    if (sig) {
#pragma unroll
                        for (int k = 0; k < 4; ++k) { v0[k] = sigmoidf_(v0[k]); v1[k] = sigmoidf_(v1[k]); } }
                    u32x4 w; w.x = cvt_pk_bf16(v0[0], v0[1]); w.y = cvt_pk_bf16(v0[2], v0[3]); w.z = cvt_pk_bf16(v1[0], v1[1]); w.w = cvt_pk_bf16(v1[2], v1[3]);
                    *(u32x4*)(rowp + bj * HALF) = w; } }
    }
};
__device__ __forceinline__ float gelu_tanh(float x) { const float y = 1.5957691216057308f * (x + 0.044715f * x * x * x); return x / (1.0f + __expf(-y)); }
struct EpiCmp {
    static constexpr bool PERM = true;
    bf16_t* HID; const float* B1P;
    __device__ __forceinline__ void operator()(const f32x4 (&acc)[2][2][4][2], const Unit& u, int wr, int wc, int fr, int fq) const {
        const int row0 = u.pm * BM + wr * 64 + fr; const float* bp = B1P + u.e * 256 + wc * 32 + 8 * fq;
        f32x4 bv[2][2];
#pragma unroll
        for (int bj = 0; bj < 2; ++bj)
#pragma unroll
            for (int n = 0; n < 2; ++n) bv[bj][n] = *(const f32x4*)(bp + bj * HALF + 4 * n);
#pragma unroll
        for (int ai = 0; ai < 2; ++ai)
#pragma unroll
            for (int m = 0; m < 4; ++m) { bf16_t* rowp = HID + (size_t)(row0 + ai * HALF + m * 16) * 256 + wc * 32 + 8 * fq;
#pragma unroll
                for (int bj = 0; bj < 2; ++bj) { f32x4 v0 = acc[ai][bj][m][0] + bv[bj][0], v1 = acc[ai][bj][m][1] + bv[bj][1];
#pragma unroll
                    for (int k = 0; k < 4; ++k) { v0[k] = gelu_tanh(v0[k]); v1[k] = gelu_tanh(v1[k]); }
                    u32x4 w; w.x = cvt_pk_bf16(v0[0], v0[1]); w.y = cvt_pk_bf16(v0[2], v0[3]); w.z = cvt_pk_bf16(v1[0], v1[1]); w.w = cvt_pk_bf16(v1[2], v1[3]);
                    *(u32x4*)(rowp + bj * HALF) = w; } }
    }
};
template <bool ADD> struct EpiGate {
    static constexpr bool PERM = true;
    bf16_t* Z; const bf16_t* MG; int goff;
    __device__ __forceinline__ void operator()(const f32x4 (&acc)[2][2][4][2], const Unit& u, int wr, int wc, int fr, int fq) const {
        const int row0 = u.pm * BM + wr * 64 + fr, col0 = u.pn * BM + wc * 32 + 8 * fq;
#pragma unroll
        for (int ai = 0; ai < 2; ++ai)
#pragma unroll
            for (int m = 0; m < 4; ++m) { const size_t row = (size_t)(row0 + ai * HALF + m * 16);
#pragma unroll
                for (int bj = 0; bj < 2; ++bj) { const int col = col0 + bj * HALF;
                    const u32x4 gw = *(const u32x4*)(MG + row * 2048 + goff + col);
                    f32x4 v0 = acc[ai][bj][m][0], v1 = acc[ai][bj][m][1];
                    v0[0] *= bflo(gw.x); v0[1] *= bfhi(gw.x); v0[2] *= bflo(gw.y); v0[3] *= bfhi(gw.y); v1[0] *= bflo(gw.z); v1[1] *= bfhi(gw.z); v1[2] *= bflo(gw.w); v1[3] *= bfhi(gw.w);
                    if (ADD) { const u32x4 zw = *(const u32x4*)(Z + row * 1024 + col);
                        v0[0] += bflo(zw.x); v0[1] += bfhi(zw.x); v0[2] += bflo(zw.y); v0[3] += bfhi(zw.y); v1[0] += bflo(zw.z); v1[1] += bfhi(zw.z); v1[2] += bflo(zw.w); v1[3] += bfhi(zw.w); }
                    u32x4 w; w.x = cvt_pk_bf16(v0[0], v0[1]); w.y = cvt_pk_bf16(v0[2], v0[3]); w.z = cvt_pk_bf16(v1[0], v1[1]); w.w = cvt_pk_bf16(v1[2], v1[3]);
                    *(u32x4*)(Z + row * 1024 + col) = w; } }
    }
};
struct EpiRes {
    static constexpr bool PERM = false;
    const float* X; float* O;
    __device__ __forceinline__ void operator()(const f32x4 (&acc)[2][2][4][2], const Unit& u, int wr, int wc, int fr, int fq) const {
        const int row0 = u.pm * BM + wr * 64 + fr, col0 = u.pn * BM + wc * 32 + 4 * fq;
#pragma unroll
        for (int ai = 0; ai < 2; ++ai)
#pragma unroll
            for (int m = 0; m < 4; ++m) { const size_t off = (size_t)(row0 + ai * HALF + m * 16) * DM + col0;
#pragma unroll
                for (int bj = 0; bj < 2; ++bj)
#pragma unroll
                    for (int n = 0; n < 2; ++n) { const f32x4 xv = *(const f32x4*)(X + off + bj * HALF + n * 16); *(f32x4*)(O + off + bj * HALF + n * 16) = xv + acc[ai][bj][m][n]; } }
    }
};
struct EpiGU {
    static constexpr bool PERM = true;
    bf16_t* ACT; const float* BGU;
    __device__ __forceinline__ void operator()(const f32x4 (&acc)[2][2][4][2], const Unit& u, int wr, int wc, int fr, int fq) const {
        const int row0 = u.pm * BM + wr * 64 + fr, col0 = u.pn * HALF + wc * 32 + 8 * fq; const float* bp = BGU + (size_t)u.e * 2048 + col0;
        f32x4 bg[2], bu[2];
#pragma unroll
        for (int n = 0; n < 2; ++n) { bg[n] = *(const f32x4*)(bp + 4 * n); bu[n] = *(const f32x4*)(bp + 1024 + 4 * n); }
#pragma unroll
        for (int ai = 0; ai < 2; ++ai)
#pragma unroll
            for (int m = 0; m < 4; ++m) { bf16_t* rowp = ACT + (size_t)(row0 + ai * HALF + m * 16) * 1024 + col0; float o[8];
#pragma unroll
                for (int n = 0; n < 2; ++n)
#pragma unroll
                    for (int k = 0; k < 4; ++k) { float g = fminf(acc[ai][0][m][n][k] + bg[n][k], 7.0f); float uu = fminf(fmaxf(acc[ai][1][m][n][k] + bu[n][k], -7.0f), 7.0f);
                        o[n * 4 + k] = (uu + 1.0f) * (g / (1.0f + __expf(-1.702f * g))); }
                u32x4 w; w.x = cvt_pk_bf16(o[0], o[1]); w.y = cvt_pk_bf16(o[2], o[3]); w.z = cvt_pk_bf16(o[4], o[5]); w.w = cvt_pk_bf16(o[6], o[7]);
                *(u32x4*)rowp = w; }
    }
};
struct EpiDN {
    static constexpr bool PERM = true;
    bf16_t* Y; const float* BDN; const float* ROWW;
    __device__ __forceinline__ void operator()(const f32x4 (&acc)[2][2][4][2], const Unit& u, int wr, int wc, int fr, int fq) const {
        const int row0 = u.pm * BM + wr * 64 + fr, col0 = u.pn * BM + wc * 32 + 8 * fq; const float* bp = BDN + (size_t)u.e * 1024 + col0;
        f32x4 bv[2][2];
#pragma unroll
        for (int bj = 0; bj < 2; ++bj)
#pragma unroll
            for (int n = 0; n < 2; ++n) bv[bj][n] = *(const f32x4*)(bp + bj * HALF + 4 * n);
#pragma unroll
        for (int ai = 0; ai < 2; ++ai)
#pragma unroll
            for (int m = 0; m < 4; ++m) { const int row = row0 + ai * HALF + m * 16; const float rw = ROWW[row]; bf16_t* rowp = Y + (size_t)row * 1024 + col0;
#pragma unroll
                for (int bj = 0; bj < 2; ++bj) { const f32x4 v0 = (acc[ai][bj][m][0] + bv[bj][0]) * rw, v1 = (acc[ai][bj][m][1] + bv[bj][1]) * rw;
                    u32x4 w; w.x = cvt_pk_bf16(v0[0], v0[1]); w.y = cvt_pk_bf16(v0[2], v0[3]); w.z = cvt_pk_bf16(v1[0], v1[1]); w.w = cvt_pk_bf16(v1[2], v1[3]);
                    *(u32x4*)(rowp + bj * HALF) = w; } }
    }
};
}

#define XB_TMO      128
#define XB_XCNT(j)  (256  + 64 * (j))
#define XB_XSUB(j)  (1280 + 64 * (j))
#define XB_XGEN(j)  (2304 + 64 * (j))
#define XB_TOP      3328
#define XB_TOPGEN   3392
#define XCD_BAR_WORDS 3456
#define XB_SPIN_CAP (1u << 18)
__device__ __forceinline__ unsigned xb_ld(unsigned* p)              { return __hip_atomic_load(p, __ATOMIC_RELAXED, __HIP_MEMORY_SCOPE_AGENT); }
__device__ __forceinline__ unsigned xb_add(unsigned* p, unsigned v) { return __hip_atomic_fetch_add(p, v, __ATOMIC_RELAXED, __HIP_MEMORY_SCOPE_AGENT); }
__device__ __forceinline__ unsigned xb_xcc_id() { return (unsigned)__builtin_amdgcn_s_getreg((3 << 11) | 20) & 0xFu; }
#define XB_SPIN(cond, bar) do { unsigned _sp = 0; while (cond) { __builtin_amdgcn_s_sleep(1); \
    if ((++_sp & 255u) == 0u) { if (xb_ld(&(bar)[XB_TMO])) break; if (_sp > XB_SPIN_CAP) { atomicAdd(&(bar)[XB_TMO], 1u); break; } } } } while (0)
struct XcdBarrier { unsigned* bar; unsigned x; volatile LAS unsigned* st; };
__device__ __forceinline__ XcdBarrier xcd_barrier_post(unsigned* bar, volatile LAS unsigned* st) {
    XcdBarrier b; b.bar = bar; b.x = xb_xcc_id(); b.st = st;
    if (threadIdx.x == 0) (void)xb_add(&bar[XB_XCNT(b.x)], 1u);
    return b;
}
__device__ __forceinline__ void xcd_barrier_complete(unsigned* bar, unsigned x, unsigned& nloc, unsigned& nx) {
    const unsigned G = gridDim.x * gridDim.y * gridDim.z;
    unsigned sum, cnt, mine, sp = 0u;
    for (;;) {
        sum = 0u; cnt = 0u; mine = 0u;
#pragma unroll
        for (unsigned j = 0; j < 16; ++j) { const unsigned c = xb_ld(&bar[XB_XCNT(j)]); sum += c; cnt += (c > 0u) ? 1u : 0u; mine = (j == x) ? c : mine; }
        if (sum == G) break;
        __builtin_amdgcn_s_sleep(1);
        if ((++sp & 255u) == 0u) { if (xb_ld(&bar[XB_TMO])) break; if (sp > XB_SPIN_CAP) { atomicAdd(&bar[XB_TMO], 1u); break; } }
    }
    nloc = mine > 0u ? mine : 1u; nx = cnt > 0u ? cnt : 1u;
}
__device__ __forceinline__ void xcd_barrier(const XcdBarrier& b) {
    asm volatile("s_waitcnt vmcnt(0)" ::: "memory");
    __syncthreads();
    if (threadIdx.x == 0) {
        unsigned* bar = b.bar;
        __builtin_amdgcn_s_waitcnt(0);
        unsigned nloc = b.st[0], nx = b.st[1];
        if (nloc == 0u) { xcd_barrier_complete(bar, b.x, nloc, nx); b.st[0] = nloc; b.st[1] = nx; }
        const unsigned old = xb_add(&bar[XB_XSUB(b.x)], 1u);
        const unsigned gen = old / nloc;
        if (old + 1u == (gen + 1u) * nloc) {
            __builtin_amdgcn_fence(__ATOMIC_RELEASE, "agent");
            asm volatile("s_waitcnt vmcnt(0)" ::: "memory");
            const unsigned og = xb_add(&bar[XB_TOP], 1u);
            const unsigned tg = og / nx;
            if (og + 1u == (tg + 1u) * nx) xb_add(&bar[XB_TOPGEN], 1u);
            else XB_SPIN(xb_ld(&bar[XB_TOPGEN]) == tg, bar);
            __builtin_amdgcn_fence(__ATOMIC_ACQUIRE, "agent");
            xb_add(&bar[XB_XGEN(b.x)], 1u);
            asm volatile("s_waitcnt vmcnt(0)" ::: "memory");
        } else {
            XB_SPIN(xb_ld(&bar[XB_XGEN(b.x)]) == gen, bar);
            __builtin_amdgcn_fence(__ATOMIC_ACQUIRE, "agent");
            asm volatile("s_waitcnt vmcnt(0)" ::: "memory");
        }
    }
    __syncthreads();
}

struct Args { const float* in[28]; float* out; unsigned char* ws; int ph_lo, ph_hi; };
enum { I_X = 0, I_GN1, I_WIN, I_GQ, I_GKC, I_GKS, I_GKW, I_PEK, I_CKW1, I_CKB1, I_CKW2, I_CKB2, I_PEV, I_CVW1, I_CVB1, I_CVW2, I_CVB2, I_CONVW, I_WPA, I_WPB, I_WO, I_GN2, I_WR, I_BR, I_WGU, I_BGU, I_WDN, I_BDN };

struct Frame {
    LAS unsigned char* lds; int tid, lane, wave, G, vcu; unsigned char* ws; const float* in[28]; float* out;
};

__device__ __forceinline__ int colmap(int mode, int n) {
    if (mode == 1) { if (n < 1280) return n; if (n < 4864) return n + 24; if (n < 4888) return n - 4864 + 1280; return -1; }
    if (mode == 2) { const int p = n >> 8, r = n & 255; return r < 128 ? 128 * p + r : 1024 + 128 * p + (r - 128); }
    return n;
}
__device__ __forceinline__ void tr_item(const float* W, int Nsrc, int K, bf16_t* WT, int mode, LAS float* scr, int kb, int nb, int lane) {
    const int k0 = 64 * kb, n0 = 32 * nb; const int col = colmap(mode, n0 + (lane & 31));
#pragma unroll 8
    for (int i = 0; i < 32; ++i) { const int kk = 2 * i + (lane >> 5); scr[kk * 33 + (lane & 31)] = col >= 0 ? W[(size_t)(k0 + kk) * Nsrc + col] : 0.f; }
    LDS_WAIT(); asm volatile("" ::: "memory");
    const int c = lane & 7;
#pragma unroll
    for (int j = 0; j < 4; ++j) { const int n = (lane >> 3) + 8 * j; const LAS float* s = scr + (8 * c) * 33 + n;
        u32x4 o; o.x = pk2(s[0 * 33], s[1 * 33]); o.y = pk2(s[2 * 33], s[3 * 33]); o.z = pk2(s[4 * 33], s[5 * 33]); o.w = pk2(s[6 * 33], s[7 * 33]);
        *(u32x4*)(WT + (size_t)(n0 + n) * K + k0 + 8 * c) = o; }
    LDS_WAIT(); asm volatile("" ::: "memory");
}
__device__ __forceinline__ void p0_prologue(Frame& F) {
    unsigned char* ws = F.ws;
    LAS float* scr = (LAS float*)(F.lds + F.wave * 16384);
    const int gw = F.vcu * 8 + F.wave, NGW = F.G * 8;
    constexpr int I_IN = 16 * 160, I_PA = 8 * 32, I_PO = 16 * 32, I_C1 = 32 * 8, I_GU = 16 * 64, I_DN = 16 * 32;
    constexpr int NTR = I_IN + 2 * I_PA + I_PO + 2 * I_C1 + NEXP * I_GU + NEXP * I_DN;
    for (int it = gw; it < NTR + T; it += NGW) {
        int r = it;
        if (r >= NTR) {
            const int m = r - NTR; const f32x4* xr = (const f32x4*)(F.in[I_X] + (size_t)m * DM) + F.lane; const f32x4* gr = (const f32x4*)F.in[I_GN1] + F.lane;
            f32x4 v[4]; float s = 0.f;
#pragma unroll
            for (int j = 0; j < 4; ++j) { v[j] = xr[64 * j]; s += (v[j].x * v[j].x + v[j].y * v[j].y) + (v[j].z * v[j].z + v[j].w * v[j].w); }
            const float rs = 1.0f / sqrtf(wave_sum(s) * (1.f / DM) + EPS);
            u32x2* o8 = (u32x2*)((bf16_t*)(ws + WS_H1) + (size_t)m * DM) + F.lane;
#pragma unroll
            for (int j = 0; j < 4; ++j) { const f32x4 g = gr[64 * j]; u32x2 o; o.x = pk2(v[j].x * rs * g.x, v[j].y * rs * g.y); o.y = pk2(v[j].z * rs * g.z, v[j].w * rs * g.w); o8[64 * j] = o; }
            continue;
        }
        if (r < I_IN) { tr_item(F.in[I_WIN], IN_COLS, DM, (bf16_t*)(ws + WS_WIN_T), 1, scr, r / 160, r % 160, F.lane); continue; } r -= I_IN;
        if (r < I_PA) { tr_item(F.in[I_WPA], DM, AW, (bf16_t*)(ws + WS_WPA_T), 0, scr, r / 32, r % 32, F.lane); continue; } r -= I_PA;
        if (r < I_PA) { tr_item(F.in[I_WPB], DM, CONVW, (bf16_t*)(ws + WS_WPB_T), 0, scr, r / 32, r % 32, F.lane); continue; } r -= I_PA;
        if (r < I_PO) { tr_item(F.in[I_WO], DM, DM, (bf16_t*)(ws + WS_WO_T), 0, scr, r / 32, r % 32, F.lane); continue; } r -= I_PO;
        if (r < I_C1) { tr_item(F.in[I_CKW1], CMP_HID, 2048, (bf16_t*)(ws + WS_CKW1_T), 0, scr, r / 8, r % 8, F.lane); continue; } r -= I_C1;
        if (r < I_C1) { tr_item(F.in[I_CVW1], CMP_HID, 2048, (bf16_t*)(ws + WS_CVW1_T), 0, scr, r / 8, r % 8, F.lane); continue; } r -= I_C1;
        if (r < NEXP * I_GU) { const int e = r / I_GU, q = r % I_GU; tr_item(F.in[I_WGU] + (size_t)e * DM * 2048, 2048, DM, (bf16_t*)(ws + WS_WGU_T) + (size_t)e * 2048 * DM, 2, scr, q / 64, q % 64, F.lane); continue; } r -= NEXP * I_GU;
        { const int e = r / I_DN, q = r % I_DN; tr_item(F.in[I_WDN] + (size_t)e * DFF * DM, DM, DFF, (bf16_t*)(ws + WS_WDN_T) + (size_t)e * DM * DFF, 0, scr, q / 32, q % 32, F.lane); }
    }
    __syncthreads();
    for (int it = blockIdx.x; it < 8; it += F.G) {
        const int kv = it >> 2, jb = it & 3, j = jb * 64 + F.lane;
        const float* pe = kv ? F.in[I_PEV] : F.in[I_PEK]; const float* w1 = kv ? F.in[I_CVW1] : F.in[I_CKW1];
        float a = 0.f;
#pragma unroll 8
        for (int i = 0; i < 256; ++i) { const int ii = F.wave * 256 + i; a += pe[ii] * w1[(size_t)ii * CMP_HID + j]; }
        LAS float* red = (LAS float*)F.lds;
        red[F.wave * 64 + F.lane] = a; __syncthreads();
        if (F.wave == 0) { float s = (kv ? F.in[I_CVB1] : F.in[I_CKB1])[j];
#pragma unroll
            for (int w = 0; w < 8; ++w) s += red[w * 64 + F.lane];
            ((float*)(ws + WS_B1P))[kv * 256 + j] = s; }
        __syncthreads();
    }
}

__device__ __forceinline__ void p2_elementwise(Frame& F) {
    unsigned char* ws = F.ws; const int lane = F.lane;
    bf16_t* Q = (bf16_t*)(ws + WS_Q); bf16_t* KV6 = (bf16_t*)(ws + WS_KV6); const bf16_t* C3 = (const bf16_t*)(ws + WS_CONV3); bf16_t* YB = (bf16_t*)(ws + WS_YB);
    const int gw = F.vcu * 8 + F.wave, NGW = F.G * 8;
    float gq[8], gk[8], cw[3][8];
    { const float* g = F.in[I_GQ] + (lane & 7) * 8; const float* g2 = (((lane >> 4) & 1) ? F.in[I_GKW] : F.in[I_GKS]) + (lane & 7) * 8;
#pragma unroll
      for (int k = 0; k < 8; ++k) { gq[k] = g[k] * QSCALE; gk[k] = g2[k]; }
#pragma unroll
      for (int j = 0; j < 3; ++j)
#pragma unroll
          for (int k = 0; k < 8; ++k) cw[j][k] = F.in[I_CONVW][j * CONVW + lane * 8 + k]; }
    for (int run = gw; run < T / 32; run += NGW) {
        const int t0 = run * 32;
        float v1[8], v2[8];
        if ((t0 & (SEQ - 1)) == 0) {
#pragma unroll
            for (int k = 0; k < 8; ++k) { v1[k] = 0.f; v2[k] = 0.f; }
        } else {
            const u32x4 c1 = *(const u32x4*)(C3 + (size_t)(t0 - 1) * 1536 + 512 + lane * 8), u1 = *(const u32x4*)(C3 + (size_t)(t0 - 1) * 1536 + 1024 + lane * 8);
            const u32x4 c2 = *(const u32x4*)(C3 + (size_t)(t0 - 2) * 1536 + 512 + lane * 8), u2 = *(const u32x4*)(C3 + (size_t)(t0 - 2) * 1536 + 1024 + lane * 8);
#pragma unroll
            for (int k = 0; k < 4; ++k) { v1[2 * k] = bflo(c1[k]) * bflo(u1[k]); v1[2 * k + 1] = bfhi(c1[k]) * bfhi(u1[k]); v2[2 * k] = bflo(c2[k]) * bflo(u2[k]); v2[2 * k + 1] = bfhi(c2[k]) * bfhi(u2[k]); }
        }
        for (int tt = 0; tt < 32; ++tt) {
            const size_t tok = (size_t)(t0 + tt);
            { u32x4 w = *(const u32x4*)(Q + tok * 512 + lane * 8); float x[8];
#pragma unroll
              for (int k = 0; k < 4; ++k) { x[2 * k] = bflo(w[k]); x[2 * k + 1] = bfhi(w[k]); }
              float s = 0.f;
#pragma unroll
              for (int k = 0; k < 8; ++k) s += x[k] * x[k];
              s += __shfl_xor(s, 1); s += __shfl_xor(s, 2); s += __shfl_xor(s, 4);
              const float rs = 1.0f / sqrtf(s * (1.f / 64.f) + EPS);
              u32x4 o; o.x = pk2(x[0] * rs * gq[0], x[1] * rs * gq[1]); o.y = pk2(x[2] * rs * gq[2], x[3] * rs * gq[3]); o.z = pk2(x[4] * rs * gq[4], x[5] * rs * gq[5]); o.w = pk2(x[6] * rs * gq[6], x[7] * rs * gq[7]);
              *(u32x4*)(Q + tok * 512 + lane * 8) = o; }
            { const int col = 256 + ((lane >> 4) & 1) * 256 + (lane & 15) * 8; u32x4 w = (u32x4){0u, 0u, 0u, 0u};
              if (lane < 32) w = *(const u32x4*)(KV6 + tok * 768 + col);
              float x[8];
#pragma unroll
              for (int k = 0; k < 4; ++k) { x[2 * k] = bflo(w[k]); x[2 * k + 1] = bfhi(w[k]); }
              float s = 0.f;
#pragma unroll
              for (int k = 0; k < 8; ++k) s += x[k] * x[k];
              s += __shfl_xor(s, 1); s += __shfl_xor(s, 2); s += __shfl_xor(s, 4);
              const float rs = 1.0f / sqrtf(s * (1.f / 64.f) + EPS);
              u32x4 o; o.x = pk2(x[0] * rs * gk[0], x[1] * rs * gk[1]); o.y = pk2(x[2] * rs * gk[2], x[3] * rs * gk[3]); o.z = pk2(x[4] * rs * gk[4], x[5] * rs * gk[5]); o.w = pk2(x[6] * rs * gk[6], x[7] * rs * gk[7]);
              if (lane < 32) *(u32x4*)(KV6 + tok * 768 + col) = o; }
            { const u32x4 b = *(const u32x4*)(C3 + tok * 1536 + lane * 8), c = *(const u32x4*)(C3 + tok * 1536 + 512 + lane * 8), u = *(const u32x4*)(C3 + tok * 1536 + 1024 + lane * 8);
              float v0[8], bb[8], y[8];
#pragma unroll
              for (int k = 0; k < 4; ++k) { v0[2 * k] = bflo(c[k]) * bflo(u[k]); v0[2 * k + 1] = bfhi(c[k]) * bfhi(u[k]); bb[2 * k] = bflo(b[k]); bb[2 * k + 1] = bfhi(b[k]); }
#pragma unroll
              for (int k = 0; k < 8; ++k) { y[k] = bb[k] * (cw[0][k] * v2[k] + cw[1][k] * v1[k] + cw[2][k] * v0[k]); v2[k] = v1[k]; v1[k] = v0[k]; }
              u32x4 o; o.x = pk2(y[0], y[1]); o.y = pk2(y[2], y[3]); o.z = pk2(y[4], y[5]); o.w = pk2(y[6], y[7]);
              *(u32x4*)(YB + tok * 512 + lane * 8) = o; }
        }
    }
}

__device__ __forceinline__ void p3_compress2(Frame& F) {
    unsigned char* ws = F.ws; const int lane = F.lane;
    const bf16_t* HID = (const bf16_t*)(ws + WS_HID);
    LAS float* hr = (LAS float*)(F.lds + F.wave * 1024);
    const int gw = F.vcu * 8 + F.wave, NGW = F.G * 8;
    for (int row = gw; row < 16384; row += NGW) {
        const int kv = row >> 13, n = row & 511;
        if (n == 511) { ((bf16_t*)(ws + (kv ? WS_VC : WS_KC)))[(size_t)(row & 8191) * 64 + lane] = 0; continue; }
        { const u32x2 w = *(const u32x2*)(HID + (size_t)row * 256 + lane * 4); hr[lane * 4 + 0] = bflo(w.x); hr[lane * 4 + 1] = bfhi(w.x); hr[lane * 4 + 2] = bflo(w.y); hr[lane * 4 + 3] = bfhi(w.y); }
        LDS_WAIT(); asm volatile("" ::: "memory");
        const float* w2 = kv ? F.in[I_CVW2] : F.in[I_CKW2];
        float a = (kv ? F.in[I_CVB2] : F.in[I_CKB2])[lane];
#pragma unroll 8
        for (int k = 0; k < 256; ++k) a += hr[k] * w2[k * 64 + lane];
        if (kv == 0) { const float ss = wave_sum(a * a); a = a * (1.0f / sqrtf(ss * (1.f / 64.f) + EPS)) * F.in[I_GKC][lane]; }
        ((bf16_t*)(ws + (kv ? WS_VC : WS_KC)))[(size_t)(row & 8191) * 64 + lane] = (bf16_t)f2bf(a);
        LDS_WAIT(); asm volatile("" ::: "memory");
    }
}

__device__ __forceinline__ float dot64(const bf16_t* krow, const f32x4 (&q4)[16]) {
    float s = 0.f;
#pragma unroll
    for (int c = 0; c < 8; ++c) { const u32x4 w = *(const u32x4*)(krow + 8 * c);
        s += q4[2 * c].x * bflo(w.x) + q4[2 * c].y * bfhi(w.x) + q4[2 * c].z * bflo(w.y) + q4[2 * c].w * bfhi(w.y)
           + q4[2 * c + 1].x * bflo(w.z) + q4[2 * c + 1].y * bfhi(w.z) + q4[2 * c + 1].z * bflo(w.w) + q4[2 * c + 1].w * bfhi(w.w); }
    return s;
}
__device__ __forceinline__ void p4_attn_naive(Frame& F) {
    unsigned char* ws = F.ws; const int lane = F.lane, h = F.wave, g = h >> 2;
    LAS float* SC = (LAS float*)F.lds + h * 1024;
    LAS float* PC = (LAS float*)F.lds + 8192 + h * 512;
    LAS float* PCg = (LAS float*)F.lds + 8192;
    LAS float* QS = (LAS float*)F.lds + 12288 + h * 64;
    LAS float* SCORE = (LAS float*)F.lds + 12800;
    LAS int* SEL = (LAS int*)((LAS float*)F.lds + 13056);
    bf16_t* Q = (bf16_t*)(ws + WS_Q); const bf16_t* KV6 = (const bf16_t*)(ws + WS_KV6);
    const bf16_t* KC = (const bf16_t*)(ws + WS_KC); const bf16_t* VC = (const bf16_t*)(ws + WS_VC); const bf16_t* NG = (const bf16_t*)(ws + WS_NG);
    const float slope2 = exp2f(-(float)(h + 1)) * LOG2E;
    const float NEGB = -1e30f;
    for (int tok = blockIdx.x; tok < T; tok += F.G) {
        const int b = tok >> 13, t = tok & (SEQ - 1), cur = t >> 6;
        QS[lane] = bf2f(Q[(size_t)tok * 512 + h * 64 + lane]);
        LDS_WAIT(); asm volatile("" ::: "memory");
        f32x4 q4[16];
#pragma unroll
        for (int i = 0; i < 16; ++i) q4[i] = *(const LAS f32x4*)(QS + 4 * i);
        const int nvalid = t >= 31 ? ((t - 31) >> 4) + 1 : 0;
        const bf16_t* kcb = KC + (size_t)((b * 2 + g) * 512) * 64; const bf16_t* vcb = VC + (size_t)((b * 2 + g) * 512) * 64;
        float oc = 0.f;
        {
            float mx = NEGB;
            for (int n = lane; n < nvalid; n += 64) { const float x = dot64(kcb + (size_t)n * 64, q4) - slope2 * (float)(t - (16 * n + 31)); SC[n] = x; mx = fmaxf(mx, x); }
            mx = wave_max(mx);
            float sum = 0.f;
            for (int n = lane; n < nvalid; n += 64) { const float p = exp2f(SC[n] - mx); SC[n] = p; sum += p; }
            sum = wave_sum(sum); const float il = nvalid > 0 ? 1.0f / sum : 0.f;
            for (int n = lane; n < 512; n += 64) PC[n] = n < nvalid ? SC[n] * il : 0.f;
            LDS_WAIT(); asm volatile("" ::: "memory");
            for (int n = 0; n < nvalid; ++n) oc += PC[n] * bf2f(vcb[(size_t)n * 64 + lane]);
        }
        __syncthreads();
        if (F.tid < 256) { const int gg = F.tid >> 7, j = F.tid & 127, a = 4 * j; float s = 0.f;
#pragma unroll
            for (int hh = 0; hh < 4; ++hh) { const LAS float* P = PCg + (gg * 4 + hh) * 512; s += (a > 0 ? P[a - 1] : 0.f) + 2.f * (P[a] + P[a + 1] + P[a + 2]) + P[a + 3]; }
            SCORE[gg * 128 + j] = j > cur ? -1e30f : ((j == 0 || j == cur || j == cur - 1) ? 1e30f : s); }
        __syncthreads();
        if (h < 2) { float a = SCORE[h * 128 + lane], bb = SCORE[h * 128 + 64 + lane];
            for (int r = 0; r < NSEL; ++r) { const float m = wave_max(fmaxf(a, bb));
                const unsigned long long ba = __ballot(a == m); int idx;
                if (ba) { idx = __ffsll((long long)ba) - 1; if (lane == idx) a = -3e38f; }
                else { const unsigned long long b2 = __ballot(bb == m); idx = __ffsll((long long)b2) - 1; if (lane == idx) bb = -3e38f; idx += 64; }
                if (lane == 0) SEL[h * 16 + r] = idx; } }
        __syncthreads();
        float os = 0.f;
        {
            float mx = NEGB;
            for (int r = 0; r < NSEL; ++r) { const int j = SEL[g * 16 + r]; float x = NEGB;
                if (j <= cur) { const int pos = 64 * j + lane; if (pos <= t) x = dot64(KV6 + (size_t)(b * SEQ + pos) * 768 + 256 + g * 64, q4) - slope2 * (float)(t - pos); }
                SC[r * 64 + lane] = x; mx = fmaxf(mx, x); }
            mx = wave_max(mx); float sum = 0.f;
            for (int r = 0; r < NSEL; ++r) { const float p = exp2f(SC[r * 64 + lane] - mx); SC[r * 64 + lane] = p; sum += p; }
            sum = wave_sum(sum); const float il = 1.0f / sum;
            LDS_WAIT(); asm volatile("" ::: "memory");
            for (int r = 0; r < NSEL; ++r) { const int j = SEL[g * 16 + r]; if (j > cur) continue;
                const bf16_t* vb = KV6 + (size_t)(b * SEQ + 64 * j) * 768 + 384 + g * 64 + lane; const int kmax = (64 * j + 63 <= t) ? 64 : (t - 64 * j + 1);
                for (int kk = 0; kk < kmax; ++kk) os += SC[r * 64 + kk] * bf2f(vb[(size_t)kk * 768]); }
            os *= il;
        }
        float ow = 0.f;
        {
            float mx = NEGB;
            for (int i = lane; i < WIN; i += 64) { const int pos = t - (WIN - 1) + i; float x = NEGB;
                if (pos >= 0) x = dot64(KV6 + (size_t)(b * SEQ + pos) * 768 + 512 + g * 64, q4) - slope2 * (float)(t - pos);
                SC[i] = x; mx = fmaxf(mx, x); }
            mx = wave_max(mx); float sum = 0.f;
            for (int i = lane; i < WIN; i += 64) { const float p = exp2f(SC[i] - mx); SC[i] = p; sum += p; }
            sum = wave_sum(sum); const float il = 1.0f / sum;
            LDS_WAIT(); asm volatile("" ::: "memory");
            const int i0 = t >= WIN - 1 ? 0 : (WIN - 1 - t);
            for (int i = i0; i < WIN; ++i) { const int pos = t - (WIN - 1) + i; ow += SC[i] * bf2f(KV6[(size_t)(b * SEQ + pos) * 768 + 640 + g * 64 + lane]); }
            ow *= il;
        }
        const float g0 = bf2f(NG[(size_t)tok * 32 + h * 3 + 0]), g1 = bf2f(NG[(size_t)tok * 32 + h * 3 + 1]), g2 = bf2f(NG[(size_t)tok * 32 + h * 3 + 2]);
        Q[(size_t)tok * 512 + h * 64 + lane] = (bf16_t)f2bf(g0 * oc + g1 * os + g2 * ow);
        __syncthreads();
    }
}

namespace at {
typedef __attribute__((address_space(3))) const char* lcp;
typedef short s16x4 __attribute__((ext_vector_type(4)));
typedef float f32x16 __attribute__((ext_vector_type(16)));
typedef short v4i16_t __attribute__((ext_vector_type(4)));
constexpr int SLOTB = 8192;
constexpr int L_K = 0, L_V = 3 * SLOTB, L_WS = 6 * SLOTB, L_OST = L_WS + 8 * 256, L_IMP = L_OST  , L_SELM = L_OST + 8 * 8192, L_UNION = L_SELM + 1024, L_NTL = L_UNION + 16, L_TL = L_NTL + 16, L_END = L_TL + 512;
static_assert(L_END <= RING_BYTES, "attention LDS");
constexpr float NEGBIG = -1e30f;
__device__ __forceinline__ void glds16(const void* gsrc, unsigned lds_dst) { unsigned keep;
    asm volatile("s_mov_b32 %0, m0\n\ts_mov_b32 m0, %2\n\ts_nop 0\n\tglobal_load_lds_dwordx4 %1, off\n\ts_mov_b32 m0, %0" : "=&s"(keep) : "v"(gsrc), "s"(lds_dst) : "memory"); }
__device__ __forceinline__ unsigned cvtpk(float lo, float hi) { unsigned r; asm("v_cvt_pk_bf16_f32 %0, %1, %2" : "=v"(r) : "v"(lo), "v"(hi)); return r; }
#define AT_WAIT_BAR(N) asm volatile("s_waitcnt vmcnt(" #N ") lgkmcnt(0)\n\ts_barrier" ::: "memory")
#define AT_SBAR() __builtin_amdgcn_sched_barrier(0)

template <int KMUL, int MODE>
__device__ __forceinline__ void qk_tile(f32x16& p0, f32x16& p1, lcp kp, const bf16x8 (&qr)[4], float cinit, float slope2, int klim2) {
    f32x16 c;
#pragma unroll
    for (int r = 0; r < 16; ++r) c[r] = cinit;
#pragma unroll
    for (int d0 = 0; d0 < 4; ++d0) {
        const bf16x8 b0 = *(const LAS bf16x8*)(kp + d0 * 2048), b1 = *(const LAS bf16x8*)(kp + d0 * 2048 + 512);
        if (d0 == 0) { p0 = __builtin_amdgcn_mfma_f32_32x32x16_bf16(b0, qr[0], c, 0, 0, 0); p1 = __builtin_amdgcn_mfma_f32_32x32x16_bf16(b1, qr[0], c, 0, 0, 0); }
        else { p0 = __builtin_amdgcn_mfma_f32_32x32x16_bf16(b0, qr[d0], p0, 0, 0, 0); p1 = __builtin_amdgcn_mfma_f32_32x32x16_bf16(b1, qr[d0], p1, 0, 0, 0); }
    }
#pragma unroll
    for (int r = 0; r < 16; ++r) { const int lit = (r & 3) + 8 * (r >> 2);
        float a = slope2 * (float)(KMUL * lit) + p0[r], b = slope2 * (float)(KMUL * (lit + 32)) + p1[r];
        if (MODE == 1) { a = (lit <= klim2) ? a : NEGBIG; b = (lit + 32 <= klim2) ? b : NEGBIG; }
        if (MODE == 2) { a = (lit > klim2) ? a : NEGBIG; b = (lit + 32 > klim2) ? b : NEGBIG; }
        p0[r] = __builtin_amdgcn_exp2f(a); p1[r] = __builtin_amdgcn_exp2f(b); }
}
__device__ __forceinline__ float psum(const f32x16& p0, const f32x16& p1) {
    float a = 0.f, b = 0.f;
#pragma unroll
    for (int r = 0; r < 16; r += 2) { a += p0[r] + p1[r]; b += p0[r + 1] + p1[r + 1]; }
    return a + b;
}
__device__ __forceinline__ void pv_tile(f32x16* o, int vb, const f32x16& p0, const f32x16& p1) {
    u32x4 pw[4];
#pragma unroll
    for (int i = 0; i < 4; ++i) { pw[0][i] = cvtpk(p0[2 * i], p0[2 * i + 1]); pw[1][i] = cvtpk(p0[8 + 2 * i], p0[9 + 2 * i]); pw[2][i] = cvtpk(p1[2 * i], p1[2 * i + 1]); pw[3][i] = cvtpk(p1[8 + 2 * i], p1[9 + 2 * i]); }
#pragma unroll
    for (int dh = 0; dh < 2; ++dh) { s16x4 lo[4], hi[4];
#pragma unroll
        for (int ks = 0; ks < 4; ++ks) {
            asm volatile("ds_read_b64_tr_b16 %0,%1 offset:%c2" : "=&v"(lo[ks]) : "v"(vb), "i"(dh * 4096 + ks * 1024) : "memory");
            asm volatile("ds_read_b64_tr_b16 %0,%1 offset:%c2" : "=&v"(hi[ks]) : "v"(vb), "i"(dh * 4096 + ks * 1024 + 512) : "memory"); }
        asm volatile("s_waitcnt lgkmcnt(0)" ::: "memory"); AT_SBAR();
#define AT_PK(k) (bf16x8){lo[k][0], lo[k][1], lo[k][2], lo[k][3], hi[k][0], hi[k][1], hi[k][2], hi[k][3]}
        o[dh] = __builtin_amdgcn_mfma_f32_32x32x16_bf16(__builtin_bit_cast(bf16x8, pw[0]), AT_PK(0), o[dh], 0, 0, 0);
        o[dh] = __builtin_amdgcn_mfma_f32_32x32x16_bf16(__builtin_bit_cast(bf16x8, pw[1]), AT_PK(1), o[dh], 0, 0, 0);
        o[dh] = __builtin_amdgcn_mfma_f32_32x32x16_bf16(__builtin_bit_cast(bf16x8, pw[2]), AT_PK(2), o[dh], 0, 0, 0);
        o[dh] = __builtin_amdgcn_mfma_f32_32x32x16_bf16(__builtin_bit_cast(bf16x8, pw[3]), AT_PK(3), o[dh], 0, 0, 0);
#undef AT_PK
    }
}
}

__device__ __forceinline__ void p4_attn(Frame& F) {
    using namespace at;
    unsigned char* ws = F.ws; const int wid = F.wave;
    LAS unsigned char* lds = F.lds;
    const unsigned lds0 = (unsigned)(uintptr_t)lds;
    bf16_t* Q = (bf16_t*)(ws + WS_Q); const bf16_t* KV6 = (const bf16_t*)(ws + WS_KV6);
    const bf16_t* KC = (const bf16_t*)(ws + WS_KC); const bf16_t* VC = (const bf16_t*)(ws + WS_VC); const bf16_t* NG = (const bf16_t*)(ws + WS_NG);
    LAS unsigned* selm = (LAS unsigned*)(lds + L_SELM);
    LAS unsigned* uni = (LAS unsigned*)(lds + L_UNION);
    LAS int* ntl = (LAS int*)(lds + L_NTL);
    LAS int* tl = (LAS int*)(lds + L_TL);
    float MREF;
    { float gqm = fabsf(F.in[I_GQ][F.lane]), gkm = fmaxf(fmaxf(fabsf(F.in[I_GKC][F.lane]), fabsf(F.in[I_GKS][F.lane])), fabsf(F.in[I_GKW][F.lane]));
      gqm = wave_max(gqm); gkm = wave_max(gkm); MREF = 64.0f * QSCALE * gqm * gkm * 1.03f; }
    const unsigned kdst = lds0 + L_K + wid * 1024, vdst = lds0 + L_V + wid * 1024;
    for (int ui = 0; ui < 8; ++ui) {
        if (F.G != 256) break;
        int lane = F.lane; asm volatile("" : "+v"(lane));
        const int r32 = lane & 31, hi = lane >> 5, hh = r32 >> 3, qi = r32 & 7;
        LAS float* wsf = (LAS float*)(lds + L_WS) + wid * 64;
        LAS float* impw = (LAS float*)(lds + L_IMP) + wid * 2048;
        LAS float* ostg = (LAS float*)(lds + L_OST) + wid * 2048;
        const lcp kp0 = (lcp)lds + L_K + hi * 1024 + r32 * 16;
        const int vb0 = (int)(lds0 + L_V) + ((lane >> 4) & 1) * 32 + (lane & 3) * 8 + (4 * hi + ((lane & 15) >> 2)) * 64;
        const int bg = F.vcu >> 4, s16 = F.vcu & 15;
        const int qt = (ui >> 1) * 32 + ((ui & 1) ? 31 - s16 : s16);
        const int b = bg >> 1, g = bg & 1, q0 = qt * 64, cur = qt;
        const int tq = q0 + 8 * wid + qi, qoff = 8 * wid + qi;
        const int h = 4 * g + hh;
        const float slope2 = exp2f(-(float)(h + 1)) * LOG2E;
        const size_t tok = (size_t)b * SEQ + tq;
        bf16x8 qr[4];
#pragma unroll
        for (int d0 = 0; d0 < 4; ++d0) qr[d0] = *(const bf16x8*)(Q + tok * 512 + h * 64 + d0 * 16 + hi * 8);
        const float g0 = bf2f(NG[tok * 32 + h * 3 + 0]), g1 = bf2f(NG[tok * 32 + h * 3 + 1]), g2 = bf2f(NG[tok * 32 + h * 3 + 2]);
        f32x16 o[2], p0, p1;
#pragma unroll
        for (int i = 0; i < 4; ++i) *(LAS f32x4*)(impw + (i * 64 + lane) * 4) = (f32x4){0.f, 0.f, 0.f, 0.f};
        if (F.tid < 4) uni[F.tid] = 0u;
        const bf16_t* kcb = KC + (size_t)(b * 2 + g) * 512 * 64; const bf16_t* vcb = VC + (size_t)(b * 2 + g) * 512 * 64;
        const int ntc = (4 * cur + 3 + 63) >> 6;
        const int nmax = tq >= 31 ? ((tq - 31) >> 4) : -1;
        const int nfull = cur >= 1 ? (4 * cur - 2) : -1;
        float lsum = 0.f;
#define AT_KSRC_C(t) (kcb + (size_t)(64 * (t) + lane) * 64 + wid * 8)
#define AT_VSRC_C(t) (vcb + (size_t)(64 * (t) + 16 * (wid & 3) + (lane >> 2)) * 64 + (wid >> 2) * 32 + (lane & 3) * 8)
        if (ntc > 0) {
            glds16(AT_KSRC_C(0), kdst); if (ntc > 1) glds16(AT_KSRC_C(1), kdst + SLOTB);
            for (int t = 0; t < ntc; ++t) {
                if (t + 1 < ntc) { AT_WAIT_BAR(1); } else { AT_WAIT_BAR(0); }
                if (t + 2 < ntc) glds16(AT_KSRC_C(t + 2), kdst + ((t + 2) % 3) * SLOTB);
                const float cinit = -slope2 * (float)(tq - 31 - 1024 * t) + slope2 * (float)(64 * hi) - MREF;
                const int klim2 = nmax - 64 * t - 4 * hi;
                if (64 * t + 63 <= nfull) qk_tile<16, 0>(p0, p1, kp0 + (t % 3) * SLOTB, qr, cinit, slope2, 0);
                else qk_tile<16, 1>(p0, p1, kp0 + (t % 3) * SLOTB, qr, cinit, slope2, klim2);
                lsum += psum(p0, p1);
            }
            AT_WAIT_BAR(0);
        }
        lsum += __shfl_xor(lsum, 32);
        const float lg2l = lsum > 0.f ? __builtin_amdgcn_logf(lsum) : 0.f;
        o[0] = f32x16{}; o[1] = f32x16{};
        if (ntc > 0) {
            float cin = 0.f;
            glds16(AT_KSRC_C(0), kdst); glds16(AT_VSRC_C(0), vdst); if (ntc > 1) { glds16(AT_KSRC_C(1), kdst + SLOTB); glds16(AT_VSRC_C(1), vdst + SLOTB); }
            for (int t = 0; t < ntc; ++t) {
                if (t + 1 < ntc) { AT_WAIT_BAR(2); } else { AT_WAIT_BAR(0); }
                if (t + 2 < ntc) { glds16(AT_KSRC_C(t + 2), kdst + ((t + 2) % 3) * SLOTB); glds16(AT_VSRC_C(t + 2), vdst + ((t + 2) % 3) * SLOTB); }
                const float cinit = -slope2 * (float)(tq - 31 - 1024 * t) + slope2 * (float)(64 * hi) - MREF - lg2l;
                const int klim2 = nmax - 64 * t - 4 * hi;
                if (64 * t + 63 <= nfull) qk_tile<16, 0>(p0, p1, kp0 + (t % 3) * SLOTB, qr, cinit, slope2, 0);
                else qk_tile<16, 1>(p0, p1, kp0 + (t % 3) * SLOTB, qr, cinit, slope2, klim2);
                float mn[8], cy[8];
#pragma unroll
                for (int a = 0; a < 4; ++a) { mn[a] = 2.f * (p0[4 * a] + p0[4 * a + 1] + p0[4 * a + 2]) + p0[4 * a + 3]; cy[a] = p0[4 * a + 3];
                                              mn[4 + a] = 2.f * (p1[4 * a] + p1[4 * a + 1] + p1[4 * a + 2]) + p1[4 * a + 3]; cy[4 + a] = p1[4 * a + 3]; }
                float rc[8];
#pragma unroll
                for (int a = 0; a < 8; ++a) rc[a] = __shfl_xor(cy[a], 32);
                if (hi) {
#pragma unroll
                    for (int a = 0; a < 8; ++a) mn[a] += rc[a];
                } else { mn[0] += cin;
#pragma unroll
                    for (int a = 1; a < 8; ++a) mn[a] += rc[a - 1];
                    cin = rc[7]; }
#pragma unroll
                for (int a = 0; a < 8; ++a) { mn[a] += __shfl_xor(mn[a], 8); mn[a] += __shfl_xor(mn[a], 16); }
                if (hh == 0) {
#pragma unroll
                    for (int a = 0; a < 8; ++a) impw[qi * 128 + 16 * t + 2 * a + hi] = mn[a]; }
                pv_tile(o, vb0 + (t % 3) * SLOTB, p0, p1);
            }
            AT_WAIT_BAR(0);
        }
        {
            const int qi8 = lane >> 3, s8 = lane & 7;
            unsigned key[16];
#pragma unroll
            for (int k = 0; k < 16; ++k) { const int j = s8 + 8 * k; const float v = impw[qi8 * 128 + j];
                const bool forced = (j == 0) || (j == cur) || (j == cur - 1);
                key[k] = j > cur ? 0u : ((forced ? 0xFFFFFF80u : (__builtin_bit_cast(unsigned, v) & 0xFFFFFF80u)) | (unsigned)(127 - j)); }
            unsigned bits = 0u;
            for (int rnd = 0; rnd < NSEL; ++rnd) {
                unsigned m = key[0];
#pragma unroll
                for (int k = 1; k < 16; ++k) m = m > key[k] ? m : key[k];
                { unsigned t2 = (unsigned)__shfl_xor((int)m, 1); m = m > t2 ? m : t2; t2 = (unsigned)__shfl_xor((int)m, 2); m = m > t2 ? m : t2; t2 = (unsigned)__shfl_xor((int)m, 4); m = m > t2 ? m : t2; }
#pragma unroll
                for (int k = 0; k < 16; ++k) { const bool hit = (key[k] == m) && (m != 0u); bits |= hit ? (1u << k) : 0u; key[k] = hit ? 0u : key[k]; }
            }
            unsigned w4[4];
#pragma unroll
            for (int q = 0; q < 4; ++q) { unsigned w = 0u;
#pragma unroll
                for (int kk = 0; kk < 4; ++kk) w |= ((bits >> (4 * q + kk)) & 1u) << (s8 + 8 * kk);
                w |= (unsigned)__shfl_xor((int)w, 1); w |= (unsigned)__shfl_xor((int)w, 2); w |= (unsigned)__shfl_xor((int)w, 4); w4[q] = w; }
            if (s8 == 0) {
#pragma unroll
                for (int q = 0; q < 4; ++q) { selm[(8 * wid + qi8) * 4 + q] = w4[q]; __hip_atomic_fetch_or(&uni[q], w4[q], __ATOMIC_RELAXED, __HIP_MEMORY_SCOPE_WORKGROUP); } }
        }
        { if (hi == 0) wsf[r32] = g0; LDS_WAIT(); asm volatile("" ::: "memory");
#pragma unroll
          for (int a = 0; a < 4; ++a) { const f32x4 sc = *(const LAS f32x4*)(wsf + 8 * a + 4 * hi);
#pragma unroll
              for (int k = 0; k < 4; ++k) { const int c = 8 * a + 4 * hi + k; ostg[c * 64 + r32] = o[0][4 * a + k] * sc[k]; ostg[c * 64 + 32 + r32] = o[1][4 * a + k] * sc[k]; } }
          LDS_WAIT(); asm volatile("" ::: "memory"); }
        AT_WAIT_BAR(0);
        if (F.tid < 128) { const int j = F.tid; const unsigned u0 = uni[0], u1 = uni[1], u2 = uni[2], u3 = uni[3];
            const unsigned wsel = j < 32 ? u0 : j < 64 ? u1 : j < 96 ? u2 : u3;
            if ((wsel >> (j & 31)) & 1u) { int pos = __builtin_popcount(wsel & ((1u << (j & 31)) - 1u));
                if (j >= 32) pos += __builtin_popcount(u0); if (j >= 64) pos += __builtin_popcount(u1); if (j >= 96) pos += __builtin_popcount(u2);
                tl[pos] = j; }
            if (j == 0) ntl[0] = __builtin_popcount(u0) + __builtin_popcount(u1) + __builtin_popcount(u2) + __builtin_popcount(u3); }
        AT_WAIT_BAR(0);
        {
            const int nt = __builtin_amdgcn_readfirstlane(ntl[0]);
            const bf16_t* ksb = KV6 + (size_t)b * SEQ * 768 + 256 + g * 64; const bf16_t* vsb = KV6 + (size_t)b * SEQ * 768 + 384 + g * 64;
#define AT_KSRC_S(j) (ksb + (size_t)(64 * (j) + lane) * 768 + wid * 8)
#define AT_VSRC_S(j) (vsb + (size_t)(64 * (j) + 16 * (wid & 3) + (lane >> 2)) * 768 + (wid >> 2) * 32 + (lane & 3) * 8)
#define AT_TL(i) __builtin_amdgcn_readfirstlane(tl[i])
            o[0] = f32x16{}; o[1] = f32x16{}; lsum = 0.f;
            const unsigned m0 = selm[(8 * wid + qi) * 4 + 0], m1 = selm[(8 * wid + qi) * 4 + 1], m2 = selm[(8 * wid + qi) * 4 + 2], m3 = selm[(8 * wid + qi) * 4 + 3];
            if (nt > 0) {
                { const int j0 = AT_TL(0); glds16(AT_KSRC_S(j0), kdst); glds16(AT_VSRC_S(j0), vdst); }
                if (nt > 1) { const int j1 = AT_TL(1); glds16(AT_KSRC_S(j1), kdst + SLOTB); glds16(AT_VSRC_S(j1), vdst + SLOTB); }
                for (int t = 0; t < nt; ++t) {
                    if (t + 1 < nt) { AT_WAIT_BAR(2); } else { AT_WAIT_BAR(0); }
                    if (t + 2 < nt) { const int j2 = AT_TL(t + 2); glds16(AT_KSRC_S(j2), kdst + ((t + 2) % 3) * SLOTB); glds16(AT_VSRC_S(j2), vdst + ((t + 2) % 3) * SLOTB); }
                    const int j = AT_TL(t);
                    const unsigned mw = j < 32 ? m0 : j < 64 ? m1 : j < 96 ? m2 : m3;
                    const bool mine = (mw >> (j & 31)) & 1u;
                    if (__any(mine)) {
                        const float cinit = mine ? (-slope2 * (float)(tq - 64 * j) + slope2 * (float)(4 * hi) - MREF) : NEGBIG;
                        if (j == cur) qk_tile<1, 1>(p0, p1, kp0 + (t % 3) * SLOTB, qr, cinit, slope2, qoff - 4 * hi);
                        else qk_tile<1, 0>(p0, p1, kp0 + (t % 3) * SLOTB, qr, cinit, slope2, 0);
                        lsum += psum(p0, p1);
                        pv_tile(o, vb0 + (t % 3) * SLOTB, p0, p1);
                    }
                }
                AT_WAIT_BAR(0);
            }
            lsum += __shfl_xor(lsum, 32);
            if (hi == 0) wsf[r32] = g1 / lsum; LDS_WAIT(); asm volatile("" ::: "memory");
#pragma unroll
            for (int a = 0; a < 4; ++a) { const f32x4 sc = *(const LAS f32x4*)(wsf + 8 * a + 4 * hi);
#pragma unroll
                for (int k = 0; k < 4; ++k) { const int c = 8 * a + 4 * hi + k; ostg[c * 64 + r32] += o[0][4 * a + k] * sc[k]; ostg[c * 64 + 32 + r32] += o[1][4 * a + k] * sc[k]; } }
            LDS_WAIT(); asm volatile("" ::: "memory");
        }
        {
            const bf16_t* kwb = KV6 + (size_t)b * SEQ * 768 + 512 + g * 64; const bf16_t* vwb = KV6 + (size_t)b * SEQ * 768 + 640 + g * 64;
#define AT_KSRC_W(p) (kwb + (size_t)((p) + lane) * 768 + wid * 8)
#define AT_VSRC_W(p) (vwb + (size_t)((p) + 16 * (wid & 3) + (lane >> 2)) * 768 + (wid >> 2) * 32 + (lane & 3) * 8)
            const int wi0 = cur >= 8 ? 0 : 8 - cur; const int nt = 9 - wi0; const int pbase = q0 - 512 + 64 * wi0;
            o[0] = f32x16{}; o[1] = f32x16{}; lsum = 0.f;
            glds16(AT_KSRC_W(pbase), kdst); glds16(AT_VSRC_W(pbase), vdst);
            if (nt > 1) { glds16(AT_KSRC_W(pbase + 64), kdst + SLOTB); glds16(AT_VSRC_W(pbase + 64), vdst + SLOTB); }
            for (int t = 0; t < nt; ++t) {
                if (t + 1 < nt) { AT_WAIT_BAR(2); } else { AT_WAIT_BAR(0); }
                if (t + 2 < nt) { glds16(AT_KSRC_W(pbase + 64 * (t + 2)), kdst + ((t + 2) % 3) * SLOTB); glds16(AT_VSRC_W(pbase + 64 * (t + 2)), vdst + ((t + 2) % 3) * SLOTB); }
                const int pos0 = pbase + 64 * t, wi = wi0 + t;
                const float cinit = -slope2 * (float)(tq - pos0) + slope2 * (float)(4 * hi) - MREF;
                if (wi == 8) qk_tile<1, 1>(p0, p1, kp0 + (t % 3) * SLOTB, qr, cinit, slope2, qoff - 4 * hi);
                else if (wi == 0) qk_tile<1, 2>(p0, p1, kp0 + (t % 3) * SLOTB, qr, cinit, slope2, qoff - 4 * hi);
                else qk_tile<1, 0>(p0, p1, kp0 + (t % 3) * SLOTB, qr, cinit, slope2, 0);
                lsum += psum(p0, p1);
                pv_tile(o, vb0 + (t % 3) * SLOTB, p0, p1);
            }
            AT_WAIT_BAR(0);
            lsum += __shfl_xor(lsum, 32);
            if (hi == 0) wsf[r32] = g2 / lsum; LDS_WAIT(); asm volatile("" ::: "memory");
#pragma unroll
            for (int a = 0; a < 4; ++a) { const f32x4 sc = *(const LAS f32x4*)(wsf + 8 * a + 4 * hi);
#pragma unroll
                for (int k = 0; k < 4; ++k) { const int c = 8 * a + 4 * hi + k; ostg[c * 64 + r32] += o[0][4 * a + k] * sc[k]; ostg[c * 64 + 32 + r32] += o[1][4 * a + k] * sc[k]; } }
            LDS_WAIT(); asm volatile("" ::: "memory");
        }
        {
#pragma unroll
          for (int i = 0; i < 4; ++i) { const int row = i * 8 + (lane >> 3), ch = lane & 7; const f32x4 a = *(const LAS f32x4*)(ostg + row * 64 + ch * 8), c2 = *(const LAS f32x4*)(ostg + row * 64 + ch * 8 + 4);
              u32x4 v; v.x = pk2(a.x, a.y); v.y = pk2(a.z, a.w); v.z = pk2(c2.x, c2.y); v.w = pk2(c2.z, c2.w);
              *(u32x4*)(Q + ((size_t)b * SEQ + q0 + 8 * wid + (row & 7)) * 512 + (4 * g + (row >> 3)) * 64 + ch * 8) = v; }
          LDS_WAIT(); asm volatile("" ::: "memory"); }
    }
#undef AT_KSRC_C
#undef AT_VSRC_C
#undef AT_KSRC_S
#undef AT_VSRC_S
#undef AT_KSRC_W
#undef AT_VSRC_W
#undef AT_TL
}

__device__ __forceinline__ void p7_route(Frame& F) {
    unsigned char* ws = F.ws; const int lane = F.lane;
    LAS float* WR = (LAS float*)F.lds;
    LAS int* CNT = (LAS int*)(F.lds + MISC_OFF + 256);
    for (int i = F.tid; i < DM * NEXP; i += 512) WR[i] = F.in[I_WR][(i & 1023) * NEXP + (i >> 10)];
    __syncthreads();
    int* TOPE = (int*)(ws + WS_TOPE); float* TOPW = (float*)(ws + WS_TOPW); int* CNTG = (int*)(ws + WS_CNT);
    bf16_t* H2 = (bf16_t*)(ws + WS_H2);
    const float* X1 = F.out;
    for (int vw = blockIdx.x; vw < 256; vw += F.G) {
        if (F.tid < 32) CNT[F.tid] = 0;
        __syncthreads();
        for (int rr = 0; rr < 32; ++rr) {
            const int tok = vw * 256 + F.wave * 32 + rr;
            const f32x4* xr = (const f32x4*)(X1 + (size_t)tok * DM) + lane; const f32x4* gr = (const f32x4*)F.in[I_GN2] + lane;
            f32x4 v[4]; float s = 0.f;
#pragma unroll
            for (int j = 0; j < 4; ++j) { v[j] = xr[64 * j]; s += (v[j].x * v[j].x + v[j].y * v[j].y) + (v[j].z * v[j].z + v[j].w * v[j].w); }
            const float rs = 1.0f / sqrtf(wave_sum(s) * (1.f / DM) + EPS);
            u32x2* o8 = (u32x2*)(H2 + (size_t)tok * DM) + lane;
#pragma unroll
            for (int j = 0; j < 4; ++j) { const f32x4 gg = gr[64 * j]; v[j].x *= rs * gg.x; v[j].y *= rs * gg.y; v[j].z *= rs * gg.z; v[j].w *= rs * gg.w;
                u32x2 o; o.x = pk2(v[j].x, v[j].y); o.y = pk2(v[j].z, v[j].w); o8[64 * j] = o; }
            float pe[32];
#pragma unroll
            for (int e = 0; e < 32; ++e) { float a = 0.f;
#pragma unroll
                for (int j = 0; j < 4; ++j) { const f32x4 w = *(const LAS f32x4*)(WR + e * 1024 + 4 * lane + 256 * j); a += v[j].x * w.x + v[j].y * w.y + v[j].z * w.z + v[j].w * w.w; }
                pe[e] = a; }
#pragma unroll
            for (int e = 0; e < 16; ++e) { const bool up = (lane & 16) != 0; const float send = up ? pe[e] : pe[e + 16], keep = up ? pe[e + 16] : pe[e]; pe[e] = keep + __shfl_xor(send, 16); }
#pragma unroll
            for (int e = 0; e < 8; ++e) { const bool up = (lane & 8) != 0; const float send = up ? pe[e] : pe[e + 8], keep = up ? pe[e + 8] : pe[e]; pe[e] = keep + __shfl_xor(send, 8); }
#pragma unroll
            for (int e = 0; e < 4; ++e) { const bool up = (lane & 4) != 0; const float send = up ? pe[e] : pe[e + 4], keep = up ? pe[e + 4] : pe[e]; pe[e] = keep + __shfl_xor(send, 4); }
#pragma unroll
            for (int e = 0; e < 2; ++e) { const bool up = (lane & 2) != 0; const float send = up ? pe[e] : pe[e + 2], keep = up ? pe[e + 2] : pe[e]; pe[e] = keep + __shfl_xor(send, 2); }
            { const bool up = (lane & 1) != 0; const float send = up ? pe[0] : pe[1], keep = up ? pe[1] : pe[0]; pe[0] = keep + __shfl_xor(send, 1); }
            float lg = pe[0] + __shfl_xor(pe[0], 32);
            lg += F.in[I_BR][lane & 31];
            float tv[4]; int te[4];
#pragma unroll
            for (int r = 0; r < 4; ++r) { const float m = wave_max(lg); const unsigned long long bm = __ballot(lg == m) & 0xffffffffull; const int idx = __ffsll((long long)bm) - 1;
                tv[r] = m; te[r] = idx; if ((lane & 31) == idx) lg = -3e38f; }
            const float e1 = __expf(tv[1] - tv[0]), e2 = __expf(tv[2] - tv[0]), e3 = __expf(tv[3] - tv[0]); const float inv = 1.0f / (1.0f + e1 + e2 + e3);
            if (lane == 0) { *(int4*)(TOPE + (size_t)tok * 4) = make_int4(te[0], te[1], te[2], te[3]); *(float4*)(TOPW + (size_t)tok * 4) = make_float4(inv, e1 * inv, e2 * inv, e3 * inv); }
            if (lane < 4) { const int e = lane == 0 ? te[0] : lane == 1 ? te[1] : lane == 2 ? te[2] : te[3]; __hip_atomic_fetch_add(&CNT[e], 1, __ATOMIC_RELAXED, __HIP_MEMORY_SCOPE_WORKGROUP); }
        }
        __syncthreads();
        if (F.tid < 32) CNTG[vw * 32 + F.tid] = CNT[F.tid];
        __syncthreads();
    }
}

__device__ __forceinline__ void p8_scatter(Frame& F) {
    unsigned char* ws = F.ws;
    LAS int* CN = (LAS int*)F.lds;
    LAS int* BASE = (LAS int*)(F.lds + 32768);
    LAS int* TS = (LAS int*)(F.lds + 32768 + 256);
    LAS int* TOT = (LAS int*)(F.lds + 32768 + 512);
    LAS int* LE = (LAS int*)(F.lds + 36864);
    LAS int* LS = (LAS int*)(F.lds + 36864 + 4096);
    const int* CNTG = (const int*)(ws + WS_CNT); const int* TOPE = (const int*)(ws + WS_TOPE); const float* TOPW = (const float*)(ws + WS_TOPW);
    int* INV = (int*)(ws + WS_INV);
    for (int vw = blockIdx.x; vw < 256; vw += F.G) {
        const int ch = vw / WPC, wl = vw % WPC;
        unsigned* ROWTOK = (unsigned*)(ws + WS_ROWTOK) + (size_t)ch * SLOTS_CH; float* ROWW = (float*)(ws + WS_ROWW) + (size_t)ch * SLOTS_CH;
        for (int i = F.tid; i < WPC * 32; i += 512) CN[i] = CNTG[ch * WPC * 32 + i];
        for (int i = F.tid; i < 1024; i += 512) LE[i] = TOPE[(size_t)vw * 1024 + i];
        __syncthreads();
        if (F.tid < 32) { int tot = 0, pre = 0; for (int w = 0; w < WPC; ++w) { const int c = CN[w * 32 + F.tid]; if (w < wl) pre += c; tot += c; } TOT[F.tid] = tot; BASE[F.tid] = pre; }
        __syncthreads();
        if (F.tid == 0) { int ts = 0; for (int e = 0; e < 32; ++e) { TS[e] = ts; ts += (TOT[e] + 255) >> 8; } TS[32] = ts; }
        __syncthreads();
        if (F.tid < 32) { const int e = F.tid; int pos = TS[e] * 256 + BASE[e]; for (int i = 0; i < 1024; ++i) if (LE[i] == e) LS[i] = pos++; }
        __syncthreads();
        for (int i = F.tid; i < 1024; i += 512) { const int slot = LS[i]; const int tok = vw * 256 + (i >> 2); ROWTOK[slot] = (unsigned)tok * 2048u; ROWW[slot] = TOPW[(size_t)vw * 1024 + i]; INV[(size_t)vw * 1024 + i] = slot; }
        if (wl < 32) { const int e = wl; const int lo = TS[e] * 256 + TOT[e], hi = TS[e + 1] * 256; for (int s = lo + F.tid; s < hi; s += 512) { ROWTOK[s] = (unsigned)(ch * TCH) * 2048u; ROWW[s] = 0.f; } }
        if (wl == 0 && F.tid < 33) ((int*)(ws + WS_TSTART))[ch * 64 + F.tid] = TS[F.tid];
        __syncthreads();
    }
}

__device__ __forceinline__ void p_combine(Frame& F, int ch) {
    unsigned char* ws = F.ws; const int lane = F.lane;
    const bf16_t* Y = (const bf16_t*)(ws + WS_YBUF); const int* INV = (const int*)(ws + WS_INV);
    const int gw = F.vcu * 8 + F.wave, NGW = F.G * 8;
    for (int i = gw; i < TCH; i += NGW) {
        const int tok = ch * TCH + i; const int4 sl = *(const int4*)(INV + (size_t)tok * 4);
        float* o = F.out + (size_t)tok * DM;
#pragma unroll
        for (int hh = 0; hh < 2; ++hh) { const int col = hh * 512 + lane * 8;
            f32x4 a0 = *(const f32x4*)(o + col), a1 = *(const f32x4*)(o + col + 4);
            const int ss[4] = {sl.x, sl.y, sl.z, sl.w};
#pragma unroll
            for (int k = 0; k < 4; ++k) { const u32x4 w = *(const u32x4*)(Y + (size_t)ss[k] * 1024 + col);
                a0.x += bflo(w.x); a0.y += bfhi(w.x); a0.z += bflo(w.y); a0.w += bfhi(w.y); a1.x += bflo(w.z); a1.y += bfhi(w.z); a1.z += bflo(w.w); a1.w += bfhi(w.w); }
            *(f32x4*)(o + col) = a0; *(f32x4*)(o + col + 4) = a1; }
    }
}

__global__ void __launch_bounds__(512, 2) mk_fwd(Args args) {
    extern __shared__ __attribute__((aligned(16))) unsigned char lds_raw[];
    Frame F;
    F.lds = (LAS unsigned char*)lds_raw;
    F.tid = threadIdx.x; F.lane = F.tid & 63; F.wave = __builtin_amdgcn_readfirstlane(F.tid >> 6);
    F.G = gridDim.x; { const int bx = blockIdx.x; F.vcu = (F.G % 8 == 0) ? (bx % 8) * (F.G / 8) + bx / 8 : bx; }
    F.ws = args.ws; F.out = args.out;
#pragma unroll
    for (int i = 0; i < 28; ++i) F.in[i] = args.in[i];
    unsigned char* ws = args.ws;
    volatile LAS unsigned* MISC = (volatile LAS unsigned*)(F.lds + MISC_OFF);
    for (int u = F.tid; u < 256; u += 512) MISC[u] = 0u;
    __syncthreads();
    XcdBarrier bar; bar.bar = (unsigned*)(ws + WS_CTL) + 1024; bar.x = 0; bar.st = nullptr;
    const int lo = args.ph_lo, hi = args.ph_hi;
    if (hi - lo > 1) bar = xcd_barrier_post((unsigned*)(ws + WS_CTL) + 1024, MISC + 8);
#define IN(k) (lo <= (k) && (k) < hi)
#define SEAM(k) do { if (IN(k) && IN((k) + 1)) xcd_barrier(bar); } while (0)
    LAS unsigned char* ring = F.lds;
    const int cid = (int)blockIdx.x;

    if (IN(0)) { p0_prologue(F); } SEAM(0);

    if (IN(1)) {
        pg8::OrdPlain S{(const char*)(ws + WS_H1), (const char*)(ws + WS_WIN_T), T / 256, NPROJ / 256, F.G, cid, (size_t)256 * DM * 2, (size_t)256 * DM * 2};
        pg8::EpiIn E{(bf16_t*)(ws + WS_Q), (bf16_t*)(ws + WS_KV6), (bf16_t*)(ws + WS_CONV3), (bf16_t*)(ws + WS_MG), (bf16_t*)(ws + WS_NG)};
        pg8::gemm_phase<pg8::EpiIn, pg8::OrdPlain, false>(ring, DM, DM * 2, 128, S, E, nullptr);
    } SEAM(1);

    if (IN(2)) {
        pg8::OrdCmp S{(const char*)(ws + WS_KV6), (const char*)(ws + WS_CKW1_T), (const char*)(ws + WS_CVW1_T), F.G, cid};
        pg8::EpiCmp E{(bf16_t*)(ws + WS_HID), (const float*)(ws + WS_B1P)};
        pg8::gemm_phase<pg8::EpiCmp, pg8::OrdCmp, false>(ring, 2048, 16 * 768 * 2, 768 * 2, S, E, nullptr);
    }
    SEAM(2);
    if (IN(3)) { p2_elementwise(F); p3_compress2(F); } SEAM(3);

    #ifdef ATTN_NAIVE
    if (IN(4)) { p4_attn_naive(F); } SEAM(4);
#else
    if (IN(4)) { p4_attn(F); } SEAM(4);
#endif

    if (IN(5)) {
        { pg8::OrdPlain S{(const char*)(ws + WS_Q), (const char*)(ws + WS_WPA_T), T / 256, DM / 256, F.G, cid, (size_t)256 * AW * 2, (size_t)256 * AW * 2};
          pg8::EpiGate<false> E{(bf16_t*)(ws + WS_Z), (const bf16_t*)(ws + WS_MG), 0};
          pg8::gemm_phase<pg8::EpiGate<false>, pg8::OrdPlain, false>(ring, AW, AW * 2, 128, S, E, nullptr); }
        VM_WAIT(); __syncthreads();
        { pg8::OrdPlain S{(const char*)(ws + WS_YB), (const char*)(ws + WS_WPB_T), T / 256, DM / 256, F.G, cid, (size_t)256 * CONVW * 2, (size_t)256 * CONVW * 2};
          pg8::EpiGate<true> E{(bf16_t*)(ws + WS_Z), (const bf16_t*)(ws + WS_MG), 1024};
          pg8::gemm_phase<pg8::EpiGate<true>, pg8::OrdPlain, false>(ring, CONVW, CONVW * 2, 128, S, E, nullptr); }
    } SEAM(5);

    if (IN(6)) {
        pg8::OrdPlain S{(const char*)(ws + WS_Z), (const char*)(ws + WS_WO_T), T / 256, DM / 256, F.G, cid, (size_t)256 * DM * 2, (size_t)256 * DM * 2};
        pg8::EpiRes E{F.in[I_X], F.out};
        pg8::gemm_phase<pg8::EpiRes, pg8::OrdPlain, false>(ring, DM, DM * 2, 128, S, E, nullptr);
    } SEAM(6);

    if (IN(7)) { p7_route(F); } SEAM(7);
    if (IN(8)) { p8_scatter(F); } SEAM(8);

#pragma unroll
    for (int ch = 0; ch < NCH; ++ch) {
        const int pgu = 9 + 2 * ch, pdn = 10 + 2 * ch;
        if (IN(pgu)) {
            LAS int* TS = (LAS int*)(F.lds + MISC_OFF + 512);
            if (F.tid < 33) TS[F.tid] = ((const int*)(ws + WS_TSTART))[ch * 64 + F.tid];
            __syncthreads();
            const int ntile = TS[32];
            pg8::OrdGrp S{(const char*)(ws + WS_H2), (const char*)(ws + WS_WGU_T), TS, ntile, 8, F.G, cid, (size_t)0, (size_t)256 * DM * 2, (size_t)2048 * DM * 2};
            LAS unsigned* gtab = (LAS unsigned*)(F.lds + GTAB_OFF);
            { const unsigned* ROWTOK = (const unsigned*)(ws + WS_ROWTOK) + (size_t)ch * SLOTS_CH;
              for (int i = 0; i < GTAB_UNITS; ++i) { int pm, pn; if (!pg8::tile_map((long)i * F.G + cid, ntile, 8, pm, pn)) break;
                  if (F.tid < 256) gtab[i * 256 + F.tid] = ROWTOK[pm * 256 + F.tid]; } }
            __syncthreads();
            pg8::EpiGU E{(bf16_t*)(ws + WS_ACT), F.in[I_BGU]};
            pg8::gemm_phase<pg8::EpiGU, pg8::OrdGrp, true>(ring, DM, 0, 128, S, E, gtab);
            if (ch > 0) p_combine(F, ch - 1);
        } SEAM(pgu);
        if (IN(pdn)) {
            LAS int* TS = (LAS int*)(F.lds + MISC_OFF + 512);
            if (F.tid < 33) TS[F.tid] = ((const int*)(ws + WS_TSTART))[ch * 64 + F.tid];
            __syncthreads();
            const int ntile = TS[32];
            pg8::OrdGrp S{(const char*)(ws + WS_ACT), (const char*)(ws + WS_WDN_T), TS, ntile, 4, F.G, cid, (size_t)256 * DFF * 2, (size_t)256 * DFF * 2, (size_t)DM * DFF * 2};
            pg8::EpiDN E{(bf16_t*)(ws + WS_YBUF), F.in[I_BDN], (const float*)(ws + WS_ROWW) + (size_t)ch * SLOTS_CH};
            pg8::gemm_phase<pg8::EpiDN, pg8::OrdGrp, false>(ring, DFF, DFF * 2, 128, S, E, nullptr);
        } SEAM(pdn);
    }
    if (IN(NPH - 1)) { p_combine(F, NCH - 1); }
#undef IN
#undef SEAM
}

extern "C" void kernel_launch(void* const* d_in, const int* in_sizes, int n_in, void* d_out, int out_size, void* d_ws, size_t ws_size, hipStream_t stream) {
    static int grid = 0;
    if (grid == 0) {
        if (n_in != 28 || out_size != T * DM || ws_size < WS_END) { fprintf(stderr, "kernel_launch: unexpected shapes (n_in %d, out %d, ws %zu)\n", n_in, out_size, ws_size); grid = -1; return; }
        int dev = 0, cus = 0;
        if (hipGetDevice(&dev) != hipSuccess || hipDeviceGetAttribute(&cus, hipDeviceAttributeMultiprocessorCount, dev) != hipSuccess) { grid = -1; return; }
        if (hipFuncSetAttribute((const void*)mk_fwd, hipFuncAttributeMaxDynamicSharedMemorySize, LDS_BYTES) != hipSuccess) { fprintf(stderr, "kernel_launch: hipFuncSetAttribute failed\n"); grid = -1; return; }
        int per_cu = 0;
        if (hipOccupancyMaxActiveBlocksPerMultiprocessor(&per_cu, (const void*)mk_fwd, 512, LDS_BYTES) != hipSuccess || per_cu < 1) fprintf(stderr, "kernel_launch: occupancy query says %d\n", per_cu);
        (void)hipGetLastError();
        grid = cus;
    }
    if (grid < 0) return;
    (void)hipMemsetAsync((char*)d_ws + WS_CTL, 0, CTL_ZERO_BYTES, stream);
    Args a{};
    for (int i = 0; i < 28; ++i) a.in[i] = (const float*)d_in[i];
    a.out = (float*)d_out; a.ws = (unsigned char*)d_ws;
#if MK_N_LAUNCHES == 1
    a.ph_lo = 0; a.ph_hi = NPH;
    hipLaunchKernelGGL(mk_fwd, dim3(grid), dim3(512), LDS_BYTES, stream, a);
#else
    for (int p = 0; p < NPH; ++p) { a.ph_lo = p; a.ph_hi = p + 1; hipLaunchKernelGGL(mk_fwd, dim3(grid), dim3(512), LDS_BYTES, stream, a); }
#endif
}
```

```cpp
#include <hip/hip_runtime.h>
#include <cstdio>
#include <cstdint>

#define LAS __attribute__((address_space(3)))
#define GAS __attribute__((address_space(1)))
typedef unsigned short bf16_t;
typedef short bf16x8 __attribute__((ext_vector_type(8)));
typedef float f32x4 __attribute__((ext_vector_type(4)));
typedef float f32x2 __attribute__((ext_vector_type(2)));
typedef unsigned u32x4 __attribute__((ext_vector_type(4)));
typedef unsigned u32x2 __attribute__((ext_vector_type(2)));

#ifndef MK_N_LAUNCHES
#define MK_N_LAUNCHES 1
#endif

constexpr int BATCH = 8, SEQ = 8192, DM = 1024, T = BATCH * SEQ;
constexpr int NH = 8, HD = 64, NGRP = 2, AW = 512;
constexpr int CMP_HID = 256, NBLK = 128, NSEL = 16, WIN = 512;
constexpr int CONVW = 512, NEXP = 32, DFF = 1024;
constexpr int NPROJ = 5120;
constexpr int IN_COLS = 4888;
constexpr float EPS = 1e-6f, LOG2E = 1.4426950408889634f;
constexpr float QSCALE = 0.125f * LOG2E;
constexpr int NCH = 2;
constexpr int TCH = T / NCH;
constexpr int SLOTS_CH = TCH * 4 + NEXP * 256;
constexpr int WPC = 256 / NCH;
constexpr int NPH = 14;

constexpr size_t MiB = 1u << 20;
constexpr size_t WS_CTL = 0, CTL_ZERO_BYTES = 64 * 1024;
constexpr size_t WS_B1P = 1 * MiB;
constexpr size_t WS_TSTART = 1 * MiB + 4096;
constexpr size_t WS_CNT = 1 * MiB + 8192;
constexpr size_t WS_WIN_T = 8 * MiB, WS_WPA_T = 18 * MiB, WS_WPB_T = 19 * MiB, WS_WO_T = 20 * MiB, WS_CKW1_T = 22 * MiB, WS_CVW1_T = 23 * MiB;
constexpr size_t WS_WGU_T = 24 * MiB, WS_WDN_T = 152 * MiB;
constexpr size_t WS_H1 = 216 * MiB, WS_YB = 216 * MiB, WS_OA = 280 * MiB, WS_Q = 344 * MiB, WS_KV6 = 408 * MiB, WS_CONV3 = 504 * MiB, WS_MG = 696 * MiB;
constexpr size_t WS_NG = 952 * MiB, WS_HID = 956 * MiB, WS_KC = 964 * MiB, WS_VC = 965 * MiB, WS_Z = 408 * MiB;
constexpr size_t WS_H2 = 216 * MiB, WS_ACT = 344 * MiB, WS_YBUF = 616 * MiB, WS_TOPE = 888 * MiB, WS_TOPW = 889 * MiB, WS_INV = 890 * MiB, WS_ROWTOK = 891 * MiB, WS_ROWW = 893 * MiB;
constexpr size_t WS_END = 966 * MiB;
static_assert((size_t)SLOTS_CH * 2048 <= 272 * MiB, "act chunk");
static_assert((size_t)NCH * SLOTS_CH * 4 <= 2 * MiB, "rowtok");

constexpr int RING_BYTES = 131072;
constexpr int GTAB_OFF = RING_BYTES, GTAB_UNITS = 20, GTAB_BYTES = GTAB_UNITS * 1024;
constexpr int MISC_OFF = GTAB_OFF + GTAB_BYTES;
constexpr int LDS_BYTES = MISC_OFF + 1024;
static_assert(LDS_BYTES <= 160 * 1024, "LDS");

__device__ __forceinline__ unsigned f2bf(float f) { unsigned u = __builtin_bit_cast(unsigned, f); return (u + 0x7fffu + ((u >> 16) & 1u)) >> 16; }
__device__ __forceinline__ unsigned pk2(float lo, float hi) { return f2bf(lo) | (f2bf(hi) << 16); }
__device__ __forceinline__ float bflo(unsigned w) { return __builtin_bit_cast(float, w << 16); }
__device__ __forceinline__ float bfhi(unsigned w) { return __builtin_bit_cast(float, w & 0xffff0000u); }
__device__ __forceinline__ float bf2f(bf16_t h) { return __builtin_bit_cast(float, (unsigned)h << 16); }
__device__ __forceinline__ float wave_sum(float v) {
#pragma unroll
    for (int o = 1; o < 64; o <<= 1) v += __shfl_xor(v, o);
    return v;
}
__device__ __forceinline__ float wave_max(float v) {
#pragma unroll
    for (int o = 1; o < 64; o <<= 1) v = fmaxf(v, __shfl_xor(v, o));
    return v;
}
__device__ __forceinline__ float sigmoidf_(float x) { return 1.0f / (1.0f + __expf(-x)); }
#define LDS_WAIT() asm volatile("s_waitcnt lgkmcnt(0)" ::: "memory")
#define VM_WAIT() asm volatile("s_waitcnt vmcnt(0)" ::: "memory")

namespace pg8 {
constexpr int BM = 256, BK = 64, HALF = 128, HTB = HALF * BK * 2, STAGE_BYTES = 8 * HTB, NXCD = 8, WGM = 8;
__host__ __device__ __forceinline__ int lds_byte(int r, int c) { const int st = (r >> 4) * 2 + (c >> 5), rr = r & 15, cc = c & 31, ob = rr * 64 + cc * 2; return st * 1024 + (ob ^ (((ob >> 9) & 1) << 5)); }
__host__ __device__ __forceinline__ void stage_rc(int b, int& R, int& C) { const int st = b / 1024, sb = b % 1024, swz = sb ^ (((sb >> 9) & 1) << 5); R = (st >> 1) * 16 + swz / 64; C = (st & 1) * 32 + (swz % 64) / 2; }
__host__ __device__ __forceinline__ int perm32(int rho) { const int n = rho >> 4, i = rho & 15; return 8 * (i >> 2) + 4 * n + (i & 3); }

struct Unit { const char* a; const char* b; int pm, pn, e; };

__device__ __forceinline__ bool tile_map(long L, int nM, int nN, int& pm, int& pn) {
    const int nwg = nM * nN; if (L >= nwg) return false;
    int wgid = (int)L; { const int q = nwg / NXCD, r = nwg % NXCD, xcd = wgid % NXCD, off = wgid / NXCD; wgid = (xcd < r ? xcd * (q + 1) : r * (q + 1) + (xcd - r) * q) + off; }
    const int nig = WGM * nN, gid = wgid / nig, fm = gid * WGM, gsz = (nM - fm) < WGM ? (nM - fm) : WGM;
    pm = fm + ((wgid % nig) % gsz); pn = (wgid % nig) / gsz; return true;
}

typedef int v8i_t __attribute__((ext_vector_type(8)));
typedef int v4i_t __attribute__((ext_vector_type(4)));
__device__ __forceinline__ v8i_t cat8(bf16x8 a, bf16x8 b) { return __builtin_shufflevector(__builtin_bit_cast(v4i_t, a), __builtin_bit_cast(v4i_t, b), 0, 1, 2, 3, 4, 5, 6, 7); }
__device__ __forceinline__ unsigned cvt_pk_bf16(float lo, float hi) { unsigned r; asm volatile("v_cvt_pk_bf16_f32 %0, %1, %2" : "=v"(r) : "v"(lo), "v"(hi)); return r; }

template <class Epi, class Sched, bool GATHER, bool F8 = false>
__device__ __forceinline__ void gemm_phase(LAS unsigned char* lds, const int K, const unsigned a_pitch, const unsigned a_kstep, const Sched& S, const Epi& E, const LAS unsigned* gtab) {
    const int tid = threadIdx.x, wid = __builtin_amdgcn_readfirstlane(tid >> 6), lane = tid & 63, wr = wid >> 2, wc = wid & 3, fr = lane & 15, fq = lane >> 4;
    const int nt = K / BK;
    unsigned voffA[2][2], voffB[2];
#pragma unroll
    for (int i = 0; i < 2; ++i) { int R, C; stage_rc(tid * 16 + i * 8192, R, C); const int Rb = Epi::PERM ? ((R & ~31) + perm32(R & 31)) : R;
        voffB[i] = (unsigned)(Rb * K + C) * 2u; voffA[0][i] = (unsigned)R * a_pitch + (unsigned)C * 2u; voffA[1][i] = voffA[0][i]; }
    const size_t kstepA = a_kstep, kstepB = (size_t)(BK * 2);
    const size_t hstepA = GATHER ? (size_t)0 : (size_t)HALF * a_pitch, hstepB = (size_t)HALF * K * 2;
    const unsigned ldsw = (unsigned)wid * 1024u;
    const int aoff = lds_byte(wr * 64 + fr, fq * 8), boff = lds_byte(wc * 32 + fr, fq * 8);
#define PG8_SA(b, h) (((b) * 2 + (h)) * HTB)
#define PG8_SB(b, h) ((4 + (b) * 2 + (h)) * HTB)
#define PG8_STAGE(bufoff, gbase, voff) do { _Pragma("unroll") for (int _i = 0; _i < 2; ++_i) \
        __builtin_amdgcn_global_load_lds((const unsigned*)((const char*)(gbase) + (voff)[_i]), (LAS unsigned*)(lds + (bufoff) + ldsw + _i * 8192), 16, 0, 0); } while (0)
#define PG8_STA(bufoff, gbase, h) do { if constexpr (GATHER) { PG8_STAGE(bufoff, gbase, voffA[h]); } else { PG8_STAGE(bufoff, (gbase) + (h) * hstepA, voffA[0]); } } while (0)
#define PG8_GLOAD(ui_) do { _Pragma("unroll") for (int _i = 0; _i < 2; ++_i) { int R_, C_; stage_rc(tid * 16 + _i * 8192, R_, C_); \
        voffA[0][_i] = gtab[(ui_) * 256 + R_] + (unsigned)C_ * 2u; voffA[1][_i] = gtab[(ui_) * 256 + 128 + R_] + (unsigned)C_ * 2u; } } while (0)
#define PG8_LDA(dst, b, h) do { _Pragma("unroll") for (int m = 0; m < 4; ++m) _Pragma("unroll") for (int k = 0; k < 2; ++k) dst[m][k] = *(const LAS bf16x8*)(lds + PG8_SA(b, h) + aoff + m * 2048 + k * 1024); } while (0)
#define PG8_LDB(dst, b, h) do { _Pragma("unroll") for (int n = 0; n < 2; ++n) _Pragma("unroll") for (int k = 0; k < 2; ++k) dst[n][k] = *(const LAS bf16x8*)(lds + PG8_SB(b, h) + boff + n * 2048 + k * 1024); } while (0)
#define PG8_MMA(ai, bj, At, Bt) do { __builtin_amdgcn_s_setprio(1); if constexpr (F8) { _Pragma("unroll") for (int m = 0; m < 4; ++m) _Pragma("unroll") for (int n = 0; n < 2; ++n) \
        acc[ai][bj][m][n] = __builtin_amdgcn_mfma_scale_f32_16x16x128_f8f6f4(cat8(Bt[n][0], Bt[n][1]), cat8(At[m][0], At[m][1]), acc[ai][bj][m][n], 0, 0, 0, 0x7f7f7f7f, 0, 0x7f7f7f7f); } \
      else { _Pragma("unroll") for (int m = 0; m < 4; ++m) _Pragma("unroll") for (int n = 0; n < 2; ++n) _Pragma("unroll") for (int k = 0; k < 2; ++k) \
        acc[ai][bj][m][n] = __builtin_amdgcn_mfma_f32_16x16x32_bf16(Bt[n][k], At[m][k], acc[ai][bj][m][n], 0, 0, 0); } __builtin_amdgcn_s_setprio(0); } while (0)
#define PG8_WAIT_V(n) asm volatile("s_waitcnt vmcnt(" #n ")" ::: "memory")
#define PG8_WAIT_L(n) asm volatile("s_waitcnt lgkmcnt(" #n ")" ::: "memory")
#define PG8_BAR __builtin_amdgcn_s_barrier()
#define PG8_SCHED __builtin_amdgcn_sched_barrier(0)
    Unit cur, nxt; int ui = 0;
    if (!S.next(0, cur)) return;
    f32x4 acc[2][2][4][2];
#pragma unroll
    for (int a = 0; a < 2; ++a)
#pragma unroll
        for (int b = 0; b < 2; ++b)
#pragma unroll
            for (int m = 0; m < 4; ++m)
#pragma unroll
                for (int n = 0; n < 2; ++n) acc[a][b][m][n] = (f32x4){0.f, 0.f, 0.f, 0.f};
    bf16x8 At[4][2], B0[2][2], B1[2][2];
    const char* cA = cur.a; const char* cB = cur.b;
    if constexpr (GATHER) { PG8_GLOAD(0); }
    PG8_STAGE(PG8_SB(0, 0), cB, voffB); PG8_STAGE(PG8_SB(0, 1), cB + hstepB, voffB); PG8_STA(PG8_SA(0, 0), cA, 0); PG8_STA(PG8_SA(0, 1), cA, 1);
    if (wr == 1) PG8_BAR;
    PG8_WAIT_V(2); PG8_BAR;
    PG8_STAGE(PG8_SB(1, 0), cB + kstepB, voffB); PG8_STA(PG8_SA(1, 0), cA + kstepA, 0); PG8_STAGE(PG8_SB(1, 1), cB + hstepB + kstepB, voffB);
    PG8_WAIT_V(6); PG8_BAR;
    for (;;) {
        const bool has_next = S.next(ui + 1, nxt);
        const char* nA = has_next ? nxt.a : cA; const char* nB = has_next ? nxt.b : cB;
#pragma unroll 1
        for (int t = 0; t < nt; t += 2) {
            const bool last = (t == nt - 2);
            const char* a1 = cA + (size_t)(t + 1) * kstepA;
            const char* a2 = last ? nA : cA + (size_t)(t + 2) * kstepA; const char* b2 = last ? nB : cB + (size_t)(t + 2) * kstepB;
            const char* a3 = a2 + kstepA; const char* b3 = b2 + kstepB;
            PG8_LDB(B0, 0, 0); PG8_LDB(B1, 0, 1); PG8_SCHED; PG8_LDA(At, 0, 0); PG8_STA(PG8_SA(1, 1), a1, 1);
            if constexpr (GATHER) { if (last && has_next) { PG8_GLOAD(ui + 1); } }
            PG8_WAIT_V(8); PG8_WAIT_L(0); PG8_BAR; PG8_MMA(0, 0, At, B0); PG8_MMA(0, 1, At, B1); PG8_BAR; PG8_SCHED;
            PG8_LDA(At, 0, 1); PG8_STAGE(PG8_SB(0, 0), b2, voffB); PG8_STAGE(PG8_SB(0, 1), b2 + hstepB, voffB); PG8_STA(PG8_SA(0, 0), a2, 0);
            PG8_WAIT_V(8); PG8_WAIT_L(0); PG8_BAR; PG8_MMA(1, 0, At, B0); PG8_MMA(1, 1, At, B1); PG8_BAR; PG8_SCHED;
            PG8_LDB(B0, 1, 0); PG8_LDB(B1, 1, 1); PG8_SCHED; PG8_LDA(At, 1, 0); PG8_STA(PG8_SA(0, 1), a2, 1);
            PG8_WAIT_V(8); PG8_WAIT_L(0); PG8_BAR; PG8_MMA(0, 0, At, B0); PG8_MMA(0, 1, At, B1); PG8_BAR; PG8_SCHED;
            PG8_LDA(At, 1, 1); PG8_STAGE(PG8_SB(1, 0), b3, voffB); PG8_STAGE(PG8_SB(1, 1), b3 + hstepB, voffB); PG8_STA(PG8_SA(1, 0), a3, 0);
            PG8_WAIT_V(8); PG8_WAIT_L(0); PG8_BAR; PG8_MMA(1, 0, At, B0); PG8_MMA(1, 1, At, B1); PG8_BAR; PG8_SCHED;
        }
        if (wr == 0) PG8_BAR;
        E(acc, cur, wr, wc, fr, fq);
        if (!has_next) break;
#pragma unroll
        for (int a = 0; a < 2; ++a)
#pragma unroll
            for (int b = 0; b < 2; ++b)
#pragma unroll
                for (int m = 0; m < 4; ++m)
#pragma unroll
                    for (int n = 0; n < 2; ++n) acc[a][b][m][n] = (f32x4){0.f, 0.f, 0.f, 0.f};
        cur = nxt; cA = nA; cB = nB; ++ui;
        if (wr == 1) PG8_BAR;
    }
    PG8_WAIT_V(0);
    PG8_BAR;
#undef PG8_SA
#undef PG8_SB
#undef PG8_STAGE
#undef PG8_STA
#undef PG8_GLOAD
#undef PG8_LDA
#undef PG8_LDB
#undef PG8_MMA
#undef PG8_WAIT_V
#undef PG8_WAIT_L
#undef PG8_BAR
#undef PG8_SCHED
}

struct OrdPlain {
    const char* A; const char* Bt; int nM, nN, G, c; size_t a_tile, b_tile;
    __device__ __forceinline__ bool next(int i, Unit& u) const { int pm, pn; if (!tile_map((long)i * G + c, nM, nN, pm, pn)) return false;
        u.pm = pm; u.pn = pn; u.e = 0; u.a = A + (size_t)pm * a_tile; u.b = Bt + (size_t)pn * b_tile; return true; }
};
struct OrdCmp {
    const char* KV6; const char* Wk; const char* Wv; int G, c;
    __device__ __forceinline__ bool next(int i, Unit& u) const { const long L = (long)i * G + c; if (L >= 64) return false;
        const int kv = (int)L >> 5, b = ((int)L >> 2) & 7, g = ((int)L >> 1) & 1, nh = (int)L & 1;
        u.pm = (int)L; u.pn = 0; u.e = kv; u.a = KV6 + ((size_t)(b * SEQ + nh * 4096) * 768 + kv * 128 + g * 64) * 2; u.b = kv ? Wv : Wk; return true; }
};
struct OrdGrp {
    const char* A; const char* Bt; const LAS int* tstart; int nM, nN, G, c; size_t a_tile, b_tile, b_grp;
    __device__ __forceinline__ bool next(int i, Unit& u) const { int pm, pn; if (!tile_map((long)i * G + c, nM, nN, pm, pn)) return false;
        int e = 0;
#pragma unroll 1
        for (int k = 1; k < NEXP; ++k) e += (pm >= tstart[k]) ? 1 : 0;
        u.pm = pm; u.pn = pn; u.e = e; u.a = A + (size_t)pm * a_tile; u.b = Bt + (size_t)e * b_grp + (size_t)pn * b_tile; return true; }
};

struct EpiIn {
    static constexpr bool PERM = true;
    bf16_t *Q, *KV6, *CONV3, *MG, *NG;
    __device__ __forceinline__ void operator()(const f32x4 (&acc)[2][2][4][2], const Unit& u, int wr, int wc, int fr, int fq) const {
        const int pn = u.pn; bf16_t* base; int ld, ct; bool sig = false;
        if (pn < 2) { base = Q; ld = 512; ct = pn * 256; } else if (pn < 5) { base = KV6; ld = 768; ct = (pn - 2) * 256; }
        else if (pn < 11) { base = CONV3; ld = 1536; ct = (pn - 5) * 256; } else if (pn < 19) { base = MG; ld = 2048; ct = (pn - 11) * 256; sig = true; }
        else { base = NG; ld = 32; ct = 0; sig = true; }
        const int row0 = u.pm * BM + wr * 64 + fr;
#pragma unroll
        for (int ai = 0; ai < 2; ++ai)
#pragma unroll
            for (int m = 0; m < 4; ++m) { bf16_t* rowp = base + (size_t)(row0 + ai * HALF + m * 16) * ld + ct + wc * 32 + 8 * fq;
#pragma unroll
                for (int bj = 0; bj < 2; ++bj) { if (pn == 19 && (bj != 0 || wc != 0)) continue;
                    f32x4 v0 = acc[ai][bj][m][0], v1 = acc[ai][bj][m][1];
                    if (sig) {
#pragma unroll
                        for (int k = 0; k < 4; ++k) { v0[k] = sigmoidf_(v0[k]); v1[k] = sigmoidf_(v1[k]); } }
                    u32x4 w; w.x = cvt_pk_bf16(v0[0], v0[1]); w.y = cvt_pk_bf16(v0[2], v0[3]); w.z = cvt_pk_bf16(v1[0], v1[1]); w.w = cvt_pk_bf16(v1[2], v1[3]);
                    *(u32x4*)(rowp + bj * HALF) = w; } }
    }
};
__device__ __forceinline__ float gelu_tanh(float x) { const float y = 1.5957691216057308f * (x + 0.044715f * x * x * x); return x / (1.0f + __expf(-y)); }
struct EpiCmp {
    static constexpr bool PERM = true;
    bf16_t* HID; const float* B1P;
    __device__ __forceinline__ void operator()(const f32x4 (&acc)[2][2][4][2], const Unit& u, int wr, int wc, int fr, int fq) const {
        const int row0 = u.pm * BM + wr * 64 + fr; const float* bp = B1P + u.e * 256 + wc * 32 + 8 * fq;
        f32x4 bv[2][2];
#pragma unroll
        for (int bj = 0; bj < 2; ++bj)
#pragma unroll
            for (int n = 0; n < 2; ++n) bv[bj][n] = *(const f32x4*)(bp + bj * HALF + 4 * n);
#pragma unroll
        for (int ai = 0; ai < 2; ++ai)
#pragma unroll
            for (int m = 0; m < 4; ++m) { bf16_t* rowp = HID + (size_t)(row0 + ai * HALF + m * 16) * 256 + wc * 32 + 8 * fq;
#pragma unroll
                for (int bj = 0; bj < 2; ++bj) { f32x4 v0 = acc[ai][bj][m][0] + bv[bj][0], v1 = acc[ai][bj][m][1] + bv[bj][1];
#pragma unroll
                    for (int k = 0; k < 4; ++k) { v0[k] = gelu_tanh(v0[k]); v1[k] = gelu_tanh(v1[k]); }
                    u32x4 w; w.x = cvt_pk_bf16(v0[0], v0[1]); w.y = cvt_pk_bf16(v0[2], v0[3]); w.z = cvt_pk_bf16(v1[0], v1[1]); w.w = cvt_pk_bf16(v1[2], v1[3]);
                    *(u32x4*)(rowp + bj * HALF) = w; } }
    }
};
template <bool ADD> struct EpiGate {
    static constexpr bool PERM = true;
    bf16_t* Z; const bf16_t* MG; int goff;
    __device__ __forceinline__ void operator()(const f32x4 (&acc)[2][2][4][2], const Unit& u, int wr, int wc, int fr, int fq) const {
        const int row0 = u.pm * BM + wr * 64 + fr, col0 = u.pn * BM + wc * 32 + 8 * fq;
#pragma unroll
        for (int ai = 0; ai < 2; ++ai)
#pragma unroll
            for (int m = 0; m < 4; ++m) { const size_t row = (size_t)(row0 + ai * HALF + m * 16);
#pragma unroll
                for (int bj = 0; bj < 2; ++bj) { const int col = col0 + bj * HALF;
                    const u32x4 gw = *(const u32x4*)(MG + row * 2048 + goff + col);
                    f32x4 v0 = acc[ai][bj][m][0], v1 = acc[ai][bj][m][1];
                    v0[0] *= bflo(gw.x); v0[1] *= bfhi(gw.x); v0[2] *= bflo(gw.y); v0[3] *= bfhi(gw.y); v1[0] *= bflo(gw.z); v1[1] *= bfhi(gw.z); v1[2] *= bflo(gw.w); v1[3] *= bfhi(gw.w);
                    if (ADD) { const u32x4 zw = *(const u32x4*)(Z + row * 1024 + col);
                        v0[0] += bflo(zw.x); v0[1] += bfhi(zw.x); v0[2] += bflo(zw.y); v0[3] += bfhi(zw.y); v1[0] += bflo(zw.z); v1[1] += bfhi(zw.z); v1[2] += bflo(zw.w); v1[3] += bfhi(zw.w); }
                    u32x4 w; w.x = cvt_pk_bf16(v0[0], v0[1]); w.y = cvt_pk_bf16(v0[2], v0[3]); w.z = cvt_pk_bf16(v1[0], v1[1]); w.w = cvt_pk_bf16(v1[2], v1[3]);
                    *(u32x4*)(Z + row * 1024 + col) = w; } }
    }
};
struct EpiRes {
    static constexpr bool PERM = false;
    const float* X; float* O;
    __device__ __forceinline__ void operator()(const f32x4 (&acc)[2][2][4][2], const Unit& u, int wr, int wc, int fr, int fq) const {
        const int row0 = u.pm * BM + wr * 64 + fr, col0 = u.pn * BM + wc * 32 + 4 * fq;
#pragma unroll
        for (int ai = 0; ai < 2; ++ai)
#pragma unroll
            for (int m = 0; m < 4; ++m) { const size_t off = (size_t)(row0 + ai * HALF + m * 16) * DM + col0;
#pragma unroll
                for (int bj = 0; bj < 2; ++bj)
#pragma unroll
                    for (int n = 0; n < 2; ++n) { const f32x4 xv = *(const f32x4*)(X + off + bj * HALF + n * 16); *(f32x4*)(O + off + bj * HALF + n * 16) = xv + acc[ai][bj][m][n]; } }
    }
};
constexpr float W8SCALE = 32.0f, W8INV = 1.0f / 32.0f;
__device__ __forceinline__ unsigned pk4_fp8(float a, float b, float c, float d) { int r = __builtin_amdgcn_cvt_pk_fp8_f32(a, b, 0, false); r = __builtin_amdgcn_cvt_pk_fp8_f32(c, d, r, true); return (unsigned)r; }
struct EpiGU {
    static constexpr bool PERM = true;
    unsigned char* ACT; const float* BGU;
    __device__ __forceinline__ void operator()(const f32x4 (&acc)[2][2][4][2], const Unit& u, int wr, int wc, int fr, int fq) const {
        const int row0 = u.pm * BM + wr * 64 + fr, col0 = u.pn * HALF + wc * 32 + 8 * fq; const float* bp = BGU + (size_t)u.e * 2048 + col0;
        f32x4 bg[2], bu[2];
#pragma unroll
        for (int n = 0; n < 2; ++n) { bg[n] = *(const f32x4*)(bp + 4 * n); bu[n] = *(const f32x4*)(bp + 1024 + 4 * n); }
#pragma unroll
        for (int ai = 0; ai < 2; ++ai)
#pragma unroll
            for (int m = 0; m < 4; ++m) { unsigned char* rowp = ACT + (size_t)(row0 + ai * HALF + m * 16) * 1024 + col0; float o[8];
#pragma unroll
                for (int n = 0; n < 2; ++n)
#pragma unroll
                    for (int k = 0; k < 4; ++k) { float g = fminf(acc[ai][0][m][n][k] * W8INV + bg[n][k], 7.0f); float uu = fminf(fmaxf(acc[ai][1][m][n][k] * W8INV + bu[n][k], -7.0f), 7.0f);
                        o[n * 4 + k] = (uu + 1.0f) * (g / (1.0f + __expf(-1.702f * g))); }
                u32x2 w; w.x = pk4_fp8(o[0], o[1], o[2], o[3]); w.y = pk4_fp8(o[4], o[5], o[6], o[7]);
                *(u32x2*)rowp = w; }
    }
};
struct EpiDN {
    static constexpr bool PERM = true;
    bf16_t* Y; const float* BDN; const float* ROWW;
    __device__ __forceinline__ void operator()(const f32x4 (&acc)[2][2][4][2], const Unit& u, int wr, int wc, int fr, int fq) const {
        const int row0 = u.pm * BM + wr * 64 + fr, col0 = u.pn * BM + wc * 32 + 8 * fq; const float* bp = BDN + (size_t)u.e * 1024 + col0;
        f32x4 bv[2][2];
#pragma unroll
        for (int bj = 0; bj < 2; ++bj)
#pragma unroll
            for (int n = 0; n < 2; ++n) bv[bj][n] = *(const f32x4*)(bp + bj * HALF + 4 * n);
#pragma unroll
        for (int ai = 0; ai < 2; ++ai)
#pragma unroll
            for (int m = 0; m < 4; ++m) { const int row = row0 + ai * HALF + m * 16; const float rw = ROWW[row]; bf16_t* rowp = Y + (size_t)row * 1024 + col0;
#pragma unroll
                for (int bj = 0; bj < 2; ++bj) { const f32x4 v0 = (acc[ai][bj][m][0] * W8INV + bv[bj][0]) * rw, v1 = (acc[ai][bj][m][1] * W8INV + bv[bj][1]) * rw;
                    u32x4 w; w.x = cvt_pk_bf16(v0[0], v0[1]); w.y = cvt_pk_bf16(v0[2], v0[3]); w.z = cvt_pk_bf16(v1[0], v1[1]); w.w = cvt_pk_bf16(v1[2], v1[3]);
                    *(u32x4*)(rowp + bj * HALF) = w; } }
    }
};
}

#define XB_TMO      128
#define XB_XCNT(j)  (256  + 64 * (j))
#define XB_XSUB(j)  (1280 + 64 * (j))
#define XB_XGEN(j)  (2304 + 64 * (j))
#define XB_TOP      3328
#define XB_TOPGEN   3392
#define XCD_BAR_WORDS 3456
#define XB_SPIN_CAP (1u << 18)
__device__ __forceinline__ unsigned xb_ld(unsigned* p)              { return __hip_atomic_load(p, __ATOMIC_RELAXED, __HIP_MEMORY_SCOPE_AGENT); }
__device__ __forceinline__ unsigned xb_add(unsigned* p, unsigned v) { return __hip_atomic_fetch_add(p, v, __ATOMIC_RELAXED, __HIP_MEMORY_SCOPE_AGENT); }
__device__ __forceinline__ unsigned xb_xcc_id() { return (unsigned)__builtin_amdgcn_s_getreg((3 << 11) | 20) & 0xFu; }
#define XB_SPIN(cond, bar) do { unsigned _sp = 0; while (cond) { __builtin_amdgcn_s_sleep(1); \
    if ((++_sp & 255u) == 0u) { if (xb_ld(&(bar)[XB_TMO])) break; if (_sp > XB_SPIN_CAP) { atomicAdd(&(bar)[XB_TMO], 1u); break; } } } } while (0)
struct XcdBarrier { unsigned* bar; unsigned x; volatile LAS unsigned* st; };
__device__ __forceinline__ XcdBarrier xcd_barrier_post(unsigned* bar, volatile LAS unsigned* st) {
    XcdBarrier b; b.bar = bar; b.x = xb_xcc_id(); b.st = st;
    if (threadIdx.x == 0) (void)xb_add(&bar[XB_XCNT(b.x)], 1u);
    return b;
}
__device__ __forceinline__ void xcd_barrier_complete(unsigned* bar, unsigned x, unsigned& nloc, unsigned& nx) {
    const unsigned G = gridDim.x * gridDim.y * gridDim.z;
    unsigned sum, cnt, mine, sp = 0u;
    for (;;) {
        sum = 0u; cnt = 0u; mine = 0u;
#pragma unroll
        for (unsigned j = 0; j < 16; ++j) { const unsigned c = xb_ld(&bar[XB_XCNT(j)]); sum += c; cnt += (c > 0u) ? 1u : 0u; mine = (j == x) ? c : mine; }
        if (sum == G) break;
        __builtin_amdgcn_s_sleep(1);
        if ((++sp & 255u) == 0u) { if (xb_ld(&bar[XB_TMO])) break; if (sp > XB_SPIN_CAP) { atomicAdd(&bar[XB_TMO], 1u); break; } }
    }
    nloc = mine > 0u ? mine : 1u; nx = cnt > 0u ? cnt : 1u;
}
__device__ __forceinline__ void xcd_barrier(const XcdBarrier& b) {
    asm volatile("s_waitcnt vmcnt(0)" ::: "memory");
    __syncthreads();
    if (threadIdx.x == 0) {
        unsigned* bar = b.bar;
        __builtin_amdgcn_s_waitcnt(0);
        unsigned nloc = b.st[0], nx = b.st[1];
        if (nloc == 0u) { xcd_barrier_complete(bar, b.x, nloc, nx); b.st[0] = nloc; b.st[1] = nx; }
        const unsigned old = xb_add(&bar[XB_XSUB(b.x)], 1u);
        const unsigned gen = old / nloc;
        if (old + 1u == (gen + 1u) * nloc) {
            __builtin_amdgcn_fence(__ATOMIC_RELEASE, "agent");
            asm volatile("s_waitcnt vmcnt(0)" ::: "memory");
            const unsigned og = xb_add(&bar[XB_TOP], 1u);
            const unsigned tg = og / nx;
            if (og + 1u == (tg + 1u) * nx) xb_add(&bar[XB_TOPGEN], 1u);
            else XB_SPIN(xb_ld(&bar[XB_TOPGEN]) == tg, bar);
            __builtin_amdgcn_fence(__ATOMIC_ACQUIRE, "agent");
            xb_add(&bar[XB_XGEN(b.x)], 1u);
            asm volatile("s_waitcnt vmcnt(0)" ::: "memory");
        } else {
            XB_SPIN(xb_ld(&bar[XB_XGEN(b.x)]) == gen, bar);
            __builtin_amdgcn_fence(__ATOMIC_ACQUIRE, "agent");
            asm volatile("s_waitcnt vmcnt(0)" ::: "memory");
        }
    }
    __syncthreads();
}

struct Args { const float* in[28]; float* out; unsigned char* ws; int ph_lo, ph_hi; };
enum { I_X = 0, I_GN1, I_WIN, I_GQ, I_GKC, I_GKS, I_GKW, I_PEK, I_CKW1, I_CKB1, I_CKW2, I_CKB2, I_PEV, I_CVW1, I_CVB1, I_CVW2, I_CVB2, I_CONVW, I_WPA, I_WPB, I_WO, I_GN2, I_WR, I_BR, I_WGU, I_BGU, I_WDN, I_BDN };

struct Frame {
    LAS unsigned char* lds; int tid, lane, wave, G, vcu; unsigned char* ws; const float* in[28]; float* out;
};

__device__ __forceinline__ int colmap(int mode, int n) {
    if (mode == 1) { if (n < 1280) return n; if (n < 4864) return n + 24; if (n < 4888) return n - 4864 + 1280; return -1; }
    if (mode == 2) { const int p = n >> 8, r = n & 255; return r < 128 ? 128 * p + r : 1024 + 128 * p + (r - 128); }
    return n;
}
__device__ __forceinline__ void tr_item(const float* W, int Nsrc, int K, bf16_t* WT, int mode, LAS float* scr, int kb, int nb, int lane) {
    const int k0 = 64 * kb, n0 = 32 * nb; const int col = colmap(mode, n0 + (lane & 31));
#pragma unroll 8
    for (int i = 0; i < 32; ++i) { const int kk = 2 * i + (lane >> 5); scr[kk * 33 + (lane & 31)] = col >= 0 ? W[(size_t)(k0 + kk) * Nsrc + col] : 0.f; }
    LDS_WAIT(); asm volatile("" ::: "memory");
    const int c = lane & 7;
#pragma unroll
    for (int j = 0; j < 4; ++j) { const int n = (lane >> 3) + 8 * j; const LAS float* s = scr + (8 * c) * 33 + n;
        u32x4 o; o.x = pk2(s[0 * 33], s[1 * 33]); o.y = pk2(s[2 * 33], s[3 * 33]); o.z = pk2(s[4 * 33], s[5 * 33]); o.w = pk2(s[6 * 33], s[7 * 33]);
        *(u32x4*)(WT + (size_t)(n0 + n) * K + k0 + 8 * c) = o; }
    LDS_WAIT(); asm volatile("" ::: "memory");
}
__device__ __forceinline__ void tr_item8(const float* W, int Nsrc, int K, unsigned char* WT, int mode, LAS float* scr, int kb, int nb, int lane) {
    const int k0 = 64 * kb, n0 = 32 * nb; const int col = colmap(mode, n0 + (lane & 31));
#pragma unroll 8
    for (int i = 0; i < 32; ++i) { const int kk = 2 * i + (lane >> 5); scr[kk * 33 + (lane & 31)] = W[(size_t)(k0 + kk) * Nsrc + col]; }
    LDS_WAIT(); asm volatile("" ::: "memory");
    const int n = lane >> 1, hf = lane & 1; const LAS float* sp = scr + (32 * hf) * 33 + n;
    u32x4 o0, o1;
#pragma unroll
    for (int q = 0; q < 4; ++q) { o0[q] = pg8::pk4_fp8(sp[(4 * q) * 33] * pg8::W8SCALE, sp[(4 * q + 1) * 33] * pg8::W8SCALE, sp[(4 * q + 2) * 33] * pg8::W8SCALE, sp[(4 * q + 3) * 33] * pg8::W8SCALE);
                                  o1[q] = pg8::pk4_fp8(sp[(16 + 4 * q) * 33] * pg8::W8SCALE, sp[(17 + 4 * q) * 33] * pg8::W8SCALE, sp[(18 + 4 * q) * 33] * pg8::W8SCALE, sp[(19 + 4 * q) * 33] * pg8::W8SCALE); }
    unsigned char* dst = WT + (size_t)(n0 + n) * K + k0 + 32 * hf;
    *(u32x4*)dst = o0; *(u32x4*)(dst + 16) = o1;
    LDS_WAIT(); asm volatile("" ::: "memory");
}
__device__ __forceinline__ void p0_prologue(Frame& F) {
    unsigned char* ws = F.ws;
    LAS float* scr = (LAS float*)(F.lds + F.wave * 16384);
    const int gw = F.vcu * 8 + F.wave, NGW = F.G * 8;
    constexpr int I_IN = 16 * 160, I_PA = 8 * 32, I_PO = 16 * 32, I_C1 = 32 * 8, I_GU = 16 * 64, I_DN = 16 * 32;
    constexpr int NTR = I_IN + 2 * I_PA + I_PO + 2 * I_C1 + NEXP * I_GU + NEXP * I_DN;
    for (int it = gw; it < NTR + T; it += NGW) {
        int r = it;
        if (r >= NTR) {
            const int m = r - NTR; const f32x4* xr = (const f32x4*)(F.in[I_X] + (size_t)m * DM) + F.lane; const f32x4* gr = (const f32x4*)F.in[I_GN1] + F.lane;
            f32x4 v[4]; float s = 0.f;
#pragma unroll
            for (int j = 0; j < 4; ++j) { v[j] = xr[64 * j]; s += (v[j].x * v[j].x + v[j].y * v[j].y) + (v[j].z * v[j].z + v[j].w * v[j].w); }
            const float rs = 1.0f / sqrtf(wave_sum(s) * (1.f / DM) + EPS);
            u32x2* o8 = (u32x2*)((bf16_t*)(ws + WS_H1) + (size_t)m * DM) + F.lane;
#pragma unroll
            for (int j = 0; j < 4; ++j) { const f32x4 g = gr[64 * j]; u32x2 o; o.x = pk2(v[j].x * rs * g.x, v[j].y * rs * g.y); o.y = pk2(v[j].z * rs * g.z, v[j].w * rs * g.w); o8[64 * j] = o; }
            continue;
        }
        if (r < I_IN) { tr_item(F.in[I_WIN], IN_COLS, DM, (bf16_t*)(ws + WS_WIN_T), 1, scr, r / 160, r % 160, F.lane); continue; } r -= I_IN;
        if (r < I_PA) { tr_item(F.in[I_WPA], DM, AW, (bf16_t*)(ws + WS_WPA_T), 0, scr, r / 32, r % 32, F.lane); continue; } r -= I_PA;
        if (r < I_PA) { tr_item(F.in[I_WPB], DM, CONVW, (bf16_t*)(ws + WS_WPB_T), 0, scr, r / 32, r % 32, F.lane); continue; } r -= I_PA;
        if (r < I_PO) { tr_item(F.in[I_WO], DM, DM, (bf16_t*)(ws + WS_WO_T), 0, scr, r / 32, r % 32, F.lane); continue; } r -= I_PO;
        if (r < I_C1) { tr_item(F.in[I_CKW1], CMP_HID, 2048, (bf16_t*)(ws + WS_CKW1_T), 0, scr, r / 8, r % 8, F.lane); continue; } r -= I_C1;
        if (r < I_C1) { tr_item(F.in[I_CVW1], CMP_HID, 2048, (bf16_t*)(ws + WS_CVW1_T), 0, scr, r / 8, r % 8, F.lane); continue; } r -= I_C1;
        if (r < NEXP * I_GU) { const int e = r / I_GU, q = r % I_GU; tr_item8(F.in[I_WGU] + (size_t)e * DM * 2048, 2048, DM, (unsigned char*)(ws + WS_WGU_T) + (size_t)e * 2048 * DM, 2, scr, q / 64, q % 64, F.lane); continue; } r -= NEXP * I_GU;
        { const int e = r / I_DN, q = r % I_DN; tr_item8(F.in[I_WDN] + (size_t)e * DFF * DM, DM, DFF, (unsigned char*)(ws + WS_WDN_T) + (size_t)e * DM * DFF, 0, scr, q / 32, q % 32, F.lane); }
    }
    __syncthreads();
    for (int it = blockIdx.x; it < 8; it += F.G) {
        const int kv = it >> 2, jb = it & 3, j = jb * 64 + F.lane;
        const float* pe = kv ? F.in[I_PEV] : F.in[I_PEK]; const float* w1 = kv ? F.in[I_CVW1] : F.in[I_CKW1];
        float a = 0.f;
#pragma unroll 8
        for (int i = 0; i < 256; ++i) { const int ii = F.wave * 256 + i; a += pe[ii] * w1[(size_t)ii * CMP_HID + j]; }
        LAS float* red = (LAS float*)F.lds;
        red[F.wave * 64 + F.lane] = a; __syncthreads();
        if (F.wave == 0) { float s = (kv ? F.in[I_CVB1] : F.in[I_CKB1])[j];
#pragma unroll
            for (int w = 0; w < 8; ++w) s += red[w * 64 + F.lane];
            ((float*)(ws + WS_B1P))[kv * 256 + j] = s; }
        __syncthreads();
    }
}

__device__ __forceinline__ void p2_elementwise(Frame& F) {
    unsigned char* ws = F.ws; const int lane = F.lane;
    bf16_t* Q = (bf16_t*)(ws + WS_Q); bf16_t* KV6 = (bf16_t*)(ws + WS_KV6); const bf16_t* C3 = (const bf16_t*)(ws + WS_CONV3); bf16_t* YB = (bf16_t*)(ws + WS_YB);
    const int gw = F.vcu * 8 + F.wave, NGW = F.G * 8;
    float gq[8], gk[8], cw[3][8];
    { const float* g = F.in[I_GQ] + (lane & 7) * 8; const float* g2 = (((lane >> 4) & 1) ? F.in[I_GKW] : F.in[I_GKS]) + (lane & 7) * 8;
#pragma unroll
      for (int k = 0; k < 8; ++k) { gq[k] = g[k] * QSCALE; gk[k] = g2[k]; }
#pragma unroll
      for (int j = 0; j < 3; ++j)
#pragma unroll
          for (int k = 0; k < 8; ++k) cw[j][k] = F.in[I_CONVW][j * CONVW + lane * 8 + k]; }
    for (int run = gw; run < T / 32; run += NGW) {
        const int t0 = run * 32;
        float v1[8], v2[8];
        if ((t0 & (SEQ - 1)) == 0) {
#pragma unroll
            for (int k = 0; k < 8; ++k) { v1[k] = 0.f; v2[k] = 0.f; }
        } else {
            const u32x4 c1 = *(const u32x4*)(C3 + (size_t)(t0 - 1) * 1536 + 512 + lane * 8), u1 = *(const u32x4*)(C3 + (size_t)(t0 - 1) * 1536 + 1024 + lane * 8);
            const u32x4 c2 = *(const u32x4*)(C3 + (size_t)(t0 - 2) * 1536 + 512 + lane * 8), u2 = *(const u32x4*)(C3 + (size_t)(t0 - 2) * 1536 + 1024 + lane * 8);
#pragma unroll
            for (int k = 0; k < 4; ++k) { v1[2 * k] = bflo(c1[k]) * bflo(u1[k]); v1[2 * k + 1] = bfhi(c1[k]) * bfhi(u1[k]); v2[2 * k] = bflo(c2[k]) * bflo(u2[k]); v2[2 * k + 1] = bfhi(c2[k]) * bfhi(u2[k]); }
        }
        for (int tt = 0; tt < 32; ++tt) {
            const size_t tok = (size_t)(t0 + tt);
            { u32x4 w = *(const u32x4*)(Q + tok * 512 + lane * 8); float x[8];
#pragma unroll
              for (int k = 0; k < 4; ++k) { x[2 * k] = bflo(w[k]); x[2 * k + 1] = bfhi(w[k]); }
              float s = 0.f;
#pragma unroll
              for (int k = 0; k < 8; ++k) s += x[k] * x[k];
              s += __shfl_xor(s, 1); s += __shfl_xor(s, 2); s += __shfl_xor(s, 4);
              const float rs = 1.0f / sqrtf(s * (1.f / 64.f) + EPS);
              u32x4 o; o.x = pk2(x[0] * rs * gq[0], x[1] * rs * gq[1]); o.y = pk2(x[2] * rs * gq[2], x[3] * rs * gq[3]); o.z = pk2(x[4] * rs * gq[4], x[5] * rs * gq[5]); o.w = pk2(x[6] * rs * gq[6], x[7] * rs * gq[7]);
              *(u32x4*)(Q + tok * 512 + lane * 8) = o; }
            { const int col = 256 + ((lane >> 4) & 1) * 256 + (lane & 15) * 8; u32x4 w = (u32x4){0u, 0u, 0u, 0u};
              if (lane < 32) w = *(const u32x4*)(KV6 + tok * 768 + col);
              float x[8];
#pragma unroll
              for (int k = 0; k < 4; ++k) { x[2 * k] = bflo(w[k]); x[2 * k + 1] = bfhi(w[k]); }
              float s = 0.f;
#pragma unroll
              for (int k = 0; k < 8; ++k) s += x[k] * x[k];
              s += __shfl_xor(s, 1); s += __shfl_xor(s, 2); s += __shfl_xor(s, 4);
              const float rs = 1.0f / sqrtf(s * (1.f / 64.f) + EPS);
              u32x4 o; o.x = pk2(x[0] * rs * gk[0], x[1] * rs * gk[1]); o.y = pk2(x[2] * rs * gk[2], x[3] * rs * gk[3]); o.z = pk2(x[4] * rs * gk[4], x[5] * rs * gk[5]); o.w = pk2(x[6] * rs * gk[6], x[7] * rs * gk[7]);
              if (lane < 32) *(u32x4*)(KV6 + tok * 768 + col) = o; }
            { const u32x4 b = *(const u32x4*)(C3 + tok * 1536 + lane * 8), c = *(const u32x4*)(C3 + tok * 1536 + 512 + lane * 8), u = *(const u32x4*)(C3 + tok * 1536 + 1024 + lane * 8);
              float v0[8], bb[8], y[8];
#pragma unroll
              for (int k = 0; k < 4; ++k) { v0[2 * k] = bflo(c[k]) * bflo(u[k]); v0[2 * k + 1] = bfhi(c[k]) * bfhi(u[k]); bb[2 * k] = bflo(b[k]); bb[2 * k + 1] = bfhi(b[k]); }
#pragma unroll
              for (int k = 0; k < 8; ++k) { y[k] = bb[k] * (cw[0][k] * v2[k] + cw[1][k] * v1[k] + cw[2][k] * v0[k]); v2[k] = v1[k]; v1[k] = v0[k]; }
              u32x4 o; o.x = pk2(y[0], y[1]); o.y = pk2(y[2], y[3]); o.z = pk2(y[4], y[5]); o.w = pk2(y[6], y[7]);
              *(u32x4*)(YB + tok * 512 + lane * 8) = o; }
        }
    }
}

__device__ __forceinline__ void p3_compress2(Frame& F) {
    unsigned char* ws = F.ws; const int lane = F.lane;
    const bf16_t* HID = (const bf16_t*)(ws + WS_HID);
    LAS float* hr = (LAS float*)(F.lds + F.wave * 1024);
    const int gw = F.vcu * 8 + F.wave, NGW = F.G * 8;
    for (int row = gw; row < 16384; row += NGW) {
        const int kv = row >> 13, n = row & 511;
        if (n == 511) { ((bf16_t*)(ws + (kv ? WS_VC : WS_KC)))[(size_t)(row & 8191) * 64 + lane] = 0; continue; }
        { const u32x2 w = *(const u32x2*)(HID + (size_t)row * 256 + lane * 4); hr[lane * 4 + 0] = bflo(w.x); hr[lane * 4 + 1] = bfhi(w.x); hr[lane * 4 + 2] = bflo(w.y); hr[lane * 4 + 3] = bfhi(w.y); }
        LDS_WAIT(); asm volatile("" ::: "memory");
        const float* w2 = kv ? F.in[I_CVW2] : F.in[I_CKW2];
        float a = (kv ? F.in[I_CVB2] : F.in[I_CKB2])[lane];
#pragma unroll 8
        for (int k = 0; k < 256; ++k) a += hr[k] * w2[k * 64 + lane];
        if (kv == 0) { const float ss = wave_sum(a * a); a = a * (1.0f / sqrtf(ss * (1.f / 64.f) + EPS)) * F.in[I_GKC][lane]; }
        ((bf16_t*)(ws + (kv ? WS_VC : WS_KC)))[(size_t)(row & 8191) * 64 + lane] = (bf16_t)f2bf(a);
        LDS_WAIT(); asm volatile("" ::: "memory");
    }
}

__device__ __forceinline__ float dot64(const bf16_t* krow, const f32x4 (&q4)[16]) {
    float s = 0.f;
#pragma unroll
    for (int c = 0; c < 8; ++c) { const u32x4 w = *(const u32x4*)(krow + 8 * c);
        s += q4[2 * c].x * bflo(w.x) + q4[2 * c].y * bfhi(w.x) + q4[2 * c].z * bflo(w.y) + q4[2 * c].w * bfhi(w.y)
           + q4[2 * c + 1].x * bflo(w.z) + q4[2 * c + 1].y * bfhi(w.z) + q4[2 * c + 1].z * bflo(w.w) + q4[2 * c + 1].w * bfhi(w.w); }
    return s;
}
__device__ __forceinline__ void p4_attn_naive(Frame& F) {
    unsigned char* ws = F.ws; const int lane = F.lane, h = F.wave, g = h >> 2;
    LAS float* SC = (LAS float*)F.lds + h * 1024;
    LAS float* PC = (LAS float*)F.lds + 8192 + h * 512;
    LAS float* PCg = (LAS float*)F.lds + 8192;
    LAS float* QS = (LAS float*)F.lds + 12288 + h * 64;
    LAS float* SCORE = (LAS float*)F.lds + 12800;
    LAS int* SEL = (LAS int*)((LAS float*)F.lds + 13056);
    bf16_t* Q = (bf16_t*)(ws + WS_Q); const bf16_t* KV6 = (const bf16_t*)(ws + WS_KV6);
    const bf16_t* KC = (const bf16_t*)(ws + WS_KC); const bf16_t* VC = (const bf16_t*)(ws + WS_VC); const bf16_t* NG = (const bf16_t*)(ws + WS_NG);
    const float slope2 = exp2f(-(float)(h + 1)) * LOG2E;
    const float NEGB = -1e30f;
    for (int tok = blockIdx.x; tok < T; tok += F.G) {
        const int b = tok >> 13, t = tok & (SEQ - 1), cur = t >> 6;
        QS[lane] = bf2f(Q[(size_t)tok * 512 + h * 64 + lane]);
        LDS_WAIT(); asm volatile("" ::: "memory");
        f32x4 q4[16];
#pragma unroll
        for (int i = 0; i < 16; ++i) q4[i] = *(const LAS f32x4*)(QS + 4 * i);
        const int nvalid = t >= 31 ? ((t - 31) >> 4) + 1 : 0;
        const bf16_t* kcb = KC + (size_t)((b * 2 + g) * 512) * 64; const bf16_t* vcb = VC + (size_t)((b * 2 + g) * 512) * 64;
        float oc = 0.f;
        {
            float mx = NEGB;
            for (int n = lane; n < nvalid; n += 64) { const float x = dot64(kcb + (size_t)n * 64, q4) - slope2 * (float)(t - (16 * n + 31)); SC[n] = x; mx = fmaxf(mx, x); }
            mx = wave_max(mx);
            float sum = 0.f;
            for (int n = lane; n < nvalid; n += 64) { const float p = exp2f(SC[n] - mx); SC[n] = p; sum += p; }
            sum = wave_sum(sum); const float il = nvalid > 0 ? 1.0f / sum : 0.f;
            for (int n = lane; n < 512; n += 64) PC[n] = n < nvalid ? SC[n] * il : 0.f;
            LDS_WAIT(); asm volatile("" ::: "memory");
            for (int n = 0; n < nvalid; ++n) oc += PC[n] * bf2f(vcb[(size_t)n * 64 + lane]);
        }
        __syncthreads();
        if (F.tid < 256) { const int gg = F.tid >> 7, j = F.tid & 127, a = 4 * j; float s = 0.f;
#pragma unroll
            for (int hh = 0; hh < 4; ++hh) { const LAS float* P = PCg + (gg * 4 + hh) * 512; s += (a > 0 ? P[a - 1] : 0.f) + 2.f * (P[a] + P[a + 1] + P[a + 2]) + P[a + 3]; }
            SCORE[gg * 128 + j] = j > cur ? -1e30f : ((j == 0 || j == cur || j == cur - 1) ? 1e30f : s); }
        __syncthreads();
        if (h < 2) { float a = SCORE[h * 128 + lane], bb = SCORE[h * 128 + 64 + lane];
            for (int r = 0; r < NSEL; ++r) { const float m = wave_max(fmaxf(a, bb));
                const unsigned long long ba = __ballot(a == m); int idx;
                if (ba) { idx = __ffsll((long long)ba) - 1; if (lane == idx) a = -3e38f; }
                else { const unsigned long long b2 = __ballot(bb == m); idx = __ffsll((long long)b2) - 1; if (lane == idx) bb = -3e38f; idx += 64; }
                if (lane == 0) SEL[h * 16 + r] = idx; } }
        __syncthreads();
        float os = 0.f;
        {
            float mx = NEGB;
            for (int r = 0; r < NSEL; ++r) { const int j = SEL[g * 16 + r]; float x = NEGB;
                if (j <= cur) { const int pos = 64 * j + lane; if (pos <= t) x = dot64(KV6 + (size_t)(b * SEQ + pos) * 768 + 256 + g * 64, q4) - slope2 * (float)(t - pos); }
                SC[r * 64 + lane] = x; mx = fmaxf(mx, x); }
            mx = wave_max(mx); float sum = 0.f;
            for (int r = 0; r < NSEL; ++r) { const float p = exp2f(SC[r * 64 + lane] - mx); SC[r * 64 + lane] = p; sum += p; }
            sum = wave_sum(sum); const float il = 1.0f / sum;
            LDS_WAIT(); asm volatile("" ::: "memory");
            for (int r = 0; r < NSEL; ++r) { const int j = SEL[g * 16 + r]; if (j > cur) continue;
                const bf16_t* vb = KV6 + (size_t)(b * SEQ + 64 * j) * 768 + 384 + g * 64 + lane; const int kmax = (64 * j + 63 <= t) ? 64 : (t - 64 * j + 1);
                for (int kk = 0; kk < kmax; ++kk) os += SC[r * 64 + kk] * bf2f(vb[(size_t)kk * 768]); }
            os *= il;
        }
        float ow = 0.f;
        {
            float mx = NEGB;
            for (int i = lane; i < WIN; i += 64) { const int pos = t - (WIN - 1) + i; float x = NEGB;
                if (pos >= 0) x = dot64(KV6 + (size_t)(b * SEQ + pos) * 768 + 512 + g * 64, q4) - slope2 * (float)(t - pos);
                SC[i] = x; mx = fmaxf(mx, x); }
            mx = wave_max(mx); float sum = 0.f;
            for (int i = lane; i < WIN; i += 64) { const float p = exp2f(SC[i] - mx); SC[i] = p; sum += p; }
            sum = wave_sum(sum); const float il = 1.0f / sum;
            LDS_WAIT(); asm volatile("" ::: "memory");
            const int i0 = t >= WIN - 1 ? 0 : (WIN - 1 - t);
            for (int i = i0; i < WIN; ++i) { const int pos = t - (WIN - 1) + i; ow += SC[i] * bf2f(KV6[(size_t)(b * SEQ + pos) * 768 + 640 + g * 64 + lane]); }
            ow *= il;
        }
        const float g0 = bf2f(NG[(size_t)tok * 32 + h * 3 + 0]), g1 = bf2f(NG[(size_t)tok * 32 + h * 3 + 1]), g2 = bf2f(NG[(size_t)tok * 32 + h * 3 + 2]);
        ((bf16_t*)(ws + WS_OA))[(size_t)tok * 512 + h * 64 + lane] = (bf16_t)f2bf(g0 * oc + g1 * os + g2 * ow);
        __syncthreads();
    }
}

namespace at {
typedef __attribute__((address_space(3))) const char* lcp;
typedef short s16x4 __attribute__((ext_vector_type(4)));
typedef float f32x16 __attribute__((ext_vector_type(16)));
typedef short v4i16_t __attribute__((ext_vector_type(4)));
constexpr int SLOTB = 8192;
constexpr int L_K = 0, L_V = 3 * SLOTB, L_WS = 6 * SLOTB, L_OST = L_WS + 8 * 256, L_IMP = L_OST  , L_SELM = L_OST + 8 * 8192, L_UNION = L_SELM + 1024, L_NTL = L_UNION + 16, L_TL = L_NTL + 16, L_END = L_TL + 512;
static_assert(L_END <= RING_BYTES, "attention LDS");
constexpr float NEGBIG = -1e30f;
__device__ __forceinline__ void glds16(const void* gsrc, unsigned lds_dst) { unsigned keep;
    asm volatile("s_mov_b32 %0, m0\n\ts_mov_b32 m0, %2\n\ts_nop 0\n\tglobal_load_lds_dwordx4 %1, off\n\ts_mov_b32 m0, %0" : "=&s"(keep) : "v"(gsrc), "s"(lds_dst) : "memory"); }
__device__ __forceinline__ unsigned cvtpk(float lo, float hi) { unsigned r; asm("v_cvt_pk_bf16_f32 %0, %1, %2" : "=v"(r) : "v"(lo), "v"(hi)); return r; }
#define AT_WAIT_BAR(N) asm volatile("s_waitcnt vmcnt(" #N ") lgkmcnt(0)\n\ts_barrier" ::: "memory")
#define AT_SBAR() __builtin_amdgcn_sched_barrier(0)

template <int KMUL, int MODE>
__device__ __forceinline__ void qk_tile(f32x16& p0, f32x16& p1, lcp kp, const bf16x8 (&qr)[4], float cinit, float slope2, int klim2) {
    f32x16 c;
#pragma unroll
    for (int r = 0; r < 16; ++r) c[r] = cinit;
#pragma unroll
    for (int d0 = 0; d0 < 4; ++d0) {
        const bf16x8 b0 = *(const LAS bf16x8*)(kp + d0 * 2048), b1 = *(const LAS bf16x8*)(kp + d0 * 2048 + 512);
        if (d0 == 0) { p0 = __builtin_amdgcn_mfma_f32_32x32x16_bf16(b0, qr[0], c, 0, 0, 0); p1 = __builtin_amdgcn_mfma_f32_32x32x16_bf16(b1, qr[0], c, 0, 0, 0); }
        else { p0 = __builtin_amdgcn_mfma_f32_32x32x16_bf16(b0, qr[d0], p0, 0, 0, 0); p1 = __builtin_amdgcn_mfma_f32_32x32x16_bf16(b1, qr[d0], p1, 0, 0, 0); }
    }
#pragma unroll
    for (int r = 0; r < 16; ++r) { const int lit = (r & 3) + 8 * (r >> 2);
        float a = slope2 * (float)(KMUL * lit) + p0[r], b = slope2 * (float)(KMUL * (lit + 32)) + p1[r];
        if (MODE == 1) { a = (lit <= klim2) ? a : NEGBIG; b = (lit + 32 <= klim2) ? b : NEGBIG; }
        if (MODE == 2) { a = (lit > klim2) ? a : NEGBIG; b = (lit + 32 > klim2) ? b : NEGBIG; }
        p0[r] = __builtin_amdgcn_exp2f(a); p1[r] = __builtin_amdgcn_exp2f(b); }
}
__device__ __forceinline__ float psum(const f32x16& p0, const f32x16& p1) {
    float a = 0.f, b = 0.f;
#pragma unroll
    for (int r = 0; r < 16; r += 2) { a += p0[r] + p1[r]; b += p0[r + 1] + p1[r + 1]; }
    return a + b;
}
__device__ __forceinline__ void pv_tile(f32x16* o, int vb, const f32x16& p0, const f32x16& p1) {
    u32x4 pw[4];
#pragma unroll
    for (int i = 0; i < 4; ++i) { pw[0][i] = cvtpk(p0[2 * i], p0[2 * i + 1]); pw[1][i] = cvtpk(p0[8 + 2 * i], p0[9 + 2 * i]); pw[2][i] = cvtpk(p1[2 * i], p1[2 * i + 1]); pw[3][i] = cvtpk(p1[8 + 2 * i], p1[9 + 2 * i]); }
#pragma unroll
    for (int dh = 0; dh < 2; ++dh) { s16x4 lo[4], hi[4];
#pragma unroll
        for (int ks = 0; ks < 4; ++ks) {
            asm volatile("ds_read_b64_tr_b16 %0,%1 offset:%c2" : "=&v"(lo[ks]) : "v"(vb), "i"(dh * 4096 + ks * 1024) : "memory");
            asm volatile("ds_read_b64_tr_b16 %0,%1 offset:%c2" : "=&v"(hi[ks]) : "v"(vb), "i"(dh * 4096 + ks * 1024 + 512) : "memory"); }
        asm volatile("s_waitcnt lgkmcnt(0)" ::: "memory"); AT_SBAR();
#define AT_PK(k) (bf16x8){lo[k][0], lo[k][1], lo[k][2], lo[k][3], hi[k][0], hi[k][1], hi[k][2], hi[k][3]}
        o[dh] = __builtin_amdgcn_mfma_f32_32x32x16_bf16(__builtin_bit_cast(bf16x8, pw[0]), AT_PK(0), o[dh], 0, 0, 0);
        o[dh] = __builtin_amdgcn_mfma_f32_32x32x16_bf16(__builtin_bit_cast(bf16x8, pw[1]), AT_PK(1), o[dh], 0, 0, 0);
        o[dh] = __builtin_amdgcn_mfma_f32_32x32x16_bf16(__builtin_bit_cast(bf16x8, pw[2]), AT_PK(2), o[dh], 0, 0, 0);
        o[dh] = __builtin_amdgcn_mfma_f32_32x32x16_bf16(__builtin_bit_cast(bf16x8, pw[3]), AT_PK(3), o[dh], 0, 0, 0);
#undef AT_PK
    }
}
}

__device__ __forceinline__ void p4_attn(Frame& F) {
    using namespace at;
    unsigned char* ws = F.ws; const int wid = F.wave;
    LAS unsigned char* lds = F.lds;
    const unsigned lds0 = (unsigned)(uintptr_t)lds;
    bf16_t* Q = (bf16_t*)(ws + WS_Q); const bf16_t* KV6 = (const bf16_t*)(ws + WS_KV6);
    const bf16_t* KC = (const bf16_t*)(ws + WS_KC); const bf16_t* VC = (const bf16_t*)(ws + WS_VC); const bf16_t* NG = (const bf16_t*)(ws + WS_NG);
    LAS unsigned* selm = (LAS unsigned*)(lds + L_SELM);
    LAS unsigned* uni = (LAS unsigned*)(lds + L_UNION);
    LAS int* ntl = (LAS int*)(lds + L_NTL);
    LAS int* tl = (LAS int*)(lds + L_TL);
    float MREF;
    { float gqm = fabsf(F.in[I_GQ][F.lane]), gkm = fmaxf(fmaxf(fabsf(F.in[I_GKC][F.lane]), fabsf(F.in[I_GKS][F.lane])), fabsf(F.in[I_GKW][F.lane]));
      gqm = wave_max(gqm); gkm = wave_max(gkm); MREF = 64.0f * QSCALE * gqm * gkm * 1.03f; }
    const unsigned kdst = lds0 + L_K + wid * 1024, vdst = lds0 + L_V + wid * 1024;
    for (int ui = 0; ui < 8; ++ui) {
        if (F.G != 256) break;
        int lane = F.lane; asm volatile("" : "+v"(lane));
        const int r32 = lane & 31, hi = lane >> 5, hh = r32 >> 3, qi = r32 & 7;
        LAS float* wsf = (LAS float*)(lds + L_WS) + wid * 64;
        LAS float* impw = (LAS float*)(lds + L_IMP) + wid * 2048;
        LAS float* ostg = (LAS float*)(lds + L_OST) + wid * 2048;
        const lcp kp0 = (lcp)lds + L_K + hi * 1024 + r32 * 16;
        const int vb0 = (int)(lds0 + L_V) + ((lane >> 4) & 1) * 32 + (lane & 3) * 8 + (4 * hi + ((lane & 15) >> 2)) * 64;
        const int bg = F.vcu >> 4, s16 = F.vcu & 15;
        const int qt = (ui >> 1) * 32 + ((ui & 1) ? 31 - s16 : s16);
        const int b = bg >> 1, g = bg & 1, q0 = qt * 64, cur = qt;
        const int tq = q0 + 8 * wid + qi, qoff = 8 * wid + qi;
        const int h = 4 * g + hh;
        const float slope2 = exp2f(-(float)(h + 1)) * LOG2E;
        const size_t tok = (size_t)b * SEQ + tq;
        bf16x8 qr[4];
#pragma unroll
        for (int d0 = 0; d0 < 4; ++d0) qr[d0] = *(const bf16x8*)(Q + tok * 512 + h * 64 + d0 * 16 + hi * 8);
        const float g0 = bf2f(NG[tok * 32 + h * 3 + 0]), g1 = bf2f(NG[tok * 32 + h * 3 + 1]), g2 = bf2f(NG[tok * 32 + h * 3 + 2]);
        f32x16 o[2], p0, p1;
#pragma unroll
        for (int i = 0; i < 4; ++i) *(LAS f32x4*)(impw + (i * 64 + lane) * 4) = (f32x4){0.f, 0.f, 0.f, 0.f};
        if (F.tid < 4) uni[F.tid] = 0u;
        const bf16_t* kcb = KC + (size_t)(b * 2 + g) * 512 * 64; const bf16_t* vcb = VC + (size_t)(b * 2 + g) * 512 * 64;
        const int ntc = (4 * cur + 3 + 63) >> 6;
        const int nmax = tq >= 31 ? ((tq - 31) >> 4) : -1;
        const int nfull = cur >= 1 ? (4 * cur - 2) : -1;
        float lsum = 0.f;
#define AT_KSRC_C(t) (kcb + (size_t)(64 * (t) + lane) * 64 + wid * 8)
#define AT_VSRC_C(t) (vcb + (size_t)(64 * (t) + 16 * (wid & 3) + (lane >> 2)) * 64 + (wid >> 2) * 32 + (lane & 3) * 8)
        if (ntc > 0) {
            glds16(AT_KSRC_C(0), kdst); if (ntc > 1) glds16(AT_KSRC_C(1), kdst + SLOTB);
            for (int t = 0; t < ntc; ++t) {
                if (t + 1 < ntc) { AT_WAIT_BAR(1); } else { AT_WAIT_BAR(0); }
                if (t + 2 < ntc) glds16(AT_KSRC_C(t + 2), kdst + ((t + 2) % 3) * SLOTB);
                const float cinit = -slope2 * (float)(tq - 31 - 1024 * t) + slope2 * (float)(64 * hi) - MREF;
                const int klim2 = nmax - 64 * t - 4 * hi;
                if (64 * t + 63 <= nfull) qk_tile<16, 0>(p0, p1, kp0 + (t % 3) * SLOTB, qr, cinit, slope2, 0);
                else qk_tile<16, 1>(p0, p1, kp0 + (t % 3) * SLOTB, qr, cinit, slope2, klim2);
                lsum += psum(p0, p1);
            }
            AT_WAIT_BAR(0);
        }
        lsum += __shfl_xor(lsum, 32);
        const float lg2l = lsum > 0.f ? __builtin_amdgcn_logf(lsum) : 0.f;
        o[0] = f32x16{}; o[1] = f32x16{};
        if (ntc > 0) {
            float cin = 0.f;
            glds16(AT_KSRC_C(0), kdst); glds16(AT_VSRC_C(0), vdst); if (ntc > 1) { glds16(AT_KSRC_C(1), kdst + SLOTB); glds16(AT_VSRC_C(1), vdst + SLOTB); }
            for (int t = 0; t < ntc; ++t) {
                if (t + 1 < ntc) { AT_WAIT_BAR(2); } else { AT_WAIT_BAR(0); }
                if (t + 2 < ntc) { glds16(AT_KSRC_C(t + 2), kdst + ((t + 2) % 3) * SLOTB); glds16(AT_VSRC_C(t + 2), vdst + ((t + 2) % 3) * SLOTB); }
                const float cinit = -slope2 * (float)(tq - 31 - 1024 * t) + slope2 * (float)(64 * hi) - MREF - lg2l;
                const int klim2 = nmax - 64 * t - 4 * hi;
                if (64 * t + 63 <= nfull) qk_tile<16, 0>(p0, p1, kp0 + (t % 3) * SLOTB, qr, cinit, slope2, 0);
                else qk_tile<16, 1>(p0, p1, kp0 + (t % 3) * SLOTB, qr, cinit, slope2, klim2);
                float mn[8], cy[8];
#pragma unroll
                for (int a = 0; a < 4; ++a) { mn[a] = 2.f * (p0[4 * a] + p0[4 * a + 1] + p0[4 * a + 2]) + p0[4 * a + 3]; cy[a] = p0[4 * a + 3];
                                              mn[4 + a] = 2.f * (p1[4 * a] + p1[4 * a + 1] + p1[4 * a + 2]) + p1[4 * a + 3]; cy[4 + a] = p1[4 * a + 3]; }
                float rc[8];
#pragma unroll
                for (int a = 0; a < 8; ++a) rc[a] = __shfl_xor(cy[a], 32);
                if (hi) {
#pragma unroll
                    for (int a = 0; a < 8; ++a) mn[a] += rc[a];
                } else { mn[0] += cin;
#pragma unroll
                    for (int a = 1; a < 8; ++a) mn[a] += rc[a - 1];
                    cin = rc[7]; }
#pragma unroll
                for (int a = 0; a < 8; ++a) { mn[a] += __shfl_xor(mn[a], 8); mn[a] += __shfl_xor(mn[a], 16); }
                if (hh == 0) {
#pragma unroll
                    for (int a = 0; a < 8; ++a) impw[qi * 128 + 16 * t + 2 * a + hi] = mn[a]; }
                pv_tile(o, vb0 + (t % 3) * SLOTB, p0, p1);
            }
            AT_WAIT_BAR(0);
        }
        {
            const int qi8 = lane >> 3, s8 = lane & 7;
            unsigned key[16];
#pragma unroll
            for (int k = 0; k < 16; ++k) { const int j = s8 + 8 * k; const float v = impw[qi8 * 128 + j];
                const bool forced = (j == 0) || (j == cur) || (j == cur - 1);
                key[k] = j > cur ? 0u : ((forced ? 0xFFFFFF80u : (__builtin_bit_cast(unsigned, v) & 0xFFFFFF80u)) | (unsigned)(127 - j)); }
            unsigned bits = 0u;
            for (int rnd = 0; rnd < NSEL; ++rnd) {
                unsigned m = key[0];
#pragma unroll
                for (int k = 1; k < 16; ++k) m = m > key[k] ? m : key[k];
                { unsigned t2 = (unsigned)__shfl_xor((int)m, 1); m = m > t2 ? m : t2; t2 = (unsigned)__shfl_xor((int)m, 2); m = m > t2 ? m : t2; t2 = (unsigned)__shfl_xor((int)m, 4); m = m > t2 ? m : t2; }
#pragma unroll
                for (int k = 0; k < 16; ++k) { const bool hit = (key[k] == m) && (m != 0u); bits |= hit ? (1u << k) : 0u; key[k] = hit ? 0u : key[k]; }
            }
            unsigned w4[4];
#pragma unroll
            for (int q = 0; q < 4; ++q) { unsigned w = 0u;
#pragma unroll
                for (int kk = 0; kk < 4; ++kk) w |= ((bits >> (4 * q + kk)) & 1u) << (s8 + 8 * kk);
                w |= (unsigned)__shfl_xor((int)w, 1); w |= (unsigned)__shfl_xor((int)w, 2); w |= (unsigned)__shfl_xor((int)w, 4); w4[q] = w; }
            if (s8 == 0) {
#pragma unroll
                for (int q = 0; q < 4; ++q) { selm[(8 * wid + qi8) * 4 + q] = w4[q]; __hip_atomic_fetch_or(&uni[q], w4[q], __ATOMIC_RELAXED, __HIP_MEMORY_SCOPE_WORKGROUP); } }
        }
        { if (hi == 0) wsf[r32] = g0; LDS_WAIT(); asm volatile("" ::: "memory");
#pragma unroll
          for (int a = 0; a < 4; ++a) { const f32x4 sc = *(const LAS f32x4*)(wsf + 8 * a + 4 * hi);
#pragma unroll
              for (int k = 0; k < 4; ++k) { const int c = 8 * a + 4 * hi + k; ostg[c * 64 + r32] = o[0][4 * a + k] * sc[k]; ostg[c * 64 + 32 + r32] = o[1][4 * a + k] * sc[k]; } }
          LDS_WAIT(); asm volatile("" ::: "memory"); }
        AT_WAIT_BAR(0);
        if (F.tid < 128) { const int j = F.tid; const unsigned u0 = uni[0], u1 = uni[1], u2 = uni[2], u3 = uni[3];
            const unsigned wsel = j < 32 ? u0 : j < 64 ? u1 : j < 96 ? u2 : u3;
            if ((wsel >> (j & 31)) & 1u) { int pos = __builtin_popcount(wsel & ((1u << (j & 31)) - 1u));
                if (j >= 32) pos += __builtin_popcount(u0); if (j >= 64) pos += __builtin_popcount(u1); if (j >= 96) pos += __builtin_popcount(u2);
                tl[pos] = j; }
            if (j == 0) ntl[0] = __builtin_popcount(u0) + __builtin_popcount(u1) + __builtin_popcount(u2) + __builtin_popcount(u3); }
        AT_WAIT_BAR(0);
        {
            const int nt = __builtin_amdgcn_readfirstlane(ntl[0]);
            const bf16_t* ksb = KV6 + (size_t)b * SEQ * 768 + 256 + g * 64; const bf16_t* vsb = KV6 + (size_t)b * SEQ * 768 + 384 + g * 64;
#define AT_KSRC_S(j) (ksb + (size_t)(64 * (j) + lane) * 768 + wid * 8)
#define AT_VSRC_S(j) (vsb + (size_t)(64 * (j) + 16 * (wid & 3) + (lane >> 2)) * 768 + (wid >> 2) * 32 + (lane & 3) * 8)
#define AT_TL(i) __builtin_amdgcn_readfirstlane(tl[i])
            o[0] = f32x16{}; o[1] = f32x16{}; lsum = 0.f;
            const unsigned m0 = selm[(8 * wid + qi) * 4 + 0], m1 = selm[(8 * wid + qi) * 4 + 1], m2 = selm[(8 * wid + qi) * 4 + 2], m3 = selm[(8 * wid + qi) * 4 + 3];
            if (nt > 0) {
                { const int j0 = AT_TL(0); glds16(AT_KSRC_S(j0), kdst); glds16(AT_VSRC_S(j0), vdst); }
                if (nt > 1) { const int j1 = AT_TL(1); glds16(AT_KSRC_S(j1), kdst + SLOTB); glds16(AT_VSRC_S(j1), vdst + SLOTB); }
                for (int t = 0; t < nt; ++t) {
                    if (t + 1 < nt) { AT_WAIT_BAR(2); } else { AT_WAIT_BAR(0); }
                    if (t + 2 < nt) { const int j2 = AT_TL(t + 2); glds16(AT_KSRC_S(j2), kdst + ((t + 2) % 3) * SLOTB); glds16(AT_VSRC_S(j2), vdst + ((t + 2) % 3) * SLOTB); }
                    const int j = AT_TL(t);
                    const unsigned mw = j < 32 ? m0 : j < 64 ? m1 : j < 96 ? m2 : m3;
                    const bool mine = (mw >> (j & 31)) & 1u;
                    if (__any(mine)) {
                        const float cinit = mine ? (-slope2 * (float)(tq - 64 * j) + slope2 * (float)(4 * hi) - MREF) : NEGBIG;
                        if (j == cur) qk_tile<1, 1>(p0, p1, kp0 + (t % 3) * SLOTB, qr, cinit, slope2, qoff - 4 * hi);
                        else qk_tile<1, 0>(p0, p1, kp0 + (t % 3) * SLOTB, qr, cinit, slope2, 0);
                        lsum += psum(p0, p1);
                        pv_tile(o, vb0 + (t % 3) * SLOTB, p0, p1);
                    }
                }
                AT_WAIT_BAR(0);
            }
            lsum += __shfl_xor(lsum, 32);
            if (hi == 0) wsf[r32] = g1 / lsum; LDS_WAIT(); asm volatile("" ::: "memory");
#pragma unroll
            for (int a = 0; a < 4; ++a) { const f32x4 sc = *(const LAS f32x4*)(wsf + 8 * a + 4 * hi);
#pragma unroll
                for (int k = 0; k < 4; ++k) { const int c = 8 * a + 4 * hi + k; ostg[c * 64 + r32] += o[0][4 * a + k] * sc[k]; ostg[c * 64 + 32 + r32] += o[1][4 * a + k] * sc[k]; } }
            LDS_WAIT(); asm volatile("" ::: "memory");
        }
        {
            const bf16_t* kwb = KV6 + (size_t)b * SEQ * 768 + 512 + g * 64; const bf16_t* vwb = KV6 + (size_t)b * SEQ * 768 + 640 + g * 64;
#define AT_KSRC_W(p) (kwb + (size_t)((p) + lane) * 768 + wid * 8)
#define AT_VSRC_W(p) (vwb + (size_t)((p) + 16 * (wid & 3) + (lane >> 2)) * 768 + (wid >> 2) * 32 + (lane & 3) * 8)
            const int wi0 = cur >= 8 ? 0 : 8 - cur; const int nt = 9 - wi0; const int pbase = q0 - 512 + 64 * wi0;
            o[0] = f32x16{}; o[1] = f32x16{}; lsum = 0.f;
            glds16(AT_KSRC_W(pbase), kdst); glds16(AT_VSRC_W(pbase), vdst);
            if (nt > 1) { glds16(AT_KSRC_W(pbase + 64), kdst + SLOTB); glds16(AT_VSRC_W(pbase + 64), vdst + SLOTB); }
            for (int t = 0; t < nt; ++t) {
                if (t + 1 < nt) { AT_WAIT_BAR(2); } else { AT_WAIT_BAR(0); }
                if (t + 2 < nt) { glds16(AT_KSRC_W(pbase + 64 * (t + 2)), kdst + ((t + 2) % 3) * SLOTB); glds16(AT_VSRC_W(pbase + 64 * (t + 2)), vdst + ((t + 2) % 3) * SLOTB); }
                const int pos0 = pbase + 64 * t, wi = wi0 + t;
                const float cinit = -slope2 * (float)(tq - pos0) + slope2 * (float)(4 * hi) - MREF;
                if (wi == 8) qk_tile<1, 1>(p0, p1, kp0 + (t % 3) * SLOTB, qr, cinit, slope2, qoff - 4 * hi);
                else if (wi == 0) qk_tile<1, 2>(p0, p1, kp0 + (t % 3) * SLOTB, qr, cinit, slope2, qoff - 4 * hi);
                else qk_tile<1, 0>(p0, p1, kp0 + (t % 3) * SLOTB, qr, cinit, slope2, 0);
                lsum += psum(p0, p1);
                pv_tile(o, vb0 + (t % 3) * SLOTB, p0, p1);
            }
            AT_WAIT_BAR(0);
            lsum += __shfl_xor(lsum, 32);
            if (hi == 0) wsf[r32] = g2 / lsum; LDS_WAIT(); asm volatile("" ::: "memory");
#pragma unroll
            for (int a = 0; a < 4; ++a) { const f32x4 sc = *(const LAS f32x4*)(wsf + 8 * a + 4 * hi);
#pragma unroll
                for (int k = 0; k < 4; ++k) { const int c = 8 * a + 4 * hi + k; ostg[c * 64 + r32] += o[0][4 * a + k] * sc[k]; ostg[c * 64 + 32 + r32] += o[1][4 * a + k] * sc[k]; } }
            LDS_WAIT(); asm volatile("" ::: "memory");
        }
        {
#pragma unroll
          for (int i = 0; i < 4; ++i) { const int row = i * 8 + (lane >> 3), ch = lane & 7; const f32x4 a = *(const LAS f32x4*)(ostg + row * 64 + ch * 8), c2 = *(const LAS f32x4*)(ostg + row * 64 + ch * 8 + 4);
              u32x4 v; v.x = pk2(a.x, a.y); v.y = pk2(a.z, a.w); v.z = pk2(c2.x, c2.y); v.w = pk2(c2.z, c2.w);
              *(u32x4*)((bf16_t*)(ws + WS_OA) + ((size_t)b * SEQ + q0 + 8 * wid + (row & 7)) * 512 + (4 * g + (row >> 3)) * 64 + ch * 8) = v; }
          LDS_WAIT(); asm volatile("" ::: "memory"); }
    }
#undef AT_KSRC_C
#undef AT_VSRC_C
#undef AT_KSRC_S
#undef AT_VSRC_S
#undef AT_KSRC_W
#undef AT_VSRC_W
#undef AT_TL
}

__device__ __forceinline__ void p7_route(Frame& F) {
    unsigned char* ws = F.ws; const int lane = F.lane;
    LAS float* WR = (LAS float*)F.lds;
    LAS int* CNT = (LAS int*)(F.lds + MISC_OFF + 256);
    for (int i = F.tid; i < DM * NEXP; i += 512) WR[i] = F.in[I_WR][(i & 1023) * NEXP + (i >> 10)];
    __syncthreads();
    int* TOPE = (int*)(ws + WS_TOPE); float* TOPW = (float*)(ws + WS_TOPW); int* CNTG = (int*)(ws + WS_CNT);
    unsigned char* H2 = (unsigned char*)(ws + WS_H2);
    const float* X1 = F.out;
    for (int vw = blockIdx.x; vw < 256; vw += F.G) {
        if (F.tid < 32) CNT[F.tid] = 0;
        __syncthreads();
        for (int rr = 0; rr < 32; ++rr) {
            const int tok = vw * 256 + F.wave * 32 + rr;
            const f32x4* xr = (const f32x4*)(X1 + (size_t)tok * DM) + lane; const f32x4* gr = (const f32x4*)F.in[I_GN2] + lane;
            f32x4 v[4]; float s = 0.f;
#pragma unroll
            for (int j = 0; j < 4; ++j) { v[j] = xr[64 * j]; s += (v[j].x * v[j].x + v[j].y * v[j].y) + (v[j].z * v[j].z + v[j].w * v[j].w); }
            const float rs = 1.0f / sqrtf(wave_sum(s) * (1.f / DM) + EPS);
            unsigned* o4 = (unsigned*)(H2 + (size_t)tok * DM) + lane;
#pragma unroll
            for (int j = 0; j < 4; ++j) { const f32x4 gg = gr[64 * j]; v[j].x *= rs * gg.x; v[j].y *= rs * gg.y; v[j].z *= rs * gg.z; v[j].w *= rs * gg.w;
                o4[64 * j] = pg8::pk4_fp8(v[j].x, v[j].y, v[j].z, v[j].w); }
            float pe[32];
#pragma unroll
            for (int e = 0; e < 32; ++e) { float a = 0.f;
#pragma unroll
                for (int j = 0; j < 4; ++j) { const f32x4 w = *(const LAS f32x4*)(WR + e * 1024 + 4 * lane + 256 * j); a += v[j].x * w.x + v[j].y * w.y + v[j].z * w.z + v[j].w * w.w; }
                pe[e] = a; }
#pragma unroll
            for (int e = 0; e < 16; ++e) { const bool up = (lane & 16) != 0; const float send = up ? pe[e] : pe[e + 16], keep = up ? pe[e + 16] : pe[e]; pe[e] = keep + __shfl_xor(send, 16); }
#pragma unroll
            for (int e = 0; e < 8; ++e) { const bool up = (lane & 8) != 0; const float send = up ? pe[e] : pe[e + 8], keep = up ? pe[e + 8] : pe[e]; pe[e] = keep + __shfl_xor(send, 8); }
#pragma unroll
            for (int e = 0; e < 4; ++e) { const bool up = (lane & 4) != 0; const float send = up ? pe[e] : pe[e + 4], keep = up ? pe[e + 4] : pe[e]; pe[e] = keep + __shfl_xor(send, 4); }
#pragma unroll
            for (int e = 0; e < 2; ++e) { const bool up = (lane & 2) != 0; const float send = up ? pe[e] : pe[e + 2], keep = up ? pe[e + 2] : pe[e]; pe[e] = keep + __shfl_xor(send, 2); }
            { const bool up = (lane & 1) != 0; const float send = up ? pe[0] : pe[1], keep = up ? pe[1] : pe[0]; pe[0] = keep + __shfl_xor(send, 1); }
            float lg = pe[0] + __shfl_xor(pe[0], 32);
            lg += F.in[I_BR][lane & 31];
            float tv[4]; int te[4];
#pragma unroll
            for (int r = 0; r < 4; ++r) { const float m = wave_max(lg); const unsigned long long bm = __ballot(lg == m) & 0xffffffffull; const int idx = __ffsll((long long)bm) - 1;
                tv[r] = m; te[r] = idx; if ((lane & 31) == idx) lg = -3e38f; }
            const float e1 = __expf(tv[1] - tv[0]), e2 = __expf(tv[2] - tv[0]), e3 = __expf(tv[3] - tv[0]); const float inv = 1.0f / (1.0f + e1 + e2 + e3);
            if (lane == 0) { *(int4*)(TOPE + (size_t)tok * 4) = make_int4(te[0], te[1], te[2], te[3]); *(float4*)(TOPW + (size_t)tok * 4) = make_float4(inv, e1 * inv, e2 * inv, e3 * inv); }
            if (lane < 4) { const int e = lane == 0 ? te[0] : lane == 1 ? te[1] : lane == 2 ? te[2] : te[3]; __hip_atomic_fetch_add(&CNT[e], 1, __ATOMIC_RELAXED, __HIP_MEMORY_SCOPE_WORKGROUP); }
        }
        __syncthreads();
        if (F.tid < 32) CNTG[vw * 32 + F.tid] = CNT[F.tid];
        __syncthreads();
    }
}

__device__ __forceinline__ void p8_scatter(Frame& F) {
    unsigned char* ws = F.ws;
    LAS int* CN = (LAS int*)F.lds;
    LAS int* BASE = (LAS int*)(F.lds + 32768);
    LAS int* TS = (LAS int*)(F.lds + 32768 + 256);
    LAS int* TOT = (LAS int*)(F.lds + 32768 + 512);
    LAS int* LE = (LAS int*)(F.lds + 36864);
    LAS int* LS = (LAS int*)(F.lds + 36864 + 4096);
    const int* CNTG = (const int*)(ws + WS_CNT); const int* TOPE = (const int*)(ws + WS_TOPE); const float* TOPW = (const float*)(ws + WS_TOPW);
    int* INV = (int*)(ws + WS_INV);
    for (int vw = blockIdx.x; vw < 256; vw += F.G) {
        const int ch = vw / WPC, wl = vw % WPC;
        unsigned* ROWTOK = (unsigned*)(ws + WS_ROWTOK) + (size_t)ch * SLOTS_CH; float* ROWW = (float*)(ws + WS_ROWW) + (size_t)ch * SLOTS_CH;
        for (int i = F.tid; i < WPC * 32; i += 512) CN[i] = CNTG[ch * WPC * 32 + i];
        for (int i = F.tid; i < 1024; i += 512) LE[i] = TOPE[(size_t)vw * 1024 + i];
        __syncthreads();
        if (F.tid < 32) { int tot = 0, pre = 0; for (int w = 0; w < WPC; ++w) { const int c = CN[w * 32 + F.tid]; if (w < wl) pre += c; tot += c; } TOT[F.tid] = tot; BASE[F.tid] = pre; }
        __syncthreads();
        if (F.tid == 0) { int ts = 0; for (int e = 0; e < 32; ++e) { TS[e] = ts; ts += (TOT[e] + 255) >> 8; } TS[32] = ts; }
        __syncthreads();
        if (F.tid < 32) { const int e = F.tid; int pos = TS[e] * 256 + BASE[e]; for (int i = 0; i < 1024; ++i) if (LE[i] == e) LS[i] = pos++; }
        __syncthreads();
        for (int i = F.tid; i < 1024; i += 512) { const int slot = LS[i]; const int tok = vw * 256 + (i >> 2); ROWTOK[slot] = (unsigned)tok * 1024u; ROWW[slot] = TOPW[(size_t)vw * 1024 + i]; INV[(size_t)vw * 1024 + i] = slot; }
        if (wl < 32) { const int e = wl; const int lo = TS[e] * 256 + TOT[e], hi = TS[e + 1] * 256; for (int s = lo + F.tid; s < hi; s += 512) { ROWTOK[s] = (unsigned)(ch * TCH) * 1024u; ROWW[s] = 0.f; } }
        if (wl == 0 && F.tid < 33) ((int*)(ws + WS_TSTART))[ch * 64 + F.tid] = TS[F.tid];
        __syncthreads();
    }
}

__device__ __forceinline__ void p_combine(Frame& F, int ch) {
    unsigned char* ws = F.ws; const int lane = F.lane;
    const bf16_t* Y = (const bf16_t*)(ws + WS_YBUF); const int* INV = (const int*)(ws + WS_INV);
    const int gw = F.vcu * 8 + F.wave, NGW = F.G * 8;
    for (int i = gw; i < TCH; i += NGW) {
        const int tok = ch * TCH + i; const int4 sl = *(const int4*)(INV + (size_t)tok * 4);
        float* o = F.out + (size_t)tok * DM;
#pragma unroll
        for (int hh = 0; hh < 2; ++hh) { const int col = hh * 512 + lane * 8;
            f32x4 a0 = *(const f32x4*)(o + col), a1 = *(const f32x4*)(o + col + 4);
            const int ss[4] = {sl.x, sl.y, sl.z, sl.w};
#pragma unroll
            for (int k = 0; k < 4; ++k) { const u32x4 w = *(const u32x4*)(Y + (size_t)ss[k] * 1024 + col);
                a0.x += bflo(w.x); a0.y += bfhi(w.x); a0.z += bflo(w.y); a0.w += bfhi(w.y); a1.x += bflo(w.z); a1.y += bfhi(w.z); a1.z += bflo(w.w); a1.w += bfhi(w.w); }
            *(f32x4*)(o + col) = a0; *(f32x4*)(o + col + 4) = a1; }
    }
}

__global__ void __launch_bounds__(512, 2) mk_fwd(Args args) {
    extern __shared__ __attribute__((aligned(16))) unsigned char lds_raw[];
    Frame F;
    F.lds = (LAS unsigned char*)lds_raw;
    F.tid = threadIdx.x; F.lane = F.tid & 63; F.wave = __builtin_amdgcn_readfirstlane(F.tid >> 6);
    F.G = gridDim.x; { const int bx = blockIdx.x; F.vcu = (F.G % 8 == 0) ? (bx % 8) * (F.G / 8) + bx / 8 : bx; }
    F.ws = args.ws; F.out = args.out;
#pragma unroll
    for (int i = 0; i < 28; ++i) F.in[i] = args.in[i];
    unsigned char* ws = args.ws;
    volatile LAS unsigned* MISC = (volatile LAS unsigned*)(F.lds + MISC_OFF);
    for (int u = F.tid; u < 256; u += 512) MISC[u] = 0u;
    __syncthreads();
    XcdBarrier bar; bar.bar = (unsigned*)(ws + WS_CTL) + 1024; bar.x = 0; bar.st = nullptr;
    const int lo = args.ph_lo, hi = args.ph_hi;
    if (hi - lo > 1) bar = xcd_barrier_post((unsigned*)(ws + WS_CTL) + 1024, MISC + 8);
#define IN(k) (lo <= (k) && (k) < hi)
#ifndef REP1
#define REP1 1
#endif
#ifndef REP4
#define REP4 1
#endif
#ifndef REP0
#define REP0 1
#endif
#ifndef REP7
#define REP7 1
#endif
#ifndef REP9
#define REP9 1
#endif
#ifndef REP10
#define REP10 1
#endif
#define SEAM(k) do { if (IN(k) && IN((k) + 1)) xcd_barrier(bar); } while (0)
    LAS unsigned char* ring = F.lds;
    const int cid = (int)blockIdx.x;

    if (IN(0)) { p0_prologue(F); if (REP0 > 1) p0_prologue(F); } SEAM(0);

    if (IN(1)) {
        pg8::OrdPlain S{(const char*)(ws + WS_H1), (const char*)(ws + WS_WIN_T), T / 256, NPROJ / 256, F.G, cid, (size_t)256 * DM * 2, (size_t)256 * DM * 2};
        pg8::EpiIn E{(bf16_t*)(ws + WS_Q), (bf16_t*)(ws + WS_KV6), (bf16_t*)(ws + WS_CONV3), (bf16_t*)(ws + WS_MG), (bf16_t*)(ws + WS_NG)};
        pg8::gemm_phase<pg8::EpiIn, pg8::OrdPlain, false>(ring, DM, DM * 2, 128, S, E, nullptr); if (REP1 > 1) pg8::gemm_phase<pg8::EpiIn, pg8::OrdPlain, false>(ring, DM, DM * 2, 128, S, E, nullptr);
    } SEAM(1);

    if (IN(2)) {
        pg8::OrdCmp S{(const char*)(ws + WS_KV6), (const char*)(ws + WS_CKW1_T), (const char*)(ws + WS_CVW1_T), F.G, cid};
        pg8::EpiCmp E{(bf16_t*)(ws + WS_HID), (const float*)(ws + WS_B1P)};
        pg8::gemm_phase<pg8::EpiCmp, pg8::OrdCmp, false>(ring, 2048, 16 * 768 * 2, 768 * 2, S, E, nullptr);
    }
    SEAM(2);
    if (IN(3)) { p2_elementwise(F); p3_compress2(F); } SEAM(3);

    #ifdef ATTN_NAIVE
    if (IN(4)) { p4_attn_naive(F); } SEAM(4);
#else
    if (IN(4)) { p4_attn(F); if (REP4 > 1) p4_attn(F); } SEAM(4);
#endif

    if (IN(5)) {
        { pg8::OrdPlain S{(const char*)(ws + WS_OA), (const char*)(ws + WS_WPA_T), T / 256, DM / 256, F.G, cid, (size_t)256 * AW * 2, (size_t)256 * AW * 2};
          pg8::EpiGate<false> E{(bf16_t*)(ws + WS_Z), (const bf16_t*)(ws + WS_MG), 0};
          pg8::gemm_phase<pg8::EpiGate<false>, pg8::OrdPlain, false>(ring, AW, AW * 2, 128, S, E, nullptr); }
        VM_WAIT(); __syncthreads();
        { pg8::OrdPlain S{(const char*)(ws + WS_YB), (const char*)(ws + WS_WPB_T), T / 256, DM / 256, F.G, cid, (size_t)256 * CONVW * 2, (size_t)256 * CONVW * 2};
          pg8::EpiGate<true> E{(bf16_t*)(ws + WS_Z), (const bf16_t*)(ws + WS_MG), 1024};
          pg8::gemm_phase<pg8::EpiGate<true>, pg8::OrdPlain, false>(ring, CONVW, CONVW * 2, 128, S, E, nullptr); }
    } SEAM(5);

    if (IN(6)) {
        pg8::OrdPlain S{(const char*)(ws + WS_Z), (const char*)(ws + WS_WO_T), T / 256, DM / 256, F.G, cid, (size_t)256 * DM * 2, (size_t)256 * DM * 2};
        pg8::EpiRes E{F.in[I_X], F.out};
        pg8::gemm_phase<pg8::EpiRes, pg8::OrdPlain, false>(ring, DM, DM * 2, 128, S, E, nullptr);
    } SEAM(6);

    if (IN(7)) { p7_route(F); if (REP7 > 1) p7_route(F); } SEAM(7);
    if (IN(8)) { p8_scatter(F); } SEAM(8);

#pragma unroll
    for (int ch = 0; ch < NCH; ++ch) {
        const int pgu = 9 + 2 * ch, pdn = 10 + 2 * ch;
        if (IN(pgu)) {
            LAS int* TS = (LAS int*)(F.lds + MISC_OFF + 512);
            if (F.tid < 33) TS[F.tid] = ((const int*)(ws + WS_TSTART))[ch * 64 + F.tid];
            __syncthreads();
            const int ntile = TS[32];
            pg8::OrdGrp S{(const char*)(ws + WS_H2), (const char*)(ws + WS_WGU_T), TS, ntile, 8, F.G, cid, (size_t)0, (size_t)256 * DM, (size_t)2048 * DM};
            LAS unsigned* gtab = (LAS unsigned*)(F.lds + GTAB_OFF);
            { const unsigned* ROWTOK = (const unsigned*)(ws + WS_ROWTOK) + (size_t)ch * SLOTS_CH;
              for (int i = 0; i < GTAB_UNITS; ++i) { int pm, pn; if (!pg8::tile_map((long)i * F.G + cid, ntile, 8, pm, pn)) break;
                  if (F.tid < 256) gtab[i * 256 + F.tid] = ROWTOK[pm * 256 + F.tid]; } }
            __syncthreads();
            pg8::EpiGU E{(unsigned char*)(ws + WS_ACT), F.in[I_BGU]};
            pg8::gemm_phase<pg8::EpiGU, pg8::OrdGrp, true, true>(ring, DM / 2, 0, 128, S, E, gtab); if (REP9 > 1) pg8::gemm_phase<pg8::EpiGU, pg8::OrdGrp, true, true>(ring, DM / 2, 0, 128, S, E, gtab);
            if (ch > 0) p_combine(F, ch - 1);
        } SEAM(pgu);
        if (IN(pdn)) {
            LAS int* TS = (LAS int*)(F.lds + MISC_OFF + 512);
            if (F.tid < 33) TS[F.tid] = ((const int*)(ws + WS_TSTART))[ch * 64 + F.tid];
            __syncthreads();
            const int ntile = TS[32];
            pg8::OrdGrp S{(const char*)(ws + WS_ACT), (const char*)(ws + WS_WDN_T), TS, ntile, 4, F.G, cid, (size_t)256 * DFF, (size_t)256 * DFF, (size_t)DM * DFF};
            pg8::EpiDN E{(bf16_t*)(ws + WS_YBUF), F.in[I_BDN], (const float*)(ws + WS_ROWW) + (size_t)ch * SLOTS_CH};
            LAS unsigned* gtab = (LAS unsigned*)(F.lds + GTAB_OFF);
            for (int i = F.tid; i < GTAB_UNITS * 256; i += 512) gtab[i] = (unsigned)(i & 255) * (unsigned)DFF;
            __syncthreads();
            pg8::gemm_phase<pg8::EpiDN, pg8::OrdGrp, true, true>(ring, DFF / 2, DFF, 128, S, E, gtab); if (REP10 > 1) pg8::gemm_phase<pg8::EpiDN, pg8::OrdGrp, true, true>(ring, DFF / 2, DFF, 128, S, E, gtab);
        } SEAM(pdn);
    }
    if (IN(NPH - 1)) { p_combine(F, NCH - 1); }
#undef IN
#undef SEAM
}

extern "C" void kernel_launch(void* const* d_in, const int* in_sizes, int n_in, void* d_out, int out_size, void* d_ws, size_t ws_size, hipStream_t stream) {
    static int grid = 0;
    if (grid == 0) {
        if (n_in != 28 || out_size != T * DM || ws_size < WS_END) { fprintf(stderr, "kernel_launch: unexpected shapes (n_in %d, out %d, ws %zu)\n", n_in, out_size, ws_size); grid = -1; return; }
        int dev = 0, cus = 0;
        if (hipGetDevice(&dev) != hipSuccess || hipDeviceGetAttribute(&cus, hipDeviceAttributeMultiprocessorCount, dev) != hipSuccess) { grid = -1; return; }
        if (hipFuncSetAttribute((const void*)mk_fwd, hipFuncAttributeMaxDynamicSharedMemorySize, LDS_BYTES) != hipSuccess) { fprintf(stderr, "kernel_launch: hipFuncSetAttribute failed\n"); grid = -1; return; }
        int per_cu = 0;
        if (hipOccupancyMaxActiveBlocksPerMultiprocessor(&per_cu, (const void*)mk_fwd, 512, LDS_BYTES) != hipSuccess || per_cu < 1) fprintf(stderr, "kernel_launch: occupancy query says %d\n", per_cu);
        (void)hipGetLastError();
        grid = cus;
    }
    if (grid < 0) return;
    (void)hipMemsetAsync((char*)d_ws + WS_CTL, 0, CTL_ZERO_BYTES, stream);
    Args a{};
    for (int i = 0; i < 28; ++i) a.in[i] = (const float*)d_in[i];
    a.out = (float*)d_out; a.ws = (unsigned char*)d_ws;
#if MK_N_LAUNCHES == 1
    a.ph_lo = 0; a.ph_hi = NPH;
    hipLaunchKernelGGL(mk_fwd, dim3(grid), dim3(512), LDS_BYTES, stream, a);
#else
    for (int p = 0; p < NPH; ++p) { a.ph_lo = p; a.ph_hi = p + 1; hipLaunchKernelGGL(mk_fwd, dim3(grid), dim3(512), LDS_BYTES, stream, a); }
#endif
}
```

```cpp
#include <hip/hip_runtime.h>
#include <cstdio>
#include <cstdint>

#define LAS __attribute__((address_space(3)))
#define GAS __attribute__((address_space(1)))
typedef unsigned short bf16_t;
typedef short bf16x8 __attribute__((ext_vector_type(8)));
typedef float f32x4 __attribute__((ext_vector_type(4)));
typedef float f32x2 __attribute__((ext_vector_type(2)));
typedef unsigned u32x4 __attribute__((ext_vector_type(4)));
typedef unsigned u32x2 __attribute__((ext_vector_type(2)));

#ifndef MK_N_LAUNCHES
#define MK_N_LAUNCHES 1
#endif

constexpr int BATCH = 8, SEQ = 8192, DM = 1024, T = BATCH * SEQ;
constexpr int NH = 8, HD = 64, NGRP = 2, AW = 512;
constexpr int CMP_HID = 256, NBLK = 128, NSEL = 16, WIN = 512;
constexpr int CONVW = 512, NEXP = 32, DFF = 1024;
constexpr int NPROJ = 3072;
constexpr int IN_COLS = 4888;
constexpr float EPS = 1e-6f, LOG2E = 1.4426950408889634f;
constexpr float QSCALE = 0.125f * LOG2E;
constexpr int NCH = 1;
constexpr int TCH = T / NCH;
constexpr int SLOTS_CH = TCH * 4 + NEXP * 256;
constexpr int WPC = 256 / NCH;
constexpr int NPH = 10 + 2 * NCH;

constexpr size_t MiB = 1u << 20;
constexpr size_t WS_CTL = 0, CTL_ZERO_BYTES = 64 * 1024;
constexpr size_t WS_B1P = 1 * MiB;
constexpr size_t WS_TSTART = 1 * MiB + 4096;
constexpr size_t WS_CNT = 1 * MiB + 8192;
constexpr size_t WS_QCTR = 1 * MiB + 65536;
constexpr size_t WS_WIN_T = 8 * MiB, WS_WPA_T = 18 * MiB, WS_WPB_T = 19 * MiB, WS_WO_T = 20 * MiB, WS_CKW1_T = 22 * MiB, WS_CVW1_T = 23 * MiB;
constexpr size_t WS_WGU_T = 24 * MiB, WS_WDN_T = 88 * MiB;
constexpr size_t WS_H1 = 120 * MiB, WS_YB = 120 * MiB, WS_OA = 184 * MiB, WS_Q = 248 * MiB, WS_KV6 = 312 * MiB, WS_CONV3 = 408 * MiB, WS_MG = 600 * MiB;
constexpr size_t WS_X1B = 712 * MiB;
constexpr size_t WS_H1F8 = 870 * MiB, WS_WMG8 = 934 * MiB;
constexpr size_t WS_NG = 856 * MiB, WS_HID = 860 * MiB, WS_KC = 868 * MiB, WS_VC = 869 * MiB, WS_Z = 312 * MiB;
constexpr size_t WS_H2 = 120 * MiB, WS_ACT = 184 * MiB, WS_YBUF = 448 * MiB, WS_TOPE = 976 * MiB, WS_TOPW = 977 * MiB, WS_INV = 978 * MiB, WS_ROWTOK = 979 * MiB, WS_ROWW = 981 * MiB, WS_ROWRS = 983 * MiB, WS_RSTD = 985 * MiB;
constexpr size_t WS_END = 986 * MiB;
static_assert((size_t)NCH * SLOTS_CH * 4 <= 2 * MiB && (size_t)T * 4 <= 1 * MiB, "routing tables");
static_assert((size_t)SLOTS_CH * 1024 <= 264 * MiB && (size_t)SLOTS_CH * 2048 <= 528 * MiB, "act / y chunk");
static_assert((size_t)NCH * SLOTS_CH * 4 <= 2 * MiB, "rowtok");

constexpr int RING_BYTES = 131072;
constexpr int GTAB_OFF = RING_BYTES, GTAB_UNITS = 40, GTAB_BYTES = GTAB_UNITS * 512;
constexpr int MISC_OFF = GTAB_OFF + GTAB_BYTES;
constexpr int EPI_OFF = MISC_OFF + 1024;
constexpr int LDS_BYTES = EPI_OFF + 2048;
static_assert(LDS_BYTES <= 160 * 1024, "LDS");

__device__ __forceinline__ unsigned f2bf(float f) { unsigned u = __builtin_bit_cast(unsigned, f); return (u + 0x7fffu + ((u >> 16) & 1u)) >> 16; }
__device__ __forceinline__ unsigned pk2(float lo, float hi) { return f2bf(lo) | (f2bf(hi) << 16); }
typedef __bf16 bf16x2_t __attribute__((ext_vector_type(2)));
__device__ __forceinline__ unsigned cvtpk_bf16(float lo, float hi) { f32x2 v = {lo, hi}; bf16x2_t b = __builtin_convertvector(v, bf16x2_t); return __builtin_bit_cast(unsigned, b); }
__device__ __forceinline__ float bflo(unsigned w) { return __builtin_bit_cast(float, w << 16); }
__device__ __forceinline__ float bfhi(unsigned w) { return __builtin_bit_cast(float, w & 0xffff0000u); }
__device__ __forceinline__ float bf2f(bf16_t h) { return __builtin_bit_cast(float, (unsigned)h << 16); }
__device__ __forceinline__ float wave_sum(float v) {
#pragma unroll
    for (int o = 1; o < 64; o <<= 1) v += __shfl_xor(v, o);
    return v;
}
__device__ __forceinline__ float wave_max(float v) {
#pragma unroll
    for (int o = 1; o < 64; o <<= 1) v = fmaxf(v, __shfl_xor(v, o));
    return v;
}
__device__ __forceinline__ float sigmoidf_(float x) { return __builtin_amdgcn_rcpf(1.0f + __builtin_amdgcn_exp2f(-1.4426950408889634f * x)); }
__device__ __forceinline__ f32x2 pk_mul2(f32x2 a, f32x2 b) { f32x2 r = a * b; asm("" : "+v"(r)); return r; }
__device__ __forceinline__ f32x2 pk_add2(f32x2 a, f32x2 b) { f32x2 r = a + b; asm("" : "+v"(r)); return r; }
#define LDS_WAIT() asm volatile("s_waitcnt lgkmcnt(0)" ::: "memory")
#define VM_WAIT() asm volatile("s_waitcnt vmcnt(0)" ::: "memory")

namespace pg8 {
constexpr int BM = 256, BK = 64, HALF = 128, HTB = HALF * BK * 2, STAGE_BYTES = 8 * HTB, NXCD = 8, WGM = 8;
__host__ __device__ __forceinline__ int lds_byte(int r, int c) { const int st = (r >> 4) * 2 + (c >> 5), rr = r & 15, cc = c & 31, ob = rr * 64 + cc * 2; return st * 1024 + (ob ^ (((ob >> 9) & 1) << 5)); }
__host__ __device__ __forceinline__ void stage_rc(int b, int& R, int& C) { const int st = b / 1024, sb = b % 1024, swz = sb ^ (((sb >> 9) & 1) << 5); R = (st >> 1) * 16 + swz / 64; C = (st & 1) * 32 + (swz % 64) / 2; }
__host__ __device__ __forceinline__ int perm32(int rho) { const int n = rho >> 4, i = rho & 15; return 8 * (i >> 2) + 4 * n + (i & 3); }

struct Unit { const char* a; const char* b; int pm, pn, e; const char* a2; };

__device__ __forceinline__ bool tile_map(long L, int nM, int nN, int& pm, int& pn) {
    const int nwg = nM * nN; if (L >= nwg) return false;
    int wgid = (int)L; { const int q = nwg / NXCD, r = nwg % NXCD, xcd = wgid % NXCD, off = wgid / NXCD; wgid = (xcd < r ? xcd * (q + 1) : r * (q + 1) + (xcd - r) * q) + off; }
    const int nig = WGM * nN, gid = wgid / nig, fm = gid * WGM, gsz = (nM - fm) < WGM ? (nM - fm) : WGM;
    pm = fm + ((wgid % nig) % gsz); pn = (wgid % nig) / gsz; return true;
}

constexpr float W8INV_ = 1.0f / 32.0f;
typedef int v8i_t __attribute__((ext_vector_type(8)));
typedef int v4i_t __attribute__((ext_vector_type(4)));
__device__ __forceinline__ v8i_t cat8(bf16x8 a, bf16x8 b) { return __builtin_shufflevector(__builtin_bit_cast(v4i_t, a), __builtin_bit_cast(v4i_t, b), 0, 1, 2, 3, 4, 5, 6, 7); }
__device__ __forceinline__ unsigned cvt_pk_bf16(float lo, float hi) { return cvtpk_bf16(lo, hi); }

template <class Epi, class Sched, bool GATHER, bool F8 = false, int KSPLIT = 0>
__device__ __forceinline__ void gemm_phase(LAS unsigned char* lds, const int K, const unsigned a_pitch, const unsigned a_kstep, const Sched& S, const Epi& E, const LAS unsigned short* gtab) {
    const int tid = threadIdx.x, wid = __builtin_amdgcn_readfirstlane(tid >> 6), lane = tid & 63, wr = wid >> 2, wc = wid & 3, fr = lane & 15, fq = lane >> 4;
    const int nt = K / BK;
    unsigned voffA[2][2], voffB[2];
#pragma unroll
    for (int i = 0; i < 2; ++i) { int R, C; stage_rc(tid * 16 + i * 8192, R, C); const int Rb = Epi::PERM ? ((R & ~31) + perm32(R & 31)) : R;
        voffB[i] = (unsigned)(Rb * K + C) * 2u; voffA[0][i] = (unsigned)R * a_pitch + (unsigned)C * 2u; voffA[1][i] = voffA[0][i]; }
    const size_t kstepA = a_kstep, kstepB = (size_t)(BK * 2);
    const size_t hstepA = GATHER ? (size_t)0 : (size_t)HALF * a_pitch, hstepB = (size_t)HALF * K * 2;
    const unsigned ldsw = (unsigned)wid * 1024u;
    const unsigned ldsbase = (unsigned)(uintptr_t)lds;
    const int aoff = lds_byte(wr * 64 + fr, fq * 8), boff = lds_byte(wc * 32 + fr, fq * 8);
#define PG8_SA(b, h) (((b) * 2 + (h)) * HTB)
#define PG8_SB(b, h) ((4 + (b) * 2 + (h)) * HTB)
#define PG8_STAGE(bufoff, gbase, voff) do { _Pragma("unroll") for (int _i = 0; _i < 2; ++_i) { unsigned _keep; \
        asm volatile("s_mov_b32 %0, m0\n\ts_mov_b32 m0, %3\n\ts_nop 0\n\tglobal_load_lds_dwordx4 %1, %2\n\ts_mov_b32 m0, %0" : "=&s"(_keep) : "v"((voff)[_i]), "s"((const char*)(gbase)), "s"(ldsbase + (unsigned)(bufoff) + ldsw + (unsigned)(_i * 8192)) : "memory"); } } while (0)
#define PG8_STA(bufoff, gbase, h) do { if constexpr (GATHER) { PG8_STAGE(bufoff, gbase, voffA[h]); } else { PG8_STAGE(bufoff, (gbase) + (h) * hstepA, voffA[0]); } } while (0)
#define PG8_GLOAD(ui_) do { _Pragma("unroll") for (int _i = 0; _i < 2; ++_i) { int R_, C_; stage_rc(tid * 16 + _i * 8192, R_, C_); \
        voffA[0][_i] = (unsigned)gtab[(ui_) * 256 + R_] * 1024u + (unsigned)C_ * 2u; voffA[1][_i] = (unsigned)gtab[(ui_) * 256 + 128 + R_] * 1024u + (unsigned)C_ * 2u; } } while (0)
#define PG8_LDA(dst, b, h) do { _Pragma("unroll") for (int m = 0; m < 4; ++m) _Pragma("unroll") for (int k = 0; k < 2; ++k) dst[m][k] = *(const LAS bf16x8*)(lds + PG8_SA(b, h) + aoff + m * 2048 + k * 1024); } while (0)
#define PG8_LDB(dst, b, h) do { _Pragma("unroll") for (int n = 0; n < 2; ++n) _Pragma("unroll") for (int k = 0; k < 2; ++k) dst[n][k] = *(const LAS bf16x8*)(lds + PG8_SB(b, h) + boff + n * 2048 + k * 1024); } while (0)
#define PG8_MMA(ai, bj, At, Bt) do { __builtin_amdgcn_s_setprio(1); if constexpr (F8) { _Pragma("unroll") for (int m = 0; m < 4; ++m) _Pragma("unroll") for (int n = 0; n < 2; ++n) \
        acc[ai][bj][m][n] = __builtin_amdgcn_mfma_scale_f32_16x16x128_f8f6f4(cat8(Bt[n][0], Bt[n][1]), cat8(At[m][0], At[m][1]), acc[ai][bj][m][n], 0, 0, 0, 0, 0, 0); }     \
      else { _Pragma("unroll") for (int m = 0; m < 4; ++m) _Pragma("unroll") for (int n = 0; n < 2; ++n) _Pragma("unroll") for (int k = 0; k < 2; ++k) \
        acc[ai][bj][m][n] = __builtin_amdgcn_mfma_f32_16x16x32_bf16(Bt[n][k], At[m][k], acc[ai][bj][m][n], 0, 0, 0); } __builtin_amdgcn_s_setprio(0); } while (0)
#define PG8_WAIT_V(n) asm volatile("s_waitcnt vmcnt(" #n ")" ::: "memory")
#define PG8_WAIT_L(n) asm volatile("s_waitcnt lgkmcnt(" #n ")" ::: "memory")
#define PG8_BAR __builtin_amdgcn_s_barrier()
#define PG8_SCHED __builtin_amdgcn_sched_barrier(0)
    Unit cur, nxt; int ui = 0;
    if (!S.next(0, cur)) return;
    f32x4 acc[2][2][4][2];
#pragma unroll
    for (int a = 0; a < 2; ++a)
#pragma unroll
        for (int b = 0; b < 2; ++b)
#pragma unroll
            for (int m = 0; m < 4; ++m)
#pragma unroll
                for (int n = 0; n < 2; ++n) acc[a][b][m][n] = (f32x4){0.f, 0.f, 0.f, 0.f};
    bf16x8 At[4][2], B0[2][2], B1[2][2];
    const char* cA = cur.a; const char* cB = cur.b;
    if constexpr (GATHER) { PG8_GLOAD(0); }
    PG8_STAGE(PG8_SB(0, 0), cB, voffB); PG8_STAGE(PG8_SB(0, 1), cB + hstepB, voffB); PG8_STA(PG8_SA(0, 0), cA, 0); PG8_STA(PG8_SA(0, 1), cA, 1);
    if (wr == 1) PG8_BAR;
    PG8_WAIT_V(2); PG8_BAR;
    PG8_STAGE(PG8_SB(1, 0), cB + kstepB, voffB); PG8_STA(PG8_SA(1, 0), cA + kstepA, 0); PG8_STAGE(PG8_SB(1, 1), cB + hstepB + kstepB, voffB);
    PG8_WAIT_V(6); PG8_BAR;
    for (;;) {
        const bool has_next = S.next(ui + 1, nxt);
        const char* nA = has_next ? nxt.a : cA; const char* nB = has_next ? nxt.b : cB;
#pragma unroll 1
        for (int t = 0; t < nt; t += 2) {
            const bool last = (t == nt - 2);
            const char* a1; const char* a2; const char* a3;
            if constexpr (KSPLIT > 0) {
                const char* cA2 = cur.a2;
                a1 = (t + 1 >= KSPLIT) ? cA2 + (size_t)(t + 1 - KSPLIT) * kstepA : cA + (size_t)(t + 1) * kstepA;
                a2 = last ? nA : ((t + 2 >= KSPLIT) ? cA2 + (size_t)(t + 2 - KSPLIT) * kstepA : cA + (size_t)(t + 2) * kstepA);
                a3 = last ? nA + kstepA : ((t + 3 >= KSPLIT) ? cA2 + (size_t)(t + 3 - KSPLIT) * kstepA : cA + (size_t)(t + 3) * kstepA);
                if (t == KSPLIT) E.mid(acc, cur, wr, wc, fr, fq);
            } else { a1 = cA + (size_t)(t + 1) * kstepA; a2 = last ? nA : cA + (size_t)(t + 2) * kstepA; a3 = a2 + kstepA; }
            const char* b2 = last ? nB : cB + (size_t)(t + 2) * kstepB; const char* b3 = b2 + kstepB;
            if constexpr (Epi::PREFETCH) { if (last) __builtin_amdgcn_global_load_lds((const unsigned*)(E.src(cur, wid) + lane), (LAS unsigned*)(lds + EPI_OFF + wid * 256), 4, 0, 0); }
            PG8_LDB(B0, 0, 0); PG8_LDB(B1, 0, 1); PG8_SCHED; PG8_LDA(At, 0, 0); PG8_STA(PG8_SA(1, 1), a1, 1);
            if constexpr (GATHER) { if (last && has_next) { PG8_GLOAD(ui + 1); } }
            PG8_WAIT_V(8); PG8_WAIT_L(0); PG8_BAR; PG8_MMA(0, 0, At, B0); PG8_MMA(0, 1, At, B1); PG8_BAR; PG8_SCHED;
            PG8_LDA(At, 0, 1); PG8_STAGE(PG8_SB(0, 0), b2, voffB); PG8_STAGE(PG8_SB(0, 1), b2 + hstepB, voffB); PG8_STA(PG8_SA(0, 0), a2, 0);
            PG8_WAIT_V(8); PG8_WAIT_L(0); PG8_BAR; PG8_MMA(1, 0, At, B0); PG8_MMA(1, 1, At, B1); PG8_BAR; PG8_SCHED;
            PG8_LDB(B0, 1, 0); PG8_LDB(B1, 1, 1); PG8_SCHED; PG8_LDA(At, 1, 0); PG8_STA(PG8_SA(0, 1), a2, 1);
            PG8_WAIT_V(8); PG8_WAIT_L(0); PG8_BAR; PG8_MMA(0, 0, At, B0); PG8_MMA(0, 1, At, B1); PG8_BAR; PG8_SCHED;
            PG8_LDA(At, 1, 1); PG8_STAGE(PG8_SB(1, 0), b3, voffB); PG8_STAGE(PG8_SB(1, 1), b3 + hstepB, voffB); PG8_STA(PG8_SA(1, 0), a3, 0);
            PG8_WAIT_V(8); PG8_WAIT_L(0); PG8_BAR; PG8_MMA(1, 0, At, B0); PG8_MMA(1, 1, At, B1); PG8_BAR; PG8_SCHED;
        }
        if (wr == 0) PG8_BAR;
        E(acc, cur, wr, wc, fr, fq);
        if (!has_next) break;
#pragma unroll
        for (int a = 0; a < 2; ++a)
#pragma unroll
            for (int b = 0; b < 2; ++b)
#pragma unroll
                for (int m = 0; m < 4; ++m)
#pragma unroll
                    for (int n = 0; n < 2; ++n) { f32x2 z0, z1; asm volatile("v_mov_b64 %0, 0" : "=v"(z0)); asm volatile("v_mov_b64 %0, 0" : "=v"(z1)); acc[a][b][m][n] = (f32x4){z0[0], z0[1], z1[0], z1[1]}; }
        cur = nxt; cA = nA; cB = nB; ++ui;
        if (wr == 1) PG8_BAR;
    }
    PG8_WAIT_V(0);
    PG8_BAR;
#undef PG8_SA
#undef PG8_SB
#undef PG8_STAGE
#undef PG8_STA
#undef PG8_GLOAD
#undef PG8_LDA
#undef PG8_LDB
#undef PG8_MMA
#undef PG8_WAIT_V
#undef PG8_WAIT_L
#undef PG8_BAR
#undef PG8_SCHED
}

struct OrdPlain {
    const char* A; const char* Bt; int nM, nN, G, c; size_t a_tile, b_tile;
    __device__ __forceinline__ bool next(int i, Unit& u) const { int pm, pn; if (!tile_map((long)i * G + c, nM, nN, pm, pn)) return false;
        u.pm = pm; u.pn = pn; u.e = 0; u.a = A + (size_t)pm * a_tile; u.b = Bt + (size_t)pn * b_tile; return true; }
};
struct OrdPlain2 {
    const char* A; const char* A2; const char* Bt; int nM, nN, G, c; size_t a_tile, b_tile;
    __device__ __forceinline__ bool next(int i, Unit& u) const { int pm, pn; if (!tile_map((long)i * G + c, nM, nN, pm, pn)) return false;
        u.pm = pm; u.pn = pn; u.e = 0; u.a = A + (size_t)pm * a_tile; u.a2 = A2 + (size_t)pm * a_tile; u.b = Bt + (size_t)pn * b_tile; return true; }
};
struct OrdCmp {
    const char* KV6; const char* Wk; const char* Wv; int G, c;
    __device__ __forceinline__ bool next(int i, Unit& u) const { const long L = (long)i * G + c; if (L >= 64) return false;
        const int kv = (int)L >> 5, b = ((int)L >> 2) & 7, g = ((int)L >> 1) & 1, nh = (int)L & 1;
        u.pm = (int)L; u.pn = 0; u.e = kv; u.a = KV6 + ((size_t)(b * SEQ + nh * 4096) * 768 + kv * 128 + g * 64) * 2; u.b = kv ? Wv : Wk; return true; }
};
struct OrdGrp {
    const char* A; const char* Bt; const LAS int* tstart; int nM, nN, G, c; size_t a_tile, b_tile, b_grp;
    __device__ __forceinline__ bool next(int i, Unit& u) const { int pm, pn; if (!tile_map((long)i * G + c, nM, nN, pm, pn)) return false;
        const int lk = (int)(threadIdx.x & 63u);
        const int e = __builtin_popcountll(__ballot(lk >= 1 && lk < NEXP && pm >= tstart[lk & 31]));
        u.pm = pm; u.pn = pn; u.e = e; u.a = A + (size_t)pm * a_tile; u.b = Bt + (size_t)e * b_grp + (size_t)pn * b_tile; return true; }
};

struct EpiIn { static constexpr bool PREFETCH = false;
    static constexpr bool PERM = true;
    bf16_t *Q, *KV6, *CBV, *MG, *NG;
    __device__ __forceinline__ void operator()(const f32x4 (&acc)[2][2][4][2], const Unit& u, int wr, int wc, int fr, int fq) const {
        const int pn = u.pn; const int row0 = u.pm * BM + wr * 64 + fr;
        if (pn >= 7 && pn < 11) {
#pragma unroll
            for (int ai = 0; ai < 2; ++ai)
#pragma unroll
                for (int m = 0; m < 4; ++m) { const f32x4 v0 = acc[ai][0][m][0] * acc[ai][1][m][0], v1 = acc[ai][0][m][1] * acc[ai][1][m][1];
                    u32x4 w; w.x = cvt_pk_bf16(v0[0], v0[1]); w.y = cvt_pk_bf16(v0[2], v0[3]); w.z = cvt_pk_bf16(v1[0], v1[1]); w.w = cvt_pk_bf16(v1[2], v1[3]);
                    *(u32x4*)(CBV + (size_t)(row0 + ai * HALF + m * 16) * 1024 + 512 + (pn - 7) * HALF + wc * 32 + 8 * fq) = w; }
            return;
        }
        bf16_t* base; int ld, ct; bool sig = false;
        if (pn < 2) { base = Q; ld = 512; ct = pn * 256; } else if (pn < 5) { base = KV6; ld = 768; ct = (pn - 2) * 256; }
        else if (pn < 7) { base = CBV; ld = 1024; ct = (pn - 5) * 256; }
        else { base = NG; ld = 32; ct = 0; sig = true; }
#pragma unroll
        for (int ai = 0; ai < 2; ++ai)
#pragma unroll
            for (int m = 0; m < 4; ++m) { bf16_t* rowp = base + (size_t)(row0 + ai * HALF + m * 16) * ld + ct + wc * 32 + 8 * fq;
#pragma unroll
                for (int bj = 0; bj < 2; ++bj) { if (pn == 11 && (bj != 0 || wc != 0)) continue;
                    f32x4 v0 = acc[ai][bj][m][0], v1 = acc[ai][bj][m][1];
                    if (sig) {
#pragma unroll
                        for (int k = 0; k < 4; ++k) { v0[k] = sigmoidf_(v0[k]); v1[k] = sigmoidf_(v1[k]); } }
                    u32x4 w; w.x = cvt_pk_bf16(v0[0], v0[1]); w.y = cvt_pk_bf16(v0[2], v0[3]); w.z = cvt_pk_bf16(v1[0], v1[1]); w.w = cvt_pk_bf16(v1[2], v1[3]);
                    *(u32x4*)(rowp + bj * HALF) = w; } }
    }
};
struct EpiMG8 { static constexpr bool PREFETCH = false;
    static constexpr bool PERM = true;
    bf16_t* MG;
    __device__ __forceinline__ void operator()(const f32x4 (&acc)[2][2][4][2], const Unit& u, int wr, int wc, int fr, int fq) const {
        const int row0 = u.pm * BM + wr * 64 + fr;
#pragma unroll
        for (int ai = 0; ai < 2; ++ai)
#pragma unroll
            for (int m = 0; m < 4; ++m) { bf16_t* rowp = MG + (size_t)(row0 + ai * HALF + m * 16) * 2048 + u.pn * HALF + wc * 32 + 8 * fq;
                f32x4 rt[2], gbv[2];
#pragma unroll
                for (int n = 0; n < 2; ++n) { const f32x2 kk = {-1.4426950408889634f * W8INV_, -1.4426950408889634f * W8INV_}, one2 = {1.0f, 1.0f};
                    const f32x2 ta0 = pk_mul2((f32x2){acc[ai][0][m][n][0], acc[ai][0][m][n][1]}, kk), ta1 = pk_mul2((f32x2){acc[ai][0][m][n][2], acc[ai][0][m][n][3]}, kk);
                    const f32x2 tb0 = pk_mul2((f32x2){acc[ai][1][m][n][0], acc[ai][1][m][n][1]}, kk), tb1 = pk_mul2((f32x2){acc[ai][1][m][n][2], acc[ai][1][m][n][3]}, kk);
                    const f32x2 da0 = pk_add2((f32x2){fminf(__builtin_amdgcn_exp2f(ta0[0]), 1e30f), fminf(__builtin_amdgcn_exp2f(ta0[1]), 1e30f)}, one2), da1 = pk_add2((f32x2){fminf(__builtin_amdgcn_exp2f(ta1[0]), 1e30f), fminf(__builtin_amdgcn_exp2f(ta1[1]), 1e30f)}, one2);
                    const f32x2 db0 = pk_add2((f32x2){fminf(__builtin_amdgcn_exp2f(tb0[0]), 1e30f), fminf(__builtin_amdgcn_exp2f(tb0[1]), 1e30f)}, one2), db1 = pk_add2((f32x2){fminf(__builtin_amdgcn_exp2f(tb1[0]), 1e30f), fminf(__builtin_amdgcn_exp2f(tb1[1]), 1e30f)}, one2);
                    rt[n] = (f32x4){db0[0] * __builtin_amdgcn_rcpf(da0[0]), db0[1] * __builtin_amdgcn_rcpf(da0[1]), db1[0] * __builtin_amdgcn_rcpf(da1[0]), db1[1] * __builtin_amdgcn_rcpf(da1[1])};
                    gbv[n] = (f32x4){__builtin_amdgcn_rcpf(db0[0]), __builtin_amdgcn_rcpf(db0[1]), __builtin_amdgcn_rcpf(db1[0]), __builtin_amdgcn_rcpf(db1[1])}; }
                { u32x4 w; w.x = cvt_pk_bf16(rt[0][0], rt[0][1]); w.y = cvt_pk_bf16(rt[0][2], rt[0][3]); w.z = cvt_pk_bf16(rt[1][0], rt[1][1]); w.w = cvt_pk_bf16(rt[1][2], rt[1][3]); *(u32x4*)rowp = w; }
                { u32x4 w; w.x = cvt_pk_bf16(gbv[0][0], gbv[0][1]); w.y = cvt_pk_bf16(gbv[0][2], gbv[0][3]); w.z = cvt_pk_bf16(gbv[1][0], gbv[1][1]); w.w = cvt_pk_bf16(gbv[1][2], gbv[1][3]); *(u32x4*)(rowp + 1024) = w; } }
    }
};
__device__ __forceinline__ float gelu_tanh(float x) { const float y = (1.5957691216057308f * 1.4426950408889634f) * (x + 0.044715f * x * x * x); return x * __builtin_amdgcn_rcpf(1.0f + __builtin_amdgcn_exp2f(-y)); }
struct EpiCmp { static constexpr bool PREFETCH = false;
    static constexpr bool PERM = true;
    bf16_t* HID; const float* B1P;
    __device__ __forceinline__ void operator()(const f32x4 (&acc)[2][2][4][2], const Unit& u, int wr, int wc, int fr, int fq) const {
        const int row0 = u.pm * BM + wr * 64 + fr; const float* bp = B1P + u.e * 256 + wc * 32 + 8 * fq;
        f32x4 bv[2][2];
#pragma unroll
        for (int bj = 0; bj < 2; ++bj)
#pragma unroll
            for (int n = 0; n < 2; ++n) bv[bj][n] = *(const f32x4*)(bp + bj * HALF + 4 * n);
#pragma unroll
        for (int ai = 0; ai < 2; ++ai)
#pragma unroll
            for (int m = 0; m < 4; ++m) { bf16_t* rowp = HID + (size_t)(row0 + ai * HALF + m * 16) * 256 + wc * 32 + 8 * fq;
#pragma unroll
                for (int bj = 0; bj < 2; ++bj) { f32x4 v0 = acc[ai][bj][m][0] + bv[bj][0], v1 = acc[ai][bj][m][1] + bv[bj][1];
#pragma unroll
                    for (int k = 0; k < 4; ++k) { v0[k] = gelu_tanh(v0[k]); v1[k] = gelu_tanh(v1[k]); }
                    u32x4 w; w.x = cvt_pk_bf16(v0[0], v0[1]); w.y = cvt_pk_bf16(v0[2], v0[3]); w.z = cvt_pk_bf16(v1[0], v1[1]); w.w = cvt_pk_bf16(v1[2], v1[3]);
                    *(u32x4*)(rowp + bj * HALF) = w; } }
    }
};
template <bool ADD> struct EpiGate { static constexpr bool PREFETCH = false;
    static constexpr bool PERM = true;
    bf16_t* Z; const bf16_t* MG; int goff;
    __device__ __forceinline__ void operator()(const f32x4 (&acc)[2][2][4][2], const Unit& u, int wr, int wc, int fr, int fq) const {
        const int row0 = u.pm * BM + wr * 64 + fr, col0 = u.pn * BM + wc * 32 + 8 * fq;
#pragma unroll
        for (int ai = 0; ai < 2; ++ai)
#pragma unroll
            for (int m = 0; m < 4; ++m) { const size_t row = (size_t)(row0 + ai * HALF + m * 16);
#pragma unroll
                for (int bj = 0; bj < 2; ++bj) { const int col = col0 + bj * HALF;
                    const u32x4 gw = *(const u32x4*)(MG + row * 2048 + goff + col);
                    f32x4 v0 = acc[ai][bj][m][0], v1 = acc[ai][bj][m][1];
                    v0[0] *= bflo(gw.x); v0[1] *= bfhi(gw.x); v0[2] *= bflo(gw.y); v0[3] *= bfhi(gw.y); v1[0] *= bflo(gw.z); v1[1] *= bfhi(gw.z); v1[2] *= bflo(gw.w); v1[3] *= bfhi(gw.w);
                    if (ADD) { const u32x4 zw = *(const u32x4*)(Z + row * 1024 + col);
                        v0[0] += bflo(zw.x); v0[1] += bfhi(zw.x); v0[2] += bflo(zw.y); v0[3] += bfhi(zw.y); v1[0] += bflo(zw.z); v1[1] += bfhi(zw.z); v1[2] += bflo(zw.w); v1[3] += bfhi(zw.w); }
                    u32x4 w; w.x = cvt_pk_bf16(v0[0], v0[1]); w.y = cvt_pk_bf16(v0[2], v0[3]); w.z = cvt_pk_bf16(v1[0], v1[1]); w.w = cvt_pk_bf16(v1[2], v1[3]);
                    *(u32x4*)(Z + row * 1024 + col) = w; } }
    }
};
struct EpiGateM { static constexpr bool PREFETCH = false;
    static constexpr bool PERM = true;
    bf16_t* Z; const bf16_t* MG;
    __device__ __forceinline__ void mid(f32x4 (&acc)[2][2][4][2], const Unit& u, int wr, int wc, int fr, int fq) const {
        const int row0 = u.pm * BM + wr * 64 + fr, col0 = u.pn * BM + wc * 32 + 8 * fq;
#pragma unroll
        for (int ai = 0; ai < 2; ++ai)
#pragma unroll
            for (int m = 0; m < 4; ++m) { const size_t row = (size_t)(row0 + ai * HALF + m * 16);
#pragma unroll
                for (int bj = 0; bj < 2; ++bj) { const int col = col0 + bj * HALF;
                    const u32x4 rw = *(const u32x4*)(MG + row * 2048 + col);
                    f32x4& a0 = acc[ai][bj][m][0]; f32x4& a1 = acc[ai][bj][m][1];
                    a0[0] *= bflo(rw.x); a0[1] *= bfhi(rw.x); a0[2] *= bflo(rw.y); a0[3] *= bfhi(rw.y); a1[0] *= bflo(rw.z); a1[1] *= bfhi(rw.z); a1[2] *= bflo(rw.w); a1[3] *= bfhi(rw.w); } }
    }
    __device__ __forceinline__ void operator()(const f32x4 (&acc)[2][2][4][2], const Unit& u, int wr, int wc, int fr, int fq) const {
        const int row0 = u.pm * BM + wr * 64 + fr, col0 = u.pn * BM + wc * 32 + 8 * fq;
#pragma unroll
        for (int ai = 0; ai < 2; ++ai)
#pragma unroll
            for (int m = 0; m < 4; ++m) { const size_t row = (size_t)(row0 + ai * HALF + m * 16);
#pragma unroll
                for (int bj = 0; bj < 2; ++bj) { const int col = col0 + bj * HALF;
                    const u32x4 gw = *(const u32x4*)(MG + row * 2048 + 1024 + col);
                    f32x4 v0 = acc[ai][bj][m][0], v1 = acc[ai][bj][m][1];
                    v0[0] *= fmaxf(bflo(gw.x), 1e-30f); v0[1] *= fmaxf(bfhi(gw.x), 1e-30f); v0[2] *= fmaxf(bflo(gw.y), 1e-30f); v0[3] *= fmaxf(bfhi(gw.y), 1e-30f); v1[0] *= fmaxf(bflo(gw.z), 1e-30f); v1[1] *= fmaxf(bfhi(gw.z), 1e-30f); v1[2] *= fmaxf(bflo(gw.w), 1e-30f); v1[3] *= fmaxf(bfhi(gw.w), 1e-30f);
                    u32x4 w; w.x = cvt_pk_bf16(v0[0], v0[1]); w.y = cvt_pk_bf16(v0[2], v0[3]); w.z = cvt_pk_bf16(v1[0], v1[1]); w.w = cvt_pk_bf16(v1[2], v1[3]);
                    *(u32x4*)(Z + row * 1024 + col) = w; } }
    }
};
struct EpiRes { static constexpr bool PREFETCH = false;
    static constexpr bool PERM = true;
    const float* X; bf16_t* O;
    __device__ __forceinline__ void operator()(const f32x4 (&acc)[2][2][4][2], const Unit& u, int wr, int wc, int fr, int fq) const {
        const int row0 = u.pm * BM + wr * 64 + fr, col0 = u.pn * BM + wc * 32 + 8 * fq;
#pragma unroll
        for (int ai = 0; ai < 2; ++ai)
#pragma unroll
            for (int m = 0; m < 4; ++m) { const size_t off = (size_t)(row0 + ai * HALF + m * 16) * DM + col0;
#pragma unroll
                for (int bj = 0; bj < 2; ++bj) { const f32x4 x0 = *(const f32x4*)(X + off + bj * HALF), x1 = *(const f32x4*)(X + off + bj * HALF + 4);
                    const f32x4 v0 = x0 + acc[ai][bj][m][0], v1 = x1 + acc[ai][bj][m][1];
                    u32x4 w; w.x = cvt_pk_bf16(v0[0], v0[1]); w.y = cvt_pk_bf16(v0[2], v0[3]); w.z = cvt_pk_bf16(v1[0], v1[1]); w.w = cvt_pk_bf16(v1[2], v1[3]);
                    *(u32x4*)(O + off + bj * HALF) = w; } }
    }
};
constexpr float W8SCALE = 32.0f, W8INV = 1.0f / 32.0f;
__device__ __forceinline__ unsigned pk4_fp8(float a, float b, float c, float d) { int r = __builtin_amdgcn_cvt_pk_fp8_f32(a, b, __builtin_bit_cast(int, a), false); r = __builtin_amdgcn_cvt_pk_fp8_f32(c, d, r, true); return (unsigned)r; }
struct EpiGU {
    static constexpr bool PERM = true, PREFETCH = true;
    unsigned char* ACT; const float* BGU; const float* ROWRS; const LAS float* el;
    __device__ __forceinline__ const float* src(const Unit& u, int wid) const { return wid < 4 ? BGU + (size_t)u.e * 2048 + (wid >> 1) * 1024 + u.pn * HALF + (wid & 1) * 64 : ROWRS + u.pm * BM + (wid - 4) * 64; }
    __device__ __forceinline__ void operator()(const f32x4 (&acc)[2][2][4][2], const Unit& u, int wr, int wc, int fr, int fq) const {
        const int row0 = u.pm * BM + wr * 64 + fr, col0 = u.pn * HALF + wc * 32 + 8 * fq;
        f32x4 bg[2], bu[2];
#pragma unroll
        for (int n = 0; n < 2; ++n) { bg[n] = *(const LAS f32x4*)(el + wc * 32 + 8 * fq + 4 * n); bu[n] = *(const LAS f32x4*)(el + 128 + wc * 32 + 8 * fq + 4 * n) + 1.0f; }
#pragma unroll
        for (int ai = 0; ai < 2; ++ai)
#pragma unroll
            for (int mp = 0; mp < 2; ++mp) { u32x2 w[2];
#pragma unroll
                for (int mm = 0; mm < 2; ++mm) { const int m = 2 * mp + mm; const int rl = ai * HALF + wr * 64 + m * 16 + fr; const float sc = W8INV * el[256 + rl];
#pragma unroll
                    for (int n = 0; n < 2; ++n) {
                        f32x4 g = acc[ai][0][m][n] * sc + bg[n], uu = acc[ai][1][m][n] * sc + bu[n], e, r;
#pragma unroll
                        for (int k = 0; k < 4; ++k) { g[k] = fminf(g[k], 7.0f); uu[k] = fminf(fmaxf(uu[k], -6.0f), 8.0f); }
                        const f32x2 kk = {-1.702f * 1.4426950408889634f, -1.702f * 1.4426950408889634f}, one2 = {1.0f, 1.0f};
                        const f32x2 t0 = pk_mul2((f32x2){g[0], g[1]}, kk), t1 = pk_mul2((f32x2){g[2], g[3]}, kk);
                        e[0] = __builtin_amdgcn_exp2f(t0[0]); e[1] = __builtin_amdgcn_exp2f(t0[1]); e[2] = __builtin_amdgcn_exp2f(t1[0]); e[3] = __builtin_amdgcn_exp2f(t1[1]);
                        const f32x2 d0 = pk_add2((f32x2){e[0], e[1]}, one2), d1 = pk_add2((f32x2){e[2], e[3]}, one2);
                        r[0] = __builtin_amdgcn_rcpf(d0[0]); r[1] = __builtin_amdgcn_rcpf(d0[1]); r[2] = __builtin_amdgcn_rcpf(d1[0]); r[3] = __builtin_amdgcn_rcpf(d1[1]);
                        const f32x2 o0 = pk_mul2(pk_mul2((f32x2){g[0], g[1]}, (f32x2){r[0], r[1]}), (f32x2){uu[0], uu[1]}), o1 = pk_mul2(pk_mul2((f32x2){g[2], g[3]}, (f32x2){r[2], r[3]}), (f32x2){uu[2], uu[3]});
                        const f32x4 o = {o0[0], o0[1], o1[0], o1[1]};
                        const unsigned pw = pk4_fp8(o[0], o[1], o[2], o[3]); if (n == 0) w[mm].x = pw; else w[mm].y = pw; } }
                const auto r0 = __builtin_amdgcn_permlane16_swap(w[0].x, w[1].x, false, false), r1 = __builtin_amdgcn_permlane16_swap(w[0].y, w[1].y, false, false);
                u32x4 v; v.x = r0[0]; v.y = r1[0]; v.z = r0[1]; v.w = r1[1];
                const int rs = ai * HALF + wr * 64 + (2 * mp + (fq & 1)) * 16 + fr;
                *(u32x4*)(ACT + (size_t)(u.pm * BM + rs) * 1024 + u.pn * HALF + wc * 32 + 8 * (fq & 2)) = v; }
        (void)row0; (void)col0;
    }
};
constexpr float YSCALE = 16.0f, YINV = 1.0f / 16.0f;
struct EpiDN {
    static constexpr bool PERM = true, PREFETCH = true;
    unsigned char* Y; const float* BDN; const float* ROWW; const LAS float* el;
    __device__ __forceinline__ const float* src(const Unit& u, int wid) const { return wid < 4 ? BDN + (size_t)u.e * 1024 + u.pn * BM + wid * 64 : ROWW + u.pm * BM + (wid - 4) * 64; }
    __device__ __forceinline__ void operator()(const f32x4 (&acc)[2][2][4][2], const Unit& u, int wr, int wc, int fr, int fq) const {
        const int col0 = u.pn * BM + wc * 32 + 8 * fq;
        f32x4 bv[2][2];
#pragma unroll
        for (int bj = 0; bj < 2; ++bj)
#pragma unroll
            for (int n = 0; n < 2; ++n) bv[bj][n] = *(const LAS f32x4*)(el + bj * HALF + wc * 32 + 8 * fq + 4 * n);
#pragma unroll
        for (int ai = 0; ai < 2; ++ai)
#pragma unroll
            for (int mp = 0; mp < 2; ++mp) { u32x2 w[2][2];
#pragma unroll
                for (int mm = 0; mm < 2; ++mm) { const int m = 2 * mp + mm; const int rl = ai * HALF + wr * 64 + m * 16 + fr; const float rw = el[256 + rl] * YSCALE;
#pragma unroll
                    for (int bj = 0; bj < 2; ++bj) { const f32x4 v0 = (acc[ai][bj][m][0] * W8INV + bv[bj][0]) * rw, v1 = (acc[ai][bj][m][1] * W8INV + bv[bj][1]) * rw;
                        w[mm][bj].x = pk4_fp8(v0[0], v0[1], v0[2], v0[3]); w[mm][bj].y = pk4_fp8(v1[0], v1[1], v1[2], v1[3]); } }
                const int rs = ai * HALF + wr * 64 + (2 * mp + (fq & 1)) * 16 + fr; unsigned char* rowp = Y + (size_t)(u.pm * BM + rs) * 1024 + u.pn * BM + wc * 32 + 8 * (fq & 2);
#pragma unroll
                for (int bj = 0; bj < 2; ++bj) { const auto r0 = __builtin_amdgcn_permlane16_swap(w[0][bj].x, w[1][bj].x, false, false), r1 = __builtin_amdgcn_permlane16_swap(w[0][bj].y, w[1][bj].y, false, false);
                    u32x4 v; v.x = r0[0]; v.y = r1[0]; v.z = r0[1]; v.w = r1[1];
                    *(u32x4*)(rowp + bj * HALF) = v; } }
        (void)col0;
    }
};
}

#define XB_TMO      128
#define XB_XCNT(j)  (256  + 64 * (j))
#define XB_XSUB(j)  (1280 + 64 * (j))
#define XB_XGEN(j)  (2304 + 64 * (j))
#define XB_TOP      3328
#define XB_TOPGEN   3392
#define XCD_BAR_WORDS 3456
#define XB_SPIN_CAP (1u << 18)
__device__ __forceinline__ unsigned xb_ld(unsigned* p)              { return __hip_atomic_load(p, __ATOMIC_RELAXED, __HIP_MEMORY_SCOPE_AGENT); }
__device__ __forceinline__ unsigned xb_add(unsigned* p, unsigned v) { return __hip_atomic_fetch_add(p, v, __ATOMIC_RELAXED, __HIP_MEMORY_SCOPE_AGENT); }
__device__ __forceinline__ unsigned xb_xcc_id() { return (unsigned)__builtin_amdgcn_s_getreg((3 << 11) | 20) & 0xFu; }
#define XB_SPIN(cond, bar) do { unsigned _sp = 0; while (cond) { __builtin_amdgcn_s_sleep(1); \
    if ((++_sp & 255u) == 0u) { if (xb_ld(&(bar)[XB_TMO])) break; if (_sp > XB_SPIN_CAP) { atomicAdd(&(bar)[XB_TMO], 1u); break; } } } } while (0)
struct XcdBarrier { unsigned* bar; unsigned x; volatile LAS unsigned* st; };
__device__ __forceinline__ XcdBarrier xcd_barrier_post(unsigned* bar, volatile LAS unsigned* st) {
    XcdBarrier b; b.bar = bar; b.x = xb_xcc_id(); b.st = st;
    if (threadIdx.x == 0) (void)xb_add(&bar[XB_XCNT(b.x)], 1u);
    return b;
}
__device__ __forceinline__ void xcd_barrier_complete(unsigned* bar, unsigned x, unsigned& nloc, unsigned& nx) {
    const unsigned G = gridDim.x * gridDim.y * gridDim.z;
    unsigned sum, cnt, mine, sp = 0u;
    for (;;) {
        sum = 0u; cnt = 0u; mine = 0u;
#pragma unroll
        for (unsigned j = 0; j < 16; ++j) { const unsigned c = xb_ld(&bar[XB_XCNT(j)]); sum += c; cnt += (c > 0u) ? 1u : 0u; mine = (j == x) ? c : mine; }
        if (sum == G) break;
        __builtin_amdgcn_s_sleep(1);
        if ((++sp & 255u) == 0u) { if (xb_ld(&bar[XB_TMO])) break; if (sp > XB_SPIN_CAP) { atomicAdd(&bar[XB_TMO], 1u); break; } }
    }
    nloc = mine > 0u ? mine : 1u; nx = cnt > 0u ? cnt : 1u;
}
__device__ __forceinline__ void xcd_barrier(const XcdBarrier& b) {
    asm volatile("s_waitcnt vmcnt(0)" ::: "memory");
    __syncthreads();
    if (threadIdx.x == 0) {
        unsigned* bar = b.bar;
        __builtin_amdgcn_s_waitcnt(0);
        unsigned nloc = b.st[0], nx = b.st[1];
        if (nloc == 0u) { xcd_barrier_complete(bar, b.x, nloc, nx); b.st[0] = nloc; b.st[1] = nx; }
        const unsigned old = xb_add(&bar[XB_XSUB(b.x)], 1u);
        const unsigned gen = old / nloc;
        if (old + 1u == (gen + 1u) * nloc) {
            __builtin_amdgcn_fence(__ATOMIC_RELEASE, "agent");
            asm volatile("s_waitcnt vmcnt(0)" ::: "memory");
            const unsigned og = xb_add(&bar[XB_TOP], 1u);
            const unsigned tg = og / nx;
            if (og + 1u == (tg + 1u) * nx) xb_add(&bar[XB_TOPGEN], 1u);
            else XB_SPIN(xb_ld(&bar[XB_TOPGEN]) == tg, bar);
            __builtin_amdgcn_fence(__ATOMIC_ACQUIRE, "agent");
            xb_add(&bar[XB_XGEN(b.x)], 1u);
            asm volatile("s_waitcnt vmcnt(0)" ::: "memory");
        } else {
            XB_SPIN(xb_ld(&bar[XB_XGEN(b.x)]) == gen, bar);
            __builtin_amdgcn_fence(__ATOMIC_ACQUIRE, "agent");
            asm volatile("s_waitcnt vmcnt(0)" ::: "memory");
        }
    }
    __syncthreads();
}

struct Args { const float* in[28]; float* out; unsigned char* ws; int ph_lo, ph_hi; };
enum { I_X = 0, I_GN1, I_WIN, I_GQ, I_GKC, I_GKS, I_GKW, I_PEK, I_CKW1, I_CKB1, I_CKW2, I_CKB2, I_PEV, I_CVW1, I_CVB1, I_CVW2, I_CVB2, I_CONVW, I_WPA, I_WPB, I_WO, I_GN2, I_WR, I_BR, I_WGU, I_BGU, I_WDN, I_BDN };

struct Frame {
    LAS unsigned char* lds; int tid, lane, wave, G, vcu; unsigned char* ws; const Args* a; float* out;
};

__device__ __forceinline__ int colmap(int mode, int n) {
    if (mode == 1) { if (n < 1280) return n; if (n < 1792) return n + 24;
        if (n < 2816) { const int p = (n - 1792) >> 8, r = (n - 1792) & 255; return r < 128 ? 1816 + 128 * p + r : 2328 + 128 * p + (r - 128); }
        if (n < 2840) return n - 2816 + 1280; return -1; }
    if (mode == 3) { const int p = n >> 8, r = n & 255; return r < 128 ? 2840 + 128 * p + r : 2840 + 1024 + 128 * p + (r - 128); }
    if (mode == 2) { const int p = n >> 8, r = n & 255; return r < 128 ? 128 * p + r : 1024 + 128 * p + (r - 128); }
    return n;
}
__device__ __forceinline__ void tr_item(const float* W, int Nsrc, int K, bf16_t* WT, int mode, LAS float* scr, int kb, int nb, int lane) {
    const int k0 = 64 * kb, n0 = 32 * nb; const int col = colmap(mode, n0 + (lane & 31));
    { const int n4 = (lane & 7) * 4; const int c0 = colmap(mode, n0 + n4); (void)col;
#pragma unroll
      for (int i = 0; i < 8; ++i) { const int kk = 8 * i + (lane >> 3); f32x4 v = (f32x4){0.f, 0.f, 0.f, 0.f}; if (c0 >= 0) v = *(const f32x4*)(W + (size_t)(k0 + kk) * Nsrc + c0);
          LAS float* d = scr + kk * 33 + n4; d[0] = v.x; d[1] = v.y; d[2] = v.z; d[3] = v.w; } }
    LDS_WAIT(); asm volatile("" ::: "memory");
    const int c = lane & 7;
#pragma unroll
    for (int j = 0; j < 4; ++j) { const int n = (lane >> 3) + 8 * j; const LAS float* s = scr + (8 * c) * 33 + n;
        u32x4 o; o.x = pk2(s[0 * 33], s[1 * 33]); o.y = pk2(s[2 * 33], s[3 * 33]); o.z = pk2(s[4 * 33], s[5 * 33]); o.w = pk2(s[6 * 33], s[7 * 33]);
        *(u32x4*)(WT + (size_t)(n0 + n) * K + k0 + 8 * c) = o; }
    LDS_WAIT(); asm volatile("" ::: "memory");
}
__device__ __forceinline__ void tr_item8(const float* W, int Nsrc, int K, unsigned char* WT, int mode, LAS float* scr, int kb, int nb, int lane) {
    const int k0 = 64 * kb, n0 = 32 * nb; const int col = colmap(mode, n0 + (lane & 31));
    { const int n4 = (lane & 7) * 4; const int c0 = colmap(mode, n0 + n4); (void)col;
#pragma unroll
      for (int i = 0; i < 8; ++i) { const int kk = 8 * i + (lane >> 3); const f32x4 v = *(const f32x4*)(W + (size_t)(k0 + kk) * Nsrc + c0);
          LAS float* d = scr + kk * 33 + n4; d[0] = v.x; d[1] = v.y; d[2] = v.z; d[3] = v.w; } }
    LDS_WAIT(); asm volatile("" ::: "memory");
    const int n = lane >> 1, hf = lane & 1; const LAS float* sp = scr + (32 * hf) * 33 + n;
    u32x4 o0, o1;
#pragma unroll
    for (int q = 0; q < 4; ++q) { o0[q] = pg8::pk4_fp8(sp[(4 * q) * 33] * pg8::W8SCALE, sp[(4 * q + 1) * 33] * pg8::W8SCALE, sp[(4 * q + 2) * 33] * pg8::W8SCALE, sp[(4 * q + 3) * 33] * pg8::W8SCALE);
                                  o1[q] = pg8::pk4_fp8(sp[(16 + 4 * q) * 33] * pg8::W8SCALE, sp[(17 + 4 * q) * 33] * pg8::W8SCALE, sp[(18 + 4 * q) * 33] * pg8::W8SCALE, sp[(19 + 4 * q) * 33] * pg8::W8SCALE); }
    unsigned char* dst = WT + (size_t)(n0 + n) * K + k0 + 32 * hf;
    *(u32x4*)dst = o0; *(u32x4*)(dst + 16) = o1;
    LDS_WAIT(); asm volatile("" ::: "memory");
}
__device__ __forceinline__ void p0_prologue(Frame& F) {
    unsigned char* ws = F.ws;
    LAS float* scr = (LAS float*)(F.lds + F.wave * 16384);
    const int gw = F.vcu * 8 + F.wave, NGW = F.G * 8;
    constexpr int I_IN = 16 * 96, I_MG = 16 * 64, I_PA = 8 * 32, I_PO = 16 * 32, I_C1 = 32 * 8;
    constexpr int NTR = I_IN + I_MG + 2 * I_PA + I_PO + 2 * I_C1;
    {
        f32x4 gn[2][2];
#pragma unroll
        for (int c = 0; c < 2; ++c) { gn[c][0] = ((const f32x4*)F.a->in[I_GN1])[2 * (64 * c + F.lane)]; gn[c][1] = ((const f32x4*)F.a->in[I_GN1])[2 * (64 * c + F.lane) + 1]; }
        f32x4 v[2][2][2], nv[2][2][2];
#define P0_LOAD(dst, m2_) do { _Pragma("unroll") for (int rr = 0; rr < 2; ++rr) { const f32x4* xr = (const f32x4*)(F.a->in[I_X] + (size_t)(2 * (m2_) + rr) * DM); \
            _Pragma("unroll") for (int c = 0; c < 2; ++c) { dst[rr][c][0] = xr[2 * (64 * c + F.lane)]; dst[rr][c][1] = xr[2 * (64 * c + F.lane) + 1]; } } } while (0)
        if (gw < T / 2) P0_LOAD(nv, gw);
        for (int m2 = gw; m2 < T / 2; m2 += NGW) {
#pragma unroll
            for (int rr = 0; rr < 2; ++rr)
#pragma unroll
                for (int c = 0; c < 2; ++c) { v[rr][c][0] = nv[rr][c][0]; v[rr][c][1] = nv[rr][c][1]; }
            { const int mn = m2 + NGW < T / 2 ? m2 + NGW : m2; P0_LOAD(nv, mn); }
#pragma unroll
            for (int rr = 0; rr < 2; ++rr) { float ss = 0.f;
#pragma unroll
                for (int c = 0; c < 2; ++c)
#pragma unroll
                    for (int q = 0; q < 2; ++q) { const f32x4 a = v[rr][c][q]; ss += (a.x * a.x + a.y * a.y) + (a.z * a.z + a.w * a.w); }
                const float rs = 1.0f / sqrtf(wave_sum(ss) * (1.f / DM) + EPS);
                u32x4* o16 = (u32x4*)((bf16_t*)(ws + WS_H1) + (size_t)(2 * m2 + rr) * DM); u32x2* o8 = (u32x2*)((unsigned char*)(ws + WS_H1F8) + (size_t)(2 * m2 + rr) * DM);
#pragma unroll
                for (int c = 0; c < 2; ++c) { const f32x4 h0 = v[rr][c][0] * rs * gn[c][0], h1v = v[rr][c][1] * rs * gn[c][1];
                    u32x4 o; o.x = cvtpk_bf16(h0.x, h0.y); o.y = cvtpk_bf16(h0.z, h0.w); o.z = cvtpk_bf16(h1v.x, h1v.y); o.w = cvtpk_bf16(h1v.z, h1v.w); o16[64 * c + F.lane] = o;
                    u32x2 p; p.x = pg8::pk4_fp8(h0.x, h0.y, h0.z, h0.w); p.y = pg8::pk4_fp8(h1v.x, h1v.y, h1v.z, h1v.w); o8[64 * c + F.lane] = p; } }
        }
#undef P0_LOAD
    }
    for (int it = gw; it < NTR; it += NGW) {
        int r = it;
        if (r < I_IN) { tr_item(F.a->in[I_WIN], IN_COLS, DM, (bf16_t*)(ws + WS_WIN_T), 1, scr, r / 96, r % 96, F.lane); continue; } r -= I_IN;
        if (r < I_MG) { tr_item8(F.a->in[I_WIN], IN_COLS, DM, (unsigned char*)(ws + WS_WMG8), 3, scr, r / 64, r % 64, F.lane); continue; } r -= I_MG;
        if (r < I_PA) { tr_item(F.a->in[I_WPA], DM, DM, (bf16_t*)(ws + WS_WPA_T), 0, scr, r / 32, r % 32, F.lane); continue; } r -= I_PA;
        if (r < I_PA) { tr_item(F.a->in[I_WPB], DM, DM, (bf16_t*)(ws + WS_WPA_T) + AW, 0, scr, r / 32, r % 32, F.lane); continue; } r -= I_PA;
        if (r < I_PO) { tr_item(F.a->in[I_WO], DM, DM, (bf16_t*)(ws + WS_WO_T), 0, scr, r / 32, r % 32, F.lane); continue; } r -= I_PO;
        if (r < I_C1) { tr_item(F.a->in[I_CKW1], CMP_HID, 2048, (bf16_t*)(ws + WS_CKW1_T), 0, scr, r / 8, r % 8, F.lane); continue; } r -= I_C1;
        { tr_item(F.a->in[I_CVW1], CMP_HID, 2048, (bf16_t*)(ws + WS_CVW1_T), 0, scr, r / 8, r % 8, F.lane); }
    }
    __syncthreads();
    for (int it = blockIdx.x; it < 8; it += F.G) {
        const int kv = it >> 2, jb = it & 3, j = jb * 64 + F.lane;
        const float* pe = kv ? F.a->in[I_PEV] : F.a->in[I_PEK]; const float* w1 = kv ? F.a->in[I_CVW1] : F.a->in[I_CKW1];
        float a = 0.f;
#pragma unroll 1
        for (int ib = 0; ib < 4; ++ib) { float wv[64];
#pragma unroll
            for (int i = 0; i < 64; ++i) wv[i] = w1[(size_t)(F.wave * 256 + ib * 64 + i) * CMP_HID + j];
#pragma unroll
            for (int i = 0; i < 64; ++i) a += pe[F.wave * 256 + ib * 64 + i] * wv[i]; }
        LAS float* red = (LAS float*)F.lds;
        red[F.wave * 64 + F.lane] = a; __syncthreads();
        if (F.wave == 0) { float s = (kv ? F.a->in[I_CVB1] : F.a->in[I_CKB1])[j];
#pragma unroll
            for (int w = 0; w < 8; ++w) s += red[w * 64 + F.lane];
            ((float*)(ws + WS_B1P))[kv * 256 + j] = s; }
        __syncthreads();
    }
}

__device__ __forceinline__ void p2_elementwise(Frame& F, int run) {
    unsigned char* ws = F.ws; const int lane = F.lane;
    bf16_t* Q = (bf16_t*)(ws + WS_Q); bf16_t* KV6 = (bf16_t*)(ws + WS_KV6); const bf16_t* C3 = (const bf16_t*)(ws + WS_CONV3); bf16_t* YB = (bf16_t*)(ws + WS_YB);
    float gq[8], gk[8], cw[3][8];
    { const float* g = F.a->in[I_GQ] + (lane & 7) * 8; const float* g2 = (((lane >> 4) & 1) ? F.a->in[I_GKW] : F.a->in[I_GKS]) + (lane & 7) * 8;
#pragma unroll
      for (int k = 0; k < 8; ++k) { gq[k] = g[k] * QSCALE; gk[k] = g2[k]; }
#pragma unroll
      for (int j = 0; j < 3; ++j)
#pragma unroll
          for (int k = 0; k < 8; ++k) cw[j][k] = F.a->in[I_CONVW][j * CONVW + lane * 8 + k]; }
    {
        const int t0 = run * 32;
        float v1[8], v2[8];
        if ((t0 & (SEQ - 1)) == 0) {
#pragma unroll
            for (int k = 0; k < 8; ++k) { v1[k] = 0.f; v2[k] = 0.f; }
        } else {
            const u32x4 c1 = *(const u32x4*)(C3 + (size_t)(t0 - 1) * 1024 + 512 + lane * 8), c2 = *(const u32x4*)(C3 + (size_t)(t0 - 2) * 1024 + 512 + lane * 8);
#pragma unroll
            for (int k = 0; k < 4; ++k) { v1[2 * k] = bflo(c1[k]); v1[2 * k + 1] = bfhi(c1[k]); v2[2 * k] = bflo(c2[k]); v2[2 * k + 1] = bfhi(c2[k]); }
        }
        const int kcol = 256 + ((lane >> 4) & 1) * 256 + (lane & 15) * 8;
        u32x4 nk, nb, nc;
        { const size_t tok = (size_t)t0; nk = *(const u32x4*)(KV6 + tok * 768 + kcol);
          nb = *(const u32x4*)(C3 + tok * 1024 + lane * 8); nc = *(const u32x4*)(C3 + tok * 1024 + 512 + lane * 8); }
        for (int tt = 0; tt < 32; ++tt) {
            const size_t tok = (size_t)(t0 + tt);
            const u32x4 wk = nk, b = nb, c = nc;
            if (tt + 1 < 32) { const size_t tn = tok + 1; nk = *(const u32x4*)(KV6 + tn * 768 + kcol);
                nb = *(const u32x4*)(C3 + tn * 1024 + lane * 8); nc = *(const u32x4*)(C3 + tn * 1024 + 512 + lane * 8); }
            { float x[8];
#pragma unroll
              for (int k = 0; k < 4; ++k) { x[2 * k] = bflo(wk[k]); x[2 * k + 1] = bfhi(wk[k]); }
              float s = 0.f;
#pragma unroll
              for (int k = 0; k < 8; ++k) s += x[k] * x[k];
              s += __shfl_xor(s, 1); s += __shfl_xor(s, 2); s += __shfl_xor(s, 4);
              const float rs = 1.0f / sqrtf(s * (1.f / 64.f) + EPS);
              u32x4 o; o.x = cvtpk_bf16(x[0] * rs * gk[0], x[1] * rs * gk[1]); o.y = cvtpk_bf16(x[2] * rs * gk[2], x[3] * rs * gk[3]); o.z = cvtpk_bf16(x[4] * rs * gk[4], x[5] * rs * gk[5]); o.w = cvtpk_bf16(x[6] * rs * gk[6], x[7] * rs * gk[7]);
              if (lane < 32) *(u32x4*)(KV6 + tok * 768 + kcol) = o; }
            { float v0[8], bb[8], y[8];
#pragma unroll
              for (int k = 0; k < 4; ++k) { v0[2 * k] = bflo(c[k]); v0[2 * k + 1] = bfhi(c[k]); bb[2 * k] = bflo(b[k]); bb[2 * k + 1] = bfhi(b[k]); }
#pragma unroll
              for (int k = 0; k < 8; ++k) { y[k] = bb[k] * (cw[0][k] * v2[k] + cw[1][k] * v1[k] + cw[2][k] * v0[k]); v2[k] = v1[k]; v1[k] = v0[k]; }
              u32x4 o; o.x = cvtpk_bf16(y[0], y[1]); o.y = cvtpk_bf16(y[2], y[3]); o.z = cvtpk_bf16(y[4], y[5]); o.w = cvtpk_bf16(y[6], y[7]);
              *(u32x4*)(YB + tok * 512 + lane * 8) = o; }
        }
    }
}

__device__ __forceinline__ void p2_queue(Frame& F) {
    unsigned char* ws = F.ws;
    constexpr int I_GU = 16 * 64, I_DN = 16 * 32, N_EW = T / 32, N_CV = NEXP * I_GU + NEXP * I_DN, CHUNK = 8;
    constexpr int NCHUNK = (N_CV + CHUNK - 1) / CHUNK;
    unsigned* head = (unsigned*)(ws + WS_CTL) + 8192;
    LAS float* scr = (LAS float*)(F.lds + F.wave * 16384);
    for (int run = F.vcu * 8 + F.wave; run < N_EW; run += F.G * 8) p2_elementwise(F, run);
    for (;;) {
        unsigned c = 0;
        if (F.lane == 0) c = __hip_atomic_fetch_add(head, 1u, __ATOMIC_RELAXED, __HIP_MEMORY_SCOPE_AGENT);
        c = (unsigned)__builtin_amdgcn_readfirstlane((int)c);
        if (c >= (unsigned)NCHUNK) break;
#pragma unroll 1
        for (int k = 0; k < CHUNK; ++k) { int r0 = (int)c * CHUNK;
            if (r0 < NEXP * I_GU) { const int e = r0 / I_GU, g64 = (r0 % I_GU) / 64, j = (r0 % 64) / 8;
                tr_item8(F.a->in[I_WGU] + (size_t)e * DM * 2048, 2048, DM, (unsigned char*)(ws + WS_WGU_T) + (size_t)e * 2048 * DM, 2, scr, g64, j + 8 * k, F.lane); continue; }
            r0 -= NEXP * I_GU;
            { const int e = r0 / I_DN, g32 = (r0 % I_DN) / 32, j = (r0 % 32) / 8;
              tr_item8(F.a->in[I_WDN] + (size_t)e * DFF * DM, DM, DFF, (unsigned char*)(ws + WS_WDN_T) + (size_t)e * DM * DFF, 0, scr, g32, j + 4 * k, F.lane); } }
    }
}

__device__ __forceinline__ void p3_compress2(Frame& F) {
    unsigned char* ws = F.ws; const int lane = F.lane;
    const bf16_t* HID = (const bf16_t*)(ws + WS_HID);
    LAS float* hr = (LAS float*)(F.lds + F.wave * 1024);
    const int gw = F.vcu * 8 + F.wave, NGW = F.G * 8;
    for (int row = gw; row < 16384; row += NGW) {
        const int kv = row >> 13, n = row & 511;
        if (n == 511) { ((bf16_t*)(ws + (kv ? WS_VC : WS_KC)))[(size_t)(row & 8191) * 64 + lane] = 0; continue; }
        { const u32x2 w = *(const u32x2*)(HID + (size_t)row * 256 + lane * 4); hr[lane * 4 + 0] = bflo(w.x); hr[lane * 4 + 1] = bfhi(w.x); hr[lane * 4 + 2] = bflo(w.y); hr[lane * 4 + 3] = bfhi(w.y); }
        LDS_WAIT(); asm volatile("" ::: "memory");
        const float* w2 = kv ? F.a->in[I_CVW2] : F.a->in[I_CKW2];
        float a = (kv ? F.a->in[I_CVB2] : F.a->in[I_CKB2])[lane];
#pragma unroll 1
        for (int kb = 0; kb < 4; ++kb) { float wv[64];
#pragma unroll
            for (int k = 0; k < 64; ++k) wv[k] = w2[(kb * 64 + k) * 64 + lane];
#pragma unroll
            for (int k = 0; k < 64; ++k) a += hr[kb * 64 + k] * wv[k]; }
        if (kv == 0) { const float ss = wave_sum(a * a); a = a * (1.0f / sqrtf(ss * (1.f / 64.f) + EPS)) * F.a->in[I_GKC][lane]; }
        ((bf16_t*)(ws + (kv ? WS_VC : WS_KC)))[(size_t)(row & 8191) * 64 + lane] = (bf16_t)f2bf(a);
        LDS_WAIT(); asm volatile("" ::: "memory");
    }
}

__device__ __forceinline__ float dot64(const bf16_t* krow, const f32x4 (&q4)[16]) {
    float s = 0.f;
#pragma unroll
    for (int c = 0; c < 8; ++c) { const u32x4 w = *(const u32x4*)(krow + 8 * c);
        s += q4[2 * c].x * bflo(w.x) + q4[2 * c].y * bfhi(w.x) + q4[2 * c].z * bflo(w.y) + q4[2 * c].w * bfhi(w.y)
           + q4[2 * c + 1].x * bflo(w.z) + q4[2 * c + 1].y * bfhi(w.z) + q4[2 * c + 1].z * bflo(w.w) + q4[2 * c + 1].w * bfhi(w.w); }
    return s;
}
__device__ __forceinline__ void p4_attn_naive(Frame& F) {
    unsigned char* ws = F.ws; const int lane = F.lane, h = F.wave, g = h >> 2;
    LAS float* SC = (LAS float*)F.lds + h * 1024;
    LAS float* PC = (LAS float*)F.lds + 8192 + h * 512;
    LAS float* PCg = (LAS float*)F.lds + 8192;
    LAS float* QS = (LAS float*)F.lds + 12288 + h * 64;
    LAS float* SCORE = (LAS float*)F.lds + 12800;
    LAS int* SEL = (LAS int*)((LAS float*)F.lds + 13056);
    bf16_t* Q = (bf16_t*)(ws + WS_Q); const bf16_t* KV6 = (const bf16_t*)(ws + WS_KV6);
    const bf16_t* KC = (const bf16_t*)(ws + WS_KC); const bf16_t* VC = (const bf16_t*)(ws + WS_VC); const bf16_t* NG = (const bf16_t*)(ws + WS_NG);
    const float slope2 = __builtin_amdgcn_ldexpf(LOG2E, -(h + 1));
    const float NEGB = -1e30f;
    for (int tok = blockIdx.x; tok < T; tok += F.G) {
        const int b = tok >> 13, t = tok & (SEQ - 1), cur = t >> 6;
        QS[lane] = bf2f(Q[(size_t)tok * 512 + h * 64 + lane]);
        LDS_WAIT(); asm volatile("" ::: "memory");
        f32x4 q4[16];
#pragma unroll
        for (int i = 0; i < 16; ++i) q4[i] = *(const LAS f32x4*)(QS + 4 * i);
        const int nvalid = t >= 31 ? ((t - 31) >> 4) + 1 : 0;
        const bf16_t* kcb = KC + (size_t)((b * 2 + g) * 512) * 64; const bf16_t* vcb = VC + (size_t)((b * 2 + g) * 512) * 64;
        float oc = 0.f;
        {
            float mx = NEGB;
            for (int n = lane; n < nvalid; n += 64) { const float x = dot64(kcb + (size_t)n * 64, q4) - slope2 * (float)(t - (16 * n + 31)); SC[n] = x; mx = fmaxf(mx, x); }
            mx = wave_max(mx);
            float sum = 0.f;
            for (int n = lane; n < nvalid; n += 64) { const float p = exp2f(SC[n] - mx); SC[n] = p; sum += p; }
            sum = wave_sum(sum); const float il = nvalid > 0 ? 1.0f / sum : 0.f;
            for (int n = lane; n < 512; n += 64) PC[n] = n < nvalid ? SC[n] * il : 0.f;
            LDS_WAIT(); asm volatile("" ::: "memory");
            for (int n = 0; n < nvalid; ++n) oc += PC[n] * bf2f(vcb[(size_t)n * 64 + lane]);
        }
        __syncthreads();
        if (F.tid < 256) { const int gg = F.tid >> 7, j = F.tid & 127, a = 4 * j; float s = 0.f;
#pragma unroll
            for (int hh = 0; hh < 4; ++hh) { const LAS float* P = PCg + (gg * 4 + hh) * 512; s += (a > 0 ? P[a - 1] : 0.f) + 2.f * (P[a] + P[a + 1] + P[a + 2]) + P[a + 3]; }
            SCORE[gg * 128 + j] = j > cur ? -1e30f : ((j == 0 || j == cur || j == cur - 1) ? 1e30f : s); }
        __syncthreads();
        if (h < 2) { float a = SCORE[h * 128 + lane], bb = SCORE[h * 128 + 64 + lane];
            for (int r = 0; r < NSEL; ++r) { const float m = wave_max(fmaxf(a, bb));
                const unsigned long long ba = __ballot(a == m); int idx;
                if (ba) { idx = __ffsll((long long)ba) - 1; if (lane == idx) a = -3e38f; }
                else { const unsigned long long b2 = __ballot(bb == m); idx = __ffsll((long long)b2) - 1; if (lane == idx) bb = -3e38f; idx += 64; }
                if (lane == 0) SEL[h * 16 + r] = idx; } }
        __syncthreads();
        float os = 0.f;
        {
            float mx = NEGB;
            for (int r = 0; r < NSEL; ++r) { const int j = SEL[g * 16 + r]; float x = NEGB;
                if (j <= cur) { const int pos = 64 * j + lane; if (pos <= t) x = dot64(KV6 + (size_t)(b * SEQ + pos) * 768 + 256 + g * 64, q4) - slope2 * (float)(t - pos); }
                SC[r * 64 + lane] = x; mx = fmaxf(mx, x); }
            mx = wave_max(mx); float sum = 0.f;
            for (int r = 0; r < NSEL; ++r) { const float p = exp2f(SC[r * 64 + lane] - mx); SC[r * 64 + lane] = p; sum += p; }
            sum = wave_sum(sum); const float il = 1.0f / sum;
            LDS_WAIT(); asm volatile("" ::: "memory");
            for (int r = 0; r < NSEL; ++r) { const int j = SEL[g * 16 + r]; if (j > cur) continue;
                const bf16_t* vb = KV6 + (size_t)(b * SEQ + 64 * j) * 768 + 384 + g * 64 + lane; const int kmax = (64 * j + 63 <= t) ? 64 : (t - 64 * j + 1);
                for (int kk = 0; kk < kmax; ++kk) os += SC[r * 64 + kk] * bf2f(vb[(size_t)kk * 768]); }
            os *= il;
        }
        float ow = 0.f;
        {
            float mx = NEGB;
            for (int i = lane; i < WIN; i += 64) { const int pos = t - (WIN - 1) + i; float x = NEGB;
                if (pos >= 0) x = dot64(KV6 + (size_t)(b * SEQ + pos) * 768 + 512 + g * 64, q4) - slope2 * (float)(t - pos);
                SC[i] = x; mx = fmaxf(mx, x); }
            mx = wave_max(mx); float sum = 0.f;
            for (int i = lane; i < WIN; i += 64) { const float p = exp2f(SC[i] - mx); SC[i] = p; sum += p; }
            sum = wave_sum(sum); const float il = 1.0f / sum;
            LDS_WAIT(); asm volatile("" ::: "memory");
            const int i0 = t >= WIN - 1 ? 0 : (WIN - 1 - t);
            for (int i = i0; i < WIN; ++i) { const int pos = t - (WIN - 1) + i; ow += SC[i] * bf2f(KV6[(size_t)(b * SEQ + pos) * 768 + 640 + g * 64 + lane]); }
            ow *= il;
        }
        const float g0 = bf2f(NG[(size_t)tok * 32 + h * 3 + 0]), g1 = bf2f(NG[(size_t)tok * 32 + h * 3 + 1]), g2 = bf2f(NG[(size_t)tok * 32 + h * 3 + 2]);
        ((bf16_t*)(ws + WS_OA))[(size_t)tok * 512 + h * 64 + lane] = (bf16_t)f2bf(g0 * oc + g1 * os + g2 * ow);
        __syncthreads();
    }
}

namespace at {
typedef __attribute__((address_space(3))) const char* lcp;
typedef short s16x4 __attribute__((ext_vector_type(4)));
typedef float f32x16 __attribute__((ext_vector_type(16)));
typedef short v4i16_t __attribute__((ext_vector_type(4)));
constexpr int SLOTB = 8192;
constexpr int NSLOT = 4;
constexpr int L_K = 0, L_V = NSLOT * SLOTB, L_WS = 2 * NSLOT * SLOTB, L_OST = L_WS + 8 * 256, L_IMP = L_OST  , L_SELM = L_OST + 8 * 8192, L_UNION = L_SELM + 1024, L_NTL = L_UNION + 16, L_TL = L_NTL + 16, L_END = L_TL + 512;
static_assert(L_END <= MISC_OFF, "attention LDS");
constexpr float NEGBIG = -1e30f;
__device__ __forceinline__ void glds16(const void* gsrc, unsigned lds_dst) { unsigned keep;
    asm volatile("s_mov_b32 %0, m0\n\ts_mov_b32 m0, %2\n\ts_nop 0\n\tglobal_load_lds_dwordx4 %1, off\n\ts_mov_b32 m0, %0" : "=&s"(keep) : "v"(gsrc), "s"(lds_dst) : "memory"); }
__device__ __forceinline__ void glds16s(const void* sbase, unsigned voff, unsigned lds_dst) { unsigned keep;
    asm volatile("s_mov_b32 %0, m0\n\ts_mov_b32 m0, %3\n\ts_nop 0\n\tglobal_load_lds_dwordx4 %1, %2\n\ts_mov_b32 m0, %0" : "=&s"(keep) : "v"(voff), "s"(sbase), "s"(lds_dst) : "memory"); }
__device__ __forceinline__ unsigned cvtpk(float lo, float hi) { return cvtpk_bf16(lo, hi); }
#define AT_WAIT_BAR(N) asm volatile("s_waitcnt vmcnt(" #N ") lgkmcnt(0)\n\ts_barrier" ::: "memory")
#define AT_SBAR() __builtin_amdgcn_sched_barrier(0)
#define AT_LOCALS(LN) const int lane = LN; const int r32 = lane & 31, hi = lane >> 5, hh = r32 >> 3, qi = r32 & 7; const int tq = q0 + 8 * wid + qi, qoff = 8 * wid + qi; const int h = 4 * g + hh; \
    const float slope2 = __builtin_amdgcn_ldexpf(LOG2E, -(h + 1)); const lcp kp0 = (lcp)lds + L_K + hi * 1024 + r32 * 16; LAS float* gst = (LAS float*)(lds + L_V + 3 * SLOTB) + wid * 128 + lane; (void)hh; (void)qoff; (void)tq; (void)gst; (void)kp0; (void)slope2

template <int KMUL, int MODE>
__device__ __forceinline__ void qk_tile(f32x16& p0, f32x16& p1, lcp kp, const bf16x8 (&qr)[4], float cinit, float slope2, int klim2) {
    f32x16 c;
#pragma unroll
    for (int r = 0; r < 16; ++r) c[r] = cinit;
#pragma unroll
    for (int d0 = 0; d0 < 4; ++d0) {
        const bf16x8 b0 = *(const LAS bf16x8*)(kp + d0 * 2048), b1 = *(const LAS bf16x8*)(kp + d0 * 2048 + 512);
        if (d0 == 0) { p0 = __builtin_amdgcn_mfma_f32_32x32x16_bf16(b0, qr[0], c, 0, 0, 0); p1 = __builtin_amdgcn_mfma_f32_32x32x16_bf16(b1, qr[0], c, 0, 0, 0); }
        else { p0 = __builtin_amdgcn_mfma_f32_32x32x16_bf16(b0, qr[d0], p0, 0, 0, 0); p1 = __builtin_amdgcn_mfma_f32_32x32x16_bf16(b1, qr[d0], p1, 0, 0, 0); }
    }
#pragma unroll
    for (int r = 0; r < 16; ++r) { const int lit = (r & 3) + 8 * (r >> 2);
        float a = slope2 * (float)(KMUL * lit) + p0[r], b = slope2 * (float)(KMUL * (lit + 32)) + p1[r];
        if (MODE == 1) { a = (lit <= klim2) ? a : NEGBIG; b = (lit + 32 <= klim2) ? b : NEGBIG; }
        if (MODE == 2) { a = (lit > klim2) ? a : NEGBIG; b = (lit + 32 > klim2) ? b : NEGBIG; }
        p0[r] = __builtin_amdgcn_exp2f(a); p1[r] = __builtin_amdgcn_exp2f(b); }
}
__device__ __forceinline__ void qk_mfma(f32x16& p0, f32x16& p1, lcp kp, const bf16x8 (&qr)[4], float cinit) {
    f32x16 c;
#pragma unroll
    for (int r = 0; r < 16; ++r) c[r] = cinit;
#pragma unroll
    for (int d0 = 0; d0 < 4; ++d0) {
        const bf16x8 b0 = *(const LAS bf16x8*)(kp + d0 * 2048), b1 = *(const LAS bf16x8*)(kp + d0 * 2048 + 512);
        if (d0 == 0) { p0 = __builtin_amdgcn_mfma_f32_32x32x16_bf16(b0, qr[0], c, 0, 0, 0); p1 = __builtin_amdgcn_mfma_f32_32x32x16_bf16(b1, qr[0], c, 0, 0, 0); }
        else { p0 = __builtin_amdgcn_mfma_f32_32x32x16_bf16(b0, qr[d0], p0, 0, 0, 0); p1 = __builtin_amdgcn_mfma_f32_32x32x16_bf16(b1, qr[d0], p1, 0, 0, 0); }
    }
}
template <int KMUL, int MODE>
__device__ __forceinline__ void sm_valu(f32x16& p0, f32x16& p1, float slope2, int klim2) {
#pragma unroll
    for (int r = 0; r < 16; ++r) { const int lit = (r & 3) + 8 * (r >> 2);
        float a = slope2 * (float)(KMUL * lit) + p0[r], b = slope2 * (float)(KMUL * (lit + 32)) + p1[r];
        if (MODE == 1) { a = (lit <= klim2) ? a : NEGBIG; b = (lit + 32 <= klim2) ? b : NEGBIG; }
        if (MODE == 2) { a = (lit > klim2) ? a : NEGBIG; b = (lit + 32 > klim2) ? b : NEGBIG; }
        p0[r] = __builtin_amdgcn_exp2f(a); p1[r] = __builtin_amdgcn_exp2f(b); }
}
__device__ __forceinline__ float psum(const f32x16& p0, const f32x16& p1) {
    float a = 0.f, b = 0.f;
#pragma unroll
    for (int r = 0; r < 16; r += 2) { a += p0[r] + p1[r]; b += p0[r + 1] + p1[r + 1]; }
    return a + b;
}
__device__ __forceinline__ void pv_tile(f32x16* o, int vb, const f32x16& p0, const f32x16& p1) {
    u32x4 pw[4];
#pragma unroll
    for (int i = 0; i < 4; ++i) { pw[0][i] = cvtpk(p0[2 * i], p0[2 * i + 1]); pw[1][i] = cvtpk(p0[8 + 2 * i], p0[9 + 2 * i]); pw[2][i] = cvtpk(p1[2 * i], p1[2 * i + 1]); pw[3][i] = cvtpk(p1[8 + 2 * i], p1[9 + 2 * i]); }
    s16x4 lo[2][4], hi[2][4];
#pragma unroll
    for (int dh = 0; dh < 2; ++dh)
#pragma unroll
        for (int ks = 0; ks < 4; ++ks) {
            asm volatile("ds_read_b64_tr_b16 %0,%1 offset:%c2" : "=&v"(lo[dh][ks]) : "v"(vb), "i"(dh * 4096 + ks * 1024) : "memory");
            asm volatile("ds_read_b64_tr_b16 %0,%1 offset:%c2" : "=&v"(hi[dh][ks]) : "v"(vb), "i"(dh * 4096 + ks * 1024 + 512) : "memory"); }
    asm volatile("s_waitcnt lgkmcnt(0)" ::: "memory"); AT_SBAR();
#define AT_PK(d, k) (bf16x8){lo[d][k][0], lo[d][k][1], lo[d][k][2], lo[d][k][3], hi[d][k][0], hi[d][k][1], hi[d][k][2], hi[d][k][3]}
#pragma unroll
    for (int ks = 0; ks < 4; ++ks) {
        o[0] = __builtin_amdgcn_mfma_f32_32x32x16_bf16(__builtin_bit_cast(bf16x8, pw[ks]), AT_PK(0, ks), o[0], 0, 0, 0);
        o[1] = __builtin_amdgcn_mfma_f32_32x32x16_bf16(__builtin_bit_cast(bf16x8, pw[ks]), AT_PK(1, ks), o[1], 0, 0, 0); }
#undef AT_PK
}
__device__ __forceinline__ void pv_tile_seq(f32x16* o, int vb, const f32x16& p0, const f32x16& p1) {
    u32x4 pw[4];
#pragma unroll
    for (int i = 0; i < 4; ++i) { pw[0][i] = cvtpk(p0[2 * i], p0[2 * i + 1]); pw[1][i] = cvtpk(p0[8 + 2 * i], p0[9 + 2 * i]); pw[2][i] = cvtpk(p1[2 * i], p1[2 * i + 1]); pw[3][i] = cvtpk(p1[8 + 2 * i], p1[9 + 2 * i]); }
#pragma unroll
    for (int dh = 0; dh < 2; ++dh) { s16x4 lo[4], hi[4];
#pragma unroll
        for (int ks = 0; ks < 4; ++ks) {
            asm volatile("ds_read_b64_tr_b16 %0,%1 offset:%c2" : "=&v"(lo[ks]) : "v"(vb), "i"(dh * 4096 + ks * 1024) : "memory");
            asm volatile("ds_read_b64_tr_b16 %0,%1 offset:%c2" : "=&v"(hi[ks]) : "v"(vb), "i"(dh * 4096 + ks * 1024 + 512) : "memory"); }
        asm volatile("s_waitcnt lgkmcnt(0)" ::: "memory"); AT_SBAR();
#define AT_PK(k) (bf16x8){lo[k][0], lo[k][1], lo[k][2], lo[k][3], hi[k][0], hi[k][1], hi[k][2], hi[k][3]}
        o[dh] = __builtin_amdgcn_mfma_f32_32x32x16_bf16(__builtin_bit_cast(bf16x8, pw[0]), AT_PK(0), o[dh], 0, 0, 0);
        o[dh] = __builtin_amdgcn_mfma_f32_32x32x16_bf16(__builtin_bit_cast(bf16x8, pw[1]), AT_PK(1), o[dh], 0, 0, 0);
        o[dh] = __builtin_amdgcn_mfma_f32_32x32x16_bf16(__builtin_bit_cast(bf16x8, pw[2]), AT_PK(2), o[dh], 0, 0, 0);
        o[dh] = __builtin_amdgcn_mfma_f32_32x32x16_bf16(__builtin_bit_cast(bf16x8, pw[3]), AT_PK(3), o[dh], 0, 0, 0);
#undef AT_PK
    }
}
template <class Br>
__device__ __forceinline__ void stream_pv(const Br br, const int nt, f32x16 (&o)[2], float& lsum, const bf16x8 (&qr)[4], lcp kp0, int vb0, unsigned kdst, unsigned vdst, float slope2) {
    if (nt <= 0) return;
    f32x16 s0, s1;
#define AT_ISSUE(t) do { glds16(br.ksrc(t), kdst + ((t) & 3) * SLOTB); glds16(br.vsrc(t), vdst + ((t) & 3) * SLOTB); } while (0)
    AT_ISSUE(0); if (nt > 1) AT_ISSUE(1); if (nt > 2) AT_ISSUE(2);
    for (int t = 0; t < nt; ++t) {
        if (t + 2 < nt) { AT_WAIT_BAR(4); } else if (t + 1 < nt) { AT_WAIT_BAR(2); } else { AT_WAIT_BAR(0); }
        if (t + 3 < nt) AT_ISSUE(t + 3);
        float ci; int kl, md; bool ac; br.info(t, ci, kl, md, ac);
        if (ac) { qk_mfma(s0, s1, kp0 + (t & 3) * SLOTB, qr, ci);
            if (md == 0) sm_valu<1, 0>(s0, s1, slope2, 0); else if (md == 1) sm_valu<1, 1>(s0, s1, slope2, kl); else sm_valu<1, 2>(s0, s1, slope2, kl);
            lsum += psum(s0, s1); pv_tile(o, vb0 + (t & 3) * SLOTB, s0, s1); }
    }
    AT_WAIT_BAR(0);
#undef AT_ISSUE
}

typedef short v4i16_t2 __attribute__((ext_vector_type(4)));
__device__ __forceinline__ s16x4 vtr(lcp p) { return __builtin_bit_cast(s16x4, __builtin_amdgcn_ds_read_tr16_b64_v4i16((__attribute__((address_space(3))) v4i16_t2*)p)); }
__device__ __forceinline__ void kload2(bf16x8* kf, lcp kp, int j) { kf[2 * j] = *(const LAS bf16x8*)(kp + j * 2048); kf[2 * j + 1] = *(const LAS bf16x8*)(kp + j * 2048 + 512); }
template <class Br>
__device__ __forceinline__ void stream2(Br br, const int nt, f32x16 (&o)[2], float& lsum, const bf16x8 (&qr)[4], lcp kp0, lcp vp0, unsigned kdst, unsigned vdst, float slope2, const int lane, const int wid) {
    if (nt <= 0) return;
#define klim2 (8 * wid + (lane & 7) - 4 * (lane >> 5))
    const int vb0 = (int)(unsigned)(uintptr_t)vp0;
#define S2_DK(off, t, slot) br.dk(off, t, kdst + (unsigned)(slot))
#define S2_DV(off, t, slot) br.dv(off, t, vdst + (unsigned)(slot))
    br.start(nt);
    S2_DK(0, 0, 0); S2_DV(0, 0, 0); if (nt > 1) S2_DK(1, 1, SLOTB); if (nt > 2) S2_DK(2, 2, 2 * SLOTB);
    if (nt > 2) { AT_WAIT_BAR(3); } else if (nt > 1) { AT_WAIT_BAR(2); } else { AT_WAIT_BAR(1); }
    f32x16 pA0, pA1, pB0, pB1;
    const bool odd = (nt & 1) != 0;
    { const float ci = br.cinit(0, 0); const int md = br.mode(0, 0); f32x16 q0_, q1_; qk_mfma(q0_, q1_, kp0, qr, ci);
      if (md == 0) sm_valu<1, 0>(q0_, q1_, slope2, 0); else if (md == 1) sm_valu<1, 1>(q0_, q1_, slope2, klim2); else sm_valu<1, 2>(q0_, q1_, slope2, klim2);
      if (odd) { pB0 = q0_; pB1 = q1_; } else { pA0 = q0_; pA1 = q1_; } }
    AT_WAIT_BAR(0);
    if (nt > 3) S2_DK(3, 3, 0); if (nt > 1) S2_DV(1, 1, SLOTB);
    float ci_cur = br.cinit(1, 1); br.advance(nt, 1);
    int sl_prev = 0, sl_cur = 0, sl_next = SLOTB;
#define S2_ROT() do { sl_prev = sl_cur; sl_cur = sl_next; sl_next = (sl_next == 2 * SLOTB) ? 0 : sl_next + SLOTB; } while (0)
    bf16x8 kf[8];
    if (nt > 1) { S2_ROT(); kload2(kf, kp0 + sl_cur, 0); kload2(kf, kp0 + sl_cur, 1); kload2(kf, kp0 + sl_cur, 2); kload2(kf, kp0 + sl_cur, 3); }
    if (nt > 3) { AT_WAIT_BAR(2); } else if (nt > 2) { AT_WAIT_BAR(1); } else { AT_WAIT_BAR(0); }
    s16x4 vlo[8], vhi[8]; u32x4 pw0, pw1, pw2, pw3;
#define S2_PKW(P, B) cvtpk(P[B], P[(B) + 1])
#define S2_PAF(k) __builtin_bit_cast(bf16x8, pw##k)
#define S2_VFR(i) (bf16x8){vlo[i][0], vlo[i][1], vlo[i][2], vlo[i][3], vhi[i][0], vhi[i][1], vhi[i][2], vhi[i][3]}
#define S2_PIN(x) asm volatile("" : "+v"(x))
#define S2_GAPA(MF, A0, A1, A2, A3, W0, W1, PW) do { MF; sacc += A0; sacc += A1; sacc += A2; sacc += A3; S2_PIN(sacc); W0; W1; S2_PIN(PW); AT_SBAR(); } while (0)
#define S2_LIT(B, i, OFS) ((float)((((B) + (i)) & 3) + 8 * (((B) + (i)) >> 2) + (OFS)))
#define S2_E1(X, B, i, OFS, MODE) do { float a_ = slope2 * S2_LIT(B, i, OFS) + X[(B) + (i)]; \
        if (MODE == 1) a_ = ((int)S2_LIT(B, i, OFS) <= klim2) ? a_ : NEGBIG; if (MODE == 2) a_ = ((int)S2_LIT(B, i, OFS) > klim2) ? a_ : NEGBIG; X[(B) + (i)] = __builtin_amdgcn_exp2f(a_); } while (0)
#define S2_GAPB(MF, X, B, OFS, MODE) do { MF; S2_E1(X, B, 0, OFS, MODE); S2_E1(X, B, 1, OFS, MODE); S2_E1(X, B, 2, OFS, MODE); S2_E1(X, B, 3, OFS, MODE); S2_PIN(X); AT_SBAR(); } while (0)
#define S2_VRD(i) do { vlo[i] = vtr(vp_ + (((i) >> 2) * 4096 + ((i) & 3) * 1024)); vhi[i] = vtr(vp_ + (((i) >> 2) * 4096 + ((i) & 3) * 1024 + 512)); } while (0)
#define S2_KRD(G, j) do { if (G) { kload2(kf, kp0 + sl_next, j); AT_SBAR(); } } while (0)
#define S2_STEP(C0, C1, P0, P1, t, GK, GV, GL, MODE) do { AT_SBAR(); \
    const lcp vp_ = vp0 + sl_prev; \
    S2_VRD(0); AT_SBAR(); float sacc = (P0[0] + P0[1]); \
    S2_GAPA(C0 = __builtin_amdgcn_mfma_f32_32x32x16_bf16(kf[0], qr[0], C0, 0, 0, 0), P0[2], P0[3], P0[4], P0[5], pw0[0] = S2_PKW(P0, 0), pw0[1] = S2_PKW(P0, 2), pw0); \
    S2_VRD(4); AT_SBAR(); S2_GAPA(C1 = __builtin_amdgcn_mfma_f32_32x32x16_bf16(kf[1], qr[0], C1, 0, 0, 0), P0[6], P0[7], P0[8], P0[9], pw0[2] = S2_PKW(P0, 4), pw0[3] = S2_PKW(P0, 6), pw0); \
    S2_VRD(1); AT_SBAR(); S2_GAPA(C0 = __builtin_amdgcn_mfma_f32_32x32x16_bf16(kf[2], qr[1], C0, 0, 0, 0), P0[10], P0[11], P0[12], P0[13], pw1[0] = S2_PKW(P0, 8), pw1[1] = S2_PKW(P0, 10), pw1); \
    S2_VRD(5); AT_SBAR(); S2_GAPA(C1 = __builtin_amdgcn_mfma_f32_32x32x16_bf16(kf[3], qr[1], C1, 0, 0, 0), P0[14], P0[15], P1[0], P1[1], pw1[2] = S2_PKW(P0, 12), pw1[3] = S2_PKW(P0, 14), pw1); \
    S2_VRD(2); AT_SBAR(); S2_GAPA(C0 = __builtin_amdgcn_mfma_f32_32x32x16_bf16(kf[4], qr[2], C0, 0, 0, 0), P1[2], P1[3], P1[4], P1[5], pw2[0] = S2_PKW(P1, 0), pw2[1] = S2_PKW(P1, 2), pw2); \
    S2_VRD(6); AT_SBAR(); S2_GAPA(C1 = __builtin_amdgcn_mfma_f32_32x32x16_bf16(kf[5], qr[2], C1, 0, 0, 0), P1[6], P1[7], P1[8], P1[9], pw2[2] = S2_PKW(P1, 4), pw2[3] = S2_PKW(P1, 6), pw2); \
    S2_VRD(3); AT_SBAR(); S2_GAPA(C0 = __builtin_amdgcn_mfma_f32_32x32x16_bf16(kf[6], qr[3], C0, 0, 0, 0), P1[10], P1[11], P1[12], P1[13], pw3[0] = S2_PKW(P1, 8), pw3[1] = S2_PKW(P1, 10), pw3); \
    S2_VRD(7); AT_SBAR(); S2_GAPA(C1 = __builtin_amdgcn_mfma_f32_32x32x16_bf16(kf[7], qr[3], C1, 0, 0, 0), P1[14], P1[15], 0.f, 0.f, pw3[2] = S2_PKW(P1, 12), pw3[3] = S2_PKW(P1, 14), pw3); \
    lsum += sacc; \
    if (GK) { S2_DK(3, (t) + 3, sl_cur); } if (GV) { S2_DV(1, (t) + 1, sl_next); } \
    AT_SBAR(); \
    S2_GAPB(o[0] = __builtin_amdgcn_mfma_f32_32x32x16_bf16(S2_PAF(0), S2_VFR(0), o[0], 0, 0, 0), C0, 0, 0, MODE); \
    S2_GAPB(o[1] = __builtin_amdgcn_mfma_f32_32x32x16_bf16(S2_PAF(0), S2_VFR(4), o[1], 0, 0, 0), C0, 4, 0, MODE); \
    S2_KRD(GL, 0); S2_GAPB(o[0] = __builtin_amdgcn_mfma_f32_32x32x16_bf16(S2_PAF(1), S2_VFR(1), o[0], 0, 0, 0), C0, 8, 0, MODE); \
    S2_KRD(GL, 1); S2_GAPB(o[1] = __builtin_amdgcn_mfma_f32_32x32x16_bf16(S2_PAF(1), S2_VFR(5), o[1], 0, 0, 0), C0, 12, 0, MODE); \
    S2_KRD(GL, 2); S2_GAPB(o[0] = __builtin_amdgcn_mfma_f32_32x32x16_bf16(S2_PAF(2), S2_VFR(2), o[0], 0, 0, 0), C1, 0, 32, MODE); \
    S2_KRD(GL, 3); S2_GAPB(o[1] = __builtin_amdgcn_mfma_f32_32x32x16_bf16(S2_PAF(2), S2_VFR(6), o[1], 0, 0, 0), C1, 4, 32, MODE); \
    S2_GAPB(o[0] = __builtin_amdgcn_mfma_f32_32x32x16_bf16(S2_PAF(3), S2_VFR(3), o[0], 0, 0, 0), C1, 8, 32, MODE); \
    S2_GAPB(o[1] = __builtin_amdgcn_mfma_f32_32x32x16_bf16(S2_PAF(3), S2_VFR(7), o[1], 0, 0, 0), C1, 12, 32, MODE); \
    } while (0)
#define S2_ENDW(tt) do { if ((tt) + 3 < nt) { AT_WAIT_BAR(2); } else if ((tt) + 2 < nt) { AT_WAIT_BAR(1); } else { AT_WAIT_BAR(0); } } while (0)
#define S2_CV(C0, C1, t) do { const float ci_ = ci_cur; float ci2_ = ci_cur; asm volatile("" : "+v"(ci2_)); _Pragma("unroll") for (int r = 0; r < 16; ++r) C0[r] = ci_; S2_PIN(C0); \
        _Pragma("unroll") for (int r = 0; r < 16; ++r) C1[r] = ci2_; S2_PIN(C1); } while (0)
#define S2_RUN(C0, C1, P0, P1, t) do { S2_CV(C0, C1, t); const bool gk_ = (t) + 3 < nt; S2_STEP(C0, C1, P0, P1, t, gk_, true, true, 0); ci_cur = br.cinit(1, (t) + 1); S2_ENDW(t); S2_ROT(); br.advance(nt, (t) + 1); } while (0)
    int t = 1;
    if (odd && nt >= 3) { S2_RUN(pA0, pA1, pB0, pB1, 1); t = 2; }
    for (; t + 2 < nt; t += 2) { S2_RUN(pB0, pB1, pA0, pA1, t); S2_RUN(pA0, pA1, pB0, pB1, t + 1); }
    if (nt >= 2) { S2_CV(pB0, pB1, t); S2_STEP(pB0, pB1, pA0, pA1, t, false, false, false, 1); }
    lsum += psum(pB0, pB1); pv_tile_seq(o, vb0 + sl_cur, pB0, pB1);
    AT_WAIT_BAR(0);
#undef klim2
#undef S2_DK
#undef S2_DV
#undef S2_ROT
#undef S2_PKW
#undef S2_PAF
#undef S2_VFR
#undef S2_PIN
#undef S2_GAPA
#undef S2_LIT
#undef S2_E1
#undef S2_GAPB
#undef S2_VRD
#undef S2_KRD
#undef S2_STEP
#undef S2_ENDW
#undef S2_CV
#undef S2_RUN
}
}

__device__ __forceinline__ void p4_attn(Frame& F) {
    using namespace at;
    unsigned char* ws = F.ws; const int wid = F.wave;
    LAS unsigned char* lds = F.lds;
    const unsigned lds0 = (unsigned)(uintptr_t)lds;
    bf16_t* Q = (bf16_t*)(ws + WS_Q); const bf16_t* KV6 = (const bf16_t*)(ws + WS_KV6);
    const bf16_t* KC = (const bf16_t*)(ws + WS_KC); const bf16_t* VC = (const bf16_t*)(ws + WS_VC); const bf16_t* NG = (const bf16_t*)(ws + WS_NG);
    LAS unsigned* selm = (LAS unsigned*)(lds + L_SELM);
    LAS unsigned* uni = (LAS unsigned*)(lds + L_UNION);
    LAS int* ntl = (LAS int*)(lds + L_NTL);
    LAS int* tl = (LAS int*)(lds + L_TL);
    const unsigned kdst = lds0 + L_K + wid * 1024, vdst = lds0 + L_V + wid * 1024;
    float MREF;
    { float gqm = fabsf(F.a->in[I_GQ][F.lane]), gkm = fmaxf(fmaxf(fabsf(F.a->in[I_GKC][F.lane]), fabsf(F.a->in[I_GKS][F.lane])), fabsf(F.a->in[I_GKW][F.lane]));
      gqm = wave_max(gqm); gkm = wave_max(gkm); MREF = __builtin_bit_cast(float, __builtin_amdgcn_readfirstlane(__builtin_bit_cast(int, 64.0f * QSCALE * gqm * gkm * 1.03f))); }
    LAS float* gql = (LAS float*)(lds + L_V + 3 * SLOTB + 4096);
    if (F.tid < 64) gql[F.tid] = F.a->in[I_GQ][F.tid];
    __syncthreads();
    bf16x8 qraw[4]; bf16_t ngr[3];
#define AT_QLOAD(U, LN) do { const int r32_ = (LN) & 31, hi_ = (LN) >> 5, hh_ = r32_ >> 3, qi_ = r32_ & 7; const int s16_ = F.vcu & 15, bg_ = F.vcu >> 4; \
        const int qt_ = ((U) >> 1) * 32 + (((U) & 1) ? 31 - s16_ : s16_); const unsigned tok_ = (unsigned)((bg_ >> 1) * SEQ + qt_ * 64 + 8 * wid + qi_); const int h_ = 4 * (bg_ & 1) + hh_; \
        _Pragma("unroll") for (int d0 = 0; d0 < 4; ++d0) qraw[d0] = *(const bf16x8*)(ws + ((unsigned)WS_Q + (tok_ * 512u + (unsigned)(h_ * 64 + d0 * 16 + hi_ * 8)) * 2u)); \
        const bf16_t* ngp_ = (const bf16_t*)(ws + ((unsigned)WS_NG + (tok_ * 32u + (unsigned)(h_ * 3)) * 2u)); ngr[0] = ngp_[0]; ngr[1] = ngp_[1]; ngr[2] = ngp_[2]; } while (0)
    if (F.G == 256) AT_QLOAD(0, F.lane);
    for (int ui = 0; ui < 8; ++ui) {
        if (F.G != 256) break;
        int lane = F.lane; asm volatile("" : "+v"(lane));
        const int r32 = lane & 31, hi = lane >> 5, hh = r32 >> 3, qi = r32 & 7;
        LAS float* wsf = (LAS float*)(lds + L_WS) + wid * 64;
        LAS float* impw = (LAS float*)(lds + L_IMP) + wid * 2048;
        LAS float* ostg = (LAS float*)(lds + L_OST) + wid * 2048;
        const lcp kp0 = (lcp)lds + L_K + hi * 1024 + r32 * 16;
        const int vb0 = (int)(lds0 + L_V) + ((lane >> 4) & 1) * 32 + (lane & 3) * 8 + (4 * hi + ((lane & 15) >> 2)) * 64;
        const int bg = F.vcu >> 4, s16 = F.vcu & 15;
        const int qt = (ui >> 1) * 32 + ((ui & 1) ? 31 - s16 : s16);
        const int b = bg >> 1, g = bg & 1, q0 = qt * 64, cur = qt;
        const int tq = q0 + 8 * wid + qi, qoff = 8 * wid + qi;
        const int h = 4 * g + hh;
        const float slope2 = __builtin_amdgcn_ldexpf(LOG2E, -(h + 1));
        const size_t tok = (size_t)b * SEQ + tq;
        bf16x8 qr[4];
#pragma unroll
        for (int d0 = 0; d0 < 4; ++d0) qr[d0] = qraw[d0];
        {
            float xq[4][8]; float ss = 0.f;
#pragma unroll
            for (int d0 = 0; d0 < 4; ++d0) { const u32x4 w = __builtin_bit_cast(u32x4, qr[d0]);
#pragma unroll
                for (int k = 0; k < 4; ++k) { xq[d0][2 * k] = bflo(w[k]); xq[d0][2 * k + 1] = bfhi(w[k]); ss += xq[d0][2 * k] * xq[d0][2 * k] + xq[d0][2 * k + 1] * xq[d0][2 * k + 1]; } }
            ss += __shfl_xor(ss, 32);
            const float rs = QSCALE * __builtin_amdgcn_rsqf(ss * (1.f / 64.f) + EPS);
#pragma unroll
            for (int d0 = 0; d0 < 4; ++d0) { const f32x4 ga = *(const LAS f32x4*)(gql + d0 * 16 + hi * 8), gb = *(const LAS f32x4*)(gql + d0 * 16 + hi * 8 + 4);
                u32x4 w; w.x = cvtpk_bf16(xq[d0][0] * rs * ga.x, xq[d0][1] * rs * ga.y); w.y = cvtpk_bf16(xq[d0][2] * rs * ga.z, xq[d0][3] * rs * ga.w);
                w.z = cvtpk_bf16(xq[d0][4] * rs * gb.x, xq[d0][5] * rs * gb.y); w.w = cvtpk_bf16(xq[d0][6] * rs * gb.z, xq[d0][7] * rs * gb.w);
                qr[d0] = __builtin_bit_cast(bf16x8, w); }
        }
        const float g0 = bf2f(ngr[0]);
        LAS float* gst = (LAS float*)(lds + L_V + 3 * SLOTB) + wid * 128 + lane;
        gst[0] = bf2f(ngr[1]); gst[64] = bf2f(ngr[2]);
        f32x16 o[2], p0, p1;
#pragma unroll
        for (int i = 0; i < 4; ++i) { const float zf = (float)(lane >> 6);
            *(LAS f32x4*)(impw + (i * 64 + lane) * 4) = (f32x4){zf, zf, zf, zf}; }
        const int tidu = wid * 64 + lane;
        if (tidu < 4) uni[tidu] = 0u;
        const unsigned kcl = (unsigned)WS_KC + (unsigned)(((b * 2 + g) * 512 + lane) * 64 + wid * 8) * 2u;
        const unsigned vcl = (unsigned)WS_VC + (unsigned)(((b * 2 + g) * 512 + 16 * (wid & 3) + (lane >> 2)) * 64 + (wid >> 2) * 32 + (lane & 3) * 8) * 2u;
        const int ntc = (4 * cur + 3 + 63) >> 6;
        const int nmax = tq >= 31 ? ((tq - 31) >> 4) : -1;
        const int nfull = cur >= 1 ? (4 * cur - 2) : -1;
        float lsum = 0.f;
#define AT_KOFF_C(t) (kcl + (unsigned)(t) * 8192u)
#define AT_VOFF_C(t) (vcl + (unsigned)(t) * 8192u)
        if (ntc > 0) {
            glds16s(ws, AT_KOFF_C(0), kdst); if (ntc > 1) glds16s(ws, AT_KOFF_C(1), kdst + SLOTB);
            for (int t = 0; t < ntc; ++t) {
                if (t + 1 < ntc) { AT_WAIT_BAR(1); } else { AT_WAIT_BAR(0); }
                if (t + 2 < ntc) glds16s(ws, AT_KOFF_C(t + 2), kdst + ((t + 2) % 3) * SLOTB);
                const float cinit = -slope2 * (float)(tq - 31 - 1024 * t) + slope2 * (float)(64 * hi) - MREF;
                const int klim2 = nmax - 64 * t - 4 * hi;
                if (64 * t + 63 <= nfull) qk_tile<16, 0>(p0, p1, kp0 + (t % 3) * SLOTB, qr, cinit, slope2, 0);
                else qk_tile<16, 1>(p0, p1, kp0 + (t % 3) * SLOTB, qr, cinit, slope2, klim2);
                lsum += psum(p0, p1);
            }
            AT_WAIT_BAR(0);
        }
        lsum += __shfl_xor(lsum, 32);
        const float lg2l = lsum > 0.f ? __builtin_amdgcn_logf(lsum) : 0.f;
        o[0] = f32x16{}; o[1] = f32x16{};
        if (ntc > 0) {
            float cin = 0.f;
            glds16s(ws, AT_KOFF_C(0), kdst); glds16s(ws, AT_VOFF_C(0), vdst); if (ntc > 1) { glds16s(ws, AT_KOFF_C(1), kdst + SLOTB); glds16s(ws, AT_VOFF_C(1), vdst + SLOTB); }
            for (int t = 0; t < ntc; ++t) {
                if (t + 1 < ntc) { AT_WAIT_BAR(2); } else { AT_WAIT_BAR(0); }
                if (t + 2 < ntc) { glds16s(ws, AT_KOFF_C(t + 2), kdst + ((t + 2) % 3) * SLOTB); glds16s(ws, AT_VOFF_C(t + 2), vdst + ((t + 2) % 3) * SLOTB); }
                const float cinit = -slope2 * (float)(tq - 31 - 1024 * t) + slope2 * (float)(64 * hi) - MREF - lg2l;
                const int klim2 = nmax - 64 * t - 4 * hi;
                if (64 * t + 63 <= nfull) qk_tile<16, 0>(p0, p1, kp0 + (t % 3) * SLOTB, qr, cinit, slope2, 0);
                else qk_tile<16, 1>(p0, p1, kp0 + (t % 3) * SLOTB, qr, cinit, slope2, klim2);
                float mn[8], cy[8];
#pragma unroll
                for (int a = 0; a < 4; ++a) { mn[a] = 2.f * (p0[4 * a] + p0[4 * a + 1] + p0[4 * a + 2]) + p0[4 * a + 3]; cy[a] = p0[4 * a + 3];
                                              mn[4 + a] = 2.f * (p1[4 * a] + p1[4 * a + 1] + p1[4 * a + 2]) + p1[4 * a + 3]; cy[4 + a] = p1[4 * a + 3]; }
                float rc[8];
#pragma unroll
                for (int a = 0; a < 8; ++a) { const auto rr = __builtin_amdgcn_permlane32_swap(__float_as_uint(cy[a]), __float_as_uint(cy[a]), false, false); rc[a] = __uint_as_float(hi ? rr[0] : rr[1]); }
                if (hi) {
#pragma unroll
                    for (int a = 0; a < 8; ++a) mn[a] += rc[a];
                } else { mn[0] += cin;
#pragma unroll
                    for (int a = 1; a < 8; ++a) mn[a] += rc[a - 1];
                    cin = rc[7]; }
#pragma unroll
                for (int a = 0; a < 8; ++a) { mn[a] += __uint_as_float((unsigned)__builtin_amdgcn_update_dpp(0, (int)__float_as_uint(mn[a]), 0x128, 0xf, 0xf, false));
                    const auto rr = __builtin_amdgcn_permlane16_swap(__float_as_uint(mn[a]), __float_as_uint(mn[a]), false, false); mn[a] = __uint_as_float(rr[0]) + __uint_as_float(rr[1]); }
                if (hh == 0) {
#pragma unroll
                    for (int a = 0; a < 8; ++a) impw[qi * 128 + 16 * t + 2 * a + hi] = mn[a]; }
                pv_tile_seq(o, vb0 + (t % 3) * SLOTB, p0, p1);
            }
            AT_WAIT_BAR(0);
        }
        {
            const int qi8 = lane >> 3, s8 = lane & 7;
            unsigned key[16];
#pragma unroll
            for (int k = 0; k < 16; ++k) { const int j = s8 + 8 * k; const float v = impw[qi8 * 128 + j];
                const bool forced = (j == 0) || (j == cur) || (j == cur - 1);
                key[k] = j > cur ? 0u : ((forced ? 0xFFFFFF80u : (__builtin_bit_cast(unsigned, v) & 0xFFFFFF80u)) | (unsigned)(127 - j)); }
            unsigned bits = 0u;
            if (cur < NSEL) {
#pragma unroll
                for (int k = 0; k < 16; ++k) bits |= ((key[k] | (0u - key[k])) >> 31) << k;
            } else {
                { const int c1 = cur - 1; const unsigned b0 = (s8 == 0) ? 1u : 0u, bc = (s8 == (cur & 7)) ? 1u : 0u, b1 = (s8 == (c1 & 7)) ? 1u : 0u;
                  bits = b0 | (bc << (cur >> 3)) | (b1 << (c1 >> 3)); }
#pragma unroll
                for (int k = 0; k < 16; ++k) { const unsigned keep = ((bits >> k) & 1u) - 1u; key[k] &= keep; }
                for (int rnd = 0; rnd < NSEL - 3; ++rnd) {
                    unsigned m = key[0];
#pragma unroll
                    for (int k = 1; k < 16; ++k) m = m > key[k] ? m : key[k];
                    { unsigned t2 = (unsigned)__builtin_amdgcn_update_dpp(0, (int)m, 0xB1, 0xf, 0xf, false); m = m > t2 ? m : t2;
                      t2 = (unsigned)__builtin_amdgcn_update_dpp(0, (int)m, 0x4E, 0xf, 0xf, false); m = m > t2 ? m : t2;
                      t2 = (unsigned)__builtin_amdgcn_update_dpp(0, (int)m, 0x141, 0xf, 0xf, false); m = m > t2 ? m : t2; }
                    const unsigned jw = 127u - (m & 127u);
                    bits |= (m != 0u && (jw & 7u) == (unsigned)s8) ? (1u << (jw >> 3)) : 0u;
#pragma unroll
                    for (int k = 0; k < 16; ++k) key[k] = (key[k] == m) ? 0u : key[k];
                }
            }
            unsigned w4[4];
#pragma unroll
            for (int q = 0; q < 4; ++q) { unsigned w = 0u;
#pragma unroll
                for (int kk = 0; kk < 4; ++kk) w |= ((bits >> (4 * q + kk)) & 1u) << (s8 + 8 * kk);
                w |= (unsigned)__shfl_xor((int)w, 1); w |= (unsigned)__shfl_xor((int)w, 2); w |= (unsigned)__shfl_xor((int)w, 4); w4[q] = w; }
            if (s8 == 0) {
#pragma unroll
                for (int q = 0; q < 4; ++q) { selm[(8 * wid + qi8) * 4 + q] = w4[q]; __hip_atomic_fetch_or(&uni[q], w4[q], __ATOMIC_RELAXED, __HIP_MEMORY_SCOPE_WORKGROUP); } }
        }
        { if (hi == 0) wsf[r32] = g0; LDS_WAIT(); asm volatile("" ::: "memory");
#pragma unroll
          for (int a = 0; a < 4; ++a) { const f32x4 sc = *(const LAS f32x4*)(wsf + 8 * a + 4 * hi);
#pragma unroll
              for (int k = 0; k < 4; ++k) { const int c = 8 * a + 4 * hi + k; ostg[c * 64 + r32] = o[0][4 * a + k] * sc[k]; ostg[c * 64 + 32 + r32] = o[1][4 * a + k] * sc[k]; } }
          LDS_WAIT(); asm volatile("" ::: "memory"); }
        AT_WAIT_BAR(0);
        if (tidu < 128) { const int j = tidu; const unsigned u0 = uni[0], u1 = uni[1], u2 = uni[2], u3 = uni[3];
            const unsigned wsel = j < 32 ? u0 : j < 64 ? u1 : j < 96 ? u2 : u3;
            if ((wsel >> (j & 31)) & 1u) { int pos = __builtin_popcount(wsel & ((1u << (j & 31)) - 1u));
                if (j >= 32) pos += __builtin_popcount(u0); if (j >= 64) pos += __builtin_popcount(u1); if (j >= 96) pos += __builtin_popcount(u2);
                tl[pos] = j; }
            if (j == 0) ntl[0] = __builtin_popcount(u0) + __builtin_popcount(u1) + __builtin_popcount(u2) + __builtin_popcount(u3); }
        AT_WAIT_BAR(0);
        int lnS = lane; asm volatile("" : "+v"(lnS));
        {
            AT_LOCALS(lnS);
            const int nt = __builtin_amdgcn_readfirstlane(ntl[0]);
            o[0] = f32x16{}; o[1] = f32x16{}; lsum = 0.f;
            { const lcp vp0 = (lcp)lds + L_V + ((lane >> 4) & 1) * 32 + (lane & 3) * 8 + (4 * hi + ((lane & 15) >> 2)) * 64;
              struct BrSel2 { const unsigned char* wsb; const LAS int* tl; unsigned kvo, vvo; const LAS unsigned* sm; float cb0, slope2; int cur; int q0, q1, q2, q3;
                  __device__ __forceinline__ int jat(int i) const { return __builtin_amdgcn_readfirstlane(tl[i]); }
                  __device__ __forceinline__ void start(int nt) { q0 = jat(0); q1 = jat(nt > 1 ? 1 : nt - 1); q2 = jat(nt > 2 ? 2 : nt - 1); q3 = jat(nt > 3 ? 3 : nt - 1); }
                  __device__ __forceinline__ void advance(int nt, int tn) { q0 = q1; q1 = q2; q2 = q3; q3 = jat(tn + 3 < nt ? tn + 3 : nt - 1); }
                  __device__ __forceinline__ int jo(int off) const { return off == 0 ? q0 : off == 1 ? q1 : off == 2 ? q2 : q3; }
                  __device__ __forceinline__ void dk(int off, int, unsigned dst) const { glds16s(wsb, kvo + (unsigned)jo(off) * (64u * 768u * 2u), dst); }
                  __device__ __forceinline__ void dv(int off, int, unsigned dst) const { glds16s(wsb, vvo + (unsigned)jo(off) * (64u * 768u * 2u), dst); }
                  __device__ __forceinline__ float cinit(int off, int) const { const int j = jo(off); const bool mine = (sm[j >> 5] >> (j & 31)) & 1u; return mine ? cb0 + slope2 * (float)(64 * j) : NEGBIG; }
                  __device__ __forceinline__ int mode(int off, int) const { return (jo(off) == cur) ? 1 : 0; } };
              const BrSel2 br2{ws, tl, (unsigned)WS_KV6 + (unsigned)((b * SEQ + lane) * 768 + 256 + g * 64 + wid * 8) * 2u,
                               (unsigned)WS_KV6 + (unsigned)((b * SEQ + 16 * (wid & 3) + (lane >> 2)) * 768 + 384 + g * 64 + (wid >> 2) * 32 + (lane & 3) * 8) * 2u,
                               selm + (8 * wid + qi) * 4, -slope2 * (float)tq + slope2 * (float)(4 * hi) - MREF, slope2, cur, 0, 0, 0, 0};
              stream2(br2, nt, o, lsum, qr, kp0, vp0, kdst, vdst, slope2, lane, wid); }
            lsum += __shfl_xor(lsum, 32);
            if (hi == 0) wsf[r32] = gst[0] * __builtin_amdgcn_rcpf(lsum); LDS_WAIT(); asm volatile("" ::: "memory");
#pragma unroll
            for (int a = 0; a < 4; ++a) { const f32x4 sc = *(const LAS f32x4*)(wsf + 8 * a + 4 * hi);
#pragma unroll
                for (int k = 0; k < 4; ++k) { const int c = 8 * a + 4 * hi + k; ostg[c * 64 + r32] += o[0][4 * a + k] * sc[k]; ostg[c * 64 + 32 + r32] += o[1][4 * a + k] * sc[k]; } }
            LDS_WAIT(); asm volatile("" ::: "memory");
        }
        int lnW = lnS; asm volatile("" : "+v"(lnW));
        {
            AT_LOCALS(lnW);
            const int wi0 = cur >= 8 ? 0 : 8 - cur; const int nt = 9 - wi0;
            const int pbase = q0 - 512 + 64 * wi0;
            o[0] = f32x16{}; o[1] = f32x16{}; lsum = 0.f;
            { const lcp vp0 = (lcp)lds + L_V + ((lane >> 4) & 1) * 32 + (lane & 3) * 8 + (4 * hi + ((lane & 15) >> 2)) * 64;
              struct BrWin2 { const unsigned char* wsb; unsigned kvo, vvo; float cbase, slope2; int wi0;
                  __device__ __forceinline__ void start(int) {}
                  __device__ __forceinline__ void advance(int, int) {}
                  __device__ __forceinline__ void dk(int, int t, unsigned dst) const { glds16s(wsb, kvo + (unsigned)t * (64u * 768u * 2u), dst); }
                  __device__ __forceinline__ void dv(int, int t, unsigned dst) const { glds16s(wsb, vvo + (unsigned)t * (64u * 768u * 2u), dst); }
                  __device__ __forceinline__ float cinit(int, int t) const { return cbase + (float)(64 * t) * slope2; }
                  __device__ __forceinline__ int mode(int, int t) const { const int wi = wi0 + t; return (wi == 8) ? 1 : (wi == 0) ? 2 : 0; } };
              const BrWin2 br2{ws, (unsigned)WS_KV6 + (unsigned)((b * SEQ + pbase + lane) * 768 + 512 + g * 64 + wid * 8) * 2u,
                               (unsigned)WS_KV6 + (unsigned)((b * SEQ + pbase + 16 * (wid & 3) + (lane >> 2)) * 768 + 640 + g * 64 + (wid >> 2) * 32 + (lane & 3) * 8) * 2u,
                               -slope2 * (float)(tq - pbase) + slope2 * (float)(4 * hi) - MREF, slope2, wi0};
              stream2(br2, nt, o, lsum, qr, kp0, vp0, kdst, vdst, slope2, lane, wid); }
            lsum += __shfl_xor(lsum, 32);
            if (hi == 0) wsf[r32] = gst[64] * __builtin_amdgcn_rcpf(lsum); LDS_WAIT(); asm volatile("" ::: "memory");
#pragma unroll
            for (int a = 0; a < 4; ++a) { const f32x4 sc = *(const LAS f32x4*)(wsf + 8 * a + 4 * hi);
#pragma unroll
                for (int k = 0; k < 4; ++k) { const int c = 8 * a + 4 * hi + k; ostg[c * 64 + r32] += o[0][4 * a + k] * sc[k]; ostg[c * 64 + 32 + r32] += o[1][4 * a + k] * sc[k]; } }
            LDS_WAIT(); asm volatile("" ::: "memory");
        }
        int lnO = lnW; asm volatile("" : "+v"(lnO));
        {
          const int lane = lnO;
          AT_QLOAD((ui + 1 < 8 ? ui + 1 : 7), lane);
#pragma unroll
          for (int i = 0; i < 4; ++i) { const int row = i * 8 + (lane >> 3), ch = lane & 7; const f32x4 a = *(const LAS f32x4*)(ostg + row * 64 + ch * 8), c2 = *(const LAS f32x4*)(ostg + row * 64 + ch * 8 + 4);
              u32x4 v; v.x = pk2(a.x, a.y); v.y = pk2(a.z, a.w); v.z = pk2(c2.x, c2.y); v.w = pk2(c2.z, c2.w);
              *(u32x4*)(ws + ((unsigned)WS_OA + (unsigned)((b * SEQ + q0 + 8 * wid + (row & 7)) * 512 + (4 * g + (row >> 3)) * 64 + ch * 8) * 2u)) = v; }
          LDS_WAIT(); asm volatile("" ::: "memory"); }
    }
#undef AT_KOFF_C
#undef AT_VOFF_C
#undef AT_QLOAD
}

__device__ __forceinline__ void p7_route(Frame& F) {
    unsigned char* ws = F.ws; const int lane = F.lane;
    constexpr int WP = 1032;
    LAS bf16_t* WH = (LAS bf16_t*)F.lds; LAS bf16_t* WL = WH + 32 * WP;
    LAS float* G2 = (LAS float*)(F.lds + 2 * 32 * WP * 2);
    LAS int* CNT = (LAS int*)(F.lds + MISC_OFF + 256);
#pragma unroll 1
    for (int jb = 0; jb < 4; ++jb) { float wv[16], gv[16];
#pragma unroll
        for (int j = 0; j < 16; ++j) { const int i = F.tid + 512 * (jb * 16 + j); wv[j] = F.a->in[I_WR][i]; gv[j] = F.a->in[I_GN2][i >> 5]; }
#pragma unroll
        for (int j = 0; j < 16; ++j) { const int i = F.tid + 512 * (jb * 16 + j); const int k = i >> 5, e = i & 31; const float w = wv[j] * gv[j];
            const unsigned h = f2bf(w); const float r = w - __builtin_bit_cast(float, h << 16); WH[e * WP + k] = (bf16_t)h; WL[e * WP + k] = (bf16_t)f2bf(r); } }
    for (int i = F.tid; i < DM; i += 512) G2[i] = F.a->in[I_GN2][i];
    __syncthreads();
    int* TOPE = (int*)(ws + WS_TOPE); float* TOPW = (float*)(ws + WS_TOPW); int* CNTG = (int*)(ws + WS_CNT); float* RSTD = (float*)(ws + WS_RSTD);
    unsigned char* H2 = (unsigned char*)(ws + WS_H2);
    const bf16_t* X1 = (const bf16_t*)(ws + WS_X1B);
    const int r = lane & 15, q = lane >> 4;
    for (int vw = blockIdx.x; vw < 256; vw += F.G) {
        if (F.tid < 32) CNT[F.tid] = 0;
        __syncthreads();
        for (int rnd = 0; rnd < 2; ++rnd) {
            const int tok0 = vw * 256 + rnd * 128 + F.wave * 16;
            const bf16_t* xr = X1 + (size_t)(tok0 + r) * DM + 8 * q; unsigned char* hr = H2 + (size_t)(tok0 + r) * DM + 8 * q;
            f32x4 acc0 = (f32x4){0.f, 0.f, 0.f, 0.f}, acc1 = acc0; float ss = 0.f;
            auto step = [&](const int ks, const u32x4 hw) __attribute__((always_inline)) {
                const f32x4 a = (f32x4){bflo(hw.x), bfhi(hw.x), bflo(hw.y), bfhi(hw.y)}, b = (f32x4){bflo(hw.z), bfhi(hw.z), bflo(hw.w), bfhi(hw.w)};
                ss += (a.x * a.x + a.y * a.y) + (a.z * a.z + a.w * a.w) + (b.x * b.x + b.y * b.y) + (b.z * b.z + b.w * b.w);
                const f32x4 ga = *(const LAS f32x4*)(G2 + 32 * ks + 8 * q), gb = *(const LAS f32x4*)(G2 + 32 * ks + 8 * q + 4);
                u32x2 o8; o8.x = pg8::pk4_fp8(a.x * ga.x, a.y * ga.y, a.z * ga.z, a.w * ga.w); o8.y = pg8::pk4_fp8(b.x * gb.x, b.y * gb.y, b.z * gb.z, b.w * gb.w);
                *(u32x2*)(hr + 32 * ks) = o8;
                const bf16x8 xh = __builtin_bit_cast(bf16x8, hw);
                const bf16x8 w0h = *(const LAS bf16x8*)(WH + r * WP + 32 * ks + 8 * q), w0l = *(const LAS bf16x8*)(WL + r * WP + 32 * ks + 8 * q);
                const bf16x8 w1h = *(const LAS bf16x8*)(WH + (16 + r) * WP + 32 * ks + 8 * q), w1l = *(const LAS bf16x8*)(WL + (16 + r) * WP + 32 * ks + 8 * q);
                acc0 = __builtin_amdgcn_mfma_f32_16x16x32_bf16(xh, w0h, acc0, 0, 0, 0); acc0 = __builtin_amdgcn_mfma_f32_16x16x32_bf16(xh, w0l, acc0, 0, 0, 0);
                acc1 = __builtin_amdgcn_mfma_f32_16x16x32_bf16(xh, w1h, acc1, 0, 0, 0); acc1 = __builtin_amdgcn_mfma_f32_16x16x32_bf16(xh, w1l, acc1, 0, 0, 0);
            };
            u32x4 bufA[8], bufB[8];
#define P7_LOAD(buf, k0) _Pragma("unroll") for (int j = 0; j < 8; ++j) buf[j] = *(const u32x4*)(xr + 32 * ((k0) + j))
#define P7_RUN(buf, k0) _Pragma("unroll") for (int j = 0; j < 8; ++j) step((k0) + j, buf[j])
            P7_LOAD(bufA, 0); P7_LOAD(bufB, 8); P7_RUN(bufA, 0); P7_LOAD(bufA, 16); P7_RUN(bufB, 8); P7_LOAD(bufB, 24); P7_RUN(bufA, 16); P7_RUN(bufB, 24);
#undef P7_LOAD
#undef P7_RUN
            ss += __shfl_xor(ss, 16); ss += __shfl_xor(ss, 32);
            const float rs = 1.0f / sqrtf(ss * (1.f / DM) + EPS);
            const float b0 = F.a->in[I_BR][r], b1 = F.a->in[I_BR][16 + r];
#pragma unroll
            for (int i = 0; i < 4; ++i) {
                const int rowi = 4 * q + i; const float rsi = __shfl(rs, rowi);
                const float l0 = acc0[i] * rsi + b0, l1 = acc1[i] * rsi + b1;
                unsigned u0 = __builtin_bit_cast(unsigned, l0), u1 = __builtin_bit_cast(unsigned, l1);
                u0 ^= (u0 >> 31) ? 0xFFFFFFFFu : 0x80000000u; u1 ^= (u1 >> 31) ? 0xFFFFFFFFu : 0x80000000u;
                unsigned k0 = (u0 & ~31u) | (unsigned)(31 - r), k1 = (u1 & ~31u) | (unsigned)(15 - r);
                float tv[4]; int te[4];
#pragma unroll
                for (int rr = 0; rr < 4; ++rr) { unsigned m = k0 > k1 ? k0 : k1;
                    { unsigned t2 = (unsigned)__builtin_amdgcn_update_dpp(0, (int)m, 0xB1, 0xf, 0xf, false); m = m > t2 ? m : t2; t2 = (unsigned)__builtin_amdgcn_update_dpp(0, (int)m, 0x4E, 0xf, 0xf, false); m = m > t2 ? m : t2;
                      t2 = (unsigned)__builtin_amdgcn_update_dpp(0, (int)m, 0x141, 0xf, 0xf, false); m = m > t2 ? m : t2; t2 = (unsigned)__builtin_amdgcn_update_dpp(0, (int)m, 0x140, 0xf, 0xf, false); m = m > t2 ? m : t2; }
                    te[rr] = 31 - (int)(m & 31u); const unsigned ub = m & ~31u; const unsigned fb = (ub & 0x80000000u) ? (ub ^ 0x80000000u) : ~ub; tv[rr] = __builtin_bit_cast(float, fb);
                    k0 = (k0 == m) ? 0u : k0; k1 = (k1 == m) ? 0u : k1; }
                if (r == 0) { const int tok = tok0 + rowi;
                    const float e1 = __expf(tv[1] - tv[0]), e2 = __expf(tv[2] - tv[0]), e3 = __expf(tv[3] - tv[0]); const float inv = 1.0f / (1.0f + e1 + e2 + e3);
                    *(int4*)(TOPE + (size_t)tok * 4) = make_int4(te[0], te[1], te[2], te[3]); *(float4*)(TOPW + (size_t)tok * 4) = make_float4(inv, e1 * inv, e2 * inv, e3 * inv);
                    RSTD[tok] = rsi;
                    __hip_atomic_fetch_add(&CNT[te[0]], 1, __ATOMIC_RELAXED, __HIP_MEMORY_SCOPE_WORKGROUP); __hip_atomic_fetch_add(&CNT[te[1]], 1, __ATOMIC_RELAXED, __HIP_MEMORY_SCOPE_WORKGROUP);
                    __hip_atomic_fetch_add(&CNT[te[2]], 1, __ATOMIC_RELAXED, __HIP_MEMORY_SCOPE_WORKGROUP); __hip_atomic_fetch_add(&CNT[te[3]], 1, __ATOMIC_RELAXED, __HIP_MEMORY_SCOPE_WORKGROUP); }
            }
        }
        __syncthreads();
        if (F.tid < 32) CNTG[vw * 32 + F.tid] = CNT[F.tid];
        __syncthreads();
    }
}

__device__ __forceinline__ void p8_scatter(Frame& F) {
    unsigned char* ws = F.ws; const int lane = F.lane;
    LAS int* CN = (LAS int*)F.lds;
    LAS int* PT = (LAS int*)(F.lds + 32768);
    LAS int* PP = PT + 512;
    LAS int* WC = PP + 512;
    LAS int* BASE = WC + 512;
    LAS int* TOT = BASE + 32;
    LAS int* TS = TOT + 32;
    const int* CNTG = (const int*)(ws + WS_CNT); const int* TOPE = (const int*)(ws + WS_TOPE); const float* TOPW = (const float*)(ws + WS_TOPW);
    int* INV = (int*)(ws + WS_INV);
    for (int vw = blockIdx.x; vw < 256; vw += F.G) {
        const int ch = vw / WPC, wl = vw % WPC;
        unsigned* ROWTOK = (unsigned*)(ws + WS_ROWTOK) + (size_t)ch * SLOTS_CH; float* ROWW = (float*)(ws + WS_ROWW) + (size_t)ch * SLOTS_CH; float* ROWRS = (float*)(ws + WS_ROWRS) + (size_t)ch * SLOTS_CH;
        for (int i = F.tid; i < WPC * 32; i += 512) CN[i] = CNTG[ch * WPC * 32 + i];
        const int e0 = TOPE[(size_t)vw * 1024 + F.tid], e1 = TOPE[(size_t)vw * 1024 + 512 + F.tid];
        __syncthreads();
        { const int e = F.tid & 31, part = F.tid >> 5; int tot = 0, pre = 0;
          for (int w = part * (WPC / 16); w < (part + 1) * (WPC / 16); ++w) { const int c = CN[w * 32 + e]; tot += c; pre += (w < wl) ? c : 0; }
          PT[part * 32 + e] = tot; PP[part * 32 + e] = pre; }
        int rk0 = 0, rk1 = 0;
        { const unsigned long long lt = (1ull << lane) - 1ull;
          for (int e = 0; e < 32; ++e) { const unsigned long long m0 = __ballot(e0 == e), m1 = __ballot(e1 == e);
              if (e0 == e) rk0 = __builtin_popcountll(m0 & lt); if (e1 == e) rk1 = __builtin_popcountll(m1 & lt);
              if (lane == 0) { WC[F.wave * 32 + e] = __builtin_popcountll(m0); WC[(8 + F.wave) * 32 + e] = __builtin_popcountll(m1); } } }
        __syncthreads();
        if (F.tid < 32) { int tot = 0, pre = 0; for (int p = 0; p < 16; ++p) { tot += PT[p * 32 + F.tid]; pre += PP[p * 32 + F.tid]; } TOT[F.tid] = tot; BASE[F.tid] = pre;
            int run = 0; for (int sgi = 0; sgi < 16; ++sgi) { const int c = WC[sgi * 32 + F.tid]; WC[sgi * 32 + F.tid] = run; run += c; } }
        __syncthreads();
        if (F.tid == 0) { int ts = 0; for (int e = 0; e < 32; ++e) { TS[e] = ts; ts += (TOT[e] + 255) >> 8; } TS[32] = ts; }
        __syncthreads();
        { const int s0 = TS[e0] * 256 + BASE[e0] + WC[F.wave * 32 + e0] + rk0, s1 = TS[e1] * 256 + BASE[e1] + WC[(8 + F.wave) * 32 + e1] + rk1;
          const int i0 = F.tid, i1 = 512 + F.tid; const int t0 = vw * 256 + (i0 >> 2), t1 = vw * 256 + (i1 >> 2);
          const float* RS = (const float*)(ws + WS_RSTD);
          ROWTOK[s0] = (unsigned)t0; ROWW[s0] = TOPW[(size_t)vw * 1024 + i0]; ROWRS[s0] = RS[t0]; INV[(size_t)vw * 1024 + i0] = s0;
          ROWTOK[s1] = (unsigned)t1; ROWW[s1] = TOPW[(size_t)vw * 1024 + i1]; ROWRS[s1] = RS[t1]; INV[(size_t)vw * 1024 + i1] = s1; }
        if (wl < 32) { const int e = wl; const int lo = TS[e] * 256 + TOT[e], hi = TS[e + 1] * 256; for (int sl = lo + F.tid; sl < hi; sl += 512) { ROWTOK[sl] = (unsigned)(ch * TCH); ROWW[sl] = 0.f; ROWRS[sl] = 0.f; } }
        if (wl == 0 && F.tid < 33) ((int*)(ws + WS_TSTART))[ch * 64 + F.tid] = TS[F.tid];
        __syncthreads();
    }
}

__device__ __forceinline__ void p_combine(Frame& F, int ch) {
    unsigned char* ws = F.ws; const int lane = F.lane;
    const unsigned char* Y = (const unsigned char*)(ws + WS_YBUF); const int* INV = (const int*)(ws + WS_INV); const bf16_t* X1 = (const bf16_t*)(ws + WS_X1B);
    const int gw = F.vcu * 8 + F.wave, NGW = F.G * 8;
    for (int i = gw; i < TCH / 2; i += NGW) {
        const int tok = ch * TCH + 2 * i; const int4 sa = *(const int4*)(INV + (size_t)tok * 4), sb = *(const int4*)(INV + (size_t)tok * 4 + 4);
        float* o = F.out + (size_t)tok * DM + lane * 16; const bf16_t* xp = X1 + (size_t)tok * DM + lane * 16;
        u32x4 y[2][4]; u32x4 xb[2][2];
#pragma unroll
        for (int tt = 0; tt < 2; ++tt) { const int4 sl = tt ? sb : sa; const int ss[4] = {sl.x, sl.y, sl.z, sl.w};
#pragma unroll
            for (int k = 0; k < 4; ++k) y[tt][k] = *(const u32x4*)(Y + (size_t)ss[k] * 1024 + lane * 16);
            xb[tt][0] = *(const u32x4*)(xp + tt * DM); xb[tt][1] = *(const u32x4*)(xp + tt * DM + 8); }
#pragma unroll
        for (int tt = 0; tt < 2; ++tt)
#pragma unroll
            for (int q = 0; q < 4; ++q) { f32x4 sacc = (f32x4){0.f, 0.f, 0.f, 0.f};
#pragma unroll
                for (int k = 0; k < 4; ++k) { const f32x2 lo = __builtin_amdgcn_cvt_pk_f32_fp8((int)y[tt][k][q], false), hi = __builtin_amdgcn_cvt_pk_f32_fp8((int)y[tt][k][q], true); sacc += (f32x4){lo.x, lo.y, hi.x, hi.y}; }
                const unsigned w0 = xb[tt][q >> 1][(q & 1) * 2], w1 = xb[tt][q >> 1][(q & 1) * 2 + 1];
                const f32x4 xv = (f32x4){bflo(w0), bfhi(w0), bflo(w1), bfhi(w1)};
                *(f32x4*)(o + tt * DM + 4 * q) = xv + sacc * pg8::YINV; }
    }
}

__device__ __forceinline__ void stagger(int cid, int us) {
    const int k = (cid >> 3) & 3; if (k == 0 || us == 0) return;
    const unsigned long long t0 = __builtin_amdgcn_s_memrealtime(), dt = (unsigned long long)(k * us) * 100ull;
    while (__builtin_amdgcn_s_memrealtime() - t0 < dt) __builtin_amdgcn_s_sleep(32);
}

__global__ void __launch_bounds__(512, 2) mk_fwd(Args args) {
    extern __shared__ __attribute__((aligned(16))) unsigned char lds_raw[];
    Frame F;
    F.lds = (LAS unsigned char*)lds_raw;
    F.tid = threadIdx.x; F.lane = F.tid & 63; F.wave = __builtin_amdgcn_readfirstlane(F.tid >> 6);
    F.G = gridDim.x; { const int bx = blockIdx.x; F.vcu = (F.G % 8 == 0) ? (bx % 8) * (F.G / 8) + bx / 8 : bx; }
    F.ws = args.ws; F.out = args.out; F.a = &args;
    unsigned char* ws = args.ws;
    volatile LAS unsigned* MISC = (volatile LAS unsigned*)(F.lds + MISC_OFF);
    for (int u = F.tid; u < 256; u += 512) MISC[u] = 0u;
    __syncthreads();
    XcdBarrier bar; bar.bar = (unsigned*)(ws + WS_CTL) + 1024; bar.x = 0; bar.st = nullptr;
    const int lo = args.ph_lo, hi = args.ph_hi;
    if (hi - lo > 1) bar = xcd_barrier_post((unsigned*)(ws + WS_CTL) + 1024, MISC + 8);
#define IN(k) (lo <= (k) && (k) < hi)
#ifndef REP1
#define REP1 1
#endif
#ifndef STAG1
#define STAG1 0
#endif
#ifndef REP4
#define REP4 1
#endif
#ifndef REP0
#define REP0 1
#endif
#ifndef REP7
#define REP7 1
#endif
#ifndef REP9
#define REP9 1
#endif
#ifndef REP10
#define REP10 1
#endif
#define SEAM(k) do { if (IN(k) && IN((k) + 1)) xcd_barrier(bar); } while (0)
    LAS unsigned char* ring = F.lds;
    const int cid = (int)blockIdx.x;

    if (IN(0)) { p0_prologue(F); if (REP0 > 1) p0_prologue(F); } SEAM(0);

    if (IN(1)) {
        { pg8::OrdPlain S{(const char*)(ws + WS_H1), (const char*)(ws + WS_WIN_T), T / 256, NPROJ / 256, F.G, cid, (size_t)256 * DM * 2, (size_t)256 * DM * 2};
          pg8::EpiIn E{(bf16_t*)(ws + WS_Q), (bf16_t*)(ws + WS_KV6), (bf16_t*)(ws + WS_CONV3), (bf16_t*)(ws + WS_MG), (bf16_t*)(ws + WS_NG)};
          pg8::gemm_phase<pg8::EpiIn, pg8::OrdPlain, false>(ring, DM, DM * 2, 128, S, E, nullptr); }
        { LAS unsigned short* gtab = (LAS unsigned short*)(F.lds + GTAB_OFF);
          for (int i = F.tid; i < GTAB_UNITS * 256; i += 512) gtab[i] = (unsigned short)(i & 255);
          __syncthreads();
          pg8::OrdPlain S{(const char*)(ws + WS_H1F8), (const char*)(ws + WS_WMG8), T / 256, 2048 / 256, F.G, cid, (size_t)256 * DM, (size_t)256 * DM};
          pg8::EpiMG8 E{(bf16_t*)(ws + WS_MG)};
          pg8::gemm_phase<pg8::EpiMG8, pg8::OrdPlain, true, true>(ring, DM / 2, DM, 128, S, E, gtab); }
    } SEAM(1);

    if (IN(2)) {
        pg8::OrdCmp S{(const char*)(ws + WS_KV6), (const char*)(ws + WS_CKW1_T), (const char*)(ws + WS_CVW1_T), F.G, cid};
        pg8::EpiCmp E{(bf16_t*)(ws + WS_HID), (const float*)(ws + WS_B1P)};
        pg8::gemm_phase<pg8::EpiCmp, pg8::OrdCmp, false>(ring, 2048, 16 * 768 * 2, 768 * 2, S, E, nullptr);
        p2_queue(F);
    }
    SEAM(2);
    if (IN(3)) { p3_compress2(F); } SEAM(3);

    #ifdef ATTN_NAIVE
    if (IN(4)) { p4_attn_naive(F); } SEAM(4);
#else
    if (IN(4)) { p4_attn(F); if (REP4 > 1) p4_attn(F); } SEAM(4);
    F.tid = threadIdx.x; asm volatile("" : "+v"(F.tid)); F.lane = F.tid & 63;
#endif

    if (IN(5)) {
        pg8::OrdPlain2 S{(const char*)(ws + WS_OA), (const char*)(ws + WS_YB), (const char*)(ws + WS_WPA_T), T / 256, DM / 256, F.G, cid, (size_t)256 * AW * 2, (size_t)256 * DM * 2};
        pg8::EpiGateM E{(bf16_t*)(ws + WS_Z), (const bf16_t*)(ws + WS_MG)};
        pg8::gemm_phase<pg8::EpiGateM, pg8::OrdPlain2, false, false, 8>(ring, DM, AW * 2, 128, S, E, nullptr);
    } SEAM(5);

    if (IN(6)) {
        pg8::OrdPlain S{(const char*)(ws + WS_Z), (const char*)(ws + WS_WO_T), T / 256, DM / 256, F.G, cid, (size_t)256 * DM * 2, (size_t)256 * DM * 2};
        pg8::EpiRes E{F.a->in[I_X], (bf16_t*)(ws + WS_X1B)};
        pg8::gemm_phase<pg8::EpiRes, pg8::OrdPlain, false>(ring, DM, DM * 2, 128, S, E, nullptr);
    } SEAM(6);

    if (IN(7)) { p7_route(F); if (REP7 > 1) p7_route(F); } SEAM(7);
    if (IN(8)) { p8_scatter(F); } SEAM(8);

#pragma unroll
    for (int ch = 0; ch < NCH; ++ch) {
        const int pgu = 9 + 2 * ch, pdn = 10 + 2 * ch;
        if (IN(pgu)) {
            LAS int* TS = (LAS int*)(F.lds + MISC_OFF + 512);
            if (F.tid < 33) TS[F.tid] = ((const int*)(ws + WS_TSTART))[ch * 64 + F.tid];
            __syncthreads();
            const int ntile = TS[32];
            pg8::OrdGrp S{(const char*)(ws + WS_H2), (const char*)(ws + WS_WGU_T), TS, ntile, 8, F.G, cid, (size_t)0, (size_t)256 * DM, (size_t)2048 * DM};
            LAS unsigned short* gtab = (LAS unsigned short*)(F.lds + GTAB_OFF);
            { const unsigned* ROWTOK = (const unsigned*)(ws + WS_ROWTOK) + (size_t)ch * SLOTS_CH;
#pragma unroll 1
              for (int i0 = 0; i0 < GTAB_UNITS; i0 += 8) { unsigned tv[8]; bool ok[8];
#pragma unroll
                  for (int j = 0; j < 8; ++j) { int pm, pn; ok[j] = pg8::tile_map((long)(i0 + j) * F.G + cid, ntile, 8, pm, pn); tv[j] = ROWTOK[(ok[j] ? pm : 0) * 256 + (F.tid & 255)]; }
#pragma unroll
                  for (int j = 0; j < 8; ++j) if (ok[j] && F.tid < 256) gtab[(i0 + j) * 256 + F.tid] = (unsigned short)tv[j];
                  if (!ok[7]) break; } }
            __syncthreads();
            pg8::EpiGU E{(unsigned char*)(ws + WS_ACT), F.a->in[I_BGU], (const float*)(ws + WS_ROWRS) + (size_t)ch * SLOTS_CH, (const LAS float*)(F.lds + EPI_OFF)};
            pg8::gemm_phase<pg8::EpiGU, pg8::OrdGrp, true, true>(ring, DM / 2, 0, 128, S, E, gtab); if (REP9 > 1) pg8::gemm_phase<pg8::EpiGU, pg8::OrdGrp, true, true>(ring, DM / 2, 0, 128, S, E, gtab);
            if (ch > 0) p_combine(F, ch - 1);
        } SEAM(pgu);
        if (IN(pdn)) {
            LAS int* TS = (LAS int*)(F.lds + MISC_OFF + 512);
            if (F.tid < 33) TS[F.tid] = ((const int*)(ws + WS_TSTART))[ch * 64 + F.tid];
            __syncthreads();
            const int ntile = TS[32];
            pg8::OrdGrp S{(const char*)(ws + WS_ACT), (const char*)(ws + WS_WDN_T), TS, ntile, 4, F.G, cid, (size_t)256 * DFF, (size_t)256 * DFF, (size_t)DM * DFF};
            pg8::EpiDN E{(unsigned char*)(ws + WS_YBUF), F.a->in[I_BDN], (const float*)(ws + WS_ROWW) + (size_t)ch * SLOTS_CH, (const LAS float*)(F.lds + EPI_OFF)};
            LAS unsigned short* gtab = (LAS unsigned short*)(F.lds + GTAB_OFF);
            for (int i = F.tid; i < GTAB_UNITS * 256; i += 512) gtab[i] = (unsigned short)(i & 255);
            __syncthreads();
            pg8::gemm_phase<pg8::EpiDN, pg8::OrdGrp, true, true>(ring, DFF / 2, DFF, 128, S, E, gtab); if (REP10 > 1) pg8::gemm_phase<pg8::EpiDN, pg8::OrdGrp, true, true>(ring, DFF / 2, DFF, 128, S, E, gtab);
        } SEAM(pdn);
    }
    if (IN(NPH - 1)) { p_combine(F, NCH - 1); }
#undef IN
#undef SEAM
}

extern "C" void kernel_launch(void* const* d_in, const int* in_sizes, int n_in, void* d_out, int out_size, void* d_ws, size_t ws_size, hipStream_t stream) {
    static int grid = 0;
    if (grid == 0) {
        if (n_in != 28 || out_size != T * DM || ws_size < WS_END) { fprintf(stderr, "kernel_launch: unexpected shapes (n_in %d, out %d, ws %zu)\n", n_in, out_size, ws_size); grid = -1; return; }
        int dev = 0, cus = 0;
        if (hipGetDevice(&dev) != hipSuccess || hipDeviceGetAttribute(&cus, hipDeviceAttributeMultiprocessorCount, dev) != hipSuccess) { grid = -1; return; }
        if (hipFuncSetAttribute((const void*)mk_fwd, hipFuncAttributeMaxDynamicSharedMemorySize, LDS_BYTES) != hipSuccess) { fprintf(stderr, "kernel_launch: hipFuncSetAttribute failed\n"); grid = -1; return; }
        int per_cu = 0;
        if (hipOccupancyMaxActiveBlocksPerMultiprocessor(&per_cu, (const void*)mk_fwd, 512, LDS_BYTES) != hipSuccess || per_cu < 1) fprintf(stderr, "kernel_launch: occupancy query says %d\n", per_cu);
        (void)hipGetLastError();
        grid = cus;
    }
    if (grid < 0) return;
    (void)hipMemsetAsync((char*)d_ws + WS_CTL, 0, CTL_ZERO_BYTES, stream);
    Args a{};
    for (int i = 0; i < 28; ++i) a.in[i] = (const float*)d_in[i];
    a.out = (float*)d_out; a.ws = (unsigned char*)d_ws;
#if MK_N_LAUNCHES == 1
    a.ph_lo = 0; a.ph_hi = NPH;
    hipLaunchKernelGGL(mk_fwd, dim3(grid), dim3(512), LDS_BYTES, stream, a);
#else
    for (int p = 0; p < NPH; ++p) { a.ph_lo = p; a.ph_hi = p + 1; hipLaunchKernelGGL(mk_fwd, dim3(grid), dim3(512), LDS_BYTES, stream, a); }
#endif
}
```

```cpp
#include <hip/hip_runtime.h>
#include <cstdio>
#include <cstdint>

#define LAS __attribute__((address_space(3)))
#define GAS __attribute__((address_space(1)))
typedef unsigned short bf16_t;
typedef short bf16x8 __attribute__((ext_vector_type(8)));
typedef float f32x4 __attribute__((ext_vector_type(4)));
typedef float f32x2 __attribute__((ext_vector_type(2)));
typedef unsigned u32x4 __attribute__((ext_vector_type(4)));
typedef unsigned u32x2 __attribute__((ext_vector_type(2)));

#ifndef MK_N_LAUNCHES
#define MK_N_LAUNCHES 1
#endif

constexpr int BATCH = 8, SEQ = 8192, DM = 1024, T = BATCH * SEQ;
constexpr int NH = 8, HD = 64, NGRP = 2, AW = 512;
constexpr int CMP_HID = 256, NBLK = 128, NSEL = 16, WIN = 512;
constexpr int CONVW = 512, NEXP = 32, DFF = 1024;
constexpr int NPROJ = 3072;
constexpr int IN_COLS = 4888;
constexpr float EPS = 1e-6f, LOG2E = 1.4426950408889634f;
constexpr float QSCALE = 0.125f * LOG2E;
constexpr int NCH = 1;
constexpr int TCH = T / NCH;
constexpr int SLOTS_CH = TCH * 4 + NEXP * 256;
constexpr int WPC = 256 / NCH;
constexpr int NPH = 10 + 2 * NCH;

constexpr size_t MiB = 1u << 20;
constexpr size_t WS_CTL = 0, CTL_ZERO_BYTES = 64 * 1024;
constexpr size_t WS_B1P = 1 * MiB;
constexpr size_t WS_TSTART = 1 * MiB + 4096;
constexpr size_t WS_CNT = 1 * MiB + 8192;
constexpr size_t WS_QCTR = 1 * MiB + 65536;
constexpr size_t WS_WIN_T = 8 * MiB, WS_WPA_T = 18 * MiB, WS_WPB_T = 19 * MiB, WS_WO_T = 20 * MiB, WS_CKW1_T = 22 * MiB, WS_CVW1_T = 23 * MiB;
constexpr size_t WS_WGU_T = 24 * MiB, WS_WDN_T = 88 * MiB;
constexpr size_t WS_H1 = 120 * MiB, WS_YB = 120 * MiB, WS_OA = 184 * MiB, WS_Q = 248 * MiB, WS_KV6 = 312 * MiB, WS_CONV3 = 408 * MiB, WS_MG = 600 * MiB;
constexpr size_t WS_X1B = 712 * MiB;
constexpr size_t WS_H1F8 = 870 * MiB, WS_WMG8 = 934 * MiB;
constexpr size_t WS_NG = 856 * MiB, WS_HID = 860 * MiB, WS_KC = 868 * MiB, WS_VC = 869 * MiB, WS_Z = 312 * MiB;
constexpr size_t WS_H2 = 120 * MiB, WS_ACT = 184 * MiB, WS_YBUF = 448 * MiB, WS_TOPE = 976 * MiB, WS_TOPW = 977 * MiB, WS_INV = 978 * MiB, WS_ROWTOK = 979 * MiB, WS_ROWW = 981 * MiB, WS_ROWRS = 983 * MiB, WS_RSTD = 985 * MiB;
constexpr size_t WS_END = 986 * MiB;
static_assert((size_t)NCH * SLOTS_CH * 4 <= 2 * MiB && (size_t)T * 4 <= 1 * MiB, "routing tables");
static_assert((size_t)SLOTS_CH * 1024 <= 264 * MiB && (size_t)SLOTS_CH * 2048 <= 528 * MiB, "act / y chunk");
static_assert((size_t)NCH * SLOTS_CH * 4 <= 2 * MiB, "rowtok");

constexpr int RING_BYTES = 131072;
constexpr int GTAB_OFF = RING_BYTES, GTAB_UNITS = 40, GTAB_BYTES = GTAB_UNITS * 512;
constexpr int MISC_OFF = GTAB_OFF + GTAB_BYTES;
constexpr int EPI_OFF = MISC_OFF + 1024;
constexpr int LDS_BYTES = EPI_OFF + 2048;
static_assert(LDS_BYTES <= 160 * 1024, "LDS");

__device__ __forceinline__ unsigned f2bf(float f) { unsigned u = __builtin_bit_cast(unsigned, f); return (u + 0x7fffu + ((u >> 16) & 1u)) >> 16; }
__device__ __forceinline__ unsigned pk2(float lo, float hi) { return f2bf(lo) | (f2bf(hi) << 16); }
typedef __bf16 bf16x2_t __attribute__((ext_vector_type(2)));
__device__ __forceinline__ unsigned cvtpk_bf16(float lo, float hi) { f32x2 v = {lo, hi}; bf16x2_t b = __builtin_convertvector(v, bf16x2_t); return __builtin_bit_cast(unsigned, b); }
__device__ __forceinline__ float bflo(unsigned w) { return __builtin_bit_cast(float, w << 16); }
__device__ __forceinline__ float bfhi(unsigned w) { return __builtin_bit_cast(float, w & 0xffff0000u); }
__device__ __forceinline__ float bf2f(bf16_t h) { return __builtin_bit_cast(float, (unsigned)h << 16); }
__device__ __forceinline__ float wave_sum(float v) {
#pragma unroll
    for (int o = 1; o < 64; o <<= 1) v += __shfl_xor(v, o);
    return v;
}
__device__ __forceinline__ float wave_max(float v) {
#pragma unroll
    for (int o = 1; o < 64; o <<= 1) v = fmaxf(v, __shfl_xor(v, o));
    return v;
}
__device__ __forceinline__ float sigmoidf_(float x) { return __builtin_amdgcn_rcpf(1.0f + __builtin_amdgcn_exp2f(-1.4426950408889634f * x)); }
__device__ __forceinline__ f32x2 pk_mul2(f32x2 a, f32x2 b) { f32x2 r = a * b; asm("" : "+v"(r)); return r; }
__device__ __forceinline__ f32x2 pk_add2(f32x2 a, f32x2 b) { f32x2 r = a + b; asm("" : "+v"(r)); return r; }
#define LDS_WAIT() asm volatile("s_waitcnt lgkmcnt(0)" ::: "memory")
#define VM_WAIT() asm volatile("s_waitcnt vmcnt(0)" ::: "memory")

namespace pg8 {
constexpr int BM = 256, BK = 64, HALF = 128, HTB = HALF * BK * 2, STAGE_BYTES = 8 * HTB, NXCD = 8, WGM = 8;
__host__ __device__ __forceinline__ int lds_byte(int r, int c) { const int st = (r >> 4) * 2 + (c >> 5), rr = r & 15, cc = c & 31, ob = rr * 64 + cc * 2; return st * 1024 + (ob ^ (((ob >> 9) & 1) << 5)); }
__host__ __device__ __forceinline__ void stage_rc(int b, int& R, int& C) { const int st = b / 1024, sb = b % 1024, swz = sb ^ (((sb >> 9) & 1) << 5); R = (st >> 1) * 16 + swz / 64; C = (st & 1) * 32 + (swz % 64) / 2; }
__host__ __device__ __forceinline__ int perm32(int rho) { const int n = rho >> 4, i = rho & 15; return 8 * (i >> 2) + 4 * n + (i & 3); }

struct Unit { const char* a; const char* b; int pm, pn, e; const char* a2; };

__device__ __forceinline__ bool tile_map(long L, int nM, int nN, int& pm, int& pn) {
    const int nwg = nM * nN; if (L >= nwg) return false;
    int wgid = (int)L; { const int q = nwg / NXCD, r = nwg % NXCD, xcd = wgid % NXCD, off = wgid / NXCD; wgid = (xcd < r ? xcd * (q + 1) : r * (q + 1) + (xcd - r) * q) + off; }
    const int nig = WGM * nN, gid = wgid / nig, fm = gid * WGM, gsz = (nM - fm) < WGM ? (nM - fm) : WGM;
    pm = fm + ((wgid % nig) % gsz); pn = (wgid % nig) / gsz; return true;
}

constexpr float W8INV_ = 1.0f / 32.0f;
typedef int v8i_t __attribute__((ext_vector_type(8)));
typedef int v4i_t __attribute__((ext_vector_type(4)));
__device__ __forceinline__ v8i_t cat8(bf16x8 a, bf16x8 b) { return __builtin_shufflevector(__builtin_bit_cast(v4i_t, a), __builtin_bit_cast(v4i_t, b), 0, 1, 2, 3, 4, 5, 6, 7); }
__device__ __forceinline__ unsigned cvt_pk_bf16(float lo, float hi) { return cvtpk_bf16(lo, hi); }

template <class Epi, class Sched, bool GATHER, bool F8 = false, int KSPLIT = 0>
__device__ __forceinline__ void gemm_phase(LAS unsigned char* lds, const int K, const unsigned a_pitch, const unsigned a_kstep, const Sched& S, const Epi& E, const LAS unsigned short* gtab) {
    const int tid = threadIdx.x, wid = __builtin_amdgcn_readfirstlane(tid >> 6), lane = tid & 63, wr = wid >> 2, wc = wid & 3, fr = lane & 15, fq = lane >> 4;
    const int nt = K / BK;
    unsigned voffA[2][2], voffB[2];
#pragma unroll
    for (int i = 0; i < 2; ++i) { int R, C; stage_rc(tid * 16 + i * 8192, R, C); const int Rb = Epi::PERM ? ((R & ~31) + perm32(R & 31)) : R;
        voffB[i] = (unsigned)(Rb * K + C) * 2u; voffA[0][i] = (unsigned)R * a_pitch + (unsigned)C * 2u; voffA[1][i] = voffA[0][i]; }
    const size_t kstepA = a_kstep, kstepB = (size_t)(BK * 2);
    const size_t hstepA = GATHER ? (size_t)0 : (size_t)HALF * a_pitch, hstepB = (size_t)HALF * K * 2;
    const unsigned ldsw = (unsigned)wid * 1024u;
    const unsigned ldsbase = (unsigned)(uintptr_t)lds;
    const int aoff = lds_byte(wr * 64 + fr, fq * 8), boff = lds_byte(wc * 32 + fr, fq * 8);
#define PG8_SA(b, h) (((b) * 2 + (h)) * HTB)
#define PG8_SB(b, h) ((4 + (b) * 2 + (h)) * HTB)
#define PG8_STAGE(bufoff, gbase, voff) do { _Pragma("unroll") for (int _i = 0; _i < 2; ++_i) { unsigned _keep; \
        asm volatile("s_mov_b32 %0, m0\n\ts_mov_b32 m0, %3\n\ts_nop 0\n\tglobal_load_lds_dwordx4 %1, %2\n\ts_mov_b32 m0, %0" : "=&s"(_keep) : "v"((voff)[_i]), "s"((const char*)(gbase)), "s"(ldsbase + (unsigned)(bufoff) + ldsw + (unsigned)(_i * 8192)) : "memory"); } } while (0)
#define PG8_STA(bufoff, gbase, h) do { if constexpr (GATHER) { PG8_STAGE(bufoff, gbase, voffA[h]); } else { PG8_STAGE(bufoff, (gbase) + (h) * hstepA, voffA[0]); } } while (0)
#define PG8_GLOAD(ui_) do { _Pragma("unroll") for (int _i = 0; _i < 2; ++_i) { int R_, C_; stage_rc(tid * 16 + _i * 8192, R_, C_); \
        voffA[0][_i] = (unsigned)gtab[(ui_) * 256 + R_] * 1024u + (unsigned)C_ * 2u; voffA[1][_i] = (unsigned)gtab[(ui_) * 256 + 128 + R_] * 1024u + (unsigned)C_ * 2u; } } while (0)
#define PG8_LDA(dst, b, h) do { _Pragma("unroll") for (int m = 0; m < 4; ++m) _Pragma("unroll") for (int k = 0; k < 2; ++k) dst[m][k] = *(const LAS bf16x8*)(lds + PG8_SA(b, h) + aoff + m * 2048 + k * 1024); } while (0)
#define PG8_LDB(dst, b, h) do { _Pragma("unroll") for (int n = 0; n < 2; ++n) _Pragma("unroll") for (int k = 0; k < 2; ++k) dst[n][k] = *(const LAS bf16x8*)(lds + PG8_SB(b, h) + boff + n * 2048 + k * 1024); } while (0)
#define PG8_MMA(ai, bj, At, Bt) do { __builtin_amdgcn_s_setprio(1); if constexpr (F8) { _Pragma("unroll") for (int m = 0; m < 4; ++m) _Pragma("unroll") for (int n = 0; n < 2; ++n) \
        acc[ai][bj][m][n] = __builtin_amdgcn_mfma_scale_f32_16x16x128_f8f6f4(cat8(Bt[n][0], Bt[n][1]), cat8(At[m][0], At[m][1]), acc[ai][bj][m][n], 0, 0, 0, 0, 0, 0); }     \
      else { _Pragma("unroll") for (int m = 0; m < 4; ++m) _Pragma("unroll") for (int n = 0; n < 2; ++n) _Pragma("unroll") for (int k = 0; k < 2; ++k) \
        acc[ai][bj][m][n] = __builtin_amdgcn_mfma_f32_16x16x32_bf16(Bt[n][k], At[m][k], acc[ai][bj][m][n], 0, 0, 0); } __builtin_amdgcn_s_setprio(0); } while (0)
#define PG8_WAIT_V(n) asm volatile("s_waitcnt vmcnt(" #n ")" ::: "memory")
#define PG8_WAIT_L(n) asm volatile("s_waitcnt lgkmcnt(" #n ")" ::: "memory")
#define PG8_BAR __builtin_amdgcn_s_barrier()
#define PG8_SCHED __builtin_amdgcn_sched_barrier(0)
    Unit cur, nxt; int ui = 0;
    if (!S.next(0, cur)) return;
    f32x4 acc[2][2][4][2];
#pragma unroll
    for (int a = 0; a < 2; ++a)
#pragma unroll
        for (int b = 0; b < 2; ++b)
#pragma unroll
            for (int m = 0; m < 4; ++m)
#pragma unroll
                for (int n = 0; n < 2; ++n) acc[a][b][m][n] = (f32x4){0.f, 0.f, 0.f, 0.f};
    bf16x8 At[4][2], B0[2][2], B1[2][2];
    const char* cA = cur.a; const char* cB = cur.b;
    if constexpr (GATHER) { PG8_GLOAD(0); }
    PG8_STAGE(PG8_SB(0, 0), cB, voffB); PG8_STAGE(PG8_SB(0, 1), cB + hstepB, voffB); PG8_STA(PG8_SA(0, 0), cA, 0); PG8_STA(PG8_SA(0, 1), cA, 1);
    if (wr == 1) PG8_BAR;
    PG8_WAIT_V(2); PG8_BAR;
    PG8_STAGE(PG8_SB(1, 0), cB + kstepB, voffB); PG8_STA(PG8_SA(1, 0), cA + kstepA, 0); PG8_STAGE(PG8_SB(1, 1), cB + hstepB + kstepB, voffB);
    PG8_WAIT_V(6); PG8_BAR;
    for (;;) {
        const bool has_next = S.next(ui + 1, nxt);
        const char* nA = has_next ? nxt.a : cA; const char* nB = has_next ? nxt.b : cB;
#pragma unroll 1
        for (int t = 0; t < nt; t += 2) {
            const bool last = (t == nt - 2);
            const char* a1; const char* a2; const char* a3;
            if constexpr (KSPLIT > 0) {
                const char* cA2 = cur.a2;
                a1 = (t + 1 >= KSPLIT) ? cA2 + (size_t)(t + 1 - KSPLIT) * kstepA : cA + (size_t)(t + 1) * kstepA;
                a2 = last ? nA : ((t + 2 >= KSPLIT) ? cA2 + (size_t)(t + 2 - KSPLIT) * kstepA : cA + (size_t)(t + 2) * kstepA);
                a3 = last ? nA + kstepA : ((t + 3 >= KSPLIT) ? cA2 + (size_t)(t + 3 - KSPLIT) * kstepA : cA + (size_t)(t + 3) * kstepA);
                if (t == KSPLIT) E.mid(acc, cur, wr, wc, fr, fq);
            } else { a1 = cA + (size_t)(t + 1) * kstepA; a2 = last ? nA : cA + (size_t)(t + 2) * kstepA; a3 = a2 + kstepA; }
            const char* b2 = last ? nB : cB + (size_t)(t + 2) * kstepB; const char* b3 = b2 + kstepB;
            if constexpr (Epi::PREFETCH) { if (last) __builtin_amdgcn_global_load_lds((const unsigned*)(E.src(cur, wid) + lane), (LAS unsigned*)(lds + EPI_OFF + wid * 256), 4, 0, 0); }
            PG8_LDB(B0, 0, 0); PG8_LDB(B1, 0, 1); PG8_SCHED; PG8_LDA(At, 0, 0); PG8_STA(PG8_SA(1, 1), a1, 1);
            if constexpr (GATHER) { if (last && has_next) { PG8_GLOAD(ui + 1); } }
            PG8_WAIT_V(8); PG8_WAIT_L(0); PG8_BAR; PG8_MMA(0, 0, At, B0); PG8_MMA(0, 1, At, B1); PG8_BAR; PG8_SCHED;
            PG8_LDA(At, 0, 1); PG8_STAGE(PG8_SB(0, 0), b2, voffB); PG8_STAGE(PG8_SB(0, 1), b2 + hstepB, voffB); PG8_STA(PG8_SA(0, 0), a2, 0);
            PG8_WAIT_V(8); PG8_WAIT_L(0); PG8_BAR; PG8_MMA(1, 0, At, B0); PG8_MMA(1, 1, At, B1); PG8_BAR; PG8_SCHED;
            PG8_LDB(B0, 1, 0); PG8_LDB(B1, 1, 1); PG8_SCHED; PG8_LDA(At, 1, 0); PG8_STA(PG8_SA(0, 1), a2, 1);
            PG8_WAIT_V(8); PG8_WAIT_L(0); PG8_BAR; PG8_MMA(0, 0, At, B0); PG8_MMA(0, 1, At, B1); PG8_BAR; PG8_SCHED;
            PG8_LDA(At, 1, 1); PG8_STAGE(PG8_SB(1, 0), b3, voffB); PG8_STAGE(PG8_SB(1, 1), b3 + hstepB, voffB); PG8_STA(PG8_SA(1, 0), a3, 0);
            PG8_WAIT_V(8); PG8_WAIT_L(0); PG8_BAR; PG8_MMA(1, 0, At, B0); PG8_MMA(1, 1, At, B1); PG8_BAR; PG8_SCHED;
        }
        if (wr == 0) PG8_BAR;
        E(acc, cur, wr, wc, fr, fq);
        if (!has_next) break;
#pragma unroll
        for (int a = 0; a < 2; ++a)
#pragma unroll
            for (int b = 0; b < 2; ++b)
#pragma unroll
                for (int m = 0; m < 4; ++m)
#pragma unroll
                    for (int n = 0; n < 2; ++n) { f32x2 z0, z1; asm volatile("v_mov_b64 %0, 0" : "=v"(z0)); asm volatile("v_mov_b64 %0, 0" : "=v"(z1)); acc[a][b][m][n] = (f32x4){z0[0], z0[1], z1[0], z1[1]}; }
        cur = nxt; cA = nA; cB = nB; ++ui;
        if (wr == 1) PG8_BAR;
    }
    PG8_WAIT_V(0);
    PG8_BAR;
#undef PG8_SA
#undef PG8_SB
#undef PG8_STAGE
#undef PG8_STA
#undef PG8_GLOAD
#undef PG8_LDA
#undef PG8_LDB
#undef PG8_MMA
#undef PG8_WAIT_V
#undef PG8_WAIT_L
#undef PG8_BAR
#undef PG8_SCHED
}

struct OrdPlain {
    const char* A; const char* Bt; int nM, nN, G, c; size_t a_tile, b_tile;
    __device__ __forceinline__ bool next(int i, Unit& u) const { int pm, pn; if (!tile_map((long)i * G + c, nM, nN, pm, pn)) return false;
        u.pm = pm; u.pn = pn; u.e = 0; u.a = A + (size_t)pm * a_tile; u.b = Bt + (size_t)pn * b_tile; return true; }
};
struct OrdPlain2 {
    const char* A; const char* A2; const char* Bt; int nM, nN, G, c; size_t a_tile, b_tile;
    __device__ __forceinline__ bool next(int i, Unit& u) const { int pm, pn; if (!tile_map((long)i * G + c, nM, nN, pm, pn)) return false;
        u.pm = pm; u.pn = pn; u.e = 0; u.a = A + (size_t)pm * a_tile; u.a2 = A2 + (size_t)pm * a_tile; u.b = Bt + (size_t)pn * b_tile; return true; }
};
struct OrdCmp {
    const char* KV6; const char* Wk; const char* Wv; int G, c;
    __device__ __forceinline__ bool next(int i, Unit& u) const { const long L = (long)i * G + c; if (L >= 64) return false;
        const int kv = (int)L >> 5, b = ((int)L >> 2) & 7, g = ((int)L >> 1) & 1, nh = (int)L & 1;
        u.pm = (int)L; u.pn = 0; u.e = kv; u.a = KV6 + ((size_t)(b * SEQ + nh * 4096) * 768 + kv * 128 + g * 64) * 2; u.b = kv ? Wv : Wk; return true; }
};
struct OrdGrp {
    const char* A; const char* Bt; const LAS int* tstart; int nM, nN, G, c; size_t a_tile, b_tile, b_grp;
    __device__ __forceinline__ bool next(int i, Unit& u) const { int pm, pn; if (!tile_map((long)i * G + c, nM, nN, pm, pn)) return false;
        const int lk = (int)(threadIdx.x & 63u);
        const int e = __builtin_popcountll(__ballot(lk >= 1 && lk < NEXP && pm >= tstart[lk & 31]));
        u.pm = pm; u.pn = pn; u.e = e; u.a = A + (size_t)pm * a_tile; u.b = Bt + (size_t)e * b_grp + (size_t)pn * b_tile; return true; }
};

struct EpiIn { static constexpr bool PREFETCH = false;
    static constexpr bool PERM = true;
    bf16_t *Q, *KV6, *CBV, *MG, *NG;
    __device__ __forceinline__ void operator()(const f32x4 (&acc)[2][2][4][2], const Unit& u, int wr, int wc, int fr, int fq) const {
        const int pn = u.pn; const int row0 = u.pm * BM + wr * 64 + fr;
        if (pn >= 7 && pn < 11) {
#pragma unroll
            for (int ai = 0; ai < 2; ++ai)
#pragma unroll
                for (int m = 0; m < 4; ++m) { const f32x4 v0 = acc[ai][0][m][0] * acc[ai][1][m][0], v1 = acc[ai][0][m][1] * acc[ai][1][m][1];
                    u32x4 w; w.x = cvt_pk_bf16(v0[0], v0[1]); w.y = cvt_pk_bf16(v0[2], v0[3]); w.z = cvt_pk_bf16(v1[0], v1[1]); w.w = cvt_pk_bf16(v1[2], v1[3]);
                    *(u32x4*)(CBV + (size_t)(row0 + ai * HALF + m * 16) * 1024 + 512 + (pn - 7) * HALF + wc * 32 + 8 * fq) = w; }
            return;
        }
        bf16_t* base; int ld, ct; bool sig = false;
        if (pn < 2) { base = Q; ld = 512; ct = pn * 256; } else if (pn < 5) { base = KV6; ld = 768; ct = (pn - 2) * 256; }
        else if (pn < 7) { base = CBV; ld = 1024; ct = (pn - 5) * 256; }
        else { base = NG; ld = 32; ct = 0; sig = true; }
#pragma unroll
        for (int ai = 0; ai < 2; ++ai)
#pragma unroll
            for (int m = 0; m < 4; ++m) { bf16_t* rowp = base + (size_t)(row0 + ai * HALF + m * 16) * ld + ct + wc * 32 + 8 * fq;
#pragma unroll
                for (int bj = 0; bj < 2; ++bj) { if (pn == 11 && (bj != 0 || wc != 0)) continue;
                    f32x4 v0 = acc[ai][bj][m][0], v1 = acc[ai][bj][m][1];
                    if (sig) {
#pragma unroll
                        for (int k = 0; k < 4; ++k) { v0[k] = sigmoidf_(v0[k]); v1[k] = sigmoidf_(v1[k]); } }
                    u32x4 w; w.x = cvt_pk_bf16(v0[0], v0[1]); w.y = cvt_pk_bf16(v0[2], v0[3]); w.z = cvt_pk_bf16(v1[0], v1[1]); w.w = cvt_pk_bf16(v1[2], v1[3]);
                    *(u32x4*)(rowp + bj * HALF) = w; } }
    }
};
struct EpiMG8 { static constexpr bool PREFETCH = false;
    static constexpr bool PERM = true;
    bf16_t* MG;
    __device__ __forceinline__ void operator()(const f32x4 (&acc)[2][2][4][2], const Unit& u, int wr, int wc, int fr, int fq) const {
        const int row0 = u.pm * BM + wr * 64 + fr;
#pragma unroll
        for (int ai = 0; ai < 2; ++ai)
#pragma unroll
            for (int m = 0; m < 4; ++m) { bf16_t* rowp = MG + (size_t)(row0 + ai * HALF + m * 16) * 2048 + u.pn * HALF + wc * 32 + 8 * fq;
                f32x4 rt[2], gbv[2];
#pragma unroll
                for (int n = 0; n < 2; ++n) { const f32x2 kk = {-1.4426950408889634f * W8INV_, -1.4426950408889634f * W8INV_}, one2 = {1.0f, 1.0f};
                    const f32x2 ta0 = pk_mul2((f32x2){acc[ai][0][m][n][0], acc[ai][0][m][n][1]}, kk), ta1 = pk_mul2((f32x2){acc[ai][0][m][n][2], acc[ai][0][m][n][3]}, kk);
                    const f32x2 tb0 = pk_mul2((f32x2){acc[ai][1][m][n][0], acc[ai][1][m][n][1]}, kk), tb1 = pk_mul2((f32x2){acc[ai][1][m][n][2], acc[ai][1][m][n][3]}, kk);
                    const f32x2 da0 = pk_add2((f32x2){fminf(__builtin_amdgcn_exp2f(ta0[0]), 1e30f), fminf(__builtin_amdgcn_exp2f(ta0[1]), 1e30f)}, one2), da1 = pk_add2((f32x2){fminf(__builtin_amdgcn_exp2f(ta1[0]), 1e30f), fminf(__builtin_amdgcn_exp2f(ta1[1]), 1e30f)}, one2);
                    const f32x2 db0 = pk_add2((f32x2){fminf(__builtin_amdgcn_exp2f(tb0[0]), 1e30f), fminf(__builtin_amdgcn_exp2f(tb0[1]), 1e30f)}, one2), db1 = pk_add2((f32x2){fminf(__builtin_amdgcn_exp2f(tb1[0]), 1e30f), fminf(__builtin_amdgcn_exp2f(tb1[1]), 1e30f)}, one2);
                    rt[n] = (f32x4){db0[0] * __builtin_amdgcn_rcpf(da0[0]), db0[1] * __builtin_amdgcn_rcpf(da0[1]), db1[0] * __builtin_amdgcn_rcpf(da1[0]), db1[1] * __builtin_amdgcn_rcpf(da1[1])};
                    gbv[n] = (f32x4){__builtin_amdgcn_rcpf(db0[0]), __builtin_amdgcn_rcpf(db0[1]), __builtin_amdgcn_rcpf(db1[0]), __builtin_amdgcn_rcpf(db1[1])}; }
                { u32x4 w; w.x = cvt_pk_bf16(rt[0][0], rt[0][1]); w.y = cvt_pk_bf16(rt[0][2], rt[0][3]); w.z = cvt_pk_bf16(rt[1][0], rt[1][1]); w.w = cvt_pk_bf16(rt[1][2], rt[1][3]); *(u32x4*)rowp = w; }
                { u32x4 w; w.x = cvt_pk_bf16(gbv[0][0], gbv[0][1]); w.y = cvt_pk_bf16(gbv[0][2], gbv[0][3]); w.z = cvt_pk_bf16(gbv[1][0], gbv[1][1]); w.w = cvt_pk_bf16(gbv[1][2], gbv[1][3]); *(u32x4*)(rowp + 1024) = w; } }
    }
};
__device__ __forceinline__ float gelu_tanh(float x) { const float y = (1.5957691216057308f * 1.4426950408889634f) * (x + 0.044715f * x * x * x); return x * __builtin_amdgcn_rcpf(1.0f + __builtin_amdgcn_exp2f(-y)); }
struct EpiCmp { static constexpr bool PREFETCH = false;
    static constexpr bool PERM = true;
    bf16_t* HID; const float* B1P;
    __device__ __forceinline__ void operator()(const f32x4 (&acc)[2][2][4][2], const Unit& u, int wr, int wc, int fr, int fq) const {
        const int row0 = u.pm * BM + wr * 64 + fr; const float* bp = B1P + u.e * 256 + wc * 32 + 8 * fq;
        f32x4 bv[2][2];
#pragma unroll
        for (int bj = 0; bj < 2; ++bj)
#pragma unroll
            for (int n = 0; n < 2; ++n) bv[bj][n] = *(const f32x4*)(bp + bj * HALF + 4 * n);
#pragma unroll
        for (int ai = 0; ai < 2; ++ai)
#pragma unroll
            for (int m = 0; m < 4; ++m) { bf16_t* rowp = HID + (size_t)(row0 + ai * HALF + m * 16) * 256 + wc * 32 + 8 * fq;
#pragma unroll
                for (int bj = 0; bj < 2; ++bj) { f32x4 v0 = acc[ai][bj][m][0] + bv[bj][0], v1 = acc[ai][bj][m][1] + bv[bj][1];
#pragma unroll
                    for (int k = 0; k < 4; ++k) { v0[k] = gelu_tanh(v0[k]); v1[k] = gelu_tanh(v1[k]); }
                    u32x4 w; w.x = cvt_pk_bf16(v0[0], v0[1]); w.y = cvt_pk_bf16(v0[2], v0[3]); w.z = cvt_pk_bf16(v1[0], v1[1]); w.w = cvt_pk_bf16(v1[2], v1[3]);
                    *(u32x4*)(rowp + bj * HALF) = w; } }
    }
};
template <bool ADD> struct EpiGate { static constexpr bool PREFETCH = false;
    static constexpr bool PERM = true;
    bf16_t* Z; const bf16_t* MG; int goff;
    __device__ __forceinline__ void operator()(const f32x4 (&acc)[2][2][4][2], const Unit& u, int wr, int wc, int fr, int fq) const {
        const int row0 = u.pm * BM + wr * 64 + fr, col0 = u.pn * BM + wc * 32 + 8 * fq;
#pragma unroll
        for (int ai = 0; ai < 2; ++ai)
#pragma unroll
            for (int m = 0; m < 4; ++m) { const size_t row = (size_t)(row0 + ai * HALF + m * 16);
#pragma unroll
                for (int bj = 0; bj < 2; ++bj) { const int col = col0 + bj * HALF;
                    const u32x4 gw = *(const u32x4*)(MG + row * 2048 + goff + col);
                    f32x4 v0 = acc[ai][bj][m][0], v1 = acc[ai][bj][m][1];
                    v0[0] *= bflo(gw.x); v0[1] *= bfhi(gw.x); v0[2] *= bflo(gw.y); v0[3] *= bfhi(gw.y); v1[0] *= bflo(gw.z); v1[1] *= bfhi(gw.z); v1[2] *= bflo(gw.w); v1[3] *= bfhi(gw.w);
                    if (ADD) { const u32x4 zw = *(const u32x4*)(Z + row * 1024 + col);
                        v0[0] += bflo(zw.x); v0[1] += bfhi(zw.x); v0[2] += bflo(zw.y); v0[3] += bfhi(zw.y); v1[0] += bflo(zw.z); v1[1] += bfhi(zw.z); v1[2] += bflo(zw.w); v1[3] += bfhi(zw.w); }
                    u32x4 w; w.x = cvt_pk_bf16(v0[0], v0[1]); w.y = cvt_pk_bf16(v0[2], v0[3]); w.z = cvt_pk_bf16(v1[0], v1[1]); w.w = cvt_pk_bf16(v1[2], v1[3]);
                    *(u32x4*)(Z + row * 1024 + col) = w; } }
    }
};
struct EpiGateM { static constexpr bool PREFETCH = false;
    static constexpr bool PERM = true;
    bf16_t* Z; const bf16_t* MG;
    __device__ __forceinline__ void mid(f32x4 (&acc)[2][2][4][2], const Unit& u, int wr, int wc, int fr, int fq) const {
        const int row0 = u.pm * BM + wr * 64 + fr, col0 = u.pn * BM + wc * 32 + 8 * fq;
#pragma unroll
        for (int ai = 0; ai < 2; ++ai)
#pragma unroll
            for (int m = 0; m < 4; ++m) { const size_t row = (size_t)(row0 + ai * HALF + m * 16);
#pragma unroll
                for (int bj = 0; bj < 2; ++bj) { const int col = col0 + bj * HALF;
                    const u32x4 rw = *(const u32x4*)(MG + row * 2048 + col);
                    f32x4& a0 = acc[ai][bj][m][0]; f32x4& a1 = acc[ai][bj][m][1];
                    a0[0] *= bflo(rw.x); a0[1] *= bfhi(rw.x); a0[2] *= bflo(rw.y); a0[3] *= bfhi(rw.y); a1[0] *= bflo(rw.z); a1[1] *= bfhi(rw.z); a1[2] *= bflo(rw.w); a1[3] *= bfhi(rw.w); } }
    }
    __device__ __forceinline__ void operator()(const f32x4 (&acc)[2][2][4][2], const Unit& u, int wr, int wc, int fr, int fq) const {
        const int row0 = u.pm * BM + wr * 64 + fr, col0 = u.pn * BM + wc * 32 + 8 * fq;
#pragma unroll
        for (int ai = 0; ai < 2; ++ai)
#pragma unroll
            for (int m = 0; m < 4; ++m) { const size_t row = (size_t)(row0 + ai * HALF + m * 16);
#pragma unroll
                for (int bj = 0; bj < 2; ++bj) { const int col = col0 + bj * HALF;
                    const u32x4 gw = *(const u32x4*)(MG + row * 2048 + 1024 + col);
                    f32x4 v0 = acc[ai][bj][m][0], v1 = acc[ai][bj][m][1];
                    v0[0] *= fmaxf(bflo(gw.x), 1e-30f); v0[1] *= fmaxf(bfhi(gw.x), 1e-30f); v0[2] *= fmaxf(bflo(gw.y), 1e-30f); v0[3] *= fmaxf(bfhi(gw.y), 1e-30f); v1[0] *= fmaxf(bflo(gw.z), 1e-30f); v1[1] *= fmaxf(bfhi(gw.z), 1e-30f); v1[2] *= fmaxf(bflo(gw.w), 1e-30f); v1[3] *= fmaxf(bfhi(gw.w), 1e-30f);
                    u32x4 w; w.x = cvt_pk_bf16(v0[0], v0[1]); w.y = cvt_pk_bf16(v0[2], v0[3]); w.z = cvt_pk_bf16(v1[0], v1[1]); w.w = cvt_pk_bf16(v1[2], v1[3]);
                    *(u32x4*)(Z + row * 1024 + col) = w; } }
    }
};
struct EpiRes { static constexpr bool PREFETCH = false;
    static constexpr bool PERM = true;
    const float* X; bf16_t* O;
    __device__ __forceinline__ void operator()(const f32x4 (&acc)[2][2][4][2], const Unit& u, int wr, int wc, int fr, int fq) const {
        const int row0 = u.pm * BM + wr * 64 + fr, col0 = u.pn * BM + wc * 32 + 8 * fq;
#pragma unroll
        for (int ai = 0; ai < 2; ++ai)
#pragma unroll
            for (int m = 0; m < 4; ++m) { const size_t off = (size_t)(row0 + ai * HALF + m * 16) * DM + col0;
#pragma unroll
                for (int bj = 0; bj < 2; ++bj) { const f32x4 x0 = *(const f32x4*)(X + off + bj * HALF), x1 = *(const f32x4*)(X + off + bj * HALF + 4);
                    const f32x4 v0 = x0 + acc[ai][bj][m][0], v1 = x1 + acc[ai][bj][m][1];
                    u32x4 w; w.x = cvt_pk_bf16(v0[0], v0[1]); w.y = cvt_pk_bf16(v0[2], v0[3]); w.z = cvt_pk_bf16(v1[0], v1[1]); w.w = cvt_pk_bf16(v1[2], v1[3]);
                    *(u32x4*)(O + off + bj * HALF) = w; } }
    }
};
constexpr float W8SCALE = 32.0f, W8INV = 1.0f / 32.0f;
__device__ __forceinline__ unsigned pk4_fp8(float a, float b, float c, float d) { int r = __builtin_amdgcn_cvt_pk_fp8_f32(a, b, __builtin_bit_cast(int, a), false); r = __builtin_amdgcn_cvt_pk_fp8_f32(c, d, r, true); return (unsigned)r; }
struct EpiGU {
    static constexpr bool PERM = true, PREFETCH = true;
    unsigned char* ACT; const float* BGU; const float* ROWRS; const LAS float* el;
    __device__ __forceinline__ const float* src(const Unit& u, int wid) const { return wid < 4 ? BGU + (size_t)u.e * 2048 + (wid >> 1) * 1024 + u.pn * HALF + (wid & 1) * 64 : ROWRS + u.pm * BM + (wid - 4) * 64; }
    __device__ __forceinline__ void operator()(const f32x4 (&acc)[2][2][4][2], const Unit& u, int wr, int wc, int fr, int fq) const {
        const int row0 = u.pm * BM + wr * 64 + fr, col0 = u.pn * HALF + wc * 32 + 8 * fq;
        f32x4 bg[2], bu[2];
#pragma unroll
        for (int n = 0; n < 2; ++n) { bg[n] = *(const LAS f32x4*)(el + wc * 32 + 8 * fq + 4 * n); bu[n] = *(const LAS f32x4*)(el + 128 + wc * 32 + 8 * fq + 4 * n) + 1.0f; }
#pragma unroll
        for (int ai = 0; ai < 2; ++ai)
#pragma unroll
            for (int mp = 0; mp < 2; ++mp) { u32x2 w[2];
#pragma unroll
                for (int mm = 0; mm < 2; ++mm) { const int m = 2 * mp + mm; const int rl = ai * HALF + wr * 64 + m * 16 + fr; const float sc = W8INV * el[256 + rl];
#pragma unroll
                    for (int n = 0; n < 2; ++n) {
                        f32x4 g = acc[ai][0][m][n] * sc + bg[n], uu = acc[ai][1][m][n] * sc + bu[n], e, r;
#pragma unroll
                        for (int k = 0; k < 4; ++k) { g[k] = fminf(g[k], 7.0f); uu[k] = fminf(fmaxf(uu[k], -6.0f), 8.0f); }
                        const f32x2 kk = {-1.702f * 1.4426950408889634f, -1.702f * 1.4426950408889634f}, one2 = {1.0f, 1.0f};
                        const f32x2 t0 = pk_mul2((f32x2){g[0], g[1]}, kk), t1 = pk_mul2((f32x2){g[2], g[3]}, kk);
                        e[0] = __builtin_amdgcn_exp2f(t0[0]); e[1] = __builtin_amdgcn_exp2f(t0[1]); e[2] = __builtin_amdgcn_exp2f(t1[0]); e[3] = __builtin_amdgcn_exp2f(t1[1]);
                        const f32x2 d0 = pk_add2((f32x2){e[0], e[1]}, one2), d1 = pk_add2((f32x2){e[2], e[3]}, one2);
                        r[0] = __builtin_amdgcn_rcpf(d0[0]); r[1] = __builtin_amdgcn_rcpf(d0[1]); r[2] = __builtin_amdgcn_rcpf(d1[0]); r[3] = __builtin_amdgcn_rcpf(d1[1]);
                        const f32x2 o0 = pk_mul2(pk_mul2((f32x2){g[0], g[1]}, (f32x2){r[0], r[1]}), (f32x2){uu[0], uu[1]}), o1 = pk_mul2(pk_mul2((f32x2){g[2], g[3]}, (f32x2){r[2], r[3]}), (f32x2){uu[2], uu[3]});
                        const f32x4 o = {o0[0], o0[1], o1[0], o1[1]};
                        const unsigned pw = pk4_fp8(o[0], o[1], o[2], o[3]); if (n == 0) w[mm].x = pw; else w[mm].y = pw; } }
                const auto r0 = __builtin_amdgcn_permlane16_swap(w[0].x, w[1].x, false, false), r1 = __builtin_amdgcn_permlane16_swap(w[0].y, w[1].y, false, false);
                u32x4 v; v.x = r0[0]; v.y = r1[0]; v.z = r0[1]; v.w = r1[1];
                const int rs = ai * HALF + wr * 64 + (2 * mp + (fq & 1)) * 16 + fr;
                *(u32x4*)(ACT + (size_t)(u.pm * BM + rs) * 1024 + u.pn * HALF + wc * 32 + 8 * (fq & 2)) = v; }
        (void)row0; (void)col0;
    }
};
constexpr float YSCALE = 16.0f, YINV = 1.0f / 16.0f;
struct EpiDN {
    static constexpr bool PERM = true, PREFETCH = true;
    unsigned char* Y; const float* BDN; const float* ROWW; const LAS float* el;
    __device__ __forceinline__ const float* src(const Unit& u, int wid) const { return wid < 4 ? BDN + (size_t)u.e * 1024 + u.pn * BM + wid * 64 : ROWW + u.pm * BM + (wid - 4) * 64; }
    __device__ __forceinline__ void operator()(const f32x4 (&acc)[2][2][4][2], const Unit& u, int wr, int wc, int fr, int fq) const {
        const int col0 = u.pn * BM + wc * 32 + 8 * fq;
        f32x4 bv[2][2];
#pragma unroll
        for (int bj = 0; bj < 2; ++bj)
#pragma unroll
            for (int n = 0; n < 2; ++n) bv[bj][n] = *(const LAS f32x4*)(el + bj * HALF + wc * 32 + 8 * fq + 4 * n);
#pragma unroll
        for (int ai = 0; ai < 2; ++ai)
#pragma unroll
            for (int mp = 0; mp < 2; ++mp) { u32x2 w[2][2];
#pragma unroll
                for (int mm = 0; mm < 2; ++mm) { const int m = 2 * mp + mm; const int rl = ai * HALF + wr * 64 + m * 16 + fr; const float rw = el[256 + rl] * YSCALE;
#pragma unroll
                    for (int bj = 0; bj < 2; ++bj) { const f32x4 v0 = (acc[ai][bj][m][0] * W8INV + bv[bj][0]) * rw, v1 = (acc[ai][bj][m][1] * W8INV + bv[bj][1]) * rw;
                        w[mm][bj].x = pk4_fp8(v0[0], v0[1], v0[2], v0[3]); w[mm][bj].y = pk4_fp8(v1[0], v1[1], v1[2], v1[3]); } }
                const int rs = ai * HALF + wr * 64 + (2 * mp + (fq & 1)) * 16 + fr; unsigned char* rowp = Y + (size_t)(u.pm * BM + rs) * 1024 + u.pn * BM + wc * 32 + 8 * (fq & 2);
#pragma unroll
                for (int bj = 0; bj < 2; ++bj) { const auto r0 = __builtin_amdgcn_permlane16_swap(w[0][bj].x, w[1][bj].x, false, false), r1 = __builtin_amdgcn_permlane16_swap(w[0][bj].y, w[1][bj].y, false, false);
                    u32x4 v; v.x = r0[0]; v.y = r1[0]; v.z = r0[1]; v.w = r1[1];
                    *(u32x4*)(rowp + bj * HALF) = v; } }
        (void)col0;
    }
};
}

#define XB_TMO      128
#define XB_XCNT(j)  (256  + 64 * (j))
#define XB_XSUB(j)  (1280 + 64 * (j))
#define XB_XGEN(j)  (2304 + 64 * (j))
#define XB_TOP      3328
#define XB_TOPGEN   3392
#define XCD_BAR_WORDS 3456
#define XB_SPIN_CAP (1u << 18)
__device__ __forceinline__ unsigned xb_ld(unsigned* p)              { return __hip_atomic_load(p, __ATOMIC_RELAXED, __HIP_MEMORY_SCOPE_AGENT); }
__device__ __forceinline__ unsigned xb_add(unsigned* p, unsigned v) { return __hip_atomic_fetch_add(p, v, __ATOMIC_RELAXED, __HIP_MEMORY_SCOPE_AGENT); }
__device__ __forceinline__ unsigned xb_xcc_id() { return (unsigned)__builtin_amdgcn_s_getreg((3 << 11) | 20) & 0xFu; }
#define XB_SPIN(cond, bar) do { unsigned _sp = 0; while (cond) { __builtin_amdgcn_s_sleep(1); \
    if ((++_sp & 255u) == 0u) { if (xb_ld(&(bar)[XB_TMO])) break; if (_sp > XB_SPIN_CAP) { atomicAdd(&(bar)[XB_TMO], 1u); break; } } } } while (0)
struct XcdBarrier { unsigned* bar; unsigned x; volatile LAS unsigned* st; };
__device__ __forceinline__ XcdBarrier xcd_barrier_post(unsigned* bar, volatile LAS unsigned* st) {
    XcdBarrier b; b.bar = bar; b.x = xb_xcc_id(); b.st = st;
    if (threadIdx.x == 0) (void)xb_add(&bar[XB_XCNT(b.x)], 1u);
    return b;
}
__device__ __forceinline__ void xcd_barrier_complete(unsigned* bar, unsigned x, unsigned& nloc, unsigned& nx) {
    const unsigned G = gridDim.x * gridDim.y * gridDim.z;
    unsigned sum, cnt, mine, sp = 0u;
    for (;;) {
        sum = 0u; cnt = 0u; mine = 0u;
#pragma unroll
        for (unsigned j = 0; j < 16; ++j) { const unsigned c = xb_ld(&bar[XB_XCNT(j)]); sum += c; cnt += (c > 0u) ? 1u : 0u; mine = (j == x) ? c : mine; }
        if (sum == G) break;
        __builtin_amdgcn_s_sleep(1);
        if ((++sp & 255u) == 0u) { if (xb_ld(&bar[XB_TMO])) break; if (sp > XB_SPIN_CAP) { atomicAdd(&bar[XB_TMO], 1u); break; } }
    }
    nloc = mine > 0u ? mine : 1u; nx = cnt > 0u ? cnt : 1u;
}
__device__ __forceinline__ void xcd_barrier(const XcdBarrier& b) {
    asm volatile("s_waitcnt vmcnt(0)" ::: "memory");
    __syncthreads();
    if (threadIdx.x == 0) {
        unsigned* bar = b.bar;
        __builtin_amdgcn_s_waitcnt(0);
        unsigned nloc = b.st[0], nx = b.st[1];
        if (nloc == 0u) { xcd_barrier_complete(bar, b.x, nloc, nx); b.st[0] = nloc; b.st[1] = nx; }
        const unsigned old = xb_add(&bar[XB_XSUB(b.x)], 1u);
        const unsigned gen = old / nloc;
        if (old + 1u == (gen + 1u) * nloc) {
            __builtin_amdgcn_fence(__ATOMIC_RELEASE, "agent");
            asm volatile("s_waitcnt vmcnt(0)" ::: "memory");
            const unsigned og = xb_add(&bar[XB_TOP], 1u);
            const unsigned tg = og / nx;
            if (og + 1u == (tg + 1u) * nx) xb_add(&bar[XB_TOPGEN], 1u);
            else XB_SPIN(xb_ld(&bar[XB_TOPGEN]) == tg, bar);
            __builtin_amdgcn_fence(__ATOMIC_ACQUIRE, "agent");
            xb_add(&bar[XB_XGEN(b.x)], 1u);
            asm volatile("s_waitcnt vmcnt(0)" ::: "memory");
        } else {
            XB_SPIN(xb_ld(&bar[XB_XGEN(b.x)]) == gen, bar);
            __builtin_amdgcn_fence(__ATOMIC_ACQUIRE, "agent");
            asm volatile("s_waitcnt vmcnt(0)" ::: "memory");
        }
    }
    __syncthreads();
}

struct Args { const float* in[28]; float* out; unsigned char* ws; int ph_lo, ph_hi; };
enum { I_X = 0, I_GN1, I_WIN, I_GQ, I_GKC, I_GKS, I_GKW, I_PEK, I_CKW1, I_CKB1, I_CKW2, I_CKB2, I_PEV, I_CVW1, I_CVB1, I_CVW2, I_CVB2, I_CONVW, I_WPA, I_WPB, I_WO, I_GN2, I_WR, I_BR, I_WGU, I_BGU, I_WDN, I_BDN };

struct Frame {
    LAS unsigned char* lds; int tid, lane, wave, G, vcu; unsigned char* ws; const Args* a; float* out;
};

__device__ __forceinline__ int colmap(int mode, int n) {
    if (mode == 1) { if (n < 1280) return n; if (n < 1792) return n + 24;
        if (n < 2816) { const int p = (n - 1792) >> 8, r = (n - 1792) & 255; return r < 128 ? 1816 + 128 * p + r : 2328 + 128 * p + (r - 128); }
        if (n < 2840) return n - 2816 + 1280; return -1; }
    if (mode == 3) { const int p = n >> 8, r = n & 255; return r < 128 ? 2840 + 128 * p + r : 2840 + 1024 + 128 * p + (r - 128); }
    if (mode == 2) { const int p = n >> 8, r = n & 255; return r < 128 ? 128 * p + r : 1024 + 128 * p + (r - 128); }
    return n;
}
__device__ __forceinline__ void tr_item(const float* W, int Nsrc, int K, bf16_t* WT, int mode, LAS float* scr, int kb, int nb, int lane) {
    const int k0 = 64 * kb, n0 = 32 * nb; const int col = colmap(mode, n0 + (lane & 31));
    { const int n4 = (lane & 7) * 4; const int c0 = colmap(mode, n0 + n4); (void)col;
#pragma unroll
      for (int i = 0; i < 8; ++i) { const int kk = 8 * i + (lane >> 3); f32x4 v = (f32x4){0.f, 0.f, 0.f, 0.f}; if (c0 >= 0) v = *(const f32x4*)(W + (size_t)(k0 + kk) * Nsrc + c0);
          LAS float* d = scr + kk * 33 + n4; d[0] = v.x; d[1] = v.y; d[2] = v.z; d[3] = v.w; } }
    LDS_WAIT(); asm volatile("" ::: "memory");
    const int c = lane & 7;
#pragma unroll
    for (int j = 0; j < 4; ++j) { const int n = (lane >> 3) + 8 * j; const LAS float* s = scr + (8 * c) * 33 + n;
        u32x4 o; o.x = pk2(s[0 * 33], s[1 * 33]); o.y = pk2(s[2 * 33], s[3 * 33]); o.z = pk2(s[4 * 33], s[5 * 33]); o.w = pk2(s[6 * 33], s[7 * 33]);
        *(u32x4*)(WT + (size_t)(n0 + n) * K + k0 + 8 * c) = o; }
    LDS_WAIT(); asm volatile("" ::: "memory");
}
__device__ __forceinline__ void tr_item8(const float* W, int Nsrc, int K, unsigned char* WT, int mode, LAS float* scr, int kb, int nb, int lane) {
    const int k0 = 64 * kb, n0 = 32 * nb; const int col = colmap(mode, n0 + (lane & 31));
    { const int n4 = (lane & 7) * 4; const int c0 = colmap(mode, n0 + n4); (void)col;
#pragma unroll
      for (int i = 0; i < 8; ++i) { const int kk = 8 * i + (lane >> 3); const f32x4 v = *(const f32x4*)(W + (size_t)(k0 + kk) * Nsrc + c0);
          LAS float* d = scr + kk * 33 + n4; d[0] = v.x; d[1] = v.y; d[2] = v.z; d[3] = v.w; } }
    LDS_WAIT(); asm volatile("" ::: "memory");
    const int n = lane >> 1, hf = lane & 1; const LAS float* sp = scr + (32 * hf) * 33 + n;
    u32x4 o0, o1;
#pragma unroll
    for (int q = 0; q < 4; ++q) { o0[q] = pg8::pk4_fp8(sp[(4 * q) * 33] * pg8::W8SCALE, sp[(4 * q + 1) * 33] * pg8::W8SCALE, sp[(4 * q + 2) * 33] * pg8::W8SCALE, sp[(4 * q + 3) * 33] * pg8::W8SCALE);
                                  o1[q] = pg8::pk4_fp8(sp[(16 + 4 * q) * 33] * pg8::W8SCALE, sp[(17 + 4 * q) * 33] * pg8::W8SCALE, sp[(18 + 4 * q) * 33] * pg8::W8SCALE, sp[(19 + 4 * q) * 33] * pg8::W8SCALE); }
    unsigned char* dst = WT + (size_t)(n0 + n) * K + k0 + 32 * hf;
    *(u32x4*)dst = o0; *(u32x4*)(dst + 16) = o1;
    LDS_WAIT(); asm volatile("" ::: "memory");
}
__device__ __forceinline__ void p0_prologue(Frame& F) {
    unsigned char* ws = F.ws;
    LAS float* scr = (LAS float*)(F.lds + F.wave * 16384);
    const int gw = F.vcu * 8 + F.wave, NGW = F.G * 8;
    constexpr int I_IN = 16 * 96, I_MG = 16 * 64, I_PA = 8 * 32, I_PO = 16 * 32, I_C1 = 32 * 8;
    constexpr int NTR = I_IN + I_MG + 2 * I_PA + I_PO + 2 * I_C1;
    {
        f32x4 gn[2][2];
#pragma unroll
        for (int c = 0; c < 2; ++c) { gn[c][0] = ((const f32x4*)F.a->in[I_GN1])[2 * (64 * c + F.lane)]; gn[c][1] = ((const f32x4*)F.a->in[I_GN1])[2 * (64 * c + F.lane) + 1]; }
        f32x4 v[2][2][2], nv[2][2][2];
#define P0_LOAD(dst, m2_) do { _Pragma("unroll") for (int rr = 0; rr < 2; ++rr) { const f32x4* xr = (const f32x4*)(F.a->in[I_X] + (size_t)(2 * (m2_) + rr) * DM); \
            _Pragma("unroll") for (int c = 0; c < 2; ++c) { dst[rr][c][0] = xr[2 * (64 * c + F.lane)]; dst[rr][c][1] = xr[2 * (64 * c + F.lane) + 1]; } } } while (0)
        if (gw < T / 2) P0_LOAD(nv, gw);
        for (int m2 = gw; m2 < T / 2; m2 += NGW) {
#pragma unroll
            for (int rr = 0; rr < 2; ++rr)
#pragma unroll
                for (int c = 0; c < 2; ++c) { v[rr][c][0] = nv[rr][c][0]; v[rr][c][1] = nv[rr][c][1]; }
            { const int mn = m2 + NGW < T / 2 ? m2 + NGW : m2; P0_LOAD(nv, mn); }
#pragma unroll
            for (int rr = 0; rr < 2; ++rr) { float ss = 0.f;
#pragma unroll
                for (int c = 0; c < 2; ++c)
#pragma unroll
                    for (int q = 0; q < 2; ++q) { const f32x4 a = v[rr][c][q]; ss += (a.x * a.x + a.y * a.y) + (a.z * a.z + a.w * a.w); }
                const float rs = 1.0f / sqrtf(wave_sum(ss) * (1.f / DM) + EPS);
                u32x4* o16 = (u32x4*)((bf16_t*)(ws + WS_H1) + (size_t)(2 * m2 + rr) * DM); u32x2* o8 = (u32x2*)((unsigned char*)(ws + WS_H1F8) + (size_t)(2 * m2 + rr) * DM);
#pragma unroll
                for (int c = 0; c < 2; ++c) { const f32x4 h0 = v[rr][c][0] * rs * gn[c][0], h1v = v[rr][c][1] * rs * gn[c][1];
                    u32x4 o; o.x = cvtpk_bf16(h0.x, h0.y); o.y = cvtpk_bf16(h0.z, h0.w); o.z = cvtpk_bf16(h1v.x, h1v.y); o.w = cvtpk_bf16(h1v.z, h1v.w); o16[64 * c + F.lane] = o;
                    u32x2 p; p.x = pg8::pk4_fp8(h0.x, h0.y, h0.z, h0.w); p.y = pg8::pk4_fp8(h1v.x, h1v.y, h1v.z, h1v.w); o8[64 * c + F.lane] = p; } }
        }
#undef P0_LOAD
    }
    for (int it = gw; it < NTR; it += NGW) {
        int r = it;
        if (r < I_IN) { tr_item(F.a->in[I_WIN], IN_COLS, DM, (bf16_t*)(ws + WS_WIN_T), 1, scr, r / 96, r % 96, F.lane); continue; } r -= I_IN;
        if (r < I_MG) { tr_item8(F.a->in[I_WIN], IN_COLS, DM, (unsigned char*)(ws + WS_WMG8), 3, scr, r / 64, r % 64, F.lane); continue; } r -= I_MG;
        if (r < I_PA) { tr_item(F.a->in[I_WPA], DM, DM, (bf16_t*)(ws + WS_WPA_T), 0, scr, r / 32, r % 32, F.lane); continue; } r -= I_PA;
        if (r < I_PA) { tr_item(F.a->in[I_WPB], DM, DM, (bf16_t*)(ws + WS_WPA_T) + AW, 0, scr, r / 32, r % 32, F.lane); continue; } r -= I_PA;
        if (r < I_PO) { tr_item(F.a->in[I_WO], DM, DM, (bf16_t*)(ws + WS_WO_T), 0, scr, r / 32, r % 32, F.lane); continue; } r -= I_PO;
        if (r < I_C1) { tr_item(F.a->in[I_CKW1], CMP_HID, 2048, (bf16_t*)(ws + WS_CKW1_T), 0, scr, r / 8, r % 8, F.lane); continue; } r -= I_C1;
        { tr_item(F.a->in[I_CVW1], CMP_HID, 2048, (bf16_t*)(ws + WS_CVW1_T), 0, scr, r / 8, r % 8, F.lane); }
    }
    __syncthreads();
    for (int it = blockIdx.x; it < 256; it += F.G) {
        const int kv = it >> 7, j0 = (it & 127) * 2;
        const float* pe = kv ? F.a->in[I_PEV] : F.a->in[I_PEK]; const float* w1 = kv ? F.a->in[I_CVW1] : F.a->in[I_CKW1];
        f32x2 wv[4]; float pv[4];
#pragma unroll
        for (int r = 0; r < 4; ++r) { const int i = F.tid + 512 * r; wv[r] = *(const f32x2*)(w1 + (size_t)i * CMP_HID + j0); pv[r] = pe[i]; }
        float a0 = 0.f, a1 = 0.f;
#pragma unroll
        for (int r = 0; r < 4; ++r) { a0 += pv[r] * wv[r][0]; a1 += pv[r] * wv[r][1]; }
        a0 = wave_sum(a0); a1 = wave_sum(a1);
        LAS float* red = (LAS float*)F.lds;
        if (F.lane == 0) { red[F.wave * 2] = a0; red[F.wave * 2 + 1] = a1; }
        __syncthreads();
        if (F.tid < 2) { float sacc = (kv ? F.a->in[I_CVB1] : F.a->in[I_CKB1])[j0 + F.tid];
#pragma unroll
            for (int w = 0; w < 8; ++w) sacc += red[w * 2 + F.tid];
            ((float*)(ws + WS_B1P))[kv * 256 + j0 + F.tid] = sacc; }
        __syncthreads();
    }
}

__device__ __forceinline__ void p2_elementwise(Frame& F, int run) {
    unsigned char* ws = F.ws; const int lane = F.lane;
    bf16_t* Q = (bf16_t*)(ws + WS_Q); bf16_t* KV6 = (bf16_t*)(ws + WS_KV6); const bf16_t* C3 = (const bf16_t*)(ws + WS_CONV3); bf16_t* YB = (bf16_t*)(ws + WS_YB);
    float gq[8], gk[8], cw[3][8];
    { const float* g = F.a->in[I_GQ] + (lane & 7) * 8; const float* g2 = (((lane >> 4) & 1) ? F.a->in[I_GKW] : F.a->in[I_GKS]) + (lane & 7) * 8;
#pragma unroll
      for (int k = 0; k < 8; ++k) { gq[k] = g[k] * QSCALE; gk[k] = g2[k]; }
#pragma unroll
      for (int j = 0; j < 3; ++j)
#pragma unroll
          for (int k = 0; k < 8; ++k) cw[j][k] = F.a->in[I_CONVW][j * CONVW + lane * 8 + k]; }
    {
        const int t0 = run * 32;
        float v1[8], v2[8];
        if ((t0 & (SEQ - 1)) == 0) {
#pragma unroll
            for (int k = 0; k < 8; ++k) { v1[k] = 0.f; v2[k] = 0.f; }
        } else {
            const u32x4 c1 = *(const u32x4*)(C3 + (size_t)(t0 - 1) * 1024 + 512 + lane * 8), c2 = *(const u32x4*)(C3 + (size_t)(t0 - 2) * 1024 + 512 + lane * 8);
#pragma unroll
            for (int k = 0; k < 4; ++k) { v1[2 * k] = bflo(c1[k]); v1[2 * k + 1] = bfhi(c1[k]); v2[2 * k] = bflo(c2[k]); v2[2 * k + 1] = bfhi(c2[k]); }
        }
        const int kcol = 256 + ((lane >> 4) & 1) * 256 + (lane & 15) * 8;
        u32x4 nk, nb, nc;
        { const size_t tok = (size_t)t0; nk = *(const u32x4*)(KV6 + tok * 768 + kcol);
          nb = *(const u32x4*)(C3 + tok * 1024 + lane * 8); nc = *(const u32x4*)(C3 + tok * 1024 + 512 + lane * 8); }
        for (int tt = 0; tt < 32; ++tt) {
            const size_t tok = (size_t)(t0 + tt);
            const u32x4 wk = nk, b = nb, c = nc;
            if (tt + 1 < 32) { const size_t tn = tok + 1; nk = *(const u32x4*)(KV6 + tn * 768 + kcol);
                nb = *(const u32x4*)(C3 + tn * 1024 + lane * 8); nc = *(const u32x4*)(C3 + tn * 1024 + 512 + lane * 8); }
            { float x[8];
#pragma unroll
              for (int k = 0; k < 4; ++k) { x[2 * k] = bflo(wk[k]); x[2 * k + 1] = bfhi(wk[k]); }
              float s = 0.f;
#pragma unroll
              for (int k = 0; k < 8; ++k) s += x[k] * x[k];
              s += __shfl_xor(s, 1); s += __shfl_xor(s, 2); s += __shfl_xor(s, 4);
              const float rs = 1.0f / sqrtf(s * (1.f / 64.f) + EPS);
              u32x4 o; o.x = cvtpk_bf16(x[0] * rs * gk[0], x[1] * rs * gk[1]); o.y = cvtpk_bf16(x[2] * rs * gk[2], x[3] * rs * gk[3]); o.z = cvtpk_bf16(x[4] * rs * gk[4], x[5] * rs * gk[5]); o.w = cvtpk_bf16(x[6] * rs * gk[6], x[7] * rs * gk[7]);
              if (lane < 32) *(u32x4*)(KV6 + tok * 768 + kcol) = o; }
            { float v0[8], bb[8], y[8];
#pragma unroll
              for (int k = 0; k < 4; ++k) { v0[2 * k] = bflo(c[k]); v0[2 * k + 1] = bfhi(c[k]); bb[2 * k] = bflo(b[k]); bb[2 * k + 1] = bfhi(b[k]); }
#pragma unroll
              for (int k = 0; k < 8; ++k) { y[k] = bb[k] * (cw[0][k] * v2[k] + cw[1][k] * v1[k] + cw[2][k] * v0[k]); v2[k] = v1[k]; v1[k] = v0[k]; }
              u32x4 o; o.x = cvtpk_bf16(y[0], y[1]); o.y = cvtpk_bf16(y[2], y[3]); o.z = cvtpk_bf16(y[4], y[5]); o.w = cvtpk_bf16(y[6], y[7]);
              *(u32x4*)(YB + tok * 512 + lane * 8) = o; }
        }
    }
}

__device__ __forceinline__ void p2_queue(Frame& F) {
    unsigned char* ws = F.ws;
    constexpr int I_GU = 16 * 64, I_DN = 16 * 32, N_EW = T / 32, N_CV = NEXP * I_GU + NEXP * I_DN, CHUNK = 8;
    constexpr int NCHUNK = (N_CV + CHUNK - 1) / CHUNK;
    unsigned* head = (unsigned*)(ws + WS_CTL) + 8192;
    LAS float* scr = (LAS float*)(F.lds + F.wave * 16384);
    for (int run = F.vcu * 8 + F.wave; run < N_EW; run += F.G * 8) p2_elementwise(F, run);
    for (;;) {
        unsigned c = 0;
        if (F.lane == 0) c = __hip_atomic_fetch_add(head, 1u, __ATOMIC_RELAXED, __HIP_MEMORY_SCOPE_AGENT);
        c = (unsigned)__builtin_amdgcn_readfirstlane((int)c);
        if (c >= (unsigned)NCHUNK) break;
#pragma unroll 1
        for (int k = 0; k < CHUNK; ++k) { int r0 = (int)c * CHUNK;
            if (r0 < NEXP * I_GU) { const int e = r0 / I_GU, g64 = (r0 % I_GU) / 64, j = (r0 % 64) / 8;
                tr_item8(F.a->in[I_WGU] + (size_t)e * DM * 2048, 2048, DM, (unsigned char*)(ws + WS_WGU_T) + (size_t)e * 2048 * DM, 2, scr, g64, j + 8 * k, F.lane); continue; }
            r0 -= NEXP * I_GU;
            { const int e = r0 / I_DN, g32 = (r0 % I_DN) / 32, j = (r0 % 32) / 8;
              tr_item8(F.a->in[I_WDN] + (size_t)e * DFF * DM, DM, DFF, (unsigned char*)(ws + WS_WDN_T) + (size_t)e * DM * DFF, 0, scr, g32, j + 4 * k, F.lane); } }
    }
}

__device__ __forceinline__ void p3_compress2(Frame& F) {
    unsigned char* ws = F.ws; const int lane = F.lane;
    const bf16_t* HID = (const bf16_t*)(ws + WS_HID);
    LAS float* hr = (LAS float*)(F.lds + F.wave * 1024);
    const int gw = F.vcu * 8 + F.wave, NGW = F.G * 8;
    for (int row = gw; row < 16384; row += NGW) {
        const int kv = row >> 13, n = row & 511;
        if (n == 511) { ((bf16_t*)(ws + (kv ? WS_VC : WS_KC)))[(size_t)(row & 8191) * 64 + lane] = 0; continue; }
        { const u32x2 w = *(const u32x2*)(HID + (size_t)row * 256 + lane * 4); hr[lane * 4 + 0] = bflo(w.x); hr[lane * 4 + 1] = bfhi(w.x); hr[lane * 4 + 2] = bflo(w.y); hr[lane * 4 + 3] = bfhi(w.y); }
        LDS_WAIT(); asm volatile("" ::: "memory");
        const float* w2 = kv ? F.a->in[I_CVW2] : F.a->in[I_CKW2];
        float a = (kv ? F.a->in[I_CVB2] : F.a->in[I_CKB2])[lane];
#pragma unroll 1
        for (int kb = 0; kb < 4; ++kb) { float wv[64];
#pragma unroll
            for (int k = 0; k < 64; ++k) wv[k] = w2[(kb * 64 + k) * 64 + lane];
#pragma unroll
            for (int k = 0; k < 64; ++k) a += hr[kb * 64 + k] * wv[k]; }
        if (kv == 0) { const float ss = wave_sum(a * a); a = a * (1.0f / sqrtf(ss * (1.f / 64.f) + EPS)) * F.a->in[I_GKC][lane]; }
        ((bf16_t*)(ws + (kv ? WS_VC : WS_KC)))[(size_t)(row & 8191) * 64 + lane] = (bf16_t)f2bf(a);
        LDS_WAIT(); asm volatile("" ::: "memory");
    }
}

__device__ __forceinline__ float dot64(const bf16_t* krow, const f32x4 (&q4)[16]) {
    float s = 0.f;
#pragma unroll
    for (int c = 0; c < 8; ++c) { const u32x4 w = *(const u32x4*)(krow + 8 * c);
        s += q4[2 * c].x * bflo(w.x) + q4[2 * c].y * bfhi(w.x) + q4[2 * c].z * bflo(w.y) + q4[2 * c].w * bfhi(w.y)
           + q4[2 * c + 1].x * bflo(w.z) + q4[2 * c + 1].y * bfhi(w.z) + q4[2 * c + 1].z * bflo(w.w) + q4[2 * c + 1].w * bfhi(w.w); }
    return s;
}
__device__ __forceinline__ void p4_attn_naive(Frame& F) {
    unsigned char* ws = F.ws; const int lane = F.lane, h = F.wave, g = h >> 2;
    LAS float* SC = (LAS float*)F.lds + h * 1024;
    LAS float* PC = (LAS float*)F.lds + 8192 + h * 512;
    LAS float* PCg = (LAS float*)F.lds + 8192;
    LAS float* QS = (LAS float*)F.lds + 12288 + h * 64;
    LAS float* SCORE = (LAS float*)F.lds + 12800;
    LAS int* SEL = (LAS int*)((LAS float*)F.lds + 13056);
    bf16_t* Q = (bf16_t*)(ws + WS_Q); const bf16_t* KV6 = (const bf16_t*)(ws + WS_KV6);
    const bf16_t* KC = (const bf16_t*)(ws + WS_KC); const bf16_t* VC = (const bf16_t*)(ws + WS_VC); const bf16_t* NG = (const bf16_t*)(ws + WS_NG);
    const float slope2 = __builtin_amdgcn_ldexpf(LOG2E, -(h + 1));
    const float NEGB = -1e30f;
    for (int tok = blockIdx.x; tok < T; tok += F.G) {
        const int b = tok >> 13, t = tok & (SEQ - 1), cur = t >> 6;
        QS[lane] = bf2f(Q[(size_t)tok * 512 + h * 64 + lane]);
        LDS_WAIT(); asm volatile("" ::: "memory");
        f32x4 q4[16];
#pragma unroll
        for (int i = 0; i < 16; ++i) q4[i] = *(const LAS f32x4*)(QS + 4 * i);
        const int nvalid = t >= 31 ? ((t - 31) >> 4) + 1 : 0;
        const bf16_t* kcb = KC + (size_t)((b * 2 + g) * 512) * 64; const bf16_t* vcb = VC + (size_t)((b * 2 + g) * 512) * 64;
        float oc = 0.f;
        {
            float mx = NEGB;
            for (int n = lane; n < nvalid; n += 64) { const float x = dot64(kcb + (size_t)n * 64, q4) - slope2 * (float)(t - (16 * n + 31)); SC[n] = x; mx = fmaxf(mx, x); }
            mx = wave_max(mx);
            float sum = 0.f;
            for (int n = lane; n < nvalid; n += 64) { const float p = exp2f(SC[n] - mx); SC[n] = p; sum += p; }
            sum = wave_sum(sum); const float il = nvalid > 0 ? 1.0f / sum : 0.f;
            for (int n = lane; n < 512; n += 64) PC[n] = n < nvalid ? SC[n] * il : 0.f;
            LDS_WAIT(); asm volatile("" ::: "memory");
            for (int n = 0; n < nvalid; ++n) oc += PC[n] * bf2f(vcb[(size_t)n * 64 + lane]);
        }
        __syncthreads();
        if (F.tid < 256) { const int gg = F.tid >> 7, j = F.tid & 127, a = 4 * j; float s = 0.f;
#pragma unroll
            for (int hh = 0; hh < 4; ++hh) { const LAS float* P = PCg + (gg * 4 + hh) * 512; s += (a > 0 ? P[a - 1] : 0.f) + 2.f * (P[a] + P[a + 1] + P[a + 2]) + P[a + 3]; }
            SCORE[gg * 128 + j] = j > cur ? -1e30f : ((j == 0 || j == cur || j == cur - 1) ? 1e30f : s); }
        __syncthreads();
        if (h < 2) { float a = SCORE[h * 128 + lane], bb = SCORE[h * 128 + 64 + lane];
            for (int r = 0; r < NSEL; ++r) { const float m = wave_max(fmaxf(a, bb));
                const unsigned long long ba = __ballot(a == m); int idx;
                if (ba) { idx = __ffsll((long long)ba) - 1; if (lane == idx) a = -3e38f; }
                else { const unsigned long long b2 = __ballot(bb == m); idx = __ffsll((long long)b2) - 1; if (lane == idx) bb = -3e38f; idx += 64; }
                if (lane == 0) SEL[h * 16 + r] = idx; } }
        __syncthreads();
        float os = 0.f;
        {
            float mx = NEGB;
            for (int r = 0; r < NSEL; ++r) { const int j = SEL[g * 16 + r]; float x = NEGB;
                if (j <= cur) { const int pos = 64 * j + lane; if (pos <= t) x = dot64(KV6 + (size_t)(b * SEQ + pos) * 768 + 256 + g * 64, q4) - slope2 * (float)(t - pos); }
                SC[r * 64 + lane] = x; mx = fmaxf(mx, x); }
            mx = wave_max(mx); float sum = 0.f;
            for (int r = 0; r < NSEL; ++r) { const float p = exp2f(SC[r * 64 + lane] - mx); SC[r * 64 + lane] = p; sum += p; }
            sum = wave_sum(sum); const float il = 1.0f / sum;
            LDS_WAIT(); asm volatile("" ::: "memory");
            for (int r = 0; r < NSEL; ++r) { const int j = SEL[g * 16 + r]; if (j > cur) continue;
                const bf16_t* vb = KV6 + (size_t)(b * SEQ + 64 * j) * 768 + 384 + g * 64 + lane; const int kmax = (64 * j + 63 <= t) ? 64 : (t - 64 * j + 1);
                for (int kk = 0; kk < kmax; ++kk) os += SC[r * 64 + kk] * bf2f(vb[(size_t)kk * 768]); }
            os *= il;
        }
        float ow = 0.f;
        {
            float mx = NEGB;
            for (int i = lane; i < WIN; i += 64) { const int pos = t - (WIN - 1) + i; float x = NEGB;
                if (pos >= 0) x = dot64(KV6 + (size_t)(b * SEQ + pos) * 768 + 512 + g * 64, q4) - slope2 * (float)(t - pos);
                SC[i] = x; mx = fmaxf(mx, x); }
            mx = wave_max(mx); float sum = 0.f;
            for (int i = lane; i < WIN; i += 64) { const float p = exp2f(SC[i] - mx); SC[i] = p; sum += p; }
            sum = wave_sum(sum); const float il = 1.0f / sum;
            LDS_WAIT(); asm volatile("" ::: "memory");
            const int i0 = t >= WIN - 1 ? 0 : (WIN - 1 - t);
            for (int i = i0; i < WIN; ++i) { const int pos = t - (WIN - 1) + i; ow += SC[i] * bf2f(KV6[(size_t)(b * SEQ + pos) * 768 + 640 + g * 64 + lane]); }
            ow *= il;
        }
        const float g0 = bf2f(NG[(size_t)tok * 32 + h * 3 + 0]), g1 = bf2f(NG[(size_t)tok * 32 + h * 3 + 1]), g2 = bf2f(NG[(size_t)tok * 32 + h * 3 + 2]);
        ((bf16_t*)(ws + WS_OA))[(size_t)tok * 512 + h * 64 + lane] = (bf16_t)f2bf(g0 * oc + g1 * os + g2 * ow);
        __syncthreads();
    }
}

namespace at {
typedef __attribute__((address_space(3))) const char* lcp;
typedef short s16x4 __attribute__((ext_vector_type(4)));
typedef float f32x16 __attribute__((ext_vector_type(16)));
typedef short v4i16_t __attribute__((ext_vector_type(4)));
constexpr int SLOTB = 8192;
constexpr int NSLOT = 4;
constexpr int L_K = 0, L_V = NSLOT * SLOTB, L_WS = 2 * NSLOT * SLOTB, L_OST = L_WS + 8 * 256, L_IMP = L_OST  , L_SELM = L_OST + 8 * 8192, L_UNION = L_SELM + 1024, L_NTL = L_UNION + 16, L_TL = L_NTL + 16, L_END = L_TL + 512;
static_assert(L_END <= MISC_OFF, "attention LDS");
constexpr float NEGBIG = -1e30f;
__device__ __forceinline__ void glds16(const void* gsrc, unsigned lds_dst) { unsigned keep;
    asm volatile("s_mov_b32 %0, m0\n\ts_mov_b32 m0, %2\n\ts_nop 0\n\tglobal_load_lds_dwordx4 %1, off\n\ts_mov_b32 m0, %0" : "=&s"(keep) : "v"(gsrc), "s"(lds_dst) : "memory"); }
__device__ __forceinline__ void glds16s(const void* sbase, unsigned voff, unsigned lds_dst) { unsigned keep;
    asm volatile("s_mov_b32 %0, m0\n\ts_mov_b32 m0, %3\n\ts_nop 0\n\tglobal_load_lds_dwordx4 %1, %2\n\ts_mov_b32 m0, %0" : "=&s"(keep) : "v"(voff), "s"(sbase), "s"(lds_dst) : "memory"); }
__device__ __forceinline__ unsigned cvtpk(float lo, float hi) { return cvtpk_bf16(lo, hi); }
#define AT_WAIT_BAR(N) asm volatile("s_waitcnt vmcnt(" #N ") lgkmcnt(0)\n\ts_barrier" ::: "memory")
#define AT_SBAR() __builtin_amdgcn_sched_barrier(0)
#define AT_LOCALS(LN) const int lane = LN; const int r32 = lane & 31, hi = lane >> 5, hh = r32 >> 3, qi = r32 & 7; const int tq = q0 + 8 * wid + qi, qoff = 8 * wid + qi; const int h = 4 * g + hh; \
    const float slope2 = __builtin_amdgcn_ldexpf(LOG2E, -(h + 1)); const lcp kp0 = (lcp)lds + L_K + hi * 1024 + r32 * 16; LAS float* gst = (LAS float*)(lds + L_V + 3 * SLOTB) + wid * 128 + lane; (void)hh; (void)qoff; (void)tq; (void)gst; (void)kp0; (void)slope2

template <int KMUL, int MODE>
__device__ __forceinline__ void qk_tile(f32x16& p0, f32x16& p1, lcp kp, const bf16x8 (&qr)[4], float cinit, float slope2, int klim2) {
    f32x16 c;
#pragma unroll
    for (int r = 0; r < 16; ++r) c[r] = cinit;
#pragma unroll
    for (int d0 = 0; d0 < 4; ++d0) {
        const bf16x8 b0 = *(const LAS bf16x8*)(kp + d0 * 2048), b1 = *(const LAS bf16x8*)(kp + d0 * 2048 + 512);
        if (d0 == 0) { p0 = __builtin_amdgcn_mfma_f32_32x32x16_bf16(b0, qr[0], c, 0, 0, 0); p1 = __builtin_amdgcn_mfma_f32_32x32x16_bf16(b1, qr[0], c, 0, 0, 0); }
        else { p0 = __builtin_amdgcn_mfma_f32_32x32x16_bf16(b0, qr[d0], p0, 0, 0, 0); p1 = __builtin_amdgcn_mfma_f32_32x32x16_bf16(b1, qr[d0], p1, 0, 0, 0); }
    }
#pragma unroll
    for (int r = 0; r < 16; ++r) { const int lit = (r & 3) + 8 * (r >> 2);
        float a = slope2 * (float)(KMUL * lit) + p0[r], b = slope2 * (float)(KMUL * (lit + 32)) + p1[r];
        if (MODE == 1) { a = (lit <= klim2) ? a : NEGBIG; b = (lit + 32 <= klim2) ? b : NEGBIG; }
        if (MODE == 2) { a = (lit > klim2) ? a : NEGBIG; b = (lit + 32 > klim2) ? b : NEGBIG; }
        p0[r] = __builtin_amdgcn_exp2f(a); p1[r] = __builtin_amdgcn_exp2f(b); }
}
__device__ __forceinline__ void qk_mfma(f32x16& p0, f32x16& p1, lcp kp, const bf16x8 (&qr)[4], float cinit) {
    f32x16 c;
#pragma unroll
    for (int r = 0; r < 16; ++r) c[r] = cinit;
#pragma unroll
    for (int d0 = 0; d0 < 4; ++d0) {
        const bf16x8 b0 = *(const LAS bf16x8*)(kp + d0 * 2048), b1 = *(const LAS bf16x8*)(kp + d0 * 2048 + 512);
        if (d0 == 0) { p0 = __builtin_amdgcn_mfma_f32_32x32x16_bf16(b0, qr[0], c, 0, 0, 0); p1 = __builtin_amdgcn_mfma_f32_32x32x16_bf16(b1, qr[0], c, 0, 0, 0); }
        else { p0 = __builtin_amdgcn_mfma_f32_32x32x16_bf16(b0, qr[d0], p0, 0, 0, 0); p1 = __builtin_amdgcn_mfma_f32_32x32x16_bf16(b1, qr[d0], p1, 0, 0, 0); }
    }
}
template <int KMUL, int MODE>
__device__ __forceinline__ void sm_valu(f32x16& p0, f32x16& p1, float slope2, int klim2) {
#pragma unroll
    for (int r = 0; r < 16; ++r) { const int lit = (r & 3) + 8 * (r >> 2);
        float a = slope2 * (float)(KMUL * lit) + p0[r], b = slope2 * (float)(KMUL * (lit + 32)) + p1[r];
        if (MODE == 1) { a = (lit <= klim2) ? a : NEGBIG; b = (lit + 32 <= klim2) ? b : NEGBIG; }
        if (MODE == 2) { a = (lit > klim2) ? a : NEGBIG; b = (lit + 32 > klim2) ? b : NEGBIG; }
        p0[r] = __builtin_amdgcn_exp2f(a); p1[r] = __builtin_amdgcn_exp2f(b); }
}
__device__ __forceinline__ float psum(const f32x16& p0, const f32x16& p1) {
    float a = 0.f, b = 0.f;
#pragma unroll
    for (int r = 0; r < 16; r += 2) { a += p0[r] + p1[r]; b += p0[r + 1] + p1[r + 1]; }
    return a + b;
}
__device__ __forceinline__ void pv_tile(f32x16* o, int vb, const f32x16& p0, const f32x16& p1) {
    u32x4 pw[4];
#pragma unroll
    for (int i = 0; i < 4; ++i) { pw[0][i] = cvtpk(p0[2 * i], p0[2 * i + 1]); pw[1][i] = cvtpk(p0[8 + 2 * i], p0[9 + 2 * i]); pw[2][i] = cvtpk(p1[2 * i], p1[2 * i + 1]); pw[3][i] = cvtpk(p1[8 + 2 * i], p1[9 + 2 * i]); }
    s16x4 lo[2][4], hi[2][4];
#pragma unroll
    for (int dh = 0; dh < 2; ++dh)
#pragma unroll
        for (int ks = 0; ks < 4; ++ks) {
            asm volatile("ds_read_b64_tr_b16 %0,%1 offset:%c2" : "=&v"(lo[dh][ks]) : "v"(vb), "i"(dh * 4096 + ks * 1024) : "memory");
            asm volatile("ds_read_b64_tr_b16 %0,%1 offset:%c2" : "=&v"(hi[dh][ks]) : "v"(vb), "i"(dh * 4096 + ks * 1024 + 512) : "memory"); }
    asm volatile("s_waitcnt lgkmcnt(0)" ::: "memory"); AT_SBAR();
#define AT_PK(d, k) (bf16x8){lo[d][k][0], lo[d][k][1], lo[d][k][2], lo[d][k][3], hi[d][k][0], hi[d][k][1], hi[d][k][2], hi[d][k][3]}
#pragma unroll
    for (int ks = 0; ks < 4; ++ks) {
        o[0] = __builtin_amdgcn_mfma_f32_32x32x16_bf16(__builtin_bit_cast(bf16x8, pw[ks]), AT_PK(0, ks), o[0], 0, 0, 0);
        o[1] = __builtin_amdgcn_mfma_f32_32x32x16_bf16(__builtin_bit_cast(bf16x8, pw[ks]), AT_PK(1, ks), o[1], 0, 0, 0); }
#undef AT_PK
}
__device__ __forceinline__ void pv_tile_seq(f32x16* o, int vb, const f32x16& p0, const f32x16& p1) {
    u32x4 pw[4];
#pragma unroll
    for (int i = 0; i < 4; ++i) { pw[0][i] = cvtpk(p0[2 * i], p0[2 * i + 1]); pw[1][i] = cvtpk(p0[8 + 2 * i], p0[9 + 2 * i]); pw[2][i] = cvtpk(p1[2 * i], p1[2 * i + 1]); pw[3][i] = cvtpk(p1[8 + 2 * i], p1[9 + 2 * i]); }
#pragma unroll
    for (int dh = 0; dh < 2; ++dh) { s16x4 lo[4], hi[4];
#pragma unroll
        for (int ks = 0; ks < 4; ++ks) {
            asm volatile("ds_read_b64_tr_b16 %0,%1 offset:%c2" : "=&v"(lo[ks]) : "v"(vb), "i"(dh * 4096 + ks * 1024) : "memory");
            asm volatile("ds_read_b64_tr_b16 %0,%1 offset:%c2" : "=&v"(hi[ks]) : "v"(vb), "i"(dh * 4096 + ks * 1024 + 512) : "memory"); }
        asm volatile("s_waitcnt lgkmcnt(0)" ::: "memory"); AT_SBAR();
#define AT_PK(k) (bf16x8){lo[k][0], lo[k][1], lo[k][2], lo[k][3], hi[k][0], hi[k][1], hi[k][2], hi[k][3]}
        o[dh] = __builtin_amdgcn_mfma_f32_32x32x16_bf16(__builtin_bit_cast(bf16x8, pw[0]), AT_PK(0), o[dh], 0, 0, 0);
        o[dh] = __builtin_amdgcn_mfma_f32_32x32x16_bf16(__builtin_bit_cast(bf16x8, pw[1]), AT_PK(1), o[dh], 0, 0, 0);
        o[dh] = __builtin_amdgcn_mfma_f32_32x32x16_bf16(__builtin_bit_cast(bf16x8, pw[2]), AT_PK(2), o[dh], 0, 0, 0);
        o[dh] = __builtin_amdgcn_mfma_f32_32x32x16_bf16(__builtin_bit_cast(bf16x8, pw[3]), AT_PK(3), o[dh], 0, 0, 0);
#undef AT_PK
    }
}
template <class Br>
__device__ __forceinline__ void stream_pv(const Br br, const int nt, f32x16 (&o)[2], float& lsum, const bf16x8 (&qr)[4], lcp kp0, int vb0, unsigned kdst, unsigned vdst, float slope2) {
    if (nt <= 0) return;
    f32x16 s0, s1;
#define AT_ISSUE(t) do { glds16(br.ksrc(t), kdst + ((t) & 3) * SLOTB); glds16(br.vsrc(t), vdst + ((t) & 3) * SLOTB); } while (0)
    AT_ISSUE(0); if (nt > 1) AT_ISSUE(1); if (nt > 2) AT_ISSUE(2);
    for (int t = 0; t < nt; ++t) {
        if (t + 2 < nt) { AT_WAIT_BAR(4); } else if (t + 1 < nt) { AT_WAIT_BAR(2); } else { AT_WAIT_BAR(0); }
        if (t + 3 < nt) AT_ISSUE(t + 3);
        float ci; int kl, md; bool ac; br.info(t, ci, kl, md, ac);
        if (ac) { qk_mfma(s0, s1, kp0 + (t & 3) * SLOTB, qr, ci);
            if (md == 0) sm_valu<1, 0>(s0, s1, slope2, 0); else if (md == 1) sm_valu<1, 1>(s0, s1, slope2, kl); else sm_valu<1, 2>(s0, s1, slope2, kl);
            lsum += psum(s0, s1); pv_tile(o, vb0 + (t & 3) * SLOTB, s0, s1); }
    }
    AT_WAIT_BAR(0);
#undef AT_ISSUE
}

typedef short v4i16_t2 __attribute__((ext_vector_type(4)));
__device__ __forceinline__ s16x4 vtr(lcp p) { return __builtin_bit_cast(s16x4, __builtin_amdgcn_ds_read_tr16_b64_v4i16((__attribute__((address_space(3))) v4i16_t2*)p)); }
__device__ __forceinline__ void kload2(bf16x8* kf, lcp kp, int j) { kf[2 * j] = *(const LAS bf16x8*)(kp + j * 2048); kf[2 * j + 1] = *(const LAS bf16x8*)(kp + j * 2048 + 512); }
template <class Br>
__device__ __forceinline__ void stream2(Br br, const int nt, f32x16 (&o)[2], float& lsum, const bf16x8 (&qr)[4], lcp kp0, lcp vp0, unsigned kdst, unsigned vdst, float slope2, const int lane, const int wid) {
    if (nt <= 0) return;
#define klim2 (8 * wid + (lane & 7) - 4 * (lane >> 5))
    const int vb0 = (int)(unsigned)(uintptr_t)vp0;
#define S2_DK(off, t, slot) br.dk(off, t, kdst + (unsigned)(slot))
#define S2_DV(off, t, slot) br.dv(off, t, vdst + (unsigned)(slot))
    br.start(nt);
    S2_DK(0, 0, 0); S2_DV(0, 0, 0); if (nt > 1) S2_DK(1, 1, SLOTB); if (nt > 2) S2_DK(2, 2, 2 * SLOTB);
    if (nt > 2) { AT_WAIT_BAR(3); } else if (nt > 1) { AT_WAIT_BAR(2); } else { AT_WAIT_BAR(1); }
    f32x16 pA0, pA1, pB0, pB1;
    const bool odd = (nt & 1) != 0;
    { const float ci = br.cinit(0, 0); const int md = br.mode(0, 0); f32x16 q0_, q1_; qk_mfma(q0_, q1_, kp0, qr, ci);
      if (md == 0) sm_valu<1, 0>(q0_, q1_, slope2, 0); else if (md == 1) sm_valu<1, 1>(q0_, q1_, slope2, klim2); else sm_valu<1, 2>(q0_, q1_, slope2, klim2);
      if (odd) { pB0 = q0_; pB1 = q1_; } else { pA0 = q0_; pA1 = q1_; } }
    AT_WAIT_BAR(0);
    if (nt > 3) S2_DK(3, 3, 0); if (nt > 1) S2_DV(1, 1, SLOTB);
    float ci_cur = br.cinit(1, 1); br.advance(nt, 1);
    int sl_prev = 0, sl_cur = 0, sl_next = SLOTB;
#define S2_ROT() do { sl_prev = sl_cur; sl_cur = sl_next; sl_next = (sl_next == 2 * SLOTB) ? 0 : sl_next + SLOTB; } while (0)
    bf16x8 kf[8];
    if (nt > 1) { S2_ROT(); kload2(kf, kp0 + sl_cur, 0); kload2(kf, kp0 + sl_cur, 1); kload2(kf, kp0 + sl_cur, 2); kload2(kf, kp0 + sl_cur, 3); }
    if (nt > 3) { AT_WAIT_BAR(2); } else if (nt > 2) { AT_WAIT_BAR(1); } else { AT_WAIT_BAR(0); }
    s16x4 vlo[8], vhi[8]; u32x4 pw0, pw1, pw2, pw3;
#define S2_PKW(P, B) cvtpk(P[B], P[(B) + 1])
#define S2_PAF(k) __builtin_bit_cast(bf16x8, pw##k)
#define S2_VFR(i) (bf16x8){vlo[i][0], vlo[i][1], vlo[i][2], vlo[i][3], vhi[i][0], vhi[i][1], vhi[i][2], vhi[i][3]}
#define S2_PIN(x) asm volatile("" : "+v"(x))
#define S2_GAPA(MF, A0, A1, A2, A3, W0, W1, PW) do { MF; sacc += A0; sacc += A1; sacc += A2; sacc += A3; S2_PIN(sacc); W0; W1; S2_PIN(PW); AT_SBAR(); } while (0)
#define S2_LIT(B, i, OFS) ((float)((((B) + (i)) & 3) + 8 * (((B) + (i)) >> 2) + (OFS)))
#define S2_E1(X, B, i, OFS, MODE) do { float a_ = slope2 * S2_LIT(B, i, OFS) + X[(B) + (i)]; \
        if (MODE == 1) a_ = ((int)S2_LIT(B, i, OFS) <= klim2) ? a_ : NEGBIG; if (MODE == 2) a_ = ((int)S2_LIT(B, i, OFS) > klim2) ? a_ : NEGBIG; X[(B) + (i)] = __builtin_amdgcn_exp2f(a_); } while (0)
#define S2_GAPB(MF, X, B, OFS, MODE) do { MF; S2_E1(X, B, 0, OFS, MODE); S2_E1(X, B, 1, OFS, MODE); S2_E1(X, B, 2, OFS, MODE); S2_E1(X, B, 3, OFS, MODE); S2_PIN(X); AT_SBAR(); } while (0)
#define S2_VRD(i) do { vlo[i] = vtr(vp_ + (((i) >> 2) * 4096 + ((i) & 3) * 1024)); vhi[i] = vtr(vp_ + (((i) >> 2) * 4096 + ((i) & 3) * 1024 + 512)); } while (0)
#define S2_KRD(G, j) do { if (G) { kload2(kf, kp0 + sl_next, j); AT_SBAR(); } } while (0)
#define S2_STEP(C0, C1, P0, P1, t, GK, GV, GL, MODE) do { AT_SBAR(); \
    const lcp vp_ = vp0 + sl_prev; \
    S2_VRD(0); AT_SBAR(); float sacc = (P0[0] + P0[1]); \
    S2_GAPA(C0 = __builtin_amdgcn_mfma_f32_32x32x16_bf16(kf[0], qr[0], C0, 0, 0, 0), P0[2], P0[3], P0[4], P0[5], pw0[0] = S2_PKW(P0, 0), pw0[1] = S2_PKW(P0, 2), pw0); \
    S2_VRD(4); AT_SBAR(); S2_GAPA(C1 = __builtin_amdgcn_mfma_f32_32x32x16_bf16(kf[1], qr[0], C1, 0, 0, 0), P0[6], P0[7], P0[8], P0[9], pw0[2] = S2_PKW(P0, 4), pw0[3] = S2_PKW(P0, 6), pw0); \
    S2_VRD(1); AT_SBAR(); S2_GAPA(C0 = __builtin_amdgcn_mfma_f32_32x32x16_bf16(kf[2], qr[1], C0, 0, 0, 0), P0[10], P0[11], P0[12], P0[13], pw1[0] = S2_PKW(P0, 8), pw1[1] = S2_PKW(P0, 10), pw1); \
    S2_VRD(5); AT_SBAR(); S2_GAPA(C1 = __builtin_amdgcn_mfma_f32_32x32x16_bf16(kf[3], qr[1], C1, 0, 0, 0), P0[14], P0[15], P1[0], P1[1], pw1[2] = S2_PKW(P0, 12), pw1[3] = S2_PKW(P0, 14), pw1); \
    S2_VRD(2); AT_SBAR(); S2_GAPA(C0 = __builtin_amdgcn_mfma_f32_32x32x16_bf16(kf[4], qr[2], C0, 0, 0, 0), P1[2], P1[3], P1[4], P1[5], pw2[0] = S2_PKW(P1, 0), pw2[1] = S2_PKW(P1, 2), pw2); \
    S2_VRD(6); AT_SBAR(); S2_GAPA(C1 = __builtin_amdgcn_mfma_f32_32x32x16_bf16(kf[5], qr[2], C1, 0, 0, 0), P1[6], P1[7], P1[8], P1[9], pw2[2] = S2_PKW(P1, 4), pw2[3] = S2_PKW(P1, 6), pw2); \
    S2_VRD(3); AT_SBAR(); S2_GAPA(C0 = __builtin_amdgcn_mfma_f32_32x32x16_bf16(kf[6], qr[3], C0, 0, 0, 0), P1[10], P1[11], P1[12], P1[13], pw3[0] = S2_PKW(P1, 8), pw3[1] = S2_PKW(P1, 10), pw3); \
    S2_VRD(7); AT_SBAR(); S2_GAPA(C1 = __builtin_amdgcn_mfma_f32_32x32x16_bf16(kf[7], qr[3], C1, 0, 0, 0), P1[14], P1[15], 0.f, 0.f, pw3[2] = S2_PKW(P1, 12), pw3[3] = S2_PKW(P1, 14), pw3); \
    lsum += sacc; \
    if (GK) { S2_DK(3, (t) + 3, sl_cur); } if (GV) { S2_DV(1, (t) + 1, sl_next); } \
    AT_SBAR(); \
    S2_GAPB(o[0] = __builtin_amdgcn_mfma_f32_32x32x16_bf16(S2_PAF(0), S2_VFR(0), o[0], 0, 0, 0), C0, 0, 0, MODE); \
    S2_GAPB(o[1] = __builtin_amdgcn_mfma_f32_32x32x16_bf16(S2_PAF(0), S2_VFR(4), o[1], 0, 0, 0), C0, 4, 0, MODE); \
    S2_KRD(GL, 0); S2_GAPB(o[0] = __builtin_amdgcn_mfma_f32_32x32x16_bf16(S2_PAF(1), S2_VFR(1), o[0], 0, 0, 0), C0, 8, 0, MODE); \
    S2_KRD(GL, 1); S2_GAPB(o[1] = __builtin_amdgcn_mfma_f32_32x32x16_bf16(S2_PAF(1), S2_VFR(5), o[1], 0, 0, 0), C0, 12, 0, MODE); \
    S2_KRD(GL, 2); S2_GAPB(o[0] = __builtin_amdgcn_mfma_f32_32x32x16_bf16(S2_PAF(2), S2_VFR(2), o[0], 0, 0, 0), C1, 0, 32, MODE); \
    S2_KRD(GL, 3); S2_GAPB(o[1] = __builtin_amdgcn_mfma_f32_32x32x16_bf16(S2_PAF(2), S2_VFR(6), o[1], 0, 0, 0), C1, 4, 32, MODE); \
    S2_GAPB(o[0] = __builtin_amdgcn_mfma_f32_32x32x16_bf16(S2_PAF(3), S2_VFR(3), o[0], 0, 0, 0), C1, 8, 32, MODE); \
    S2_GAPB(o[1] = __builtin_amdgcn_mfma_f32_32x32x16_bf16(S2_PAF(3), S2_VFR(7), o[1], 0, 0, 0), C1, 12, 32, MODE); \
    } while (0)
#define S2_ENDW(tt) do { if ((tt) + 3 < nt) { AT_WAIT_BAR(2); } else if ((tt) + 2 < nt) { AT_WAIT_BAR(1); } else { AT_WAIT_BAR(0); } } while (0)
#define S2_CV(C0, C1, t) do { const float ci_ = ci_cur; float ci2_ = ci_cur; asm volatile("" : "+v"(ci2_)); _Pragma("unroll") for (int r = 0; r < 16; ++r) C0[r] = ci_; S2_PIN(C0); \
        _Pragma("unroll") for (int r = 0; r < 16; ++r) C1[r] = ci2_; S2_PIN(C1); } while (0)
#define S2_RUN(C0, C1, P0, P1, t) do { S2_CV(C0, C1, t); const bool gk_ = (t) + 3 < nt; S2_STEP(C0, C1, P0, P1, t, gk_, true, true, 0); ci_cur = br.cinit(1, (t) + 1); S2_ENDW(t); S2_ROT(); br.advance(nt, (t) + 1); } while (0)
    int t = 1;
    if (odd && nt >= 3) { S2_RUN(pA0, pA1, pB0, pB1, 1); t = 2; }
    for (; t + 2 < nt; t += 2) { S2_RUN(pB0, pB1, pA0, pA1, t); S2_RUN(pA0, pA1, pB0, pB1, t + 1); }
    if (nt >= 2) { S2_CV(pB0, pB1, t); S2_STEP(pB0, pB1, pA0, pA1, t, false, false, false, 1); }
    lsum += psum(pB0, pB1); pv_tile_seq(o, vb0 + sl_cur, pB0, pB1);
    AT_WAIT_BAR(0);
#undef klim2
#undef S2_DK
#undef S2_DV
#undef S2_ROT
#undef S2_PKW
#undef S2_PAF
#undef S2_VFR
#undef S2_PIN
#undef S2_GAPA
#undef S2_LIT
#undef S2_E1
#undef S2_GAPB
#undef S2_VRD
#undef S2_KRD
#undef S2_STEP
#undef S2_ENDW
#undef S2_CV
#undef S2_RUN
}
}

__device__ __forceinline__ void p4_attn(Frame& F) {
    using namespace at;
    unsigned char* ws = F.ws; const int wid = F.wave;
    LAS unsigned char* lds = F.lds;
    const unsigned lds0 = (unsigned)(uintptr_t)lds;
    bf16_t* Q = (bf16_t*)(ws + WS_Q); const bf16_t* KV6 = (const bf16_t*)(ws + WS_KV6);
    const bf16_t* KC = (const bf16_t*)(ws + WS_KC); const bf16_t* VC = (const bf16_t*)(ws + WS_VC); const bf16_t* NG = (const bf16_t*)(ws + WS_NG);
    LAS unsigned* selm = (LAS unsigned*)(lds + L_SELM);
    LAS unsigned* uni = (LAS unsigned*)(lds + L_UNION);
    LAS int* ntl = (LAS int*)(lds + L_NTL);
    LAS int* tl = (LAS int*)(lds + L_TL);
    const unsigned kdst = lds0 + L_K + wid * 1024, vdst = lds0 + L_V + wid * 1024;
    float MREF;
    { float gqm = fabsf(F.a->in[I_GQ][F.lane]), gkm = fmaxf(fmaxf(fabsf(F.a->in[I_GKC][F.lane]), fabsf(F.a->in[I_GKS][F.lane])), fabsf(F.a->in[I_GKW][F.lane]));
      gqm = wave_max(gqm); gkm = wave_max(gkm); MREF = __builtin_bit_cast(float, __builtin_amdgcn_readfirstlane(__builtin_bit_cast(int, 64.0f * QSCALE * gqm * gkm * 1.03f))); }
    LAS float* gql = (LAS float*)(lds + L_V + 3 * SLOTB + 4096);
    if (F.tid < 64) gql[F.tid] = F.a->in[I_GQ][F.tid];
    __syncthreads();
    bf16x8 qraw[4]; bf16_t ngr[3];
#define AT_QLOAD(U, LN) do { const int r32_ = (LN) & 31, hi_ = (LN) >> 5, hh_ = r32_ >> 3, qi_ = r32_ & 7; const int s16_ = F.vcu & 15, bg_ = F.vcu >> 4; \
        const int qt_ = ((U) >> 1) * 32 + (((U) & 1) ? 31 - s16_ : s16_); const unsigned tok_ = (unsigned)((bg_ >> 1) * SEQ + qt_ * 64 + 8 * wid + qi_); const int h_ = 4 * (bg_ & 1) + hh_; \
        _Pragma("unroll") for (int d0 = 0; d0 < 4; ++d0) qraw[d0] = *(const bf16x8*)(ws + ((unsigned)WS_Q + (tok_ * 512u + (unsigned)(h_ * 64 + d0 * 16 + hi_ * 8)) * 2u)); \
        const bf16_t* ngp_ = (const bf16_t*)(ws + ((unsigned)WS_NG + (tok_ * 32u + (unsigned)(h_ * 3)) * 2u)); ngr[0] = ngp_[0]; ngr[1] = ngp_[1]; ngr[2] = ngp_[2]; } while (0)
    if (F.G == 256) AT_QLOAD(0, F.lane);
    for (int ui = 0; ui < 8; ++ui) {
        if (F.G != 256) break;
        int lane = F.lane; asm volatile("" : "+v"(lane));
        const int r32 = lane & 31, hi = lane >> 5, hh = r32 >> 3, qi = r32 & 7;
        LAS float* wsf = (LAS float*)(lds + L_WS) + wid * 64;
        LAS float* impw = (LAS float*)(lds + L_IMP) + wid * 2048;
        LAS float* ostg = (LAS float*)(lds + L_OST) + wid * 2048;
        const lcp kp0 = (lcp)lds + L_K + hi * 1024 + r32 * 16;
        const int vb0 = (int)(lds0 + L_V) + ((lane >> 4) & 1) * 32 + (lane & 3) * 8 + (4 * hi + ((lane & 15) >> 2)) * 64;
        const int bg = F.vcu >> 4, s16 = F.vcu & 15;
        const int qt = (ui >> 1) * 32 + ((ui & 1) ? 31 - s16 : s16);
        const int b = bg >> 1, g = bg & 1, q0 = qt * 64, cur = qt;
        const int tq = q0 + 8 * wid + qi, qoff = 8 * wid + qi;
        const int h = 4 * g + hh;
        const float slope2 = __builtin_amdgcn_ldexpf(LOG2E, -(h + 1));
        const size_t tok = (size_t)b * SEQ + tq;
        bf16x8 qr[4];
#pragma unroll
        for (int d0 = 0; d0 < 4; ++d0) qr[d0] = qraw[d0];
        {
            float xq[4][8]; float ss = 0.f;
#pragma unroll
            for (int d0 = 0; d0 < 4; ++d0) { const u32x4 w = __builtin_bit_cast(u32x4, qr[d0]);
#pragma unroll
                for (int k = 0; k < 4; ++k) { xq[d0][2 * k] = bflo(w[k]); xq[d0][2 * k + 1] = bfhi(w[k]); ss += xq[d0][2 * k] * xq[d0][2 * k] + xq[d0][2 * k + 1] * xq[d0][2 * k + 1]; } }
            ss += __shfl_xor(ss, 32);
            const float rs = QSCALE * __builtin_amdgcn_rsqf(ss * (1.f / 64.f) + EPS);
#pragma unroll
            for (int d0 = 0; d0 < 4; ++d0) { const f32x4 ga = *(const LAS f32x4*)(gql + d0 * 16 + hi * 8), gb = *(const LAS f32x4*)(gql + d0 * 16 + hi * 8 + 4);
                u32x4 w; w.x = cvtpk_bf16(xq[d0][0] * rs * ga.x, xq[d0][1] * rs * ga.y); w.y = cvtpk_bf16(xq[d0][2] * rs * ga.z, xq[d0][3] * rs * ga.w);
                w.z = cvtpk_bf16(xq[d0][4] * rs * gb.x, xq[d0][5] * rs * gb.y); w.w = cvtpk_bf16(xq[d0][6] * rs * gb.z, xq[d0][7] * rs * gb.w);
                qr[d0] = __builtin_bit_cast(bf16x8, w); }
        }
        const float g0 = bf2f(ngr[0]);
        LAS float* gst = (LAS float*)(lds + L_V + 3 * SLOTB) + wid * 128 + lane;
        gst[0] = bf2f(ngr[1]); gst[64] = bf2f(ngr[2]);
        f32x16 o[2], p0, p1;
#pragma unroll
        for (int i = 0; i < 4; ++i) { const float zf = (float)(lane >> 6);
            *(LAS f32x4*)(impw + (i * 64 + lane) * 4) = (f32x4){zf, zf, zf, zf}; }
        const int tidu = wid * 64 + lane;
        if (tidu < 4) uni[tidu] = 0u;
        const unsigned kcl = (unsigned)WS_KC + (unsigned)(((b * 2 + g) * 512 + lane) * 64 + wid * 8) * 2u;
        const unsigned vcl = (unsigned)WS_VC + (unsigned)(((b * 2 + g) * 512 + 16 * (wid & 3) + (lane >> 2)) * 64 + (wid >> 2) * 32 + (lane & 3) * 8) * 2u;
        const int ntc = (4 * cur + 3 + 63) >> 6;
        const int nmax = tq >= 31 ? ((tq - 31) >> 4) : -1;
        const int nfull = cur >= 1 ? (4 * cur - 2) : -1;
        float lsum = 0.f;
#define AT_KOFF_C(t) (kcl + (unsigned)(t) * 8192u)
#define AT_VOFF_C(t) (vcl + (unsigned)(t) * 8192u)
        if (ntc > 0) {
            glds16s(ws, AT_KOFF_C(0), kdst); if (ntc > 1) glds16s(ws, AT_KOFF_C(1), kdst + SLOTB);
            for (int t = 0; t < ntc; ++t) {
                if (t + 1 < ntc) { AT_WAIT_BAR(1); } else { AT_WAIT_BAR(0); }
                if (t + 2 < ntc) glds16s(ws, AT_KOFF_C(t + 2), kdst + ((t + 2) % 3) * SLOTB);
                const float cinit = -slope2 * (float)(tq - 31 - 1024 * t) + slope2 * (float)(64 * hi) - MREF;
                const int klim2 = nmax - 64 * t - 4 * hi;
                if (64 * t + 63 <= nfull) qk_tile<16, 0>(p0, p1, kp0 + (t % 3) * SLOTB, qr, cinit, slope2, 0);
                else qk_tile<16, 1>(p0, p1, kp0 + (t % 3) * SLOTB, qr, cinit, slope2, klim2);
                lsum += psum(p0, p1);
            }
            AT_WAIT_BAR(0);
        }
        lsum += __shfl_xor(lsum, 32);
        const float lg2l = lsum > 0.f ? __builtin_amdgcn_logf(lsum) : 0.f;
        o[0] = f32x16{}; o[1] = f32x16{};
        if (ntc > 0) {
            float cin = 0.f;
            glds16s(ws, AT_KOFF_C(0), kdst); glds16s(ws, AT_VOFF_C(0), vdst); if (ntc > 1) { glds16s(ws, AT_KOFF_C(1), kdst + SLOTB); glds16s(ws, AT_VOFF_C(1), vdst + SLOTB); }
            for (int t = 0; t < ntc; ++t) {
                if (t + 1 < ntc) { AT_WAIT_BAR(2); } else { AT_WAIT_BAR(0); }
                if (t + 2 < ntc) { glds16s(ws, AT_KOFF_C(t + 2), kdst + ((t + 2) % 3) * SLOTB); glds16s(ws, AT_VOFF_C(t + 2), vdst + ((t + 2) % 3) * SLOTB); }
                const float cinit = -slope2 * (float)(tq - 31 - 1024 * t) + slope2 * (float)(64 * hi) - MREF - lg2l;
                const int klim2 = nmax - 64 * t - 4 * hi;
                if (64 * t + 63 <= nfull) qk_tile<16, 0>(p0, p1, kp0 + (t % 3) * SLOTB, qr, cinit, slope2, 0);
                else qk_tile<16, 1>(p0, p1, kp0 + (t % 3) * SLOTB, qr, cinit, slope2, klim2);
                float mn[8], cy[8];
#pragma unroll
                for (int a = 0; a < 4; ++a) { mn[a] = 2.f * (p0[4 * a] + p0[4 * a + 1] + p0[4 * a + 2]) + p0[4 * a + 3]; cy[a] = p0[4 * a + 3];
                                              mn[4 + a] = 2.f * (p1[4 * a] + p1[4 * a + 1] + p1[4 * a + 2]) + p1[4 * a + 3]; cy[4 + a] = p1[4 * a + 3]; }
                float rc[8];
#pragma unroll
                for (int a = 0; a < 8; ++a) { const auto rr = __builtin_amdgcn_permlane32_swap(__float_as_uint(cy[a]), __float_as_uint(cy[a]), false, false); rc[a] = __uint_as_float(hi ? rr[0] : rr[1]); }
                if (hi) {
#pragma unroll
                    for (int a = 0; a < 8; ++a) mn[a] += rc[a];
                } else { mn[0] += cin;
#pragma unroll
                    for (int a = 1; a < 8; ++a) mn[a] += rc[a - 1];
                    cin = rc[7]; }
#pragma unroll
                for (int a = 0; a < 8; ++a) { mn[a] += __uint_as_float((unsigned)__builtin_amdgcn_update_dpp(0, (int)__float_as_uint(mn[a]), 0x128, 0xf, 0xf, false));
                    const auto rr = __builtin_amdgcn_permlane16_swap(__float_as_uint(mn[a]), __float_as_uint(mn[a]), false, false); mn[a] = __uint_as_float(rr[0]) + __uint_as_float(rr[1]); }
                if (hh == 0) {
#pragma unroll
                    for (int a = 0; a < 8; ++a) impw[qi * 128 + 16 * t + 2 * a + hi] = mn[a]; }
                pv_tile_seq(o, vb0 + (t % 3) * SLOTB, p0, p1);
            }
            AT_WAIT_BAR(0);
        }
        {
            const int qi8 = lane >> 3, s8 = lane & 7;
            unsigned key[16];
#pragma unroll
            for (int k = 0; k < 16; ++k) { const int j = s8 + 8 * k; const float v = impw[qi8 * 128 + j];
                const bool forced = (j == 0) || (j == cur) || (j == cur - 1);
                key[k] = j > cur ? 0u : ((forced ? 0xFFFFFF80u : (__builtin_bit_cast(unsigned, v) & 0xFFFFFF80u)) | (unsigned)(127 - j)); }
            unsigned bits = 0u;
            if (cur < NSEL) {
#pragma unroll
                for (int k = 0; k < 16; ++k) bits |= ((key[k] | (0u - key[k])) >> 31) << k;
            } else {
                { const int c1 = cur - 1; const unsigned b0 = (s8 == 0) ? 1u : 0u, bc = (s8 == (cur & 7)) ? 1u : 0u, b1 = (s8 == (c1 & 7)) ? 1u : 0u;
                  bits = b0 | (bc << (cur >> 3)) | (b1 << (c1 >> 3)); }
#pragma unroll
                for (int k = 0; k < 16; ++k) { const unsigned keep = ((bits >> k) & 1u) - 1u; key[k] &= keep; }
                for (int rnd = 0; rnd < NSEL - 3; ++rnd) {
                    unsigned m = key[0];
#pragma unroll
                    for (int k = 1; k < 16; ++k) m = m > key[k] ? m : key[k];
                    { unsigned t2 = (unsigned)__builtin_amdgcn_update_dpp(0, (int)m, 0xB1, 0xf, 0xf, false); m = m > t2 ? m : t2;
                      t2 = (unsigned)__builtin_amdgcn_update_dpp(0, (int)m, 0x4E, 0xf, 0xf, false); m = m > t2 ? m : t2;
                      t2 = (unsigned)__builtin_amdgcn_update_dpp(0, (int)m, 0x141, 0xf, 0xf, false); m = m > t2 ? m : t2; }
                    const unsigned jw = 127u - (m & 127u);
                    bits |= (m != 0u && (jw & 7u) == (unsigned)s8) ? (1u << (jw >> 3)) : 0u;
#pragma unroll
                    for (int k = 0; k < 16; ++k) key[k] = (key[k] == m) ? 0u : key[k];
                }
            }
            unsigned w4[4];
#pragma unroll
            for (int q = 0; q < 4; ++q) { unsigned w = 0u;
#pragma unroll
                for (int kk = 0; kk < 4; ++kk) w |= ((bits >> (4 * q + kk)) & 1u) << (s8 + 8 * kk);
                w |= (unsigned)__shfl_xor((int)w, 1); w |= (unsigned)__shfl_xor((int)w, 2); w |= (unsigned)__shfl_xor((int)w, 4); w4[q] = w; }
            if (s8 == 0) {
#pragma unroll
                for (int q = 0; q < 4; ++q) { selm[(8 * wid + qi8) * 4 + q] = w4[q]; __hip_atomic_fetch_or(&uni[q], w4[q], __ATOMIC_RELAXED, __HIP_MEMORY_SCOPE_WORKGROUP); } }
        }
        { if (hi == 0) wsf[r32] = g0; LDS_WAIT(); asm volatile("" ::: "memory");
#pragma unroll
          for (int a = 0; a < 4; ++a) { const f32x4 sc = *(const LAS f32x4*)(wsf + 8 * a + 4 * hi);
#pragma unroll
              for (int k = 0; k < 4; ++k) { const int c = 8 * a + 4 * hi + k; ostg[c * 64 + r32] = o[0][4 * a + k] * sc[k]; ostg[c * 64 + 32 + r32] = o[1][4 * a + k] * sc[k]; } }
          LDS_WAIT(); asm volatile("" ::: "memory"); }
        AT_WAIT_BAR(0);
        if (tidu < 128) { const int j = tidu; const unsigned u0 = uni[0], u1 = uni[1], u2 = uni[2], u3 = uni[3];
            const unsigned wsel = j < 32 ? u0 : j < 64 ? u1 : j < 96 ? u2 : u3;
            if ((wsel >> (j & 31)) & 1u) { int pos = __builtin_popcount(wsel & ((1u << (j & 31)) - 1u));
                if (j >= 32) pos += __builtin_popcount(u0); if (j >= 64) pos += __builtin_popcount(u1); if (j >= 96) pos += __builtin_popcount(u2);
                tl[pos] = j; }
            if (j == 0) ntl[0] = __builtin_popcount(u0) + __builtin_popcount(u1) + __builtin_popcount(u2) + __builtin_popcount(u3); }
        AT_WAIT_BAR(0);
        int lnS = lane; asm volatile("" : "+v"(lnS));
        {
            AT_LOCALS(lnS);
            const int nt = __builtin_amdgcn_readfirstlane(ntl[0]);
            o[0] = f32x16{}; o[1] = f32x16{}; lsum = 0.f;
            { const lcp vp0 = (lcp)lds + L_V + ((lane >> 4) & 1) * 32 + (lane & 3) * 8 + (4 * hi + ((lane & 15) >> 2)) * 64;
              struct BrSel2 { const unsigned char* wsb; const LAS int* tl; unsigned kvo, vvo; const LAS unsigned* sm; float cb0, slope2; int cur; int q0, q1, q2, q3;
                  __device__ __forceinline__ int jat(int i) const { return __builtin_amdgcn_readfirstlane(tl[i]); }
                  __device__ __forceinline__ void start(int nt) { q0 = jat(0); q1 = jat(nt > 1 ? 1 : nt - 1); q2 = jat(nt > 2 ? 2 : nt - 1); q3 = jat(nt > 3 ? 3 : nt - 1); }
                  __device__ __forceinline__ void advance(int nt, int tn) { q0 = q1; q1 = q2; q2 = q3; q3 = jat(tn + 3 < nt ? tn + 3 : nt - 1); }
                  __device__ __forceinline__ int jo(int off) const { return off == 0 ? q0 : off == 1 ? q1 : off == 2 ? q2 : q3; }
                  __device__ __forceinline__ void dk(int off, int, unsigned dst) const { glds16s(wsb, kvo + (unsigned)jo(off) * (64u * 768u * 2u), dst); }
                  __device__ __forceinline__ void dv(int off, int, unsigned dst) const { glds16s(wsb, vvo + (unsigned)jo(off) * (64u * 768u * 2u), dst); }
                  __device__ __forceinline__ float cinit(int off, int) const { const int j = jo(off); const bool mine = (sm[j >> 5] >> (j & 31)) & 1u; return mine ? cb0 + slope2 * (float)(64 * j) : NEGBIG; }
                  __device__ __forceinline__ int mode(int off, int) const { return (jo(off) == cur) ? 1 : 0; } };
              const BrSel2 br2{ws, tl, (unsigned)WS_KV6 + (unsigned)((b * SEQ + lane) * 768 + 256 + g * 64 + wid * 8) * 2u,
                               (unsigned)WS_KV6 + (unsigned)((b * SEQ + 16 * (wid & 3) + (lane >> 2)) * 768 + 384 + g * 64 + (wid >> 2) * 32 + (lane & 3) * 8) * 2u,
                               selm + (8 * wid + qi) * 4, -slope2 * (float)tq + slope2 * (float)(4 * hi) - MREF, slope2, cur, 0, 0, 0, 0};
              stream2(br2, nt, o, lsum, qr, kp0, vp0, kdst, vdst, slope2, lane, wid); }
            lsum += __shfl_xor(lsum, 32);
            if (hi == 0) wsf[r32] = gst[0] * __builtin_amdgcn_rcpf(lsum); LDS_WAIT(); asm volatile("" ::: "memory");
#pragma unroll
            for (int a = 0; a < 4; ++a) { const f32x4 sc = *(const LAS f32x4*)(wsf + 8 * a + 4 * hi);
#pragma unroll
                for (int k = 0; k < 4; ++k) { const int c = 8 * a + 4 * hi + k; ostg[c * 64 + r32] += o[0][4 * a + k] * sc[k]; ostg[c * 64 + 32 + r32] += o[1][4 * a + k] * sc[k]; } }
            LDS_WAIT(); asm volatile("" ::: "memory");
        }
        int lnW = lnS; asm volatile("" : "+v"(lnW));
        {
            AT_LOCALS(lnW);
            const int wi0 = cur >= 8 ? 0 : 8 - cur; const int nt = 9 - wi0;
            const int pbase = q0 - 512 + 64 * wi0;
            o[0] = f32x16{}; o[1] = f32x16{}; lsum = 0.f;
            { const lcp vp0 = (lcp)lds + L_V + ((lane >> 4) & 1) * 32 + (lane & 3) * 8 + (4 * hi + ((lane & 15) >> 2)) * 64;
              struct BrWin2 { const unsigned char* wsb; unsigned kvo, vvo; float cbase, slope2; int wi0;
                  __device__ __forceinline__ void start(int) {}
                  __device__ __forceinline__ void advance(int, int) {}
                  __device__ __forceinline__ void dk(int, int t, unsigned dst) const { glds16s(wsb, kvo + (unsigned)t * (64u * 768u * 2u), dst); }
                  __device__ __forceinline__ void dv(int, int t, unsigned dst) const { glds16s(wsb, vvo + (unsigned)t * (64u * 768u * 2u), dst); }
                  __device__ __forceinline__ float cinit(int, int t) const { return cbase + (float)(64 * t) * slope2; }
                  __device__ __forceinline__ int mode(int, int t) const { const int wi = wi0 + t; return (wi == 8) ? 1 : (wi == 0) ? 2 : 0; } };
              const BrWin2 br2{ws, (unsigned)WS_KV6 + (unsigned)((b * SEQ + pbase + lane) * 768 + 512 + g * 64 + wid * 8) * 2u,
                               (unsigned)WS_KV6 + (unsigned)((b * SEQ + pbase + 16 * (wid & 3) + (lane >> 2)) * 768 + 640 + g * 64 + (wid >> 2) * 32 + (lane & 3) * 8) * 2u,
                               -slope2 * (float)(tq - pbase) + slope2 * (float)(4 * hi) - MREF, slope2, wi0};
              stream2(br2, nt, o, lsum, qr, kp0, vp0, kdst, vdst, slope2, lane, wid); }
            lsum += __shfl_xor(lsum, 32);
            if (hi == 0) wsf[r32] = gst[64] * __builtin_amdgcn_rcpf(lsum); LDS_WAIT(); asm volatile("" ::: "memory");
#pragma unroll
            for (int a = 0; a < 4; ++a) { const f32x4 sc = *(const LAS f32x4*)(wsf + 8 * a + 4 * hi);
#pragma unroll
                for (int k = 0; k < 4; ++k) { const int c = 8 * a + 4 * hi + k; ostg[c * 64 + r32] += o[0][4 * a + k] * sc[k]; ostg[c * 64 + 32 + r32] += o[1][4 * a + k] * sc[k]; } }
            LDS_WAIT(); asm volatile("" ::: "memory");
        }
        int lnO = lnW; asm volatile("" : "+v"(lnO));
        {
          const int lane = lnO;
          AT_QLOAD((ui + 1 < 8 ? ui + 1 : 7), lane);
#pragma unroll
          for (int i = 0; i < 4; ++i) { const int row = i * 8 + (lane >> 3), ch = lane & 7; const f32x4 a = *(const LAS f32x4*)(ostg + row * 64 + ch * 8), c2 = *(const LAS f32x4*)(ostg + row * 64 + ch * 8 + 4);
              u32x4 v; v.x = pk2(a.x, a.y); v.y = pk2(a.z, a.w); v.z = pk2(c2.x, c2.y); v.w = pk2(c2.z, c2.w);
              *(u32x4*)(ws + ((unsigned)WS_OA + (unsigned)((b * SEQ + q0 + 8 * wid + (row & 7)) * 512 + (4 * g + (row >> 3)) * 64 + ch * 8) * 2u)) = v; }
          LDS_WAIT(); asm volatile("" ::: "memory"); }
    }
#undef AT_KOFF_C
#undef AT_VOFF_C
#undef AT_QLOAD
}

__device__ __forceinline__ void p7_route(Frame& F) {
    unsigned char* ws = F.ws; const int lane = F.lane;
    constexpr int WP = 1032;
    LAS bf16_t* WH = (LAS bf16_t*)F.lds; LAS bf16_t* WL = WH + 32 * WP;
    LAS float* G2 = (LAS float*)(F.lds + 2 * 32 * WP * 2);
    LAS int* CNT = (LAS int*)(F.lds + MISC_OFF + 256);
#pragma unroll 1
    for (int jb = 0; jb < 4; ++jb) { float wv[16], gv[16];
#pragma unroll
        for (int j = 0; j < 16; ++j) { const int i = F.tid + 512 * (jb * 16 + j); wv[j] = F.a->in[I_WR][i]; gv[j] = F.a->in[I_GN2][i >> 5]; }
#pragma unroll
        for (int j = 0; j < 16; ++j) { const int i = F.tid + 512 * (jb * 16 + j); const int k = i >> 5, e = i & 31; const float w = wv[j] * gv[j];
            const unsigned h = f2bf(w); const float r = w - __builtin_bit_cast(float, h << 16); WH[e * WP + k] = (bf16_t)h; WL[e * WP + k] = (bf16_t)f2bf(r); } }
    for (int i = F.tid; i < DM; i += 512) G2[i] = F.a->in[I_GN2][i];
    __syncthreads();
    int* TOPE = (int*)(ws + WS_TOPE); float* TOPW = (float*)(ws + WS_TOPW); int* CNTG = (int*)(ws + WS_CNT); float* RSTD = (float*)(ws + WS_RSTD);
    unsigned char* H2 = (unsigned char*)(ws + WS_H2);
    const bf16_t* X1 = (const bf16_t*)(ws + WS_X1B);
    const int r = lane & 15, q = lane >> 4;
    for (int vw = blockIdx.x; vw < 256; vw += F.G) {
        if (F.tid < 32) CNT[F.tid] = 0;
        __syncthreads();
        for (int rnd = 0; rnd < 2; ++rnd) {
            const int tok0 = vw * 256 + rnd * 128 + F.wave * 16;
            const bf16_t* xr = X1 + (size_t)(tok0 + r) * DM + 8 * q; unsigned char* hr = H2 + (size_t)(tok0 + r) * DM + 8 * q;
            f32x4 acc0 = (f32x4){0.f, 0.f, 0.f, 0.f}, acc1 = acc0; float ss = 0.f;
            auto step = [&](const int ks, const u32x4 hw) __attribute__((always_inline)) {
                const f32x4 a = (f32x4){bflo(hw.x), bfhi(hw.x), bflo(hw.y), bfhi(hw.y)}, b = (f32x4){bflo(hw.z), bfhi(hw.z), bflo(hw.w), bfhi(hw.w)};
                ss += (a.x * a.x + a.y * a.y) + (a.z * a.z + a.w * a.w) + (b.x * b.x + b.y * b.y) + (b.z * b.z + b.w * b.w);
                const f32x4 ga = *(const LAS f32x4*)(G2 + 32 * ks + 8 * q), gb = *(const LAS f32x4*)(G2 + 32 * ks + 8 * q + 4);
                u32x2 o8; o8.x = pg8::pk4_fp8(a.x * ga.x, a.y * ga.y, a.z * ga.z, a.w * ga.w); o8.y = pg8::pk4_fp8(b.x * gb.x, b.y * gb.y, b.z * gb.z, b.w * gb.w);
                *(u32x2*)(hr + 32 * ks) = o8;
                const bf16x8 xh = __builtin_bit_cast(bf16x8, hw);
                const bf16x8 w0h = *(const LAS bf16x8*)(WH + r * WP + 32 * ks + 8 * q), w0l = *(const LAS bf16x8*)(WL + r * WP + 32 * ks + 8 * q);
                const bf16x8 w1h = *(const LAS bf16x8*)(WH + (16 + r) * WP + 32 * ks + 8 * q), w1l = *(const LAS bf16x8*)(WL + (16 + r) * WP + 32 * ks + 8 * q);
                acc0 = __builtin_amdgcn_mfma_f32_16x16x32_bf16(xh, w0h, acc0, 0, 0, 0); acc0 = __builtin_amdgcn_mfma_f32_16x16x32_bf16(xh, w0l, acc0, 0, 0, 0);
                acc1 = __builtin_amdgcn_mfma_f32_16x16x32_bf16(xh, w1h, acc1, 0, 0, 0); acc1 = __builtin_amdgcn_mfma_f32_16x16x32_bf16(xh, w1l, acc1, 0, 0, 0);
            };
            u32x4 bufA[8], bufB[8];
#define P7_LOAD(buf, k0) _Pragma("unroll") for (int j = 0; j < 8; ++j) buf[j] = *(const u32x4*)(xr + 32 * ((k0) + j))
#define P7_RUN(buf, k0) _Pragma("unroll") for (int j = 0; j < 8; ++j) step((k0) + j, buf[j])
            P7_LOAD(bufA, 0); P7_LOAD(bufB, 8); P7_RUN(bufA, 0); P7_LOAD(bufA, 16); P7_RUN(bufB, 8); P7_LOAD(bufB, 24); P7_RUN(bufA, 16); P7_RUN(bufB, 24);
#undef P7_LOAD
#undef P7_RUN
            ss += __shfl_xor(ss, 16); ss += __shfl_xor(ss, 32);
            const float rs = 1.0f / sqrtf(ss * (1.f / DM) + EPS);
            const float b0 = F.a->in[I_BR][r], b1 = F.a->in[I_BR][16 + r];
#pragma unroll
            for (int i = 0; i < 4; ++i) {
                const int rowi = 4 * q + i; const float rsi = __shfl(rs, rowi);
                const float l0 = acc0[i] * rsi + b0, l1 = acc1[i] * rsi + b1;
                unsigned u0 = __builtin_bit_cast(unsigned, l0), u1 = __builtin_bit_cast(unsigned, l1);
                u0 ^= (u0 >> 31) ? 0xFFFFFFFFu : 0x80000000u; u1 ^= (u1 >> 31) ? 0xFFFFFFFFu : 0x80000000u;
                unsigned k0 = (u0 & ~31u) | (unsigned)(31 - r), k1 = (u1 & ~31u) | (unsigned)(15 - r);
                float tv[4]; int te[4];
#pragma unroll
                for (int rr = 0; rr < 4; ++rr) { unsigned m = k0 > k1 ? k0 : k1;
                    { unsigned t2 = (unsigned)__builtin_amdgcn_update_dpp(0, (int)m, 0xB1, 0xf, 0xf, false); m = m > t2 ? m : t2; t2 = (unsigned)__builtin_amdgcn_update_dpp(0, (int)m, 0x4E, 0xf, 0xf, false); m = m > t2 ? m : t2;
                      t2 = (unsigned)__builtin_amdgcn_update_dpp(0, (int)m, 0x141, 0xf, 0xf, false); m = m > t2 ? m : t2; t2 = (unsigned)__builtin_amdgcn_update_dpp(0, (int)m, 0x140, 0xf, 0xf, false); m = m > t2 ? m : t2; }
                    te[rr] = 31 - (int)(m & 31u); const unsigned ub = m & ~31u; const unsigned fb = (ub & 0x80000000u) ? (ub ^ 0x80000000u) : ~ub; tv[rr] = __builtin_bit_cast(float, fb);
                    k0 = (k0 == m) ? 0u : k0; k1 = (k1 == m) ? 0u : k1; }
                if (r == 0) { const int tok = tok0 + rowi;
                    const float e1 = __expf(tv[1] - tv[0]), e2 = __expf(tv[2] - tv[0]), e3 = __expf(tv[3] - tv[0]); const float inv = 1.0f / (1.0f + e1 + e2 + e3);
                    *(int4*)(TOPE + (size_t)tok * 4) = make_int4(te[0], te[1], te[2], te[3]); *(float4*)(TOPW + (size_t)tok * 4) = make_float4(inv, e1 * inv, e2 * inv, e3 * inv);
                    RSTD[tok] = rsi;
                    __hip_atomic_fetch_add(&CNT[te[0]], 1, __ATOMIC_RELAXED, __HIP_MEMORY_SCOPE_WORKGROUP); __hip_atomic_fetch_add(&CNT[te[1]], 1, __ATOMIC_RELAXED, __HIP_MEMORY_SCOPE_WORKGROUP);
                    __hip_atomic_fetch_add(&CNT[te[2]], 1, __ATOMIC_RELAXED, __HIP_MEMORY_SCOPE_WORKGROUP); __hip_atomic_fetch_add(&CNT[te[3]], 1, __ATOMIC_RELAXED, __HIP_MEMORY_SCOPE_WORKGROUP); }
            }
        }
        __syncthreads();
        if (F.tid < 32) CNTG[vw * 32 + F.tid] = CNT[F.tid];
        __syncthreads();
    }
}

__device__ __forceinline__ void p8_scatter(Frame& F) {
    unsigned char* ws = F.ws; const int lane = F.lane;
    LAS int* CN = (LAS int*)F.lds;
    LAS int* PT = (LAS int*)(F.lds + 32768);
    LAS int* PP = PT + 512;
    LAS int* WC = PP + 512;
    LAS int* BASE = WC + 512;
    LAS int* TOT = BASE + 32;
    LAS int* TS = TOT + 32;
    const int* CNTG = (const int*)(ws + WS_CNT); const int* TOPE = (const int*)(ws + WS_TOPE); const float* TOPW = (const float*)(ws + WS_TOPW);
    int* INV = (int*)(ws + WS_INV);
    for (int vw = blockIdx.x; vw < 256; vw += F.G) {
        const int ch = vw / WPC, wl = vw % WPC;
        unsigned* ROWTOK = (unsigned*)(ws + WS_ROWTOK) + (size_t)ch * SLOTS_CH; float* ROWW = (float*)(ws + WS_ROWW) + (size_t)ch * SLOTS_CH; float* ROWRS = (float*)(ws + WS_ROWRS) + (size_t)ch * SLOTS_CH;
        for (int i = F.tid; i < WPC * 32; i += 512) CN[i] = CNTG[ch * WPC * 32 + i];
        const int e0 = TOPE[(size_t)vw * 1024 + F.tid], e1 = TOPE[(size_t)vw * 1024 + 512 + F.tid];
        __syncthreads();
        { const int e = F.tid & 31, part = F.tid >> 5; int tot = 0, pre = 0;
          for (int w = part * (WPC / 16); w < (part + 1) * (WPC / 16); ++w) { const int c = CN[w * 32 + e]; tot += c; pre += (w < wl) ? c : 0; }
          PT[part * 32 + e] = tot; PP[part * 32 + e] = pre; }
        int rk0 = 0, rk1 = 0;
        { const unsigned long long lt = (1ull << lane) - 1ull;
          for (int e = 0; e < 32; ++e) { const unsigned long long m0 = __ballot(e0 == e), m1 = __ballot(e1 == e);
              if (e0 == e) rk0 = __builtin_popcountll(m0 & lt); if (e1 == e) rk1 = __builtin_popcountll(m1 & lt);
              if (lane == 0) { WC[F.wave * 32 + e] = __builtin_popcountll(m0); WC[(8 + F.wave) * 32 + e] = __builtin_popcountll(m1); } } }
        __syncthreads();
        if (F.tid < 32) { int tot = 0, pre = 0; for (int p = 0; p < 16; ++p) { tot += PT[p * 32 + F.tid]; pre += PP[p * 32 + F.tid]; } TOT[F.tid] = tot; BASE[F.tid] = pre;
            int run = 0; for (int sgi = 0; sgi < 16; ++sgi) { const int c = WC[sgi * 32 + F.tid]; WC[sgi * 32 + F.tid] = run; run += c; } }
        __syncthreads();
        if (F.tid == 0) { int ts = 0; for (int e = 0; e < 32; ++e) { TS[e] = ts; ts += (TOT[e] + 255) >> 8; } TS[32] = ts; }
        __syncthreads();
        { const int s0 = TS[e0] * 256 + BASE[e0] + WC[F.wave * 32 + e0] + rk0, s1 = TS[e1] * 256 + BASE[e1] + WC[(8 + F.wave) * 32 + e1] + rk1;
          const int i0 = F.tid, i1 = 512 + F.tid; const int t0 = vw * 256 + (i0 >> 2), t1 = vw * 256 + (i1 >> 2);
          const float* RS = (const float*)(ws + WS_RSTD);
          ROWTOK[s0] = (unsigned)t0; ROWW[s0] = TOPW[(size_t)vw * 1024 + i0]; ROWRS[s0] = RS[t0]; INV[(size_t)vw * 1024 + i0] = s0;
          ROWTOK[s1] = (unsigned)t1; ROWW[s1] = TOPW[(size_t)vw * 1024 + i1]; ROWRS[s1] = RS[t1]; INV[(size_t)vw * 1024 + i1] = s1; }
        if (wl < 32) { const int e = wl; const int lo = TS[e] * 256 + TOT[e], hi = TS[e + 1] * 256; for (int sl = lo + F.tid; sl < hi; sl += 512) { ROWTOK[sl] = (unsigned)(ch * TCH); ROWW[sl] = 0.f; ROWRS[sl] = 0.f; } }
        if (wl == 0 && F.tid < 33) ((int*)(ws + WS_TSTART))[ch * 64 + F.tid] = TS[F.tid];
        __syncthreads();
    }
}

__device__ __forceinline__ void p_combine(Frame& F, int ch) {
    unsigned char* ws = F.ws; const int lane = F.lane;
    const unsigned char* Y = (const unsigned char*)(ws + WS_YBUF); const int* INV = (const int*)(ws + WS_INV); const bf16_t* X1 = (const bf16_t*)(ws + WS_X1B);
    const int gw = F.vcu * 8 + F.wave, NGW = F.G * 8;
    for (int i = gw; i < TCH / 2; i += NGW) {
        const int tok = ch * TCH + 2 * i; const int4 sa = *(const int4*)(INV + (size_t)tok * 4), sb = *(const int4*)(INV + (size_t)tok * 4 + 4);
        float* o = F.out + (size_t)tok * DM + lane * 16; const bf16_t* xp = X1 + (size_t)tok * DM + lane * 16;
        u32x4 y[2][4]; u32x4 xb[2][2];
#pragma unroll
        for (int tt = 0; tt < 2; ++tt) { const int4 sl = tt ? sb : sa; const int ss[4] = {sl.x, sl.y, sl.z, sl.w};
#pragma unroll
            for (int k = 0; k < 4; ++k) y[tt][k] = *(const u32x4*)(Y + (size_t)ss[k] * 1024 + lane * 16);
            xb[tt][0] = *(const u32x4*)(xp + tt * DM); xb[tt][1] = *(const u32x4*)(xp + tt * DM + 8); }
#pragma unroll
        for (int tt = 0; tt < 2; ++tt)
#pragma unroll
            for (int q = 0; q < 4; ++q) { f32x4 sacc = (f32x4){0.f, 0.f, 0.f, 0.f};
#pragma unroll
                for (int k = 0; k < 4; ++k) { const f32x2 lo = __builtin_amdgcn_cvt_pk_f32_fp8((int)y[tt][k][q], false), hi = __builtin_amdgcn_cvt_pk_f32_fp8((int)y[tt][k][q], true); sacc += (f32x4){lo.x, lo.y, hi.x, hi.y}; }
                const unsigned w0 = xb[tt][q >> 1][(q & 1) * 2], w1 = xb[tt][q >> 1][(q & 1) * 2 + 1];
                const f32x4 xv = (f32x4){bflo(w0), bfhi(w0), bflo(w1), bfhi(w1)};
                *(f32x4*)(o + tt * DM + 4 * q) = xv + sacc * pg8::YINV; }
    }
}

__device__ __forceinline__ void stagger(int cid, int us) {
    const int k = (cid >> 3) & 3; if (k == 0 || us == 0) return;
    const unsigned long long t0 = __builtin_amdgcn_s_memrealtime(), dt = (unsigned long long)(k * us) * 100ull;
    while (__builtin_amdgcn_s_memrealtime() - t0 < dt) __builtin_amdgcn_s_sleep(32);
}

__global__ void __launch_bounds__(512, 2) mk_fwd(Args args) {
    extern __shared__ __attribute__((aligned(16))) unsigned char lds_raw[];
    Frame F;
    F.lds = (LAS unsigned char*)lds_raw;
    F.tid = threadIdx.x; F.lane = F.tid & 63; F.wave = __builtin_amdgcn_readfirstlane(F.tid >> 6);
    F.G = gridDim.x; { const int bx = blockIdx.x; F.vcu = (F.G % 8 == 0) ? (bx % 8) * (F.G / 8) + bx / 8 : bx; }
    F.ws = args.ws; F.out = args.out; F.a = &args;
    unsigned char* ws = args.ws;
    volatile LAS unsigned* MISC = (volatile LAS unsigned*)(F.lds + MISC_OFF);
    for (int u = F.tid; u < 256; u += 512) MISC[u] = 0u;
    __syncthreads();
    XcdBarrier bar; bar.bar = (unsigned*)(ws + WS_CTL) + 1024; bar.x = 0; bar.st = nullptr;
    const int lo = args.ph_lo, hi = args.ph_hi;
    if (hi - lo > 1) bar = xcd_barrier_post((unsigned*)(ws + WS_CTL) + 1024, MISC + 8);
#define IN(k) (lo <= (k) && (k) < hi)
#ifndef REP1
#define REP1 1
#endif
#ifndef STAG1
#define STAG1 0
#endif
#ifndef REP4
#define REP4 1
#endif
#ifndef REP0
#define REP0 1
#endif
#ifndef REP7
#define REP7 1
#endif
#ifndef REP9
#define REP9 1
#endif
#ifndef REP10
#define REP10 1
#endif
#define SEAM(k) do { if (IN(k) && IN((k) + 1)) xcd_barrier(bar); } while (0)
    LAS unsigned char* ring = F.lds;
    const int cid = (int)blockIdx.x;

    if (IN(0)) { p0_prologue(F); if (REP0 > 1) p0_prologue(F); } SEAM(0);

    if (IN(1)) {
        { pg8::OrdPlain S{(const char*)(ws + WS_H1), (const char*)(ws + WS_WIN_T), T / 256, NPROJ / 256, F.G, cid, (size_t)256 * DM * 2, (size_t)256 * DM * 2};
          pg8::EpiIn E{(bf16_t*)(ws + WS_Q), (bf16_t*)(ws + WS_KV6), (bf16_t*)(ws + WS_CONV3), (bf16_t*)(ws + WS_MG), (bf16_t*)(ws + WS_NG)};
          pg8::gemm_phase<pg8::EpiIn, pg8::OrdPlain, false>(ring, DM, DM * 2, 128, S, E, nullptr); }
        { LAS unsigned short* gtab = (LAS unsigned short*)(F.lds + GTAB_OFF);
          for (int i = F.tid; i < GTAB_UNITS * 256; i += 512) gtab[i] = (unsigned short)(i & 255);
          __syncthreads();
          pg8::OrdPlain S{(const char*)(ws + WS_H1F8), (const char*)(ws + WS_WMG8), T / 256, 2048 / 256, F.G, cid, (size_t)256 * DM, (size_t)256 * DM};
          pg8::EpiMG8 E{(bf16_t*)(ws + WS_MG)};
          pg8::gemm_phase<pg8::EpiMG8, pg8::OrdPlain, true, true>(ring, DM / 2, DM, 128, S, E, gtab); }
    } SEAM(1);

    if (IN(2)) {
        pg8::OrdCmp S{(const char*)(ws + WS_KV6), (const char*)(ws + WS_CKW1_T), (const char*)(ws + WS_CVW1_T), F.G, cid};
        pg8::EpiCmp E{(bf16_t*)(ws + WS_HID), (const float*)(ws + WS_B1P)};
        pg8::gemm_phase<pg8::EpiCmp, pg8::OrdCmp, false>(ring, 2048, 16 * 768 * 2, 768 * 2, S, E, nullptr);
        p2_queue(F);
    }
    SEAM(2);
    if (IN(3)) { p3_compress2(F); } SEAM(3);

    #ifdef ATTN_NAIVE
    if (IN(4)) { p4_attn_naive(F); } SEAM(4);
#else
    if (IN(4)) { p4_attn(F); if (REP4 > 1) p4_attn(F); } SEAM(4);
    F.tid = threadIdx.x; asm volatile("" : "+v"(F.tid)); F.lane = F.tid & 63;
#endif

    if (IN(5)) {
        pg8::OrdPlain2 S{(const char*)(ws + WS_OA), (const char*)(ws + WS_YB), (const char*)(ws + WS_WPA_T), T / 256, DM / 256, F.G, cid, (size_t)256 * AW * 2, (size_t)256 * DM * 2};
        pg8::EpiGateM E{(bf16_t*)(ws + WS_Z), (const bf16_t*)(ws + WS_MG)};
        pg8::gemm_phase<pg8::EpiGateM, pg8::OrdPlain2, false, false, 8>(ring, DM, AW * 2, 128, S, E, nullptr);
    } SEAM(5);

    if (IN(6)) {
        pg8::OrdPlain S{(const char*)(ws + WS_Z), (const char*)(ws + WS_WO_T), T / 256, DM / 256, F.G, cid, (size_t)256 * DM * 2, (size_t)256 * DM * 2};
        pg8::EpiRes E{F.a->in[I_X], (bf16_t*)(ws + WS_X1B)};
        pg8::gemm_phase<pg8::EpiRes, pg8::OrdPlain, false>(ring, DM, DM * 2, 128, S, E, nullptr);
    } SEAM(6);

    if (IN(7)) { p7_route(F); if (REP7 > 1) p7_route(F); } SEAM(7);
    if (IN(8)) { p8_scatter(F); } SEAM(8);

#pragma unroll
    for (int ch = 0; ch < NCH; ++ch) {
        const int pgu = 9 + 2 * ch, pdn = 10 + 2 * ch;
        if (IN(pgu)) {
            LAS int* TS = (LAS int*)(F.lds + MISC_OFF + 512);
            if (F.tid < 33) TS[F.tid] = ((const int*)(ws + WS_TSTART))[ch * 64 + F.tid];
            __syncthreads();
            const int ntile = TS[32];
            pg8::OrdGrp S{(const char*)(ws + WS_H2), (const char*)(ws + WS_WGU_T), TS, ntile, 8, F.G, cid, (size_t)0, (size_t)256 * DM, (size_t)2048 * DM};
            LAS unsigned short* gtab = (LAS unsigned short*)(F.lds + GTAB_OFF);
            { const unsigned* ROWTOK = (const unsigned*)(ws + WS_ROWTOK) + (size_t)ch * SLOTS_CH;
#pragma unroll 1
              for (int i0 = 0; i0 < GTAB_UNITS; i0 += 8) { unsigned tv[8]; bool ok[8];
#pragma unroll
                  for (int j = 0; j < 8; ++j) { int pm, pn; ok[j] = pg8::tile_map((long)(i0 + j) * F.G + cid, ntile, 8, pm, pn); tv[j] = ROWTOK[(ok[j] ? pm : 0) * 256 + (F.tid & 255)]; }
#pragma unroll
                  for (int j = 0; j < 8; ++j) if (ok[j] && F.tid < 256) gtab[(i0 + j) * 256 + F.tid] = (unsigned short)tv[j];
                  if (!ok[7]) break; } }
            __syncthreads();
            pg8::EpiGU E{(unsigned char*)(ws + WS_ACT), F.a->in[I_BGU], (const float*)(ws + WS_ROWRS) + (size_t)ch * SLOTS_CH, (const LAS float*)(F.lds + EPI_OFF)};
            pg8::gemm_phase<pg8::EpiGU, pg8::OrdGrp, true, true>(ring, DM / 2, 0, 128, S, E, gtab); if (REP9 > 1) pg8::gemm_phase<pg8::EpiGU, pg8::OrdGrp, true, true>(ring, DM / 2, 0, 128, S, E, gtab);
            if (ch > 0) p_combine(F, ch - 1);
        } SEAM(pgu);
        if (IN(pdn)) {
            LAS int* TS = (LAS int*)(F.lds + MISC_OFF + 512);
            if (F.tid < 33) TS[F.tid] = ((const int*)(ws + WS_TSTART))[ch * 64 + F.tid];
            __syncthreads();
            const int ntile = TS[32];
            pg8::OrdGrp S{(const char*)(ws + WS_ACT), (const char*)(ws + WS_WDN_T), TS, ntile, 4, F.G, cid, (size_t)256 * DFF, (size_t)256 * DFF, (size_t)DM * DFF};
            pg8::EpiDN E{(unsigned char*)(ws + WS_YBUF), F.a->in[I_BDN], (const float*)(ws + WS_ROWW) + (size_t)ch * SLOTS_CH, (const LAS float*)(F.lds + EPI_OFF)};
            LAS unsigned short* gtab = (LAS unsigned short*)(F.lds + GTAB_OFF);
            for (int i = F.tid; i < GTAB_UNITS * 256; i += 512) gtab[i] = (unsigned short)(i & 255);
            __syncthreads();
            pg8::gemm_phase<pg8::EpiDN, pg8::OrdGrp, true, true>(ring, DFF / 2, DFF, 128, S, E, gtab); if (REP10 > 1) pg8::gemm_phase<pg8::EpiDN, pg8::OrdGrp, true, true>(ring, DFF / 2, DFF, 128, S, E, gtab);
        } SEAM(pdn);
    }
    if (IN(NPH - 1)) { p_combine(F, NCH - 1); }
#undef IN
#undef SEAM
}

extern "C" void kernel_launch(void* const* d_in, const int* in_sizes, int n_in, void* d_out, int out_size, void* d_ws, size_t ws_size, hipStream_t stream) {
    static int grid = 0;
    if (grid == 0) {
        if (n_in != 28 || out_size != T * DM || ws_size < WS_END) { fprintf(stderr, "kernel_launch: unexpected shapes (n_in %d, out %d, ws %zu)\n", n_in, out_size, ws_size); grid = -1; return; }
        int dev = 0, cus = 0;
        if (hipGetDevice(&dev) != hipSuccess || hipDeviceGetAttribute(&cus, hipDeviceAttributeMultiprocessorCount, dev) != hipSuccess) { grid = -1; return; }
        if (hipFuncSetAttribute((const void*)mk_fwd, hipFuncAttributeMaxDynamicSharedMemorySize, LDS_BYTES) != hipSuccess) { fprintf(stderr, "kernel_launch: hipFuncSetAttribute failed\n"); grid = -1; return; }
        int per_cu = 0;
        if (hipOccupancyMaxActiveBlocksPerMultiprocessor(&per_cu, (const void*)mk_fwd, 512, LDS_BYTES) != hipSuccess || per_cu < 1) fprintf(stderr, "kernel_launch: occupancy query says %d\n", per_cu);
        (void)hipGetLastError();
        grid = cus;
    }
    if (grid < 0) return;
    (void)hipMemsetAsync((char*)d_ws + WS_CTL, 0, CTL_ZERO_BYTES, stream);
    Args a{};
    for (int i = 0; i < 28; ++i) a.in[i] = (const float*)d_in[i];
    a.out = (float*)d_out; a.ws = (unsigned char*)d_ws;
#if MK_N_LAUNCHES == 1
    a.ph_lo = 0; a.ph_hi = NPH;
    hipLaunchKernelGGL(mk_fwd, dim3(grid), dim3(512), LDS_BYTES, stream, a);
#else
    for (int p = 0; p < NPH; ++p) { a.ph_lo = p; a.ph_hi = p + 1; hipLaunchKernelGGL(mk_fwd, dim3(grid), dim3(512), LDS_BYTES, stream, a); }
#endif
}
```

```cpp
#include <hip/hip_runtime.h>
#include <cstdio>
#include <cstdint>

#define LAS __attribute__((address_space(3)))
#define GAS __attribute__((address_space(1)))
typedef unsigned short bf16_t;
typedef short bf16x8 __attribute__((ext_vector_type(8)));
typedef float f32x4 __attribute__((ext_vector_type(4)));
typedef float f32x2 __attribute__((ext_vector_type(2)));
typedef unsigned u32x4 __attribute__((ext_vector_type(4)));
typedef unsigned u32x2 __attribute__((ext_vector_type(2)));

#ifndef MK_N_LAUNCHES
#define MK_N_LAUNCHES 1
#endif

constexpr int BATCH = 8, SEQ = 8192, DM = 1024, T = BATCH * SEQ;
constexpr int NH = 8, HD = 64, NGRP = 2, AW = 512;
constexpr int CMP_HID = 256, NBLK = 128, NSEL = 16, WIN = 512;
constexpr int CONVW = 512, NEXP = 32, DFF = 1024;
constexpr int NPROJ = 3072;
constexpr int IN_COLS = 4888;
constexpr float EPS = 1e-6f, LOG2E = 1.4426950408889634f;
constexpr float QSCALE = 0.125f * LOG2E;
constexpr int NCH = 1;
constexpr int TCH = T / NCH;
constexpr int SLOTS_CH = TCH * 4 + NEXP * 256;
constexpr int WPC = 256 / NCH;
constexpr int NPH = 10 + 2 * NCH;

constexpr size_t MiB = 1u << 20;
constexpr size_t WS_CTL = 0, CTL_ZERO_BYTES = 64 * 1024;
constexpr size_t WS_B1P = 1 * MiB;
constexpr size_t WS_TSTART = 1 * MiB + 4096;
constexpr size_t WS_CNT = 1 * MiB + 8192;
constexpr size_t WS_QCTR = 1 * MiB + 65536;
constexpr size_t WS_WIN_T = 8 * MiB, WS_WPA_T = 18 * MiB, WS_WPB_T = 19 * MiB, WS_WO_T = 20 * MiB, WS_CKW1_T = 22 * MiB, WS_CVW1_T = 23 * MiB;
constexpr size_t WS_WGU_T = 24 * MiB, WS_WDN_T = 88 * MiB;
constexpr size_t WS_H1 = 120 * MiB, WS_YB = 120 * MiB, WS_OA = 184 * MiB, WS_Q = 248 * MiB, WS_KV6 = 312 * MiB, WS_CONV3 = 408 * MiB, WS_MG = 600 * MiB;
constexpr size_t WS_X1B = 712 * MiB;
constexpr size_t WS_H1F8 = 870 * MiB, WS_WMG8 = 934 * MiB;
constexpr size_t WS_NG = 856 * MiB, WS_HID = 860 * MiB, WS_KC = 868 * MiB, WS_VC = 869 * MiB, WS_Z = 312 * MiB;
constexpr size_t WS_H2 = 120 * MiB, WS_ACT = 184 * MiB, WS_YBUF = 448 * MiB, WS_TOPE = 976 * MiB, WS_TOPW = 977 * MiB, WS_INV = 978 * MiB, WS_ROWTOK = 979 * MiB, WS_ROWW = 981 * MiB, WS_ROWRS = 983 * MiB, WS_RSTD = 985 * MiB;
constexpr size_t WS_END = 986 * MiB;
static_assert((size_t)NCH * SLOTS_CH * 4 <= 2 * MiB && (size_t)T * 4 <= 1 * MiB, "routing tables");
static_assert((size_t)SLOTS_CH * 1024 <= 264 * MiB && (size_t)SLOTS_CH * 2048 <= 528 * MiB, "act / y chunk");
static_assert((size_t)NCH * SLOTS_CH * 4 <= 2 * MiB, "rowtok");

constexpr int RING_BYTES = 131072;
constexpr int GTAB_OFF = RING_BYTES, GTAB_UNITS = 40, GTAB_BYTES = GTAB_UNITS * 512;
constexpr int MISC_OFF = GTAB_OFF + GTAB_BYTES;
constexpr int EPI_OFF = MISC_OFF + 1024;
constexpr int LDS_BYTES = EPI_OFF + 2048;
static_assert(LDS_BYTES <= 160 * 1024, "LDS");

__device__ __forceinline__ unsigned f2bf(float f) { unsigned u = __builtin_bit_cast(unsigned, f); return (u + 0x7fffu + ((u >> 16) & 1u)) >> 16; }
__device__ __forceinline__ unsigned pk2(float lo, float hi) { return f2bf(lo) | (f2bf(hi) << 16); }
typedef __bf16 bf16x2_t __attribute__((ext_vector_type(2)));
__device__ __forceinline__ unsigned cvtpk_bf16(float lo, float hi) { f32x2 v = {lo, hi}; bf16x2_t b = __builtin_convertvector(v, bf16x2_t); return __builtin_bit_cast(unsigned, b); }
__device__ __forceinline__ float bflo(unsigned w) { return __builtin_bit_cast(float, w << 16); }
__device__ __forceinline__ float bfhi(unsigned w) { return __builtin_bit_cast(float, w & 0xffff0000u); }
__device__ __forceinline__ float bf2f(bf16_t h) { return __builtin_bit_cast(float, (unsigned)h << 16); }
__device__ __forceinline__ float wave_sum(float v) {
#pragma unroll
    for (int o = 1; o < 64; o <<= 1) v += __shfl_xor(v, o);
    return v;
}
__device__ __forceinline__ float wave_max(float v) {
#pragma unroll
    for (int o = 1; o < 64; o <<= 1) v = fmaxf(v, __shfl_xor(v, o));
    return v;
}
__device__ __forceinline__ float sigmoidf_(float x) { return __builtin_amdgcn_rcpf(1.0f + __builtin_amdgcn_exp2f(-1.4426950408889634f * x)); }
__device__ __forceinline__ f32x2 pk_mul2(f32x2 a, f32x2 b) { f32x2 r = a * b; asm("" : "+v"(r)); return r; }
__device__ __forceinline__ f32x2 pk_add2(f32x2 a, f32x2 b) { f32x2 r = a + b; asm("" : "+v"(r)); return r; }
#define LDS_WAIT() asm volatile("s_waitcnt lgkmcnt(0)" ::: "memory")
#define VM_WAIT() asm volatile("s_waitcnt vmcnt(0)" ::: "memory")

namespace pg8 {
constexpr int BM = 256, BK = 64, HALF = 128, HTB = HALF * BK * 2, STAGE_BYTES = 8 * HTB, NXCD = 8, WGM = 8;
__host__ __device__ __forceinline__ int lds_byte(int r, int c) { const int st = (r >> 4) * 2 + (c >> 5), rr = r & 15, cc = c & 31, ob = rr * 64 + cc * 2; return st * 1024 + (ob ^ (((ob >> 9) & 1) << 5)); }
__host__ __device__ __forceinline__ void stage_rc(int b, int& R, int& C) { const int st = b / 1024, sb = b % 1024, swz = sb ^ (((sb >> 9) & 1) << 5); R = (st >> 1) * 16 + swz / 64; C = (st & 1) * 32 + (swz % 64) / 2; }
__host__ __device__ __forceinline__ int perm32(int rho) { const int n = rho >> 4, i = rho & 15; return 8 * (i >> 2) + 4 * n + (i & 3); }

struct Unit { const char* a; const char* b; int pm, pn, e; const char* a2; };

__device__ __forceinline__ bool tile_map(long L, int nM, int nN, int& pm, int& pn) {
    const int nwg = nM * nN; if (L >= nwg) return false;
    int wgid = (int)L; { const int q = nwg / NXCD, r = nwg % NXCD, xcd = wgid % NXCD, off = wgid / NXCD; wgid = (xcd < r ? xcd * (q + 1) : r * (q + 1) + (xcd - r) * q) + off; }
    const int nig = WGM * nN, gid = wgid / nig, fm = gid * WGM, gsz = (nM - fm) < WGM ? (nM - fm) : WGM;
    pm = fm + ((wgid % nig) % gsz); pn = (wgid % nig) / gsz; return true;
}

constexpr float W8INV_ = 1.0f / 32.0f;
typedef int v8i_t __attribute__((ext_vector_type(8)));
typedef int v4i_t __attribute__((ext_vector_type(4)));
__device__ __forceinline__ v8i_t cat8(bf16x8 a, bf16x8 b) { return __builtin_shufflevector(__builtin_bit_cast(v4i_t, a), __builtin_bit_cast(v4i_t, b), 0, 1, 2, 3, 4, 5, 6, 7); }
__device__ __forceinline__ unsigned cvt_pk_bf16(float lo, float hi) { return cvtpk_bf16(lo, hi); }

template <class Epi, class Sched, bool GATHER, bool F8 = false, int KSPLIT = 0>
__device__ __forceinline__ void gemm_phase(LAS unsigned char* lds, const int K, const unsigned a_pitch, const unsigned a_kstep, const Sched& S, const Epi& E, const LAS unsigned short* gtab) {
    const int tid = threadIdx.x, wid = __builtin_amdgcn_readfirstlane(tid >> 6), lane = tid & 63, wr = wid >> 2, wc = wid & 3, fr = lane & 15, fq = lane >> 4;
    const int nt = K / BK;
    unsigned voffA[2][2], voffB[2];
#pragma unroll
    for (int i = 0; i < 2; ++i) { int R, C; stage_rc(tid * 16 + i * 8192, R, C); const int Rb = Epi::PERM ? ((R & ~31) + perm32(R & 31)) : R;
        voffB[i] = (unsigned)(Rb * K + C) * 2u; voffA[0][i] = (unsigned)R * a_pitch + (unsigned)C * 2u; voffA[1][i] = voffA[0][i]; }
    const size_t kstepA = a_kstep, kstepB = (size_t)(BK * 2);
    const size_t hstepA = GATHER ? (size_t)0 : (size_t)HALF * a_pitch, hstepB = (size_t)HALF * K * 2;
    const unsigned ldsw = (unsigned)wid * 1024u;
    const unsigned ldsbase = (unsigned)(uintptr_t)lds;
    const int aoff = lds_byte(wr * 64 + fr, fq * 8), boff = lds_byte(wc * 32 + fr, fq * 8);
#define PG8_SA(b, h) (((b) * 2 + (h)) * HTB)
#define PG8_SB(b, h) ((4 + (b) * 2 + (h)) * HTB)
#define PG8_STAGE(bufoff, gbase, voff) do { _Pragma("unroll") for (int _i = 0; _i < 2; ++_i) { unsigned _keep; \
        asm volatile("s_mov_b32 %0, m0\n\ts_mov_b32 m0, %3\n\ts_nop 0\n\tglobal_load_lds_dwordx4 %1, %2\n\ts_mov_b32 m0, %0" : "=&s"(_keep) : "v"((voff)[_i]), "s"((const char*)(gbase)), "s"(ldsbase + (unsigned)(bufoff) + ldsw + (unsigned)(_i * 8192)) : "memory"); } } while (0)
#define PG8_STA(bufoff, gbase, h) do { if constexpr (GATHER) { PG8_STAGE(bufoff, gbase, voffA[h]); } else { PG8_STAGE(bufoff, (gbase) + (h) * hstepA, voffA[0]); } } while (0)
#define PG8_GLOAD(ui_) do { _Pragma("unroll") for (int _i = 0; _i < 2; ++_i) { int R_, C_; stage_rc(tid * 16 + _i * 8192, R_, C_); \
        voffA[0][_i] = (unsigned)gtab[(ui_) * 256 + R_] * 1024u + (unsigned)C_ * 2u; voffA[1][_i] = (unsigned)gtab[(ui_) * 256 + 128 + R_] * 1024u + (unsigned)C_ * 2u; } } while (0)
#define PG8_LDA(dst, b, h) do { _Pragma("unroll") for (int m = 0; m < 4; ++m) _Pragma("unroll") for (int k = 0; k < 2; ++k) dst[m][k] = *(const LAS bf16x8*)(lds + PG8_SA(b, h) + aoff + m * 2048 + k * 1024); } while (0)
#define PG8_LDB(dst, b, h) do { _Pragma("unroll") for (int n = 0; n < 2; ++n) _Pragma("unroll") for (int k = 0; k < 2; ++k) dst[n][k] = *(const LAS bf16x8*)(lds + PG8_SB(b, h) + boff + n * 2048 + k * 1024); } while (0)
#define PG8_MMA(ai, bj, At, Bt) do { __builtin_amdgcn_s_setprio(1); if constexpr (F8) { _Pragma("unroll") for (int m = 0; m < 4; ++m) _Pragma("unroll") for (int n = 0; n < 2; ++n) \
        acc[ai][bj][m][n] = __builtin_amdgcn_mfma_scale_f32_16x16x128_f8f6f4(cat8(Bt[n][0], Bt[n][1]), cat8(At[m][0], At[m][1]), acc[ai][bj][m][n], 0, 0, 0, 0, 0, 0); }     \
      else { _Pragma("unroll") for (int m = 0; m < 4; ++m) _Pragma("unroll") for (int n = 0; n < 2; ++n) _Pragma("unroll") for (int k = 0; k < 2; ++k) \
        acc[ai][bj][m][n] = __builtin_amdgcn_mfma_f32_16x16x32_bf16(Bt[n][k], At[m][k], acc[ai][bj][m][n], 0, 0, 0); } __builtin_amdgcn_s_setprio(0); } while (0)
#define PG8_WAIT_V(n) asm volatile("s_waitcnt vmcnt(" #n ")" ::: "memory")
#define PG8_WAIT_L(n) asm volatile("s_waitcnt lgkmcnt(" #n ")" ::: "memory")
#define PG8_BAR __builtin_amdgcn_s_barrier()
#define PG8_SCHED __builtin_amdgcn_sched_barrier(0)
    Unit cur, nxt; int ui = 0;
    if (!S.next(0, cur)) return;
    f32x4 acc[2][2][4][2];
#pragma unroll
    for (int a = 0; a < 2; ++a)
#pragma unroll
        for (int b = 0; b < 2; ++b)
#pragma unroll
            for (int m = 0; m < 4; ++m)
#pragma unroll
                for (int n = 0; n < 2; ++n) acc[a][b][m][n] = (f32x4){0.f, 0.f, 0.f, 0.f};
    bf16x8 At[4][2], B0[2][2], B1[2][2];
    const char* cA = cur.a; const char* cB = cur.b;
    if constexpr (GATHER) { PG8_GLOAD(0); }
    PG8_STAGE(PG8_SB(0, 0), cB, voffB); PG8_STAGE(PG8_SB(0, 1), cB + hstepB, voffB); PG8_STA(PG8_SA(0, 0), cA, 0); PG8_STA(PG8_SA(0, 1), cA, 1);
    if (wr == 1) PG8_BAR;
    PG8_WAIT_V(2); PG8_BAR;
    PG8_STAGE(PG8_SB(1, 0), cB + kstepB, voffB); PG8_STA(PG8_SA(1, 0), cA + kstepA, 0); PG8_STAGE(PG8_SB(1, 1), cB + hstepB + kstepB, voffB);
    PG8_WAIT_V(6); PG8_BAR;
    for (;;) {
        const bool has_next = S.next(ui + 1, nxt);
        const char* nA = has_next ? nxt.a : cA; const char* nB = has_next ? nxt.b : cB;
#pragma unroll 1
        for (int t = 0; t < nt; t += 2) {
            const bool last = (t == nt - 2);
            const char* a1; const char* a2; const char* a3;
            if constexpr (KSPLIT > 0) {
                const char* cA2 = cur.a2;
                a1 = (t + 1 >= KSPLIT) ? cA2 + (size_t)(t + 1 - KSPLIT) * kstepA : cA + (size_t)(t + 1) * kstepA;
                a2 = last ? nA : ((t + 2 >= KSPLIT) ? cA2 + (size_t)(t + 2 - KSPLIT) * kstepA : cA + (size_t)(t + 2) * kstepA);
                a3 = last ? nA + kstepA : ((t + 3 >= KSPLIT) ? cA2 + (size_t)(t + 3 - KSPLIT) * kstepA : cA + (size_t)(t + 3) * kstepA);
                if (t == KSPLIT) E.mid(acc, cur, wr, wc, fr, fq);
            } else { a1 = cA + (size_t)(t + 1) * kstepA; a2 = last ? nA : cA + (size_t)(t + 2) * kstepA; a3 = a2 + kstepA; }
            const char* b2 = last ? nB : cB + (size_t)(t + 2) * kstepB; const char* b3 = b2 + kstepB;
            if constexpr (Epi::PREFETCH) { if (last) __builtin_amdgcn_global_load_lds((const unsigned*)(E.src(cur, wid) + lane), (LAS unsigned*)(lds + EPI_OFF + wid * 256), 4, 0, 0); }
            PG8_LDB(B0, 0, 0); PG8_LDB(B1, 0, 1); PG8_SCHED; PG8_LDA(At, 0, 0); PG8_STA(PG8_SA(1, 1), a1, 1);
            if constexpr (GATHER) { if (last && has_next) { PG8_GLOAD(ui + 1); } }
            PG8_WAIT_V(8); PG8_WAIT_L(0); PG8_BAR; PG8_MMA(0, 0, At, B0); PG8_MMA(0, 1, At, B1); PG8_BAR; PG8_SCHED;
            PG8_LDA(At, 0, 1); PG8_STAGE(PG8_SB(0, 0), b2, voffB); PG8_STAGE(PG8_SB(0, 1), b2 + hstepB, voffB); PG8_STA(PG8_SA(0, 0), a2, 0);
            PG8_WAIT_V(8); PG8_WAIT_L(0); PG8_BAR; PG8_MMA(1, 0, At, B0); PG8_MMA(1, 1, At, B1); PG8_BAR; PG8_SCHED;
            PG8_LDB(B0, 1, 0); PG8_LDB(B1, 1, 1); PG8_SCHED; PG8_LDA(At, 1, 0); PG8_STA(PG8_SA(0, 1), a2, 1);
            PG8_WAIT_V(8); PG8_WAIT_L(0); PG8_BAR; PG8_MMA(0, 0, At, B0); PG8_MMA(0, 1, At, B1); PG8_BAR; PG8_SCHED;
            PG8_LDA(At, 1, 1); PG8_STAGE(PG8_SB(1, 0), b3, voffB); PG8_STAGE(PG8_SB(1, 1), b3 + hstepB, voffB); PG8_STA(PG8_SA(1, 0), a3, 0);
            PG8_WAIT_V(8); PG8_WAIT_L(0); PG8_BAR; PG8_MMA(1, 0, At, B0); PG8_MMA(1, 1, At, B1); PG8_BAR; PG8_SCHED;
        }
        if (wr == 0) PG8_BAR;
        E(acc, cur, wr, wc, fr, fq);
        if (!has_next) break;
#pragma unroll
        for (int a = 0; a < 2; ++a)
#pragma unroll
            for (int b = 0; b < 2; ++b)
#pragma unroll
                for (int m = 0; m < 4; ++m)
#pragma unroll
                    for (int n = 0; n < 2; ++n) { f32x2 z0, z1; asm volatile("v_mov_b64 %0, 0" : "=v"(z0)); asm volatile("v_mov_b64 %0, 0" : "=v"(z1)); acc[a][b][m][n] = (f32x4){z0[0], z0[1], z1[0], z1[1]}; }
        cur = nxt; cA = nA; cB = nB; ++ui;
        if (wr == 1) PG8_BAR;
    }
    PG8_WAIT_V(0);
    PG8_BAR;
#undef PG8_SA
#undef PG8_SB
#undef PG8_STAGE
#undef PG8_STA
#undef PG8_GLOAD
#undef PG8_LDA
#undef PG8_LDB
#undef PG8_MMA
#undef PG8_WAIT_V
#undef PG8_WAIT_L
#undef PG8_BAR
#undef PG8_SCHED
}

struct OrdPlain {
    const char* A; const char* Bt; int nM, nN, G, c; size_t a_tile, b_tile;
    __device__ __forceinline__ bool next(int i, Unit& u) const { int pm, pn; if (!tile_map((long)i * G + c, nM, nN, pm, pn)) return false;
        u.pm = pm; u.pn = pn; u.e = 0; u.a = A + (size_t)pm * a_tile; u.b = Bt + (size_t)pn * b_tile; return true; }
};
struct OrdPlain2 {
    const char* A; const char* A2; const char* Bt; int nM, nN, G, c; size_t a_tile, b_tile;
    __device__ __forceinline__ bool next(int i, Unit& u) const { int pm, pn; if (!tile_map((long)i * G + c, nM, nN, pm, pn)) return false;
        u.pm = pm; u.pn = pn; u.e = 0; u.a = A + (size_t)pm * a_tile; u.a2 = A2 + (size_t)pm * a_tile; u.b = Bt + (size_t)pn * b_tile; return true; }
};
struct OrdCmp {
    const char* KV6; const char* Wk; const char* Wv; int G, c;
    __device__ __forceinline__ bool next(int i, Unit& u) const { const long L = (long)i * G + c; if (L >= 64) return false;
        const int kv = (int)L >> 5, b = ((int)L >> 2) & 7, g = ((int)L >> 1) & 1, nh = (int)L & 1;
        u.pm = (int)L; u.pn = 0; u.e = kv; u.a = KV6 + ((size_t)(b * SEQ + nh * 4096) * 768 + kv * 128 + g * 64) * 2; u.b = kv ? Wv : Wk; return true; }
};
struct OrdGrp {
    const char* A; const char* Bt; const LAS int* tstart; int nM, nN, G, c; size_t a_tile, b_tile, b_grp; int rev;
    __device__ __forceinline__ bool next(int i, Unit& u) const { int pm, pn; if (!tile_map((long)i * G + c, nM, nN, pm, pn)) return false;
        if (rev) pm = nM - 1 - pm;
        const int lk = (int)(threadIdx.x & 63u);
        const int e = __builtin_popcountll(__ballot(lk >= 1 && lk < NEXP && pm >= tstart[lk & 31]));
        u.pm = pm; u.pn = pn; u.e = e; u.a = A + (size_t)pm * a_tile; u.b = Bt + (size_t)e * b_grp + (size_t)pn * b_tile; return true; }
};

struct EpiIn { static constexpr bool PREFETCH = false;
    static constexpr bool PERM = true;
    bf16_t *Q, *KV6, *CBV, *MG, *NG;
    __device__ __forceinline__ void operator()(const f32x4 (&acc)[2][2][4][2], const Unit& u, int wr, int wc, int fr, int fq) const {
        const int pn = u.pn; const int row0 = u.pm * BM + wr * 64 + fr;
        if (pn >= 7 && pn < 11) {
#pragma unroll
            for (int ai = 0; ai < 2; ++ai)
#pragma unroll
                for (int m = 0; m < 4; ++m) { const f32x4 v0 = acc[ai][0][m][0] * acc[ai][1][m][0], v1 = acc[ai][0][m][1] * acc[ai][1][m][1];
                    u32x4 w; w.x = cvt_pk_bf16(v0[0], v0[1]); w.y = cvt_pk_bf16(v0[2], v0[3]); w.z = cvt_pk_bf16(v1[0], v1[1]); w.w = cvt_pk_bf16(v1[2], v1[3]);
                    *(u32x4*)(CBV + (size_t)(row0 + ai * HALF + m * 16) * 1024 + 512 + (pn - 7) * HALF + wc * 32 + 8 * fq) = w; }
            return;
        }
        bf16_t* base; int ld, ct; bool sig = false;
        if (pn < 2) { base = Q; ld = 512; ct = pn * 256; } else if (pn < 5) { base = KV6; ld = 768; ct = (pn - 2) * 256; }
        else if (pn < 7) { base = CBV; ld = 1024; ct = (pn - 5) * 256; }
        else { base = NG; ld = 32; ct = 0; sig = true; }
#pragma unroll
        for (int ai = 0; ai < 2; ++ai)
#pragma unroll
            for (int m = 0; m < 4; ++m) { bf16_t* rowp = base + (size_t)(row0 + ai * HALF + m * 16) * ld + ct + wc * 32 + 8 * fq;
#pragma unroll
                for (int bj = 0; bj < 2; ++bj) { if (pn == 11 && (bj != 0 || wc != 0)) continue;
                    f32x4 v0 = acc[ai][bj][m][0], v1 = acc[ai][bj][m][1];
                    if (sig) {
#pragma unroll
                        for (int k = 0; k < 4; ++k) { v0[k] = sigmoidf_(v0[k]); v1[k] = sigmoidf_(v1[k]); } }
                    u32x4 w; w.x = cvt_pk_bf16(v0[0], v0[1]); w.y = cvt_pk_bf16(v0[2], v0[3]); w.z = cvt_pk_bf16(v1[0], v1[1]); w.w = cvt_pk_bf16(v1[2], v1[3]);
                    *(u32x4*)(rowp + bj * HALF) = w; } }
    }
};
struct EpiMG8 { static constexpr bool PREFETCH = false;
    static constexpr bool PERM = true;
    bf16_t* MG;
    __device__ __forceinline__ void operator()(const f32x4 (&acc)[2][2][4][2], const Unit& u, int wr, int wc, int fr, int fq) const {
        const int row0 = u.pm * BM + wr * 64 + fr;
#pragma unroll
        for (int ai = 0; ai < 2; ++ai)
#pragma unroll
            for (int m = 0; m < 4; ++m) { bf16_t* rowp = MG + (size_t)(row0 + ai * HALF + m * 16) * 2048 + u.pn * HALF + wc * 32 + 8 * fq;
                f32x4 rt[2], gbv[2];
#pragma unroll
                for (int n = 0; n < 2; ++n) { const f32x2 kk = {-1.4426950408889634f * W8INV_, -1.4426950408889634f * W8INV_}, one2 = {1.0f, 1.0f};
                    const f32x2 ta0 = pk_mul2((f32x2){acc[ai][0][m][n][0], acc[ai][0][m][n][1]}, kk), ta1 = pk_mul2((f32x2){acc[ai][0][m][n][2], acc[ai][0][m][n][3]}, kk);
                    const f32x2 tb0 = pk_mul2((f32x2){acc[ai][1][m][n][0], acc[ai][1][m][n][1]}, kk), tb1 = pk_mul2((f32x2){acc[ai][1][m][n][2], acc[ai][1][m][n][3]}, kk);
                    const f32x2 da0 = pk_add2((f32x2){fminf(__builtin_amdgcn_exp2f(ta0[0]), 1e30f), fminf(__builtin_amdgcn_exp2f(ta0[1]), 1e30f)}, one2), da1 = pk_add2((f32x2){fminf(__builtin_amdgcn_exp2f(ta1[0]), 1e30f), fminf(__builtin_amdgcn_exp2f(ta1[1]), 1e30f)}, one2);
                    const f32x2 db0 = pk_add2((f32x2){fminf(__builtin_amdgcn_exp2f(tb0[0]), 1e30f), fminf(__builtin_amdgcn_exp2f(tb0[1]), 1e30f)}, one2), db1 = pk_add2((f32x2){fminf(__builtin_amdgcn_exp2f(tb1[0]), 1e30f), fminf(__builtin_amdgcn_exp2f(tb1[1]), 1e30f)}, one2);
                    rt[n] = (f32x4){db0[0] * __builtin_amdgcn_rcpf(da0[0]), db0[1] * __builtin_amdgcn_rcpf(da0[1]), db1[0] * __builtin_amdgcn_rcpf(da1[0]), db1[1] * __builtin_amdgcn_rcpf(da1[1])};
                    gbv[n] = (f32x4){__builtin_amdgcn_rcpf(db0[0]), __builtin_amdgcn_rcpf(db0[1]), __builtin_amdgcn_rcpf(db1[0]), __builtin_amdgcn_rcpf(db1[1])}; }
                { u32x4 w; w.x = cvt_pk_bf16(rt[0][0], rt[0][1]); w.y = cvt_pk_bf16(rt[0][2], rt[0][3]); w.z = cvt_pk_bf16(rt[1][0], rt[1][1]); w.w = cvt_pk_bf16(rt[1][2], rt[1][3]); *(u32x4*)rowp = w; }
                { u32x4 w; w.x = cvt_pk_bf16(gbv[0][0], gbv[0][1]); w.y = cvt_pk_bf16(gbv[0][2], gbv[0][3]); w.z = cvt_pk_bf16(gbv[1][0], gbv[1][1]); w.w = cvt_pk_bf16(gbv[1][2], gbv[1][3]); *(u32x4*)(rowp + 1024) = w; } }
    }
};
__device__ __forceinline__ float gelu_tanh(float x) { const float y = (1.5957691216057308f * 1.4426950408889634f) * (x + 0.044715f * x * x * x); return x * __builtin_amdgcn_rcpf(1.0f + __builtin_amdgcn_exp2f(-y)); }
struct EpiCmp { static constexpr bool PREFETCH = false;
    static constexpr bool PERM = true;
    bf16_t* HID; const float* B1P;
    __device__ __forceinline__ void operator()(const f32x4 (&acc)[2][2][4][2], const Unit& u, int wr, int wc, int fr, int fq) const {
        const int row0 = u.pm * BM + wr * 64 + fr; const float* bp = B1P + u.e * 256 + wc * 32 + 8 * fq;
        f32x4 bv[2][2];
#pragma unroll
        for (int bj = 0; bj < 2; ++bj)
#pragma unroll
            for (int n = 0; n < 2; ++n) bv[bj][n] = *(const f32x4*)(bp + bj * HALF + 4 * n);
#pragma unroll
        for (int ai = 0; ai < 2; ++ai)
#pragma unroll
            for (int m = 0; m < 4; ++m) { bf16_t* rowp = HID + (size_t)(row0 + ai * HALF + m * 16) * 256 + wc * 32 + 8 * fq;
#pragma unroll
                for (int bj = 0; bj < 2; ++bj) { f32x4 v0 = acc[ai][bj][m][0] + bv[bj][0], v1 = acc[ai][bj][m][1] + bv[bj][1];
#pragma unroll
                    for (int k = 0; k < 4; ++k) { v0[k] = gelu_tanh(v0[k]); v1[k] = gelu_tanh(v1[k]); }
                    u32x4 w; w.x = cvt_pk_bf16(v0[0], v0[1]); w.y = cvt_pk_bf16(v0[2], v0[3]); w.z = cvt_pk_bf16(v1[0], v1[1]); w.w = cvt_pk_bf16(v1[2], v1[3]);
                    *(u32x4*)(rowp + bj * HALF) = w; } }
    }
};
template <bool ADD> struct EpiGate { static constexpr bool PREFETCH = false;
    static constexpr bool PERM = true;
    bf16_t* Z; const bf16_t* MG; int goff;
    __device__ __forceinline__ void operator()(const f32x4 (&acc)[2][2][4][2], const Unit& u, int wr, int wc, int fr, int fq) const {
        const int row0 = u.pm * BM + wr * 64 + fr, col0 = u.pn * BM + wc * 32 + 8 * fq;
#pragma unroll
        for (int ai = 0; ai < 2; ++ai)
#pragma unroll
            for (int m = 0; m < 4; ++m) { const size_t row = (size_t)(row0 + ai * HALF + m * 16);
#pragma unroll
                for (int bj = 0; bj < 2; ++bj) { const int col = col0 + bj * HALF;
                    const u32x4 gw = *(const u32x4*)(MG + row * 2048 + goff + col);
                    f32x4 v0 = acc[ai][bj][m][0], v1 = acc[ai][bj][m][1];
                    v0[0] *= bflo(gw.x); v0[1] *= bfhi(gw.x); v0[2] *= bflo(gw.y); v0[3] *= bfhi(gw.y); v1[0] *= bflo(gw.z); v1[1] *= bfhi(gw.z); v1[2] *= bflo(gw.w); v1[3] *= bfhi(gw.w);
                    if (ADD) { const u32x4 zw = *(const u32x4*)(Z + row * 1024 + col);
                        v0[0] += bflo(zw.x); v0[1] += bfhi(zw.x); v0[2] += bflo(zw.y); v0[3] += bfhi(zw.y); v1[0] += bflo(zw.z); v1[1] += bfhi(zw.z); v1[2] += bflo(zw.w); v1[3] += bfhi(zw.w); }
                    u32x4 w; w.x = cvt_pk_bf16(v0[0], v0[1]); w.y = cvt_pk_bf16(v0[2], v0[3]); w.z = cvt_pk_bf16(v1[0], v1[1]); w.w = cvt_pk_bf16(v1[2], v1[3]);
                    *(u32x4*)(Z + row * 1024 + col) = w; } }
    }
};
struct EpiGateM { static constexpr bool PREFETCH = false;
    static constexpr bool PERM = true;
    bf16_t* Z; const bf16_t* MG;
    __device__ __forceinline__ void mid(f32x4 (&acc)[2][2][4][2], const Unit& u, int wr, int wc, int fr, int fq) const {
        const int row0 = u.pm * BM + wr * 64 + fr, col0 = u.pn * BM + wc * 32 + 8 * fq;
#pragma unroll
        for (int ai = 0; ai < 2; ++ai)
#pragma unroll
            for (int m = 0; m < 4; ++m) { const size_t row = (size_t)(row0 + ai * HALF + m * 16);
#pragma unroll
                for (int bj = 0; bj < 2; ++bj) { const int col = col0 + bj * HALF;
                    const u32x4 rw = *(const u32x4*)(MG + row * 2048 + col);
                    f32x4& a0 = acc[ai][bj][m][0]; f32x4& a1 = acc[ai][bj][m][1];
                    a0[0] *= bflo(rw.x); a0[1] *= bfhi(rw.x); a0[2] *= bflo(rw.y); a0[3] *= bfhi(rw.y); a1[0] *= bflo(rw.z); a1[1] *= bfhi(rw.z); a1[2] *= bflo(rw.w); a1[3] *= bfhi(rw.w); } }
    }
    __device__ __forceinline__ void operator()(const f32x4 (&acc)[2][2][4][2], const Unit& u, int wr, int wc, int fr, int fq) const {
        const int row0 = u.pm * BM + wr * 64 + fr, col0 = u.pn * BM + wc * 32 + 8 * fq;
#pragma unroll
        for (int ai = 0; ai < 2; ++ai)
#pragma unroll
            for (int m = 0; m < 4; ++m) { const size_t row = (size_t)(row0 + ai * HALF + m * 16);
#pragma unroll
                for (int bj = 0; bj < 2; ++bj) { const int col = col0 + bj * HALF;
                    const u32x4 gw = *(const u32x4*)(MG + row * 2048 + 1024 + col);
                    f32x4 v0 = acc[ai][bj][m][0], v1 = acc[ai][bj][m][1];
                    v0[0] *= fmaxf(bflo(gw.x), 1e-30f); v0[1] *= fmaxf(bfhi(gw.x), 1e-30f); v0[2] *= fmaxf(bflo(gw.y), 1e-30f); v0[3] *= fmaxf(bfhi(gw.y), 1e-30f); v1[0] *= fmaxf(bflo(gw.z), 1e-30f); v1[1] *= fmaxf(bfhi(gw.z), 1e-30f); v1[2] *= fmaxf(bflo(gw.w), 1e-30f); v1[3] *= fmaxf(bfhi(gw.w), 1e-30f);
                    u32x4 w; w.x = cvt_pk_bf16(v0[0], v0[1]); w.y = cvt_pk_bf16(v0[2], v0[3]); w.z = cvt_pk_bf16(v1[0], v1[1]); w.w = cvt_pk_bf16(v1[2], v1[3]);
                    *(u32x4*)(Z + row * 1024 + col) = w; } }
    }
};
struct EpiRes { static constexpr bool PREFETCH = false;
    static constexpr bool PERM = true;
    const float* X; bf16_t* O;
    __device__ __forceinline__ void operator()(const f32x4 (&acc)[2][2][4][2], const Unit& u, int wr, int wc, int fr, int fq) const {
        const int row0 = u.pm * BM + wr * 64 + fr, col0 = u.pn * BM + wc * 32 + 8 * fq;
#pragma unroll
        for (int ai = 0; ai < 2; ++ai)
#pragma unroll
            for (int m = 0; m < 4; ++m) { const size_t off = (size_t)(row0 + ai * HALF + m * 16) * DM + col0;
#pragma unroll
                for (int bj = 0; bj < 2; ++bj) { const f32x4 x0 = *(const f32x4*)(X + off + bj * HALF), x1 = *(const f32x4*)(X + off + bj * HALF + 4);
                    const f32x4 v0 = x0 + acc[ai][bj][m][0], v1 = x1 + acc[ai][bj][m][1];
                    u32x4 w; w.x = cvt_pk_bf16(v0[0], v0[1]); w.y = cvt_pk_bf16(v0[2], v0[3]); w.z = cvt_pk_bf16(v1[0], v1[1]); w.w = cvt_pk_bf16(v1[2], v1[3]);
                    *(u32x4*)(O + off + bj * HALF) = w; } }
    }
};
constexpr float W8SCALE = 32.0f, W8INV = 1.0f / 32.0f;
__device__ __forceinline__ unsigned pk4_fp8(float a, float b, float c, float d) { int r = __builtin_amdgcn_cvt_pk_fp8_f32(a, b, __builtin_bit_cast(int, a), false); r = __builtin_amdgcn_cvt_pk_fp8_f32(c, d, r, true); return (unsigned)r; }
struct EpiGU {
    static constexpr bool PERM = true, PREFETCH = true;
    unsigned char* ACT; const float* BGU; const float* ROWRS; const LAS float* el;
    __device__ __forceinline__ const float* src(const Unit& u, int wid) const { return wid < 4 ? BGU + (size_t)u.e * 2048 + (wid >> 1) * 1024 + u.pn * HALF + (wid & 1) * 64 : ROWRS + u.pm * BM + (wid - 4) * 64; }
    __device__ __forceinline__ void operator()(const f32x4 (&acc)[2][2][4][2], const Unit& u, int wr, int wc, int fr, int fq) const {
        const int row0 = u.pm * BM + wr * 64 + fr, col0 = u.pn * HALF + wc * 32 + 8 * fq;
        f32x4 bg[2], bu[2];
#pragma unroll
        for (int n = 0; n < 2; ++n) { bg[n] = *(const LAS f32x4*)(el + wc * 32 + 8 * fq + 4 * n); bu[n] = *(const LAS f32x4*)(el + 128 + wc * 32 + 8 * fq + 4 * n) + 1.0f; }
#pragma unroll
        for (int ai = 0; ai < 2; ++ai)
#pragma unroll
            for (int mp = 0; mp < 2; ++mp) { u32x2 w[2];
#pragma unroll
                for (int mm = 0; mm < 2; ++mm) { const int m = 2 * mp + mm; const int rl = ai * HALF + wr * 64 + m * 16 + fr; const float sc = W8INV * el[256 + rl];
#pragma unroll
                    for (int n = 0; n < 2; ++n) {
                        f32x4 g = acc[ai][0][m][n] * sc + bg[n], uu = acc[ai][1][m][n] * sc + bu[n], e, r;
#pragma unroll
                        for (int k = 0; k < 4; ++k) { g[k] = fminf(g[k], 7.0f); uu[k] = fminf(fmaxf(uu[k], -6.0f), 8.0f); }
                        const f32x2 kk = {-1.702f * 1.4426950408889634f, -1.702f * 1.4426950408889634f}, one2 = {1.0f, 1.0f};
                        const f32x2 t0 = pk_mul2((f32x2){g[0], g[1]}, kk), t1 = pk_mul2((f32x2){g[2], g[3]}, kk);
                        e[0] = __builtin_amdgcn_exp2f(t0[0]); e[1] = __builtin_amdgcn_exp2f(t0[1]); e[2] = __builtin_amdgcn_exp2f(t1[0]); e[3] = __builtin_amdgcn_exp2f(t1[1]);
                        const f32x2 d0 = pk_add2((f32x2){e[0], e[1]}, one2), d1 = pk_add2((f32x2){e[2], e[3]}, one2);
                        r[0] = __builtin_amdgcn_rcpf(d0[0]); r[1] = __builtin_amdgcn_rcpf(d0[1]); r[2] = __builtin_amdgcn_rcpf(d1[0]); r[3] = __builtin_amdgcn_rcpf(d1[1]);
                        const f32x2 o0 = pk_mul2(pk_mul2((f32x2){g[0], g[1]}, (f32x2){r[0], r[1]}), (f32x2){uu[0], uu[1]}), o1 = pk_mul2(pk_mul2((f32x2){g[2], g[3]}, (f32x2){r[2], r[3]}), (f32x2){uu[2], uu[3]});
                        const f32x4 o = {o0[0], o0[1], o1[0], o1[1]};
                        const unsigned pw = pk4_fp8(o[0], o[1], o[2], o[3]); if (n == 0) w[mm].x = pw; else w[mm].y = pw; } }
                const auto r0 = __builtin_amdgcn_permlane16_swap(w[0].x, w[1].x, false, false), r1 = __builtin_amdgcn_permlane16_swap(w[0].y, w[1].y, false, false);
                u32x4 v; v.x = r0[0]; v.y = r1[0]; v.z = r0[1]; v.w = r1[1];
                const int rs = ai * HALF + wr * 64 + (2 * mp + (fq & 1)) * 16 + fr;
                *(u32x4*)(ACT + (size_t)(u.pm * BM + rs) * 1024 + u.pn * HALF + wc * 32 + 8 * (fq & 2)) = v; }
        (void)row0; (void)col0;
    }
};
constexpr float YSCALE = 16.0f, YINV = 1.0f / 16.0f;
struct EpiDN {
    static constexpr bool PERM = true, PREFETCH = true;
    unsigned char* Y; const float* BDN; const float* ROWW; const LAS float* el;
    __device__ __forceinline__ const float* src(const Unit& u, int wid) const { return wid < 4 ? BDN + (size_t)u.e * 1024 + u.pn * BM + wid * 64 : ROWW + u.pm * BM + (wid - 4) * 64; }
    __device__ __forceinline__ void operator()(const f32x4 (&acc)[2][2][4][2], const Unit& u, int wr, int wc, int fr, int fq) const {
        const int col0 = u.pn * BM + wc * 32 + 8 * fq;
        f32x4 bv[2][2];
#pragma unroll
        for (int bj = 0; bj < 2; ++bj)
#pragma unroll
            for (int n = 0; n < 2; ++n) bv[bj][n] = *(const LAS f32x4*)(el + bj * HALF + wc * 32 + 8 * fq + 4 * n);
#pragma unroll
        for (int ai = 0; ai < 2; ++ai)
#pragma unroll
            for (int mp = 0; mp < 2; ++mp) { u32x2 w[2][2];
#pragma unroll
                for (int mm = 0; mm < 2; ++mm) { const int m = 2 * mp + mm; const int rl = ai * HALF + wr * 64 + m * 16 + fr; const float rw = el[256 + rl] * YSCALE;
#pragma unroll
                    for (int bj = 0; bj < 2; ++bj) { const f32x4 v0 = (acc[ai][bj][m][0] * W8INV + bv[bj][0]) * rw, v1 = (acc[ai][bj][m][1] * W8INV + bv[bj][1]) * rw;
                        w[mm][bj].x = pk4_fp8(v0[0], v0[1], v0[2], v0[3]); w[mm][bj].y = pk4_fp8(v1[0], v1[1], v1[2], v1[3]); } }
                const int rs = ai * HALF + wr * 64 + (2 * mp + (fq & 1)) * 16 + fr; unsigned char* rowp = Y + (size_t)(u.pm * BM + rs) * 1024 + u.pn * BM + wc * 32 + 8 * (fq & 2);
#pragma unroll
                for (int bj = 0; bj < 2; ++bj) { const auto r0 = __builtin_amdgcn_permlane16_swap(w[0][bj].x, w[1][bj].x, false, false), r1 = __builtin_amdgcn_permlane16_swap(w[0][bj].y, w[1][bj].y, false, false);
                    u32x4 v; v.x = r0[0]; v.y = r1[0]; v.z = r0[1]; v.w = r1[1];
                    *(u32x4*)(rowp + bj * HALF) = v; } }
        (void)col0;
    }
};
}

#define XB_TMO      128
#define XB_XCNT(j)  (256  + 64 * (j))
#define XB_XSUB(j)  (1280 + 64 * (j))
#define XB_XGEN(j)  (2304 + 64 * (j))
#define XB_TOP      3328
#define XB_TOPGEN   3392
#define XCD_BAR_WORDS 3456
#define XB_SPIN_CAP (1u << 18)
__device__ __forceinline__ unsigned xb_ld(unsigned* p)              { return __hip_atomic_load(p, __ATOMIC_RELAXED, __HIP_MEMORY_SCOPE_AGENT); }
__device__ __forceinline__ unsigned xb_add(unsigned* p, unsigned v) { return __hip_atomic_fetch_add(p, v, __ATOMIC_RELAXED, __HIP_MEMORY_SCOPE_AGENT); }
__device__ __forceinline__ unsigned xb_xcc_id() { return (unsigned)__builtin_amdgcn_s_getreg((3 << 11) | 20) & 0xFu; }
#define XB_SPIN(cond, bar) do { unsigned _sp = 0; while (cond) { __builtin_amdgcn_s_sleep(1); \
    if ((++_sp & 255u) == 0u) { if (xb_ld(&(bar)[XB_TMO])) break; if (_sp > XB_SPIN_CAP) { atomicAdd(&(bar)[XB_TMO], 1u); break; } } } } while (0)
struct XcdBarrier { unsigned* bar; unsigned x; volatile LAS unsigned* st; };
__device__ __forceinline__ XcdBarrier xcd_barrier_post(unsigned* bar, volatile LAS unsigned* st) {
    XcdBarrier b; b.bar = bar; b.x = xb_xcc_id(); b.st = st;
    if (threadIdx.x == 0) (void)xb_add(&bar[XB_XCNT(b.x)], 1u);
    return b;
}
__device__ __forceinline__ void xcd_barrier_complete(unsigned* bar, unsigned x, unsigned& nloc, unsigned& nx) {
    const unsigned G = gridDim.x * gridDim.y * gridDim.z;
    unsigned sum, cnt, mine, sp = 0u;
    for (;;) {
        sum = 0u; cnt = 0u; mine = 0u;
#pragma unroll
        for (unsigned j = 0; j < 16; ++j) { const unsigned c = xb_ld(&bar[XB_XCNT(j)]); sum += c; cnt += (c > 0u) ? 1u : 0u; mine = (j == x) ? c : mine; }
        if (sum == G) break;
        __builtin_amdgcn_s_sleep(1);
        if ((++sp & 255u) == 0u) { if (xb_ld(&bar[XB_TMO])) break; if (sp > XB_SPIN_CAP) { atomicAdd(&bar[XB_TMO], 1u); break; } }
    }
    nloc = mine > 0u ? mine : 1u; nx = cnt > 0u ? cnt : 1u;
}
__device__ __forceinline__ void xcd_barrier(const XcdBarrier& b) {
    asm volatile("s_waitcnt vmcnt(0)" ::: "memory");
    __syncthreads();
    if (threadIdx.x == 0) {
        unsigned* bar = b.bar;
        __builtin_amdgcn_s_waitcnt(0);
        unsigned nloc = b.st[0], nx = b.st[1];
        if (nloc == 0u) { xcd_barrier_complete(bar, b.x, nloc, nx); b.st[0] = nloc; b.st[1] = nx; }
        const unsigned old = xb_add(&bar[XB_XSUB(b.x)], 1u);
        const unsigned gen = old / nloc;
        if (old + 1u == (gen + 1u) * nloc) {
            __builtin_amdgcn_fence(__ATOMIC_RELEASE, "agent");
            asm volatile("s_waitcnt vmcnt(0)" ::: "memory");
            const unsigned og = xb_add(&bar[XB_TOP], 1u);
            const unsigned tg = og / nx;
            if (og + 1u == (tg + 1u) * nx) xb_add(&bar[XB_TOPGEN], 1u);
            else XB_SPIN(xb_ld(&bar[XB_TOPGEN]) == tg, bar);
            __builtin_amdgcn_fence(__ATOMIC_ACQUIRE, "agent");
            xb_add(&bar[XB_XGEN(b.x)], 1u);
            asm volatile("s_waitcnt vmcnt(0)" ::: "memory");
        } else {
            XB_SPIN(xb_ld(&bar[XB_XGEN(b.x)]) == gen, bar);
            __builtin_amdgcn_fence(__ATOMIC_ACQUIRE, "agent");
            asm volatile("s_waitcnt vmcnt(0)" ::: "memory");
        }
    }
    __syncthreads();
}

struct Args { const float* in[28]; float* out; unsigned char* ws; int ph_lo, ph_hi; };
enum { I_X = 0, I_GN1, I_WIN, I_GQ, I_GKC, I_GKS, I_GKW, I_PEK, I_CKW1, I_CKB1, I_CKW2, I_CKB2, I_PEV, I_CVW1, I_CVB1, I_CVW2, I_CVB2, I_CONVW, I_WPA, I_WPB, I_WO, I_GN2, I_WR, I_BR, I_WGU, I_BGU, I_WDN, I_BDN };

struct Frame {
    LAS unsigned char* lds; int tid, lane, wave, G, vcu; unsigned char* ws; const Args* a; float* out;
};

__device__ __forceinline__ int colmap(int mode, int n) {
    if (mode == 1) { if (n < 1280) return n; if (n < 1792) return n + 24;
        if (n < 2816) { const int p = (n - 1792) >> 8, r = (n - 1792) & 255; return r < 128 ? 1816 + 128 * p + r : 2328 + 128 * p + (r - 128); }
        if (n < 2840) return n - 2816 + 1280; return -1; }
    if (mode == 3) { const int p = n >> 8, r = n & 255; return r < 128 ? 2840 + 128 * p + r : 2840 + 1024 + 128 * p + (r - 128); }
    if (mode == 2) { const int p = n >> 8, r = n & 255; return r < 128 ? 128 * p + r : 1024 + 128 * p + (r - 128); }
    return n;
}
__device__ __forceinline__ void tr_item(const float* W, int Nsrc, int K, bf16_t* WT, int mode, LAS float* scr, int kb, int nb, int lane) {
    const int k0 = 64 * kb, n0 = 32 * nb; const int col = colmap(mode, n0 + (lane & 31));
    { const int n4 = (lane & 7) * 4; const int c0 = colmap(mode, n0 + n4); (void)col;
#pragma unroll
      for (int i = 0; i < 8; ++i) { const int kk = 8 * i + (lane >> 3); f32x4 v = (f32x4){0.f, 0.f, 0.f, 0.f}; if (c0 >= 0) v = *(const f32x4*)(W + (size_t)(k0 + kk) * Nsrc + c0);
          LAS float* d = scr + kk * 33 + n4; d[0] = v.x; d[1] = v.y; d[2] = v.z; d[3] = v.w; } }
    LDS_WAIT(); asm volatile("" ::: "memory");
    const int c = lane & 7;
#pragma unroll
    for (int j = 0; j < 4; ++j) { const int n = (lane >> 3) + 8 * j; const LAS float* s = scr + (8 * c) * 33 + n;
        u32x4 o; o.x = pk2(s[0 * 33], s[1 * 33]); o.y = pk2(s[2 * 33], s[3 * 33]); o.z = pk2(s[4 * 33], s[5 * 33]); o.w = pk2(s[6 * 33], s[7 * 33]);
        *(u32x4*)(WT + (size_t)(n0 + n) * K + k0 + 8 * c) = o; }
    LDS_WAIT(); asm volatile("" ::: "memory");
}
__device__ __forceinline__ void tr_item8(const float* W, int Nsrc, int K, unsigned char* WT, int mode, LAS float* scr, int kb, int nb, int lane) {
    const int k0 = 64 * kb, n0 = 32 * nb; const int col = colmap(mode, n0 + (lane & 31));
    { const int n4 = (lane & 7) * 4; const int c0 = colmap(mode, n0 + n4); (void)col;
#pragma unroll
      for (int i = 0; i < 8; ++i) { const int kk = 8 * i + (lane >> 3); const f32x4 v = *(const f32x4*)(W + (size_t)(k0 + kk) * Nsrc + c0);
          LAS float* d = scr + kk * 33 + n4; d[0] = v.x; d[1] = v.y; d[2] = v.z; d[3] = v.w; } }
    LDS_WAIT(); asm volatile("" ::: "memory");
    const int n = lane >> 1, hf = lane & 1; const LAS float* sp = scr + (32 * hf) * 33 + n;
    u32x4 o0, o1;
#pragma unroll
    for (int q = 0; q < 4; ++q) { o0[q] = pg8::pk4_fp8(sp[(4 * q) * 33] * pg8::W8SCALE, sp[(4 * q + 1) * 33] * pg8::W8SCALE, sp[(4 * q + 2) * 33] * pg8::W8SCALE, sp[(4 * q + 3) * 33] * pg8::W8SCALE);
                                  o1[q] = pg8::pk4_fp8(sp[(16 + 4 * q) * 33] * pg8::W8SCALE, sp[(17 + 4 * q) * 33] * pg8::W8SCALE, sp[(18 + 4 * q) * 33] * pg8::W8SCALE, sp[(19 + 4 * q) * 33] * pg8::W8SCALE); }
    unsigned char* dst = WT + (size_t)(n0 + n) * K + k0 + 32 * hf;
    *(u32x4*)dst = o0; *(u32x4*)(dst + 16) = o1;
    LDS_WAIT(); asm volatile("" ::: "memory");
}
__device__ __forceinline__ void p0_prologue(Frame& F) {
    unsigned char* ws = F.ws;
    LAS float* scr = (LAS float*)(F.lds + F.wave * 16384);
    const int gw = F.vcu * 8 + F.wave, NGW = F.G * 8;
    constexpr int I_IN = 16 * 96, I_MG = 16 * 64, I_PA = 8 * 32, I_PO = 16 * 32, I_C1 = 32 * 8;
    constexpr int NTR = I_IN + I_MG + 2 * I_PA + I_PO + 2 * I_C1;
    for (int m2 = gw; m2 < T / 2; m2 += NGW) {
        const f32x4* gr = (const f32x4*)F.a->in[I_GN1] + F.lane;
        f32x4 v[2][4]; float ss[2] = {0.f, 0.f};
#pragma unroll
        for (int rr = 0; rr < 2; ++rr) { const f32x4* xr = (const f32x4*)(F.a->in[I_X] + (size_t)(2 * m2 + rr) * DM) + F.lane;
#pragma unroll
            for (int j = 0; j < 4; ++j) v[rr][j] = xr[64 * j]; }
#pragma unroll
        for (int rr = 0; rr < 2; ++rr)
#pragma unroll
            for (int j = 0; j < 4; ++j) ss[rr] += (v[rr][j].x * v[rr][j].x + v[rr][j].y * v[rr][j].y) + (v[rr][j].z * v[rr][j].z + v[rr][j].w * v[rr][j].w);
#pragma unroll
        for (int rr = 0; rr < 2; ++rr) { const float rs = 1.0f / sqrtf(wave_sum(ss[rr]) * (1.f / DM) + EPS);
            u32x2* o8 = (u32x2*)((bf16_t*)(ws + WS_H1) + (size_t)(2 * m2 + rr) * DM) + F.lane;
            unsigned* o4 = (unsigned*)((unsigned char*)(ws + WS_H1F8) + (size_t)(2 * m2 + rr) * DM) + F.lane;
#pragma unroll
            for (int j = 0; j < 4; ++j) { const f32x4 g = gr[64 * j]; const float h0 = v[rr][j].x * rs * g.x, h1v = v[rr][j].y * rs * g.y, h2v = v[rr][j].z * rs * g.z, h3 = v[rr][j].w * rs * g.w;
                u32x2 o; o.x = cvtpk_bf16(h0, h1v); o.y = cvtpk_bf16(h2v, h3); o8[64 * j] = o; o4[64 * j] = pg8::pk4_fp8(h0, h1v, h2v, h3); } }
    }
    const bool bias_wg = F.G > 8 && blockIdx.x < 8;
    const int gtr = F.G > 8 ? ((int)blockIdx.x - 8) * 8 + F.wave : gw, ntrw = F.G > 8 ? (F.G - 8) * 8 : NGW;
    if (!bias_wg) for (int it = gtr; it < NTR; it += ntrw) {
        int r = it;
        if (r < I_IN) { tr_item(F.a->in[I_WIN], IN_COLS, DM, (bf16_t*)(ws + WS_WIN_T), 1, scr, r / 96, r % 96, F.lane); continue; } r -= I_IN;
        if (r < I_MG) { tr_item8(F.a->in[I_WIN], IN_COLS, DM, (unsigned char*)(ws + WS_WMG8), 3, scr, r / 64, r % 64, F.lane); continue; } r -= I_MG;
        if (r < I_PA) { tr_item(F.a->in[I_WPA], DM, DM, (bf16_t*)(ws + WS_WPA_T), 0, scr, r / 32, r % 32, F.lane); continue; } r -= I_PA;
        if (r < I_PA) { tr_item(F.a->in[I_WPB], DM, DM, (bf16_t*)(ws + WS_WPA_T) + AW, 0, scr, r / 32, r % 32, F.lane); continue; } r -= I_PA;
        if (r < I_PO) { tr_item(F.a->in[I_WO], DM, DM, (bf16_t*)(ws + WS_WO_T), 0, scr, r / 32, r % 32, F.lane); continue; } r -= I_PO;
        if (r < I_C1) { tr_item(F.a->in[I_CKW1], CMP_HID, 2048, (bf16_t*)(ws + WS_CKW1_T), 0, scr, r / 8, r % 8, F.lane); continue; } r -= I_C1;
        { tr_item(F.a->in[I_CVW1], CMP_HID, 2048, (bf16_t*)(ws + WS_CVW1_T), 0, scr, r / 8, r % 8, F.lane); }
    }
    __syncthreads();
    for (int it = blockIdx.x; it < 8; it += F.G) {
        const int kv = it >> 2, jb = it & 3, j = jb * 64 + F.lane;
        const float* pe = kv ? F.a->in[I_PEV] : F.a->in[I_PEK]; const float* w1 = kv ? F.a->in[I_CVW1] : F.a->in[I_CKW1];
        float a = 0.f;
#pragma unroll 1
        for (int ib = 0; ib < 4; ++ib) { float wv[64];
#pragma unroll
            for (int i = 0; i < 64; ++i) wv[i] = w1[(size_t)(F.wave * 256 + ib * 64 + i) * CMP_HID + j];
#pragma unroll
            for (int i = 0; i < 64; ++i) a += pe[F.wave * 256 + ib * 64 + i] * wv[i]; }
        LAS float* red = (LAS float*)F.lds;
        red[F.wave * 64 + F.lane] = a; __syncthreads();
        if (F.wave == 0) { float s = (kv ? F.a->in[I_CVB1] : F.a->in[I_CKB1])[j];
#pragma unroll
            for (int w = 0; w < 8; ++w) s += red[w * 64 + F.lane];
            ((float*)(ws + WS_B1P))[kv * 256 + j] = s; }
        __syncthreads();
    }
}

__device__ __forceinline__ void p2_elementwise(Frame& F, int run) {
    unsigned char* ws = F.ws; const int lane = F.lane;
    bf16_t* Q = (bf16_t*)(ws + WS_Q); bf16_t* KV6 = (bf16_t*)(ws + WS_KV6); const bf16_t* C3 = (const bf16_t*)(ws + WS_CONV3); bf16_t* YB = (bf16_t*)(ws + WS_YB);
    float gq[8], gk[8], cw[3][8];
    { const float* g = F.a->in[I_GQ] + (lane & 7) * 8; const float* g2 = (((lane >> 4) & 1) ? F.a->in[I_GKW] : F.a->in[I_GKS]) + (lane & 7) * 8;
#pragma unroll
      for (int k = 0; k < 8; ++k) { gq[k] = g[k] * QSCALE; gk[k] = g2[k]; }
#pragma unroll
      for (int j = 0; j < 3; ++j)
#pragma unroll
          for (int k = 0; k < 8; ++k) cw[j][k] = F.a->in[I_CONVW][j * CONVW + lane * 8 + k]; }
    {
        const int t0 = run * 32;
        float v1[8], v2[8];
        if ((t0 & (SEQ - 1)) == 0) {
#pragma unroll
            for (int k = 0; k < 8; ++k) { v1[k] = 0.f; v2[k] = 0.f; }
        } else {
            const u32x4 c1 = *(const u32x4*)(C3 + (size_t)(t0 - 1) * 1024 + 512 + lane * 8), c2 = *(const u32x4*)(C3 + (size_t)(t0 - 2) * 1024 + 512 + lane * 8);
#pragma unroll
            for (int k = 0; k < 4; ++k) { v1[2 * k] = bflo(c1[k]); v1[2 * k + 1] = bfhi(c1[k]); v2[2 * k] = bflo(c2[k]); v2[2 * k + 1] = bfhi(c2[k]); }
        }
        const int kcol = 256 + ((lane >> 4) & 1) * 256 + (lane & 15) * 8;
        u32x4 nk, nb, nc;
        { const size_t tok = (size_t)t0; nk = *(const u32x4*)(KV6 + tok * 768 + kcol);
          nb = *(const u32x4*)(C3 + tok * 1024 + lane * 8); nc = *(const u32x4*)(C3 + tok * 1024 + 512 + lane * 8); }
        for (int tt = 0; tt < 32; ++tt) {
            const size_t tok = (size_t)(t0 + tt);
            const u32x4 wk = nk, b = nb, c = nc;
            if (tt + 1 < 32) { const size_t tn = tok + 1; nk = *(const u32x4*)(KV6 + tn * 768 + kcol);
                nb = *(const u32x4*)(C3 + tn * 1024 + lane * 8); nc = *(const u32x4*)(C3 + tn * 1024 + 512 + lane * 8); }
            { float x[8];
#pragma unroll
              for (int k = 0; k < 4; ++k) { x[2 * k] = bflo(wk[k]); x[2 * k + 1] = bfhi(wk[k]); }
              float s = 0.f;
#pragma unroll
              for (int k = 0; k < 8; ++k) s += x[k] * x[k];
              s += __shfl_xor(s, 1); s += __shfl_xor(s, 2); s += __shfl_xor(s, 4);
              const float rs = 1.0f / sqrtf(s * (1.f / 64.f) + EPS);
              u32x4 o; o.x = cvtpk_bf16(x[0] * rs * gk[0], x[1] * rs * gk[1]); o.y = cvtpk_bf16(x[2] * rs * gk[2], x[3] * rs * gk[3]); o.z = cvtpk_bf16(x[4] * rs * gk[4], x[5] * rs * gk[5]); o.w = cvtpk_bf16(x[6] * rs * gk[6], x[7] * rs * gk[7]);
              if (lane < 32) *(u32x4*)(KV6 + tok * 768 + kcol) = o; }
            { float v0[8], bb[8], y[8];
#pragma unroll
              for (int k = 0; k < 4; ++k) { v0[2 * k] = bflo(c[k]); v0[2 * k + 1] = bfhi(c[k]); bb[2 * k] = bflo(b[k]); bb[2 * k + 1] = bfhi(b[k]); }
#pragma unroll
              for (int k = 0; k < 8; ++k) { y[k] = bb[k] * (cw[0][k] * v2[k] + cw[1][k] * v1[k] + cw[2][k] * v0[k]); v2[k] = v1[k]; v1[k] = v0[k]; }
              u32x4 o; o.x = cvtpk_bf16(y[0], y[1]); o.y = cvtpk_bf16(y[2], y[3]); o.z = cvtpk_bf16(y[4], y[5]); o.w = cvtpk_bf16(y[6], y[7]);
              *(u32x4*)(YB + tok * 512 + lane * 8) = o; }
        }
    }
}

__device__ __forceinline__ void p2_queue(Frame& F) {
    unsigned char* ws = F.ws;
    constexpr int I_GU = 16 * 64, I_DN = 16 * 32, N_EW = T / 32, N_CV = NEXP * I_GU + NEXP * I_DN, CHUNK = 8;
    constexpr int NCHUNK = (N_CV + CHUNK - 1) / CHUNK;
    unsigned* head = (unsigned*)(ws + WS_CTL) + 8192;
    LAS float* scr = (LAS float*)(F.lds + F.wave * 16384);
    for (int run = F.vcu * 8 + F.wave; run < N_EW; run += F.G * 8) p2_elementwise(F, run);
    for (;;) {
        unsigned c = 0;
        if (F.lane == 0) c = __hip_atomic_fetch_add(head, 1u, __ATOMIC_RELAXED, __HIP_MEMORY_SCOPE_AGENT);
        c = (unsigned)__builtin_amdgcn_readfirstlane((int)c);
        if (c >= (unsigned)NCHUNK) break;
#pragma unroll 1
        for (int k = 0; k < CHUNK; ++k) { int r0 = (int)c * CHUNK;
            if (r0 < NEXP * I_GU) { const int e = r0 / I_GU, g64 = (r0 % I_GU) / 64, j = (r0 % 64) / 8;
                tr_item8(F.a->in[I_WGU] + (size_t)e * DM * 2048, 2048, DM, (unsigned char*)(ws + WS_WGU_T) + (size_t)e * 2048 * DM, 2, scr, g64, j + 8 * k, F.lane); continue; }
            r0 -= NEXP * I_GU;
            { const int e = r0 / I_DN, g32 = (r0 % I_DN) / 32, j = (r0 % 32) / 8;
              tr_item8(F.a->in[I_WDN] + (size_t)e * DFF * DM, DM, DFF, (unsigned char*)(ws + WS_WDN_T) + (size_t)e * DM * DFF, 0, scr, g32, j + 4 * k, F.lane); } }
    }
}

__device__ __forceinline__ void p3_compress2(Frame& F) {
    unsigned char* ws = F.ws; const int lane = F.lane;
    const bf16_t* HID = (const bf16_t*)(ws + WS_HID);
    LAS float* hr = (LAS float*)(F.lds + F.wave * 16384);
    const int gw = F.vcu * 8 + F.wave, NGW = F.G * 8;
    if (NGW != 2048) {
        for (int row = gw; row < 16384; row += NGW) {
            const int kv = row >> 13, n = row & 511;
            if (n == 511) { ((bf16_t*)(ws + (kv ? WS_VC : WS_KC)))[(size_t)(row & 8191) * 64 + lane] = 0; continue; }
            { const u32x2 w = *(const u32x2*)(HID + (size_t)row * 256 + lane * 4); hr[lane * 4 + 0] = bflo(w.x); hr[lane * 4 + 1] = bfhi(w.x); hr[lane * 4 + 2] = bflo(w.y); hr[lane * 4 + 3] = bfhi(w.y); }
            LDS_WAIT(); asm volatile("" ::: "memory");
            const float* w2 = kv ? F.a->in[I_CVW2] : F.a->in[I_CKW2];
            float a = (kv ? F.a->in[I_CVB2] : F.a->in[I_CKB2])[lane];
            for (int k = 0; k < 256; ++k) a += hr[k] * w2[k * 64 + lane];
            if (kv == 0) { const float ss = wave_sum(a * a); a = a * (1.0f / sqrtf(ss * (1.f / 64.f) + EPS)) * F.a->in[I_GKC][lane]; }
            ((bf16_t*)(ws + (kv ? WS_VC : WS_KC)))[(size_t)(row & 8191) * 64 + lane] = (bf16_t)f2bf(a);
            LDS_WAIT(); asm volatile("" ::: "memory");
        }
        return;
    }
    u32x2 hw[8]; f32x4 wst[8];
#define P3_W2LOAD(KV) do { const f32x4* w2v_ = (const f32x4*)((KV) ? F.a->in[I_CVW2] : F.a->in[I_CKW2]); _Pragma("unroll") for (int j = 0; j < 8; ++j) wst[j] = w2v_[F.tid + 512 * j]; } while (0)
#define P3_W2STORE() do { _Pragma("unroll") for (int j = 0; j < 8; ++j) { const int idx_ = F.tid + 512 * j, kk_ = idx_ >> 4, c4_ = (idx_ & 15) * 4; \
        *(LAS f32x4*)((LAS float*)(F.lds + (kk_ >> 5) * 16384 + 8192) + (kk_ & 31) * 64 + c4_) = wst[j]; } } while (0)
#pragma unroll
    for (int i = 0; i < 8; ++i) hw[i] = *(const u32x2*)(HID + (size_t)(gw + 2048 * i) * 256 + lane * 4);
    P3_W2LOAD(0);
#pragma unroll
    for (int i = 0; i < 8; ++i) { LAS float* d = hr + i * 256 + lane * 4; d[0] = bflo(hw[i].x); d[1] = bfhi(hw[i].x); d[2] = bflo(hw[i].y); d[3] = bfhi(hw[i].y); }
    P3_W2STORE();
    P3_W2LOAD(1);
    __syncthreads();
#pragma unroll 1
    for (int kv = 0; kv < 2; ++kv) {
        if (kv == 1) { __syncthreads(); P3_W2STORE(); __syncthreads(); }
        const float b2 = (kv ? F.a->in[I_CVB2] : F.a->in[I_CKB2])[lane];
        float a[4] = {b2, b2, b2, b2};
#pragma unroll 1
        for (int kb = 0; kb < 4; ++kb) { float wv[64];
#pragma unroll
            for (int k = 0; k < 64; ++k) wv[k] = ((const LAS float*)(F.lds + (2 * kb + (k >> 5)) * 16384 + 8192))[(k & 31) * 64 + lane];
#pragma unroll
            for (int k4 = 0; k4 < 16; ++k4)
#pragma unroll
                for (int r = 0; r < 4; ++r) { const f32x4 h4 = *(const LAS f32x4*)(hr + (4 * kv + r) * 256 + kb * 64 + 4 * k4);
                    a[r] += h4[0] * wv[4 * k4] + h4[1] * wv[4 * k4 + 1] + h4[2] * wv[4 * k4 + 2] + h4[3] * wv[4 * k4 + 3]; } }
#pragma unroll
        for (int r = 0; r < 4; ++r) { const int row = gw + 2048 * (4 * kv + r), n = row & 511; float v = a[r];
            if (kv == 0) { const float ss = wave_sum(v * v); v = v * (1.0f / sqrtf(ss * (1.f / 64.f) + EPS)) * F.a->in[I_GKC][lane]; }
            ((bf16_t*)(ws + (kv ? WS_VC : WS_KC)))[(size_t)(row & 8191) * 64 + lane] = (n == 511) ? (bf16_t)0 : (bf16_t)f2bf(v); }
    }
#undef P3_W2LOAD
#undef P3_W2STORE
    __syncthreads();
    LDS_WAIT(); asm volatile("" ::: "memory");
}

__device__ __forceinline__ float dot64(const bf16_t* krow, const f32x4 (&q4)[16]) {
    float s = 0.f;
#pragma unroll
    for (int c = 0; c < 8; ++c) { const u32x4 w = *(const u32x4*)(krow + 8 * c);
        s += q4[2 * c].x * bflo(w.x) + q4[2 * c].y * bfhi(w.x) + q4[2 * c].z * bflo(w.y) + q4[2 * c].w * bfhi(w.y)
           + q4[2 * c + 1].x * bflo(w.z) + q4[2 * c + 1].y * bfhi(w.z) + q4[2 * c + 1].z * bflo(w.w) + q4[2 * c + 1].w * bfhi(w.w); }
    return s;
}
__device__ __forceinline__ void p4_attn_naive(Frame& F) {
    unsigned char* ws = F.ws; const int lane = F.lane, h = F.wave, g = h >> 2;
    LAS float* SC = (LAS float*)F.lds + h * 1024;
    LAS float* PC = (LAS float*)F.lds + 8192 + h * 512;
    LAS float* PCg = (LAS float*)F.lds + 8192;
    LAS float* QS = (LAS float*)F.lds + 12288 + h * 64;
    LAS float* SCORE = (LAS float*)F.lds + 12800;
    LAS int* SEL = (LAS int*)((LAS float*)F.lds + 13056);
    bf16_t* Q = (bf16_t*)(ws + WS_Q); const bf16_t* KV6 = (const bf16_t*)(ws + WS_KV6);
    const bf16_t* KC = (const bf16_t*)(ws + WS_KC); const bf16_t* VC = (const bf16_t*)(ws + WS_VC); const bf16_t* NG = (const bf16_t*)(ws + WS_NG);
    const float slope2 = __builtin_amdgcn_ldexpf(LOG2E, -(h + 1));
    const float NEGB = -1e30f;
    for (int tok = blockIdx.x; tok < T; tok += F.G) {
        const int b = tok >> 13, t = tok & (SEQ - 1), cur = t >> 6;
        QS[lane] = bf2f(Q[(size_t)tok * 512 + h * 64 + lane]);
        LDS_WAIT(); asm volatile("" ::: "memory");
        f32x4 q4[16];
#pragma unroll
        for (int i = 0; i < 16; ++i) q4[i] = *(const LAS f32x4*)(QS + 4 * i);
        const int nvalid = t >= 31 ? ((t - 31) >> 4) + 1 : 0;
        const bf16_t* kcb = KC + (size_t)((b * 2 + g) * 512) * 64; const bf16_t* vcb = VC + (size_t)((b * 2 + g) * 512) * 64;
        float oc = 0.f;
        {
            float mx = NEGB;
            for (int n = lane; n < nvalid; n += 64) { const float x = dot64(kcb + (size_t)n * 64, q4) - slope2 * (float)(t - (16 * n + 31)); SC[n] = x; mx = fmaxf(mx, x); }
            mx = wave_max(mx);
            float sum = 0.f;
            for (int n = lane; n < nvalid; n += 64) { const float p = exp2f(SC[n] - mx); SC[n] = p; sum += p; }
            sum = wave_sum(sum); const float il = nvalid > 0 ? 1.0f / sum : 0.f;
            for (int n = lane; n < 512; n += 64) PC[n] = n < nvalid ? SC[n] * il : 0.f;
            LDS_WAIT(); asm volatile("" ::: "memory");
            for (int n = 0; n < nvalid; ++n) oc += PC[n] * bf2f(vcb[(size_t)n * 64 + lane]);
        }
        __syncthreads();
        if (F.tid < 256) { const int gg = F.tid >> 7, j = F.tid & 127, a = 4 * j; float s = 0.f;
#pragma unroll
            for (int hh = 0; hh < 4; ++hh) { const LAS float* P = PCg + (gg * 4 + hh) * 512; s += (a > 0 ? P[a - 1] : 0.f) + 2.f * (P[a] + P[a + 1] + P[a + 2]) + P[a + 3]; }
            SCORE[gg * 128 + j] = j > cur ? -1e30f : ((j == 0 || j == cur || j == cur - 1) ? 1e30f : s); }
        __syncthreads();
        if (h < 2) { float a = SCORE[h * 128 + lane], bb = SCORE[h * 128 + 64 + lane];
            for (int r = 0; r < NSEL; ++r) { const float m = wave_max(fmaxf(a, bb));
                const unsigned long long ba = __ballot(a == m); int idx;
                if (ba) { idx = __ffsll((long long)ba) - 1; if (lane == idx) a = -3e38f; }
                else { const unsigned long long b2 = __ballot(bb == m); idx = __ffsll((long long)b2) - 1; if (lane == idx) bb = -3e38f; idx += 64; }
                if (lane == 0) SEL[h * 16 + r] = idx; } }
        __syncthreads();
        float os = 0.f;
        {
            float mx = NEGB;
            for (int r = 0; r < NSEL; ++r) { const int j = SEL[g * 16 + r]; float x = NEGB;
                if (j <= cur) { const int pos = 64 * j + lane; if (pos <= t) x = dot64(KV6 + (size_t)(b * SEQ + pos) * 768 + 256 + g * 64, q4) - slope2 * (float)(t - pos); }
                SC[r * 64 + lane] = x; mx = fmaxf(mx, x); }
            mx = wave_max(mx); float sum = 0.f;
            for (int r = 0; r < NSEL; ++r) { const float p = exp2f(SC[r * 64 + lane] - mx); SC[r * 64 + lane] = p; sum += p; }
            sum = wave_sum(sum); const float il = 1.0f / sum;
            LDS_WAIT(); asm volatile("" ::: "memory");
            for (int r = 0; r < NSEL; ++r) { const int j = SEL[g * 16 + r]; if (j > cur) continue;
                const bf16_t* vb = KV6 + (size_t)(b * SEQ + 64 * j) * 768 + 384 + g * 64 + lane; const int kmax = (64 * j + 63 <= t) ? 64 : (t - 64 * j + 1);
                for (int kk = 0; kk < kmax; ++kk) os += SC[r * 64 + kk] * bf2f(vb[(size_t)kk * 768]); }
            os *= il;
        }
        float ow = 0.f;
        {
            float mx = NEGB;
            for (int i = lane; i < WIN; i += 64) { const int pos = t - (WIN - 1) + i; float x = NEGB;
                if (pos >= 0) x = dot64(KV6 + (size_t)(b * SEQ + pos) * 768 + 512 + g * 64, q4) - slope2 * (float)(t - pos);
                SC[i] = x; mx = fmaxf(mx, x); }
            mx = wave_max(mx); float sum = 0.f;
            for (int i = lane; i < WIN; i += 64) { const float p = exp2f(SC[i] - mx); SC[i] = p; sum += p; }
            sum = wave_sum(sum); const float il = 1.0f / sum;
            LDS_WAIT(); asm volatile("" ::: "memory");
            const int i0 = t >= WIN - 1 ? 0 : (WIN - 1 - t);
            for (int i = i0; i < WIN; ++i) { const int pos = t - (WIN - 1) + i; ow += SC[i] * bf2f(KV6[(size_t)(b * SEQ + pos) * 768 + 640 + g * 64 + lane]); }
            ow *= il;
        }
        const float g0 = bf2f(NG[(size_t)tok * 32 + h * 3 + 0]), g1 = bf2f(NG[(size_t)tok * 32 + h * 3 + 1]), g2 = bf2f(NG[(size_t)tok * 32 + h * 3 + 2]);
        ((bf16_t*)(ws + WS_OA))[(size_t)tok * 512 + h * 64 + lane] = (bf16_t)f2bf(g0 * oc + g1 * os + g2 * ow);
        __syncthreads();
    }
}

namespace at {
typedef __attribute__((address_space(3))) const char* lcp;
typedef short s16x4 __attribute__((ext_vector_type(4)));
typedef float f32x16 __attribute__((ext_vector_type(16)));
typedef short v4i16_t __attribute__((ext_vector_type(4)));
constexpr int SLOTB = 8192;
constexpr int NSLOT = 4;
constexpr int L_K = 0, L_V = NSLOT * SLOTB, L_WS = 2 * NSLOT * SLOTB, L_OST = L_WS + 8 * 256, L_IMP = L_OST  , L_SELM = L_OST + 8 * 8192, L_UNION = L_SELM + 1024, L_NTL = L_UNION + 16, L_TL = L_NTL + 16, L_END = L_TL + 512;
static_assert(L_END <= MISC_OFF, "attention LDS");
constexpr float NEGBIG = -1e30f;
__device__ __forceinline__ void glds16(const void* gsrc, unsigned lds_dst) { unsigned keep;
    asm volatile("s_mov_b32 %0, m0\n\ts_mov_b32 m0, %2\n\ts_nop 0\n\tglobal_load_lds_dwordx4 %1, off\n\ts_mov_b32 m0, %0" : "=&s"(keep) : "v"(gsrc), "s"(lds_dst) : "memory"); }
__device__ __forceinline__ void glds16s(const void* sbase, unsigned voff, unsigned lds_dst) { unsigned keep;
    asm volatile("s_mov_b32 %0, m0\n\ts_mov_b32 m0, %3\n\ts_nop 0\n\tglobal_load_lds_dwordx4 %1, %2\n\ts_mov_b32 m0, %0" : "=&s"(keep) : "v"(voff), "s"(sbase), "s"(lds_dst) : "memory"); }
__device__ __forceinline__ unsigned cvtpk(float lo, float hi) { return cvtpk_bf16(lo, hi); }
#define AT_WAIT_BAR(N) asm volatile("s_waitcnt vmcnt(" #N ") lgkmcnt(0)\n\ts_barrier" ::: "memory")
#define AT_SBAR() __builtin_amdgcn_sched_barrier(0)
#define AT_LOCALS(LN) const int lane = LN; const int r32 = lane & 31, hi = lane >> 5, hh = r32 >> 3, qi = r32 & 7; const int tq = q0 + 8 * wid + qi, qoff = 8 * wid + qi; const int h = 4 * g + hh; \
    const float slope2 = __builtin_amdgcn_ldexpf(LOG2E, -(h + 1)); const lcp kp0 = (lcp)lds + L_K + hi * 1024 + r32 * 16; LAS float* gst = (LAS float*)(lds + L_V + 3 * SLOTB) + wid * 128 + lane; (void)hh; (void)qoff; (void)tq; (void)gst; (void)kp0; (void)slope2

template <int KMUL, int MODE>
__device__ __forceinline__ void qk_tile(f32x16& p0, f32x16& p1, lcp kp, const bf16x8 (&qr)[4], float cinit, float slope2, int klim2) {
    f32x16 c;
#pragma unroll
    for (int r = 0; r < 16; ++r) c[r] = cinit;
#pragma unroll
    for (int d0 = 0; d0 < 4; ++d0) {
        const bf16x8 b0 = *(const LAS bf16x8*)(kp + d0 * 2048), b1 = *(const LAS bf16x8*)(kp + d0 * 2048 + 512);
        if (d0 == 0) { p0 = __builtin_amdgcn_mfma_f32_32x32x16_bf16(b0, qr[0], c, 0, 0, 0); p1 = __builtin_amdgcn_mfma_f32_32x32x16_bf16(b1, qr[0], c, 0, 0, 0); }
        else { p0 = __builtin_amdgcn_mfma_f32_32x32x16_bf16(b0, qr[d0], p0, 0, 0, 0); p1 = __builtin_amdgcn_mfma_f32_32x32x16_bf16(b1, qr[d0], p1, 0, 0, 0); }
    }
#pragma unroll
    for (int r = 0; r < 16; ++r) { const int lit = (r & 3) + 8 * (r >> 2);
        float a = slope2 * (float)(KMUL * lit) + p0[r], b = slope2 * (float)(KMUL * (lit + 32)) + p1[r];
        if (MODE == 1) { a = (lit <= klim2) ? a : NEGBIG; b = (lit + 32 <= klim2) ? b : NEGBIG; }
        if (MODE == 2) { a = (lit > klim2) ? a : NEGBIG; b = (lit + 32 > klim2) ? b : NEGBIG; }
        p0[r] = __builtin_amdgcn_exp2f(a); p1[r] = __builtin_amdgcn_exp2f(b); }
}
__device__ __forceinline__ void qk_mfma(f32x16& p0, f32x16& p1, lcp kp, const bf16x8 (&qr)[4], float cinit) {
    f32x16 c;
#pragma unroll
    for (int r = 0; r < 16; ++r) c[r] = cinit;
#pragma unroll
    for (int d0 = 0; d0 < 4; ++d0) {
        const bf16x8 b0 = *(const LAS bf16x8*)(kp + d0 * 2048), b1 = *(const LAS bf16x8*)(kp + d0 * 2048 + 512);
        if (d0 == 0) { p0 = __builtin_amdgcn_mfma_f32_32x32x16_bf16(b0, qr[0], c, 0, 0, 0); p1 = __builtin_amdgcn_mfma_f32_32x32x16_bf16(b1, qr[0], c, 0, 0, 0); }
        else { p0 = __builtin_amdgcn_mfma_f32_32x32x16_bf16(b0, qr[d0], p0, 0, 0, 0); p1 = __builtin_amdgcn_mfma_f32_32x32x16_bf16(b1, qr[d0], p1, 0, 0, 0); }
    }
}
template <int KMUL, int MODE>
__device__ __forceinline__ void sm_valu(f32x16& p0, f32x16& p1, float slope2, int klim2) {
#pragma unroll
    for (int r = 0; r < 16; ++r) { const int lit = (r & 3) + 8 * (r >> 2);
        float a = slope2 * (float)(KMUL * lit) + p0[r], b = slope2 * (float)(KMUL * (lit + 32)) + p1[r];
        if (MODE == 1) { a = (lit <= klim2) ? a : NEGBIG; b = (lit + 32 <= klim2) ? b : NEGBIG; }
        if (MODE == 2) { a = (lit > klim2) ? a : NEGBIG; b = (lit + 32 > klim2) ? b : NEGBIG; }
        p0[r] = __builtin_amdgcn_exp2f(a); p1[r] = __builtin_amdgcn_exp2f(b); }
}
__device__ __forceinline__ float psum(const f32x16& p0, const f32x16& p1) {
    float a = 0.f, b = 0.f;
#pragma unroll
    for (int r = 0; r < 16; r += 2) { a += p0[r] + p1[r]; b += p0[r + 1] + p1[r + 1]; }
    return a + b;
}
__device__ __forceinline__ void pv_tile(f32x16* o, int vb, const f32x16& p0, const f32x16& p1) {
    u32x4 pw[4];
#pragma unroll
    for (int i = 0; i < 4; ++i) { pw[0][i] = cvtpk(p0[2 * i], p0[2 * i + 1]); pw[1][i] = cvtpk(p0[8 + 2 * i], p0[9 + 2 * i]); pw[2][i] = cvtpk(p1[2 * i], p1[2 * i + 1]); pw[3][i] = cvtpk(p1[8 + 2 * i], p1[9 + 2 * i]); }
    s16x4 lo[2][4], hi[2][4];
#pragma unroll
    for (int dh = 0; dh < 2; ++dh)
#pragma unroll
        for (int ks = 0; ks < 4; ++ks) {
            asm volatile("ds_read_b64_tr_b16 %0,%1 offset:%c2" : "=&v"(lo[dh][ks]) : "v"(vb), "i"(dh * 4096 + ks * 1024) : "memory");
            asm volatile("ds_read_b64_tr_b16 %0,%1 offset:%c2" : "=&v"(hi[dh][ks]) : "v"(vb), "i"(dh * 4096 + ks * 1024 + 512) : "memory"); }
    asm volatile("s_waitcnt lgkmcnt(0)" ::: "memory"); AT_SBAR();
#define AT_PK(d, k) (bf16x8){lo[d][k][0], lo[d][k][1], lo[d][k][2], lo[d][k][3], hi[d][k][0], hi[d][k][1], hi[d][k][2], hi[d][k][3]}
#pragma unroll
    for (int ks = 0; ks < 4; ++ks) {
        o[0] = __builtin_amdgcn_mfma_f32_32x32x16_bf16(__builtin_bit_cast(bf16x8, pw[ks]), AT_PK(0, ks), o[0], 0, 0, 0);
        o[1] = __builtin_amdgcn_mfma_f32_32x32x16_bf16(__builtin_bit_cast(bf16x8, pw[ks]), AT_PK(1, ks), o[1], 0, 0, 0); }
#undef AT_PK
}
__device__ __forceinline__ void pv_tile_seq(f32x16* o, int vb, const f32x16& p0, const f32x16& p1) {
    u32x4 pw[4];
#pragma unroll
    for (int i = 0; i < 4; ++i) { pw[0][i] = cvtpk(p0[2 * i], p0[2 * i + 1]); pw[1][i] = cvtpk(p0[8 + 2 * i], p0[9 + 2 * i]); pw[2][i] = cvtpk(p1[2 * i], p1[2 * i + 1]); pw[3][i] = cvtpk(p1[8 + 2 * i], p1[9 + 2 * i]); }
#pragma unroll
    for (int dh = 0; dh < 2; ++dh) { s16x4 lo[4], hi[4];
#pragma unroll
        for (int ks = 0; ks < 4; ++ks) {
            asm volatile("ds_read_b64_tr_b16 %0,%1 offset:%c2" : "=&v"(lo[ks]) : "v"(vb), "i"(dh * 4096 + ks * 1024) : "memory");
            asm volatile("ds_read_b64_tr_b16 %0,%1 offset:%c2" : "=&v"(hi[ks]) : "v"(vb), "i"(dh * 4096 + ks * 1024 + 512) : "memory"); }
        asm volatile("s_waitcnt lgkmcnt(0)" ::: "memory"); AT_SBAR();
#define AT_PK(k) (bf16x8){lo[k][0], lo[k][1], lo[k][2], lo[k][3], hi[k][0], hi[k][1], hi[k][2], hi[k][3]}
        o[dh] = __builtin_amdgcn_mfma_f32_32x32x16_bf16(__builtin_bit_cast(bf16x8, pw[0]), AT_PK(0), o[dh], 0, 0, 0);
        o[dh] = __builtin_amdgcn_mfma_f32_32x32x16_bf16(__builtin_bit_cast(bf16x8, pw[1]), AT_PK(1), o[dh], 0, 0, 0);
        o[dh] = __builtin_amdgcn_mfma_f32_32x32x16_bf16(__builtin_bit_cast(bf16x8, pw[2]), AT_PK(2), o[dh], 0, 0, 0);
        o[dh] = __builtin_amdgcn_mfma_f32_32x32x16_bf16(__builtin_bit_cast(bf16x8, pw[3]), AT_PK(3), o[dh], 0, 0, 0);
#undef AT_PK
    }
}
template <class Br>
__device__ __forceinline__ void stream_pv(const Br br, const int nt, f32x16 (&o)[2], float& lsum, const bf16x8 (&qr)[4], lcp kp0, int vb0, unsigned kdst, unsigned vdst, float slope2) {
    if (nt <= 0) return;
    f32x16 s0, s1;
#define AT_ISSUE(t) do { glds16(br.ksrc(t), kdst + ((t) & 3) * SLOTB); glds16(br.vsrc(t), vdst + ((t) & 3) * SLOTB); } while (0)
    AT_ISSUE(0); if (nt > 1) AT_ISSUE(1); if (nt > 2) AT_ISSUE(2);
    for (int t = 0; t < nt; ++t) {
        if (t + 2 < nt) { AT_WAIT_BAR(4); } else if (t + 1 < nt) { AT_WAIT_BAR(2); } else { AT_WAIT_BAR(0); }
        if (t + 3 < nt) AT_ISSUE(t + 3);
        float ci; int kl, md; bool ac; br.info(t, ci, kl, md, ac);
        if (ac) { qk_mfma(s0, s1, kp0 + (t & 3) * SLOTB, qr, ci);
            if (md == 0) sm_valu<1, 0>(s0, s1, slope2, 0); else if (md == 1) sm_valu<1, 1>(s0, s1, slope2, kl); else sm_valu<1, 2>(s0, s1, slope2, kl);
            lsum += psum(s0, s1); pv_tile(o, vb0 + (t & 3) * SLOTB, s0, s1); }
    }
    AT_WAIT_BAR(0);
#undef AT_ISSUE
}

typedef short v4i16_t2 __attribute__((ext_vector_type(4)));
__device__ __forceinline__ s16x4 vtr(lcp p) { return __builtin_bit_cast(s16x4, __builtin_amdgcn_ds_read_tr16_b64_v4i16((__attribute__((address_space(3))) v4i16_t2*)p)); }
__device__ __forceinline__ void kload2(bf16x8* kf, lcp kp, int j) { kf[2 * j] = *(const LAS bf16x8*)(kp + j * 2048); kf[2 * j + 1] = *(const LAS bf16x8*)(kp + j * 2048 + 512); }
template <class Br>
__device__ __forceinline__ void stream2(Br br, const int nt, f32x16 (&o)[2], float& lsum, const bf16x8 (&qr)[4], lcp kp0, lcp vp0, unsigned kdst, unsigned vdst, float slope2, const int lane, const int wid) {
    if (nt <= 0) return;
#define klim2 (8 * wid + (lane & 7) - 4 * (lane >> 5))
    const int vb0 = (int)(unsigned)(uintptr_t)vp0;
#define S2_DK(off, t, slot) br.dk(off, t, kdst + (unsigned)(slot))
#define S2_DV(off, t, slot) br.dv(off, t, vdst + (unsigned)(slot))
    br.start(nt);
    S2_DK(0, 0, 0); S2_DV(0, 0, 0); if (nt > 1) S2_DK(1, 1, SLOTB); if (nt > 2) S2_DK(2, 2, 2 * SLOTB);
    if (nt > 2) { AT_WAIT_BAR(3); } else if (nt > 1) { AT_WAIT_BAR(2); } else { AT_WAIT_BAR(1); }
    f32x16 pA0, pA1, pB0, pB1;
    const bool odd = (nt & 1) != 0;
    { const float ci = br.cinit(0, 0); const int md = br.mode(0, 0); f32x16 q0_, q1_; qk_mfma(q0_, q1_, kp0, qr, ci);
      if (md == 0) sm_valu<1, 0>(q0_, q1_, slope2, 0); else if (md == 1) sm_valu<1, 1>(q0_, q1_, slope2, klim2); else sm_valu<1, 2>(q0_, q1_, slope2, klim2);
      if (odd) { pB0 = q0_; pB1 = q1_; } else { pA0 = q0_; pA1 = q1_; } }
    AT_WAIT_BAR(0);
    if (nt > 3) S2_DK(3, 3, 0); if (nt > 1) S2_DV(1, 1, SLOTB);
    float ci_cur = br.cinit(1, 1); br.advance(nt, 1);
    int sl_prev = 0, sl_cur = 0, sl_next = SLOTB;
#define S2_ROT() do { sl_prev = sl_cur; sl_cur = sl_next; sl_next = (sl_next == 2 * SLOTB) ? 0 : sl_next + SLOTB; } while (0)
    bf16x8 kf[8];
    if (nt > 1) { S2_ROT(); kload2(kf, kp0 + sl_cur, 0); kload2(kf, kp0 + sl_cur, 1); kload2(kf, kp0 + sl_cur, 2); kload2(kf, kp0 + sl_cur, 3); }
    if (nt > 3) { AT_WAIT_BAR(2); } else if (nt > 2) { AT_WAIT_BAR(1); } else { AT_WAIT_BAR(0); }
    s16x4 vlo[8], vhi[8]; u32x4 pw0, pw1, pw2, pw3;
#define S2_PKW(P, B) cvtpk(P[B], P[(B) + 1])
#define S2_PAF(k) __builtin_bit_cast(bf16x8, pw##k)
#define S2_VFR(i) (bf16x8){vlo[i][0], vlo[i][1], vlo[i][2], vlo[i][3], vhi[i][0], vhi[i][1], vhi[i][2], vhi[i][3]}
#define S2_PIN(x) asm volatile("" : "+v"(x))
#define S2_GAPA(MF, A0, A1, A2, A3, W0, W1, PW) do { MF; sacc += A0; sacc += A1; sacc += A2; sacc += A3; S2_PIN(sacc); W0; W1; S2_PIN(PW); AT_SBAR(); } while (0)
#define S2_LIT(B, i, OFS) ((float)((((B) + (i)) & 3) + 8 * (((B) + (i)) >> 2) + (OFS)))
#define S2_E1(X, B, i, OFS, MODE) do { float a_ = slope2 * S2_LIT(B, i, OFS) + X[(B) + (i)]; \
        if (MODE == 1) a_ = ((int)S2_LIT(B, i, OFS) <= klim2) ? a_ : NEGBIG; if (MODE == 2) a_ = ((int)S2_LIT(B, i, OFS) > klim2) ? a_ : NEGBIG; X[(B) + (i)] = __builtin_amdgcn_exp2f(a_); } while (0)
#define S2_GAPB(MF, X, B, OFS, MODE) do { MF; S2_E1(X, B, 0, OFS, MODE); S2_E1(X, B, 1, OFS, MODE); S2_E1(X, B, 2, OFS, MODE); S2_E1(X, B, 3, OFS, MODE); S2_PIN(X); AT_SBAR(); } while (0)
#define S2_VRD(i) do { vlo[i] = vtr(vp_ + (((i) >> 2) * 4096 + ((i) & 3) * 1024)); vhi[i] = vtr(vp_ + (((i) >> 2) * 4096 + ((i) & 3) * 1024 + 512)); } while (0)
#define S2_KRD(G, j) do { if (G) { kload2(kf, kp0 + sl_next, j); AT_SBAR(); } } while (0)
#define S2_STEP(C0, C1, P0, P1, t, GK, GV, GL, MODE) do { AT_SBAR(); \
    const lcp vp_ = vp0 + sl_prev; \
    S2_VRD(0); AT_SBAR(); float sacc = (P0[0] + P0[1]); \
    S2_GAPA(C0 = __builtin_amdgcn_mfma_f32_32x32x16_bf16(kf[0], qr[0], C0, 0, 0, 0), P0[2], P0[3], P0[4], P0[5], pw0[0] = S2_PKW(P0, 0), pw0[1] = S2_PKW(P0, 2), pw0); \
    S2_VRD(4); AT_SBAR(); S2_GAPA(C1 = __builtin_amdgcn_mfma_f32_32x32x16_bf16(kf[1], qr[0], C1, 0, 0, 0), P0[6], P0[7], P0[8], P0[9], pw0[2] = S2_PKW(P0, 4), pw0[3] = S2_PKW(P0, 6), pw0); \
    S2_VRD(1); AT_SBAR(); S2_GAPA(C0 = __builtin_amdgcn_mfma_f32_32x32x16_bf16(kf[2], qr[1], C0, 0, 0, 0), P0[10], P0[11], P0[12], P0[13], pw1[0] = S2_PKW(P0, 8), pw1[1] = S2_PKW(P0, 10), pw1); \
    S2_VRD(5); AT_SBAR(); S2_GAPA(C1 = __builtin_amdgcn_mfma_f32_32x32x16_bf16(kf[3], qr[1], C1, 0, 0, 0), P0[14], P0[15], P1[0], P1[1], pw1[2] = S2_PKW(P0, 12), pw1[3] = S2_PKW(P0, 14), pw1); \
    S2_VRD(2); AT_SBAR(); S2_GAPA(C0 = __builtin_amdgcn_mfma_f32_32x32x16_bf16(kf[4], qr[2], C0, 0, 0, 0), P1[2], P1[3], P1[4], P1[5], pw2[0] = S2_PKW(P1, 0), pw2[1] = S2_PKW(P1, 2), pw2); \
    S2_VRD(6); AT_SBAR(); S2_GAPA(C1 = __builtin_amdgcn_mfma_f32_32x32x16_bf16(kf[5], qr[2], C1, 0, 0, 0), P1[6], P1[7], P1[8], P1[9], pw2[2] = S2_PKW(P1, 4), pw2[3] = S2_PKW(P1, 6), pw2); \
    S2_VRD(3); AT_SBAR(); S2_GAPA(C0 = __builtin_amdgcn_mfma_f32_32x32x16_bf16(kf[6], qr[3], C0, 0, 0, 0), P1[10], P1[11], P1[12], P1[13], pw3[0] = S2_PKW(P1, 8), pw3[1] = S2_PKW(P1, 10), pw3); \
    S2_VRD(7); AT_SBAR(); S2_GAPA(C1 = __builtin_amdgcn_mfma_f32_32x32x16_bf16(kf[7], qr[3], C1, 0, 0, 0), P1[14], P1[15], 0.f, 0.f, pw3[2] = S2_PKW(P1, 12), pw3[3] = S2_PKW(P1, 14), pw3); \
    lsum += sacc; \
    if (GK) { S2_DK(3, (t) + 3, sl_cur); } if (GV) { S2_DV(1, (t) + 1, sl_next); } \
    AT_SBAR(); \
    S2_GAPB(o[0] = __builtin_amdgcn_mfma_f32_32x32x16_bf16(S2_PAF(0), S2_VFR(0), o[0], 0, 0, 0), C0, 0, 0, MODE); \
    S2_GAPB(o[1] = __builtin_amdgcn_mfma_f32_32x32x16_bf16(S2_PAF(0), S2_VFR(4), o[1], 0, 0, 0), C0, 4, 0, MODE); \
    S2_KRD(GL, 0); S2_GAPB(o[0] = __builtin_amdgcn_mfma_f32_32x32x16_bf16(S2_PAF(1), S2_VFR(1), o[0], 0, 0, 0), C0, 8, 0, MODE); \
    S2_KRD(GL, 1); S2_GAPB(o[1] = __builtin_amdgcn_mfma_f32_32x32x16_bf16(S2_PAF(1), S2_VFR(5), o[1], 0, 0, 0), C0, 12, 0, MODE); \
    S2_KRD(GL, 2); S2_GAPB(o[0] = __builtin_amdgcn_mfma_f32_32x32x16_bf16(S2_PAF(2), S2_VFR(2), o[0], 0, 0, 0), C1, 0, 32, MODE); \
    S2_KRD(GL, 3); S2_GAPB(o[1] = __builtin_amdgcn_mfma_f32_32x32x16_bf16(S2_PAF(2), S2_VFR(6), o[1], 0, 0, 0), C1, 4, 32, MODE); \
    S2_GAPB(o[0] = __builtin_amdgcn_mfma_f32_32x32x16_bf16(S2_PAF(3), S2_VFR(3), o[0], 0, 0, 0), C1, 8, 32, MODE); \
    S2_GAPB(o[1] = __builtin_amdgcn_mfma_f32_32x32x16_bf16(S2_PAF(3), S2_VFR(7), o[1], 0, 0, 0), C1, 12, 32, MODE); \
    } while (0)
#define S2_ENDW(tt) do { if ((tt) + 3 < nt) { AT_WAIT_BAR(2); } else if ((tt) + 2 < nt) { AT_WAIT_BAR(1); } else { AT_WAIT_BAR(0); } } while (0)
#define S2_CV(C0, C1, t) do { const float ci_ = ci_cur; float ci2_ = ci_cur; asm volatile("" : "+v"(ci2_)); _Pragma("unroll") for (int r = 0; r < 16; ++r) C0[r] = ci_; S2_PIN(C0); \
        _Pragma("unroll") for (int r = 0; r < 16; ++r) C1[r] = ci2_; S2_PIN(C1); } while (0)
#define S2_RUN(C0, C1, P0, P1, t) do { S2_CV(C0, C1, t); const bool gk_ = (t) + 3 < nt; S2_STEP(C0, C1, P0, P1, t, gk_, true, true, 0); ci_cur = br.cinit(1, (t) + 1); S2_ENDW(t); S2_ROT(); br.advance(nt, (t) + 1); } while (0)
    int t = 1;
    if (odd && nt >= 3) { S2_RUN(pA0, pA1, pB0, pB1, 1); t = 2; }
    for (; t + 2 < nt; t += 2) { S2_RUN(pB0, pB1, pA0, pA1, t); S2_RUN(pA0, pA1, pB0, pB1, t + 1); }
    if (nt >= 2) { S2_CV(pB0, pB1, t); S2_STEP(pB0, pB1, pA0, pA1, t, false, false, false, 1); }
    lsum += psum(pB0, pB1); pv_tile_seq(o, vb0 + sl_cur, pB0, pB1);
    AT_WAIT_BAR(0);
#undef klim2
#undef S2_DK
#undef S2_DV
#undef S2_ROT
#undef S2_PKW
#undef S2_PAF
#undef S2_VFR
#undef S2_PIN
#undef S2_GAPA
#undef S2_LIT
#undef S2_E1
#undef S2_GAPB
#undef S2_VRD
#undef S2_KRD
#undef S2_STEP
#undef S2_ENDW
#undef S2_CV
#undef S2_RUN
}
}

__device__ __forceinline__ void p4_attn(Frame& F) {
    using namespace at;
    unsigned char* ws = F.ws; const int wid = F.wave;
    LAS unsigned char* lds = F.lds;
    const unsigned lds0 = (unsigned)(uintptr_t)lds;
    bf16_t* Q = (bf16_t*)(ws + WS_Q); const bf16_t* KV6 = (const bf16_t*)(ws + WS_KV6);
    const bf16_t* KC = (const bf16_t*)(ws + WS_KC); const bf16_t* VC = (const bf16_t*)(ws + WS_VC); const bf16_t* NG = (const bf16_t*)(ws + WS_NG);
    LAS unsigned* selm = (LAS unsigned*)(lds + L_SELM);
    LAS unsigned* uni = (LAS unsigned*)(lds + L_UNION);
    LAS int* ntl = (LAS int*)(lds + L_NTL);
    LAS int* tl = (LAS int*)(lds + L_TL);
    const unsigned kdst = lds0 + L_K + wid * 1024, vdst = lds0 + L_V + wid * 1024;
    float MREF;
    { float gqm = fabsf(F.a->in[I_GQ][F.lane]), gkm = fmaxf(fmaxf(fabsf(F.a->in[I_GKC][F.lane]), fabsf(F.a->in[I_GKS][F.lane])), fabsf(F.a->in[I_GKW][F.lane]));
      gqm = wave_max(gqm); gkm = wave_max(gkm); MREF = __builtin_bit_cast(float, __builtin_amdgcn_readfirstlane(__builtin_bit_cast(int, 64.0f * QSCALE * gqm * gkm * 1.03f))); }
    LAS float* gql = (LAS float*)(lds + L_V + 3 * SLOTB + 4096);
    if (F.tid < 64) gql[F.tid] = F.a->in[I_GQ][F.tid];
    __syncthreads();
    bf16x8 qraw[4]; bf16_t ngr[3];
#define AT_QLOAD(U, LN) do { const int r32_ = (LN) & 31, hi_ = (LN) >> 5, hh_ = r32_ >> 3, qi_ = r32_ & 7; const int s16_ = F.vcu & 15, bg_ = F.vcu >> 4; \
        const int qt_ = ((U) >> 1) * 32 + (((U) & 1) ? 31 - s16_ : s16_); const unsigned tok_ = (unsigned)((bg_ >> 1) * SEQ + qt_ * 64 + 8 * wid + qi_); const int h_ = 4 * (bg_ & 1) + hh_; \
        _Pragma("unroll") for (int d0 = 0; d0 < 4; ++d0) qraw[d0] = *(const bf16x8*)(ws + ((unsigned)WS_Q + (tok_ * 512u + (unsigned)(h_ * 64 + d0 * 16 + hi_ * 8)) * 2u)); \
        const bf16_t* ngp_ = (const bf16_t*)(ws + ((unsigned)WS_NG + (tok_ * 32u + (unsigned)(h_ * 3)) * 2u)); ngr[0] = ngp_[0]; ngr[1] = ngp_[1]; ngr[2] = ngp_[2]; } while (0)
    if (F.G == 256) AT_QLOAD(0, F.lane);
    for (int ui = 0; ui < 8; ++ui) {
        if (F.G != 256) break;
        int lane = F.lane; asm volatile("" : "+v"(lane));
        const int r32 = lane & 31, hi = lane >> 5, hh = r32 >> 3, qi = r32 & 7;
        LAS float* wsf = (LAS float*)(lds + L_WS) + wid * 64;
        LAS float* impw = (LAS float*)(lds + L_IMP) + wid * 2048;
        LAS float* ostg = (LAS float*)(lds + L_OST) + wid * 2048;
        const lcp kp0 = (lcp)lds + L_K + hi * 1024 + r32 * 16;
        const int vb0 = (int)(lds0 + L_V) + ((lane >> 4) & 1) * 32 + (lane & 3) * 8 + (4 * hi + ((lane & 15) >> 2)) * 64;
        const int bg = F.vcu >> 4, s16 = F.vcu & 15;
        const int qt = (ui >> 1) * 32 + ((ui & 1) ? 31 - s16 : s16);
        const int b = bg >> 1, g = bg & 1, q0 = qt * 64, cur = qt;
        const int tq = q0 + 8 * wid + qi, qoff = 8 * wid + qi;
        const int h = 4 * g + hh;
        const float slope2 = __builtin_amdgcn_ldexpf(LOG2E, -(h + 1));
        const size_t tok = (size_t)b * SEQ + tq;
        bf16x8 qr[4];
#pragma unroll
        for (int d0 = 0; d0 < 4; ++d0) qr[d0] = qraw[d0];
        {
            float xq[4][8]; float ss = 0.f;
#pragma unroll
            for (int d0 = 0; d0 < 4; ++d0) { const u32x4 w = __builtin_bit_cast(u32x4, qr[d0]);
#pragma unroll
                for (int k = 0; k < 4; ++k) { xq[d0][2 * k] = bflo(w[k]); xq[d0][2 * k + 1] = bfhi(w[k]); ss += xq[d0][2 * k] * xq[d0][2 * k] + xq[d0][2 * k + 1] * xq[d0][2 * k + 1]; } }
            ss += __shfl_xor(ss, 32);
            const float rs = QSCALE * __builtin_amdgcn_rsqf(ss * (1.f / 64.f) + EPS);
#pragma unroll
            for (int d0 = 0; d0 < 4; ++d0) { const f32x4 ga = *(const LAS f32x4*)(gql + d0 * 16 + hi * 8), gb = *(const LAS f32x4*)(gql + d0 * 16 + hi * 8 + 4);
                u32x4 w; w.x = cvtpk_bf16(xq[d0][0] * rs * ga.x, xq[d0][1] * rs * ga.y); w.y = cvtpk_bf16(xq[d0][2] * rs * ga.z, xq[d0][3] * rs * ga.w);
                w.z = cvtpk_bf16(xq[d0][4] * rs * gb.x, xq[d0][5] * rs * gb.y); w.w = cvtpk_bf16(xq[d0][6] * rs * gb.z, xq[d0][7] * rs * gb.w);
                qr[d0] = __builtin_bit_cast(bf16x8, w); }
        }
        const float g0 = bf2f(ngr[0]);
        LAS float* gst = (LAS float*)(lds + L_V + 3 * SLOTB) + wid * 128 + lane;
        gst[0] = bf2f(ngr[1]); gst[64] = bf2f(ngr[2]);
        f32x16 o[2], p0, p1;
#pragma unroll
        for (int i = 0; i < 4; ++i) { const float zf = (float)(lane >> 6);
            *(LAS f32x4*)(impw + (i * 64 + lane) * 4) = (f32x4){zf, zf, zf, zf}; }
        const int tidu = wid * 64 + lane;
        if (tidu < 4) uni[tidu] = 0u;
        const unsigned kcl = (unsigned)WS_KC + (unsigned)(((b * 2 + g) * 512 + lane) * 64 + wid * 8) * 2u;
        const unsigned vcl = (unsigned)WS_VC + (unsigned)(((b * 2 + g) * 512 + 16 * (wid & 3) + (lane >> 2)) * 64 + (wid >> 2) * 32 + (lane & 3) * 8) * 2u;
        const int ntc = (4 * cur + 3 + 63) >> 6;
        const int nmax = tq >= 31 ? ((tq - 31) >> 4) : -1;
        const int nfull = cur >= 1 ? (4 * cur - 2) : -1;
        float lsum = 0.f;
#define AT_KOFF_C(t) (kcl + (unsigned)(t) * 8192u)
#define AT_VOFF_C(t) (vcl + (unsigned)(t) * 8192u)
        if (ntc > 0) {
            glds16s(ws, AT_KOFF_C(0), kdst); if (ntc > 1) glds16s(ws, AT_KOFF_C(1), kdst + SLOTB);
            for (int t = 0; t < ntc; ++t) {
                if (t + 1 < ntc) { AT_WAIT_BAR(1); } else { AT_WAIT_BAR(0); }
                if (t + 2 < ntc) glds16s(ws, AT_KOFF_C(t + 2), kdst + ((t + 2) % 3) * SLOTB);
                const float cinit = -slope2 * (float)(tq - 31 - 1024 * t) + slope2 * (float)(64 * hi) - MREF;
                const int klim2 = nmax - 64 * t - 4 * hi;
                if (64 * t + 63 <= nfull) qk_tile<16, 0>(p0, p1, kp0 + (t % 3) * SLOTB, qr, cinit, slope2, 0);
                else qk_tile<16, 1>(p0, p1, kp0 + (t % 3) * SLOTB, qr, cinit, slope2, klim2);
                lsum += psum(p0, p1);
            }
            AT_WAIT_BAR(0);
        }
        lsum += __shfl_xor(lsum, 32);
        const float lg2l = lsum > 0.f ? __builtin_amdgcn_logf(lsum) : 0.f;
        o[0] = f32x16{}; o[1] = f32x16{};
        if (ntc > 0) {
            float cin = 0.f;
            glds16s(ws, AT_KOFF_C(0), kdst); glds16s(ws, AT_VOFF_C(0), vdst); if (ntc > 1) { glds16s(ws, AT_KOFF_C(1), kdst + SLOTB); glds16s(ws, AT_VOFF_C(1), vdst + SLOTB); }
            for (int t = 0; t < ntc; ++t) {
                if (t + 1 < ntc) { AT_WAIT_BAR(2); } else { AT_WAIT_BAR(0); }
                if (t + 2 < ntc) { glds16s(ws, AT_KOFF_C(t + 2), kdst + ((t + 2) % 3) * SLOTB); glds16s(ws, AT_VOFF_C(t + 2), vdst + ((t + 2) % 3) * SLOTB); }
                const float cinit = -slope2 * (float)(tq - 31 - 1024 * t) + slope2 * (float)(64 * hi) - MREF - lg2l;
                const int klim2 = nmax - 64 * t - 4 * hi;
                if (64 * t + 63 <= nfull) qk_tile<16, 0>(p0, p1, kp0 + (t % 3) * SLOTB, qr, cinit, slope2, 0);
                else qk_tile<16, 1>(p0, p1, kp0 + (t % 3) * SLOTB, qr, cinit, slope2, klim2);
                float mn[8], cy[8];
#pragma unroll
                for (int a = 0; a < 4; ++a) { mn[a] = 2.f * (p0[4 * a] + p0[4 * a + 1] + p0[4 * a + 2]) + p0[4 * a + 3]; cy[a] = p0[4 * a + 3];
                                              mn[4 + a] = 2.f * (p1[4 * a] + p1[4 * a + 1] + p1[4 * a + 2]) + p1[4 * a + 3]; cy[4 + a] = p1[4 * a + 3]; }
                float rc[8];
#pragma unroll
                for (int a = 0; a < 8; ++a) { const auto rr = __builtin_amdgcn_permlane32_swap(__float_as_uint(cy[a]), __float_as_uint(cy[a]), false, false); rc[a] = __uint_as_float(hi ? rr[0] : rr[1]); }
                if (hi) {
#pragma unroll
                    for (int a = 0; a < 8; ++a) mn[a] += rc[a];
                } else { mn[0] += cin;
#pragma unroll
                    for (int a = 1; a < 8; ++a) mn[a] += rc[a - 1];
                    cin = rc[7]; }
#pragma unroll
                for (int a = 0; a < 8; ++a) { mn[a] += __uint_as_float((unsigned)__builtin_amdgcn_update_dpp(0, (int)__float_as_uint(mn[a]), 0x128, 0xf, 0xf, false));
                    const auto rr = __builtin_amdgcn_permlane16_swap(__float_as_uint(mn[a]), __float_as_uint(mn[a]), false, false); mn[a] = __uint_as_float(rr[0]) + __uint_as_float(rr[1]); }
                if (hh == 0) {
#pragma unroll
                    for (int a = 0; a < 8; ++a) impw[qi * 128 + 16 * t + 2 * a + hi] = mn[a]; }
                pv_tile_seq(o, vb0 + (t % 3) * SLOTB, p0, p1);
            }
            AT_WAIT_BAR(0);
        }
        {
            const int qi8 = lane >> 3, s8 = lane & 7;
            unsigned key[16];
#pragma unroll
            for (int k = 0; k < 16; ++k) { const int j = s8 + 8 * k; const float v = impw[qi8 * 128 + j];
                const bool forced = (j == 0) || (j == cur) || (j == cur - 1);
                key[k] = j > cur ? 0u : ((forced ? 0xFFFFFF80u : (__builtin_bit_cast(unsigned, v) & 0xFFFFFF80u)) | (unsigned)(127 - j)); }
            unsigned bits = 0u;
            if (cur < NSEL) {
#pragma unroll
                for (int k = 0; k < 16; ++k) bits |= ((key[k] | (0u - key[k])) >> 31) << k;
            } else {
                { const int c1 = cur - 1; const unsigned b0 = (s8 == 0) ? 1u : 0u, bc = (s8 == (cur & 7)) ? 1u : 0u, b1 = (s8 == (c1 & 7)) ? 1u : 0u;
                  bits = b0 | (bc << (cur >> 3)) | (b1 << (c1 >> 3)); }
#pragma unroll
                for (int k = 0; k < 16; ++k) { const unsigned keep = ((bits >> k) & 1u) - 1u; key[k] &= keep; }
                for (int rnd = 0; rnd < NSEL - 3; ++rnd) {
                    unsigned m = key[0];
#pragma unroll
                    for (int k = 1; k < 16; ++k) m = m > key[k] ? m : key[k];
                    { unsigned t2 = (unsigned)__builtin_amdgcn_update_dpp(0, (int)m, 0xB1, 0xf, 0xf, false); m = m > t2 ? m : t2;
                      t2 = (unsigned)__builtin_amdgcn_update_dpp(0, (int)m, 0x4E, 0xf, 0xf, false); m = m > t2 ? m : t2;
                      t2 = (unsigned)__builtin_amdgcn_update_dpp(0, (int)m, 0x141, 0xf, 0xf, false); m = m > t2 ? m : t2; }
                    const unsigned jw = 127u - (m & 127u);
                    bits |= (m != 0u && (jw & 7u) == (unsigned)s8) ? (1u << (jw >> 3)) : 0u;
#pragma unroll
                    for (int k = 0; k < 16; ++k) key[k] = (key[k] == m) ? 0u : key[k];
                }
            }
            unsigned w4[4];
#pragma unroll
            for (int q = 0; q < 4; ++q) { unsigned w = 0u;
#pragma unroll
                for (int kk = 0; kk < 4; ++kk) w |= ((bits >> (4 * q + kk)) & 1u) << (s8 + 8 * kk);
                w |= (unsigned)__shfl_xor((int)w, 1); w |= (unsigned)__shfl_xor((int)w, 2); w |= (unsigned)__shfl_xor((int)w, 4); w4[q] = w; }
            if (s8 == 0) {
#pragma unroll
                for (int q = 0; q < 4; ++q) { selm[(8 * wid + qi8) * 4 + q] = w4[q]; __hip_atomic_fetch_or(&uni[q], w4[q], __ATOMIC_RELAXED, __HIP_MEMORY_SCOPE_WORKGROUP); } }
        }
        { if (hi == 0) wsf[r32] = g0; LDS_WAIT(); asm volatile("" ::: "memory");
#pragma unroll
          for (int a = 0; a < 4; ++a) { const f32x4 sc = *(const LAS f32x4*)(wsf + 8 * a + 4 * hi);
#pragma unroll
              for (int k = 0; k < 4; ++k) { const int c = 8 * a + 4 * hi + k; ostg[c * 64 + r32] = o[0][4 * a + k] * sc[k]; ostg[c * 64 + 32 + r32] = o[1][4 * a + k] * sc[k]; } }
          LDS_WAIT(); asm volatile("" ::: "memory"); }
        AT_WAIT_BAR(0);
        if (tidu < 128) { const int j = tidu; const unsigned u0 = uni[0], u1 = uni[1], u2 = uni[2], u3 = uni[3];
            const unsigned wsel = j < 32 ? u0 : j < 64 ? u1 : j < 96 ? u2 : u3;
            if ((wsel >> (j & 31)) & 1u) { int pos = __builtin_popcount(wsel & ((1u << (j & 31)) - 1u));
                if (j >= 32) pos += __builtin_popcount(u0); if (j >= 64) pos += __builtin_popcount(u1); if (j >= 96) pos += __builtin_popcount(u2);
                tl[pos] = j; }
            if (j == 0) ntl[0] = __builtin_popcount(u0) + __builtin_popcount(u1) + __builtin_popcount(u2) + __builtin_popcount(u3); }
        AT_WAIT_BAR(0);
        int lnS = lane; asm volatile("" : "+v"(lnS));
        {
            AT_LOCALS(lnS);
            const int nt = __builtin_amdgcn_readfirstlane(ntl[0]);
            o[0] = f32x16{}; o[1] = f32x16{}; lsum = 0.f;
            { const lcp vp0 = (lcp)lds + L_V + ((lane >> 4) & 1) * 32 + (lane & 3) * 8 + (4 * hi + ((lane & 15) >> 2)) * 64;
              struct BrSel2 { const unsigned char* wsb; const LAS int* tl; unsigned kvo, vvo; const LAS unsigned* sm; float cb0, slope2; int cur; int q0, q1, q2, q3;
                  __device__ __forceinline__ int jat(int i) const { return __builtin_amdgcn_readfirstlane(tl[i]); }
                  __device__ __forceinline__ void start(int nt) { q0 = jat(0); q1 = jat(nt > 1 ? 1 : nt - 1); q2 = jat(nt > 2 ? 2 : nt - 1); q3 = jat(nt > 3 ? 3 : nt - 1); }
                  __device__ __forceinline__ void advance(int nt, int tn) { q0 = q1; q1 = q2; q2 = q3; q3 = jat(tn + 3 < nt ? tn + 3 : nt - 1); }
                  __device__ __forceinline__ int jo(int off) const { return off == 0 ? q0 : off == 1 ? q1 : off == 2 ? q2 : q3; }
                  __device__ __forceinline__ void dk(int off, int, unsigned dst) const { glds16s(wsb, kvo + (unsigned)jo(off) * (64u * 768u * 2u), dst); }
                  __device__ __forceinline__ void dv(int off, int, unsigned dst) const { glds16s(wsb, vvo + (unsigned)jo(off) * (64u * 768u * 2u), dst); }
                  __device__ __forceinline__ float cinit(int off, int) const { const int j = jo(off); const bool mine = (sm[j >> 5] >> (j & 31)) & 1u; return mine ? cb0 + slope2 * (float)(64 * j) : NEGBIG; }
                  __device__ __forceinline__ int mode(int off, int) const { return (jo(off) == cur) ? 1 : 0; } };
              const BrSel2 br2{ws, tl, (unsigned)WS_KV6 + (unsigned)((b * SEQ + lane) * 768 + 256 + g * 64 + wid * 8) * 2u,
                               (unsigned)WS_KV6 + (unsigned)((b * SEQ + 16 * (wid & 3) + (lane >> 2)) * 768 + 384 + g * 64 + (wid >> 2) * 32 + (lane & 3) * 8) * 2u,
                               selm + (8 * wid + qi) * 4, -slope2 * (float)tq + slope2 * (float)(4 * hi) - MREF, slope2, cur, 0, 0, 0, 0};
              stream2(br2, nt, o, lsum, qr, kp0, vp0, kdst, vdst, slope2, lane, wid); }
            lsum += __shfl_xor(lsum, 32);
            if (hi == 0) wsf[r32] = gst[0] * __builtin_amdgcn_rcpf(lsum); LDS_WAIT(); asm volatile("" ::: "memory");
#pragma unroll
            for (int a = 0; a < 4; ++a) { const f32x4 sc = *(const LAS f32x4*)(wsf + 8 * a + 4 * hi);
#pragma unroll
                for (int k = 0; k < 4; ++k) { const int c = 8 * a + 4 * hi + k; ostg[c * 64 + r32] += o[0][4 * a + k] * sc[k]; ostg[c * 64 + 32 + r32] += o[1][4 * a + k] * sc[k]; } }
            LDS_WAIT(); asm volatile("" ::: "memory");
        }
        int lnW = lnS; asm volatile("" : "+v"(lnW));
        {
            AT_LOCALS(lnW);
            const int wi0 = cur >= 8 ? 0 : 8 - cur; const int nt = 9 - wi0;
            const int pbase = q0 - 512 + 64 * wi0;
            o[0] = f32x16{}; o[1] = f32x16{}; lsum = 0.f;
            { const lcp vp0 = (lcp)lds + L_V + ((lane >> 4) & 1) * 32 + (lane & 3) * 8 + (4 * hi + ((lane & 15) >> 2)) * 64;
              struct BrWin2 { const unsigned char* wsb; unsigned kvo, vvo; float cbase, slope2; int wi0;
                  __device__ __forceinline__ void start(int) {}
                  __device__ __forceinline__ void advance(int, int) {}
                  __device__ __forceinline__ void dk(int, int t, unsigned dst) const { glds16s(wsb, kvo + (unsigned)t * (64u * 768u * 2u), dst); }
                  __device__ __forceinline__ void dv(int, int t, unsigned dst) const { glds16s(wsb, vvo + (unsigned)t * (64u * 768u * 2u), dst); }
                  __device__ __forceinline__ float cinit(int, int t) const { return cbase + (float)(64 * t) * slope2; }
                  __device__ __forceinline__ int mode(int, int t) const { const int wi = wi0 + t; return (wi == 8) ? 1 : (wi == 0) ? 2 : 0; } };
              const BrWin2 br2{ws, (unsigned)WS_KV6 + (unsigned)((b * SEQ + pbase + lane) * 768 + 512 + g * 64 + wid * 8) * 2u,
                               (unsigned)WS_KV6 + (unsigned)((b * SEQ + pbase + 16 * (wid & 3) + (lane >> 2)) * 768 + 640 + g * 64 + (wid >> 2) * 32 + (lane & 3) * 8) * 2u,
                               -slope2 * (float)(tq - pbase) + slope2 * (float)(4 * hi) - MREF, slope2, wi0};
              stream2(br2, nt, o, lsum, qr, kp0, vp0, kdst, vdst, slope2, lane, wid); }
            lsum += __shfl_xor(lsum, 32);
            if (hi == 0) wsf[r32] = gst[64] * __builtin_amdgcn_rcpf(lsum); LDS_WAIT(); asm volatile("" ::: "memory");
#pragma unroll
            for (int a = 0; a < 4; ++a) { const f32x4 sc = *(const LAS f32x4*)(wsf + 8 * a + 4 * hi);
#pragma unroll
                for (int k = 0; k < 4; ++k) { const int c = 8 * a + 4 * hi + k; ostg[c * 64 + r32] += o[0][4 * a + k] * sc[k]; ostg[c * 64 + 32 + r32] += o[1][4 * a + k] * sc[k]; } }
            LDS_WAIT(); asm volatile("" ::: "memory");
        }
        int lnO = lnW; asm volatile("" : "+v"(lnO));
        {
          const int lane = lnO;
          AT_QLOAD((ui + 1 < 8 ? ui + 1 : 7), lane);
#pragma unroll
          for (int i = 0; i < 4; ++i) { const int row = i * 8 + (lane >> 3), ch = lane & 7; const f32x4 a = *(const LAS f32x4*)(ostg + row * 64 + ch * 8), c2 = *(const LAS f32x4*)(ostg + row * 64 + ch * 8 + 4);
              u32x4 v; v.x = pk2(a.x, a.y); v.y = pk2(a.z, a.w); v.z = pk2(c2.x, c2.y); v.w = pk2(c2.z, c2.w);
              *(u32x4*)(ws + ((unsigned)WS_OA + (unsigned)((b * SEQ + q0 + 8 * wid + (row & 7)) * 512 + (4 * g + (row >> 3)) * 64 + ch * 8) * 2u)) = v; }
          LDS_WAIT(); asm volatile("" ::: "memory"); }
    }
#undef AT_KOFF_C
#undef AT_VOFF_C
#undef AT_QLOAD
}

__device__ __forceinline__ void p7_route(Frame& F) {
    unsigned char* ws = F.ws; const int lane = F.lane;
    constexpr int WP = 1032;
    LAS bf16_t* WH = (LAS bf16_t*)F.lds; LAS bf16_t* WL = WH + 32 * WP;
    LAS float* G2 = (LAS float*)(F.lds + 2 * 32 * WP * 2);
    LAS int* CNT = (LAS int*)(F.lds + MISC_OFF + 256);
#pragma unroll 1
    for (int jb = 0; jb < 4; ++jb) { float wv[16], gv[16];
#pragma unroll
        for (int j = 0; j < 16; ++j) { const int i = F.tid + 512 * (jb * 16 + j); wv[j] = F.a->in[I_WR][i]; gv[j] = F.a->in[I_GN2][i >> 5]; }
#pragma unroll
        for (int j = 0; j < 16; ++j) { const int i = F.tid + 512 * (jb * 16 + j); const int k = i >> 5, e = i & 31; const float w = wv[j] * gv[j];
            const unsigned h = f2bf(w); const float r = w - __builtin_bit_cast(float, h << 16); WH[e * WP + k] = (bf16_t)h; WL[e * WP + k] = (bf16_t)f2bf(r); } }
    for (int i = F.tid; i < DM; i += 512) G2[i] = F.a->in[I_GN2][i];
    __syncthreads();
    int* TOPE = (int*)(ws + WS_TOPE); float* TOPW = (float*)(ws + WS_TOPW); int* CNTG = (int*)(ws + WS_CNT); float* RSTD = (float*)(ws + WS_RSTD);
    unsigned char* H2 = (unsigned char*)(ws + WS_H2);
    const bf16_t* X1 = (const bf16_t*)(ws + WS_X1B);
    const int r = lane & 15, q = lane >> 4;
    for (int vw = blockIdx.x; vw < 256; vw += F.G) {
        if (F.tid < 32) CNT[F.tid] = 0;
        __syncthreads();
        for (int rnd = 0; rnd < 2; ++rnd) {
            const int tok0 = vw * 256 + rnd * 128 + F.wave * 16;
            const bf16_t* xr = X1 + (size_t)(tok0 + r) * DM + 8 * q; unsigned char* hr = H2 + (size_t)(tok0 + r) * DM + 8 * q;
            f32x4 acc0 = (f32x4){0.f, 0.f, 0.f, 0.f}, acc1 = acc0; float ss = 0.f;
            auto step = [&](const int ks, const u32x4 hw) __attribute__((always_inline)) {
                const f32x4 a = (f32x4){bflo(hw.x), bfhi(hw.x), bflo(hw.y), bfhi(hw.y)}, b = (f32x4){bflo(hw.z), bfhi(hw.z), bflo(hw.w), bfhi(hw.w)};
                ss += (a.x * a.x + a.y * a.y) + (a.z * a.z + a.w * a.w) + (b.x * b.x + b.y * b.y) + (b.z * b.z + b.w * b.w);
                const f32x4 ga = *(const LAS f32x4*)(G2 + 32 * ks + 8 * q), gb = *(const LAS f32x4*)(G2 + 32 * ks + 8 * q + 4);
                u32x2 o8; o8.x = pg8::pk4_fp8(a.x * ga.x, a.y * ga.y, a.z * ga.z, a.w * ga.w); o8.y = pg8::pk4_fp8(b.x * gb.x, b.y * gb.y, b.z * gb.z, b.w * gb.w);
                *(u32x2*)(hr + 32 * ks) = o8;
                const bf16x8 xh = __builtin_bit_cast(bf16x8, hw);
                const bf16x8 w0h = *(const LAS bf16x8*)(WH + r * WP + 32 * ks + 8 * q), w0l = *(const LAS bf16x8*)(WL + r * WP + 32 * ks + 8 * q);
                const bf16x8 w1h = *(const LAS bf16x8*)(WH + (16 + r) * WP + 32 * ks + 8 * q), w1l = *(const LAS bf16x8*)(WL + (16 + r) * WP + 32 * ks + 8 * q);
                acc0 = __builtin_amdgcn_mfma_f32_16x16x32_bf16(xh, w0h, acc0, 0, 0, 0); acc0 = __builtin_amdgcn_mfma_f32_16x16x32_bf16(xh, w0l, acc0, 0, 0, 0);
                acc1 = __builtin_amdgcn_mfma_f32_16x16x32_bf16(xh, w1h, acc1, 0, 0, 0); acc1 = __builtin_amdgcn_mfma_f32_16x16x32_bf16(xh, w1l, acc1, 0, 0, 0);
            };
            u32x4 bufA[8], bufB[8];
#define P7_LOAD(buf, k0) _Pragma("unroll") for (int j = 0; j < 8; ++j) buf[j] = *(const u32x4*)(xr + 32 * ((k0) + j))
#define P7_RUN(buf, k0) _Pragma("unroll") for (int j = 0; j < 8; ++j) step((k0) + j, buf[j])
            P7_LOAD(bufA, 0); P7_LOAD(bufB, 8); P7_RUN(bufA, 0); P7_LOAD(bufA, 16); P7_RUN(bufB, 8); P7_LOAD(bufB, 24); P7_RUN(bufA, 16); P7_RUN(bufB, 24);
#undef P7_LOAD
#undef P7_RUN
            ss += __shfl_xor(ss, 16); ss += __shfl_xor(ss, 32);
            const float rs = 1.0f / sqrtf(ss * (1.f / DM) + EPS);
            const float b0 = F.a->in[I_BR][r], b1 = F.a->in[I_BR][16 + r];
#pragma unroll
            for (int i = 0; i < 4; ++i) {
                const int rowi = 4 * q + i; const float rsi = __shfl(rs, rowi);
                const float l0 = acc0[i] * rsi + b0, l1 = acc1[i] * rsi + b1;
                unsigned u0 = __builtin_bit_cast(unsigned, l0), u1 = __builtin_bit_cast(unsigned, l1);
                u0 ^= (u0 >> 31) ? 0xFFFFFFFFu : 0x80000000u; u1 ^= (u1 >> 31) ? 0xFFFFFFFFu : 0x80000000u;
                unsigned k0 = (u0 & ~31u) | (unsigned)(31 - r), k1 = (u1 & ~31u) | (unsigned)(15 - r);
                float tv[4]; int te[4];
#pragma unroll
                for (int rr = 0; rr < 4; ++rr) { unsigned m = k0 > k1 ? k0 : k1;
                    { unsigned t2 = (unsigned)__builtin_amdgcn_update_dpp(0, (int)m, 0xB1, 0xf, 0xf, false); m = m > t2 ? m : t2; t2 = (unsigned)__builtin_amdgcn_update_dpp(0, (int)m, 0x4E, 0xf, 0xf, false); m = m > t2 ? m : t2;
                      t2 = (unsigned)__builtin_amdgcn_update_dpp(0, (int)m, 0x141, 0xf, 0xf, false); m = m > t2 ? m : t2; t2 = (unsigned)__builtin_amdgcn_update_dpp(0, (int)m, 0x140, 0xf, 0xf, false); m = m > t2 ? m : t2; }
                    te[rr] = 31 - (int)(m & 31u); const unsigned ub = m & ~31u; const unsigned fb = (ub & 0x80000000u) ? (ub ^ 0x80000000u) : ~ub; tv[rr] = __builtin_bit_cast(float, fb);
                    k0 = (k0 == m) ? 0u : k0; k1 = (k1 == m) ? 0u : k1; }
                if (r == 0) { const int tok = tok0 + rowi;
                    const float e1 = __expf(tv[1] - tv[0]), e2 = __expf(tv[2] - tv[0]), e3 = __expf(tv[3] - tv[0]); const float inv = 1.0f / (1.0f + e1 + e2 + e3);
                    *(int4*)(TOPE + (size_t)tok * 4) = make_int4(te[0], te[1], te[2], te[3]); *(float4*)(TOPW + (size_t)tok * 4) = make_float4(inv, e1 * inv, e2 * inv, e3 * inv);
                    RSTD[tok] = rsi;
                    __hip_atomic_fetch_add(&CNT[te[0]], 1, __ATOMIC_RELAXED, __HIP_MEMORY_SCOPE_WORKGROUP); __hip_atomic_fetch_add(&CNT[te[1]], 1, __ATOMIC_RELAXED, __HIP_MEMORY_SCOPE_WORKGROUP);
                    __hip_atomic_fetch_add(&CNT[te[2]], 1, __ATOMIC_RELAXED, __HIP_MEMORY_SCOPE_WORKGROUP); __hip_atomic_fetch_add(&CNT[te[3]], 1, __ATOMIC_RELAXED, __HIP_MEMORY_SCOPE_WORKGROUP); }
            }
        }
        __syncthreads();
        if (F.tid < 32) CNTG[vw * 32 + F.tid] = CNT[F.tid];
        __syncthreads();
    }
}

__device__ __forceinline__ void p8_scatter(Frame& F) {
    unsigned char* ws = F.ws; const int lane = F.lane;
    LAS int* CN = (LAS int*)F.lds;
    LAS int* PT = (LAS int*)(F.lds + 32768);
    LAS int* PP = PT + 512;
    LAS int* WC = PP + 512;
    LAS int* BASE = WC + 512;
    LAS int* TOT = BASE + 32;
    LAS int* TS = TOT + 32;
    const int* CNTG = (const int*)(ws + WS_CNT); const int* TOPE = (const int*)(ws + WS_TOPE); const float* TOPW = (const float*)(ws + WS_TOPW);
    int* INV = (int*)(ws + WS_INV);
    for (int vw = blockIdx.x; vw < 256; vw += F.G) {
        const int ch = vw / WPC, wl = vw % WPC;
        unsigned* ROWTOK = (unsigned*)(ws + WS_ROWTOK) + (size_t)ch * SLOTS_CH; float* ROWW = (float*)(ws + WS_ROWW) + (size_t)ch * SLOTS_CH; float* ROWRS = (float*)(ws + WS_ROWRS) + (size_t)ch * SLOTS_CH;
        for (int i = F.tid; i < WPC * 32; i += 512) CN[i] = CNTG[ch * WPC * 32 + i];
        const int e0 = TOPE[(size_t)vw * 1024 + F.tid], e1 = TOPE[(size_t)vw * 1024 + 512 + F.tid];
        const float tw0 = TOPW[(size_t)vw * 1024 + F.tid], tw1 = TOPW[(size_t)vw * 1024 + 512 + F.tid];
        const float rs0 = ((const float*)(ws + WS_RSTD))[vw * 256 + (F.tid >> 2)], rs1 = ((const float*)(ws + WS_RSTD))[vw * 256 + ((512 + F.tid) >> 2)];
        __syncthreads();
        { const int e = F.tid & 31, part = F.tid >> 5; int tot = 0, pre = 0;
          for (int w = part * (WPC / 16); w < (part + 1) * (WPC / 16); ++w) { const int c = CN[w * 32 + e]; tot += c; pre += (w < wl) ? c : 0; }
          PT[part * 32 + e] = tot; PP[part * 32 + e] = pre; }
        int rk0 = 0, rk1 = 0;
        { const unsigned long long lt = (1ull << lane) - 1ull;
          for (int e = 0; e < 32; ++e) { const unsigned long long m0 = __ballot(e0 == e), m1 = __ballot(e1 == e);
              if (e0 == e) rk0 = __builtin_popcountll(m0 & lt); if (e1 == e) rk1 = __builtin_popcountll(m1 & lt);
              if (lane == 0) { WC[F.wave * 32 + e] = __builtin_popcountll(m0); WC[(8 + F.wave) * 32 + e] = __builtin_popcountll(m1); } } }
        __syncthreads();
        if (F.tid < 32) { int tot = 0, pre = 0; for (int p = 0; p < 16; ++p) { tot += PT[p * 32 + F.tid]; pre += PP[p * 32 + F.tid]; } TOT[F.tid] = tot; BASE[F.tid] = pre;
            int run = 0; for (int sgi = 0; sgi < 16; ++sgi) { const int c = WC[sgi * 32 + F.tid]; WC[sgi * 32 + F.tid] = run; run += c; } }
        __syncthreads();
        if (F.tid == 0) { int ts = 0; for (int e = 0; e < 32; ++e) { TS[e] = ts; ts += (TOT[e] + 255) >> 8; } TS[32] = ts; }
        __syncthreads();
        { const int s0 = TS[e0] * 256 + BASE[e0] + WC[F.wave * 32 + e0] + rk0, s1 = TS[e1] * 256 + BASE[e1] + WC[(8 + F.wave) * 32 + e1] + rk1;
          const int i0 = F.tid, i1 = 512 + F.tid; const int t0 = vw * 256 + (i0 >> 2), t1 = vw * 256 + (i1 >> 2);
          ROWTOK[s0] = (unsigned)t0; ROWW[s0] = tw0; ROWRS[s0] = rs0; INV[(size_t)vw * 1024 + i0] = s0;
          ROWTOK[s1] = (unsigned)t1; ROWW[s1] = tw1; ROWRS[s1] = rs1; INV[(size_t)vw * 1024 + i1] = s1; }
        if (wl < 32) { const int e = wl; const int lo = TS[e] * 256 + TOT[e], hi = TS[e + 1] * 256; for (int sl = lo + F.tid; sl < hi; sl += 512) { ROWTOK[sl] = (unsigned)(ch * TCH); ROWW[sl] = 0.f; ROWRS[sl] = 0.f; } }
        if (wl == 0 && F.tid < 33) ((int*)(ws + WS_TSTART))[ch * 64 + F.tid] = TS[F.tid];
        __syncthreads();
    }
}

__device__ __forceinline__ void p_combine(Frame& F, int ch) {
    unsigned char* ws = F.ws; const int lane = F.lane;
    const unsigned char* Y = (const unsigned char*)(ws + WS_YBUF); const int* INV = (const int*)(ws + WS_INV); const bf16_t* X1 = (const bf16_t*)(ws + WS_X1B);
    const int gw = F.vcu * 8 + F.wave, NGW = F.G * 8;
    for (int i = gw; i < TCH / 2; i += NGW) {
        const int tok = ch * TCH + 2 * i; const int4 sa = *(const int4*)(INV + (size_t)tok * 4), sb = *(const int4*)(INV + (size_t)tok * 4 + 4);
        float* o = F.out + (size_t)tok * DM + lane * 16; const bf16_t* xp = X1 + (size_t)tok * DM + lane * 16;
        u32x4 y[2][4]; u32x4 xb[2][2];
#pragma unroll
        for (int tt = 0; tt < 2; ++tt) { const int4 sl = tt ? sb : sa; const int ss[4] = {sl.x, sl.y, sl.z, sl.w};
#pragma unroll
            for (int k = 0; k < 4; ++k) y[tt][k] = *(const u32x4*)(Y + (size_t)ss[k] * 1024 + lane * 16);
            xb[tt][0] = *(const u32x4*)(xp + tt * DM); xb[tt][1] = *(const u32x4*)(xp + tt * DM + 8); }
#pragma unroll
        for (int tt = 0; tt < 2; ++tt)
#pragma unroll
            for (int q = 0; q < 4; ++q) { f32x4 sacc = (f32x4){0.f, 0.f, 0.f, 0.f};
#pragma unroll
                for (int k = 0; k < 4; ++k) { const f32x2 lo = __builtin_amdgcn_cvt_pk_f32_fp8((int)y[tt][k][q], false), hi = __builtin_amdgcn_cvt_pk_f32_fp8((int)y[tt][k][q], true); sacc += (f32x4){lo.x, lo.y, hi.x, hi.y}; }
                const unsigned w0 = xb[tt][q >> 1][(q & 1) * 2], w1 = xb[tt][q >> 1][(q & 1) * 2 + 1];
                const f32x4 xv = (f32x4){bflo(w0), bfhi(w0), bflo(w1), bfhi(w1)};
                *(f32x4*)(o + tt * DM + 4 * q) = xv + sacc * pg8::YINV; }
    }
}

__device__ __forceinline__ void stagger(int cid, int us) {
    const int k = (cid >> 3) & 3; if (k == 0 || us == 0) return;
    const unsigned long long t0 = __builtin_amdgcn_s_memrealtime(), dt = (unsigned long long)(k * us) * 100ull;
    while (__builtin_amdgcn_s_memrealtime() - t0 < dt) __builtin_amdgcn_s_sleep(32);
}

__global__ void __launch_bounds__(512, 2) mk_fwd(Args args) {
    extern __shared__ __attribute__((aligned(16))) unsigned char lds_raw[];
    Frame F;
    F.lds = (LAS unsigned char*)lds_raw;
    F.tid = threadIdx.x; F.lane = F.tid & 63; F.wave = __builtin_amdgcn_readfirstlane(F.tid >> 6);
    F.G = gridDim.x; { const int bx = blockIdx.x; F.vcu = (F.G % 8 == 0) ? (bx % 8) * (F.G / 8) + bx / 8 : bx; }
    F.ws = args.ws; F.out = args.out; F.a = &args;
    unsigned char* ws = args.ws;
    volatile LAS unsigned* MISC = (volatile LAS unsigned*)(F.lds + MISC_OFF);
    for (int u = F.tid; u < 256; u += 512) MISC[u] = 0u;
    __syncthreads();
    XcdBarrier bar; bar.bar = (unsigned*)(ws + WS_CTL) + 1024; bar.x = 0; bar.st = nullptr;
    const int lo = args.ph_lo, hi = args.ph_hi;
    if (hi - lo > 1) bar = xcd_barrier_post((unsigned*)(ws + WS_CTL) + 1024, MISC + 8);
#define IN(k) (lo <= (k) && (k) < hi)
#ifndef REP1
#define REP1 1
#endif
#ifndef STAG1
#define STAG1 0
#endif
#ifndef REP4
#define REP4 1
#endif
#ifndef REP0
#define REP0 1
#endif
#ifndef REP7
#define REP7 1
#endif
#ifndef REP9
#define REP9 1
#endif
#ifndef REP10
#define REP10 1
#endif
#define SEAM(k) do { if (IN(k) && IN((k) + 1)) xcd_barrier(bar); } while (0)
    LAS unsigned char* ring = F.lds;
    const int cid = (int)blockIdx.x;

    if (IN(0)) { p0_prologue(F); if (REP0 > 1) p0_prologue(F); } SEAM(0);

    if (IN(1)) {
        { pg8::OrdPlain S{(const char*)(ws + WS_H1), (const char*)(ws + WS_WIN_T), T / 256, NPROJ / 256, F.G, cid, (size_t)256 * DM * 2, (size_t)256 * DM * 2};
          pg8::EpiIn E{(bf16_t*)(ws + WS_Q), (bf16_t*)(ws + WS_KV6), (bf16_t*)(ws + WS_CONV3), (bf16_t*)(ws + WS_MG), (bf16_t*)(ws + WS_NG)};
          pg8::gemm_phase<pg8::EpiIn, pg8::OrdPlain, false>(ring, DM, DM * 2, 128, S, E, nullptr); }
        { LAS unsigned short* gtab = (LAS unsigned short*)(F.lds + GTAB_OFF);
          for (int i = F.tid; i < GTAB_UNITS * 256; i += 512) gtab[i] = (unsigned short)(i & 255);
          __syncthreads();
          pg8::OrdPlain S{(const char*)(ws + WS_H1F8), (const char*)(ws + WS_WMG8), T / 256, 2048 / 256, F.G, cid, (size_t)256 * DM, (size_t)256 * DM};
          pg8::EpiMG8 E{(bf16_t*)(ws + WS_MG)};
          pg8::gemm_phase<pg8::EpiMG8, pg8::OrdPlain, true, true>(ring, DM / 2, DM, 128, S, E, gtab); }
    } SEAM(1);

    if (IN(2)) {
        pg8::OrdCmp S{(const char*)(ws + WS_KV6), (const char*)(ws + WS_CKW1_T), (const char*)(ws + WS_CVW1_T), F.G, cid};
        pg8::EpiCmp E{(bf16_t*)(ws + WS_HID), (const float*)(ws + WS_B1P)};
        pg8::gemm_phase<pg8::EpiCmp, pg8::OrdCmp, false>(ring, 2048, 16 * 768 * 2, 768 * 2, S, E, nullptr);
        p2_queue(F);
    }
    SEAM(2);
    if (IN(3)) { p3_compress2(F); } SEAM(3);

    #ifdef ATTN_NAIVE
    if (IN(4)) { p4_attn_naive(F); } SEAM(4);
#else
    if (IN(4)) { p4_attn(F); if (REP4 > 1) p4_attn(F); } SEAM(4);
    F.tid = threadIdx.x; asm volatile("" : "+v"(F.tid)); F.lane = F.tid & 63;
#endif

    if (IN(5)) {
        pg8::OrdPlain2 S{(const char*)(ws + WS_OA), (const char*)(ws + WS_YB), (const char*)(ws + WS_WPA_T), T / 256, DM / 256, F.G, cid, (size_t)256 * AW * 2, (size_t)256 * DM * 2};
        pg8::EpiGateM E{(bf16_t*)(ws + WS_Z), (const bf16_t*)(ws + WS_MG)};
        pg8::gemm_phase<pg8::EpiGateM, pg8::OrdPlain2, false, false, 8>(ring, DM, AW * 2, 128, S, E, nullptr);
    } SEAM(5);

    if (IN(6)) {
        pg8::OrdPlain S{(const char*)(ws + WS_Z), (const char*)(ws + WS_WO_T), T / 256, DM / 256, F.G, cid, (size_t)256 * DM * 2, (size_t)256 * DM * 2};
        pg8::EpiRes E{F.a->in[I_X], (bf16_t*)(ws + WS_X1B)};
        pg8::gemm_phase<pg8::EpiRes, pg8::OrdPlain, false>(ring, DM, DM * 2, 128, S, E, nullptr);
    } SEAM(6);

    if (IN(7)) { p7_route(F); if (REP7 > 1) p7_route(F); } SEAM(7);
    if (IN(8)) { p8_scatter(F); } SEAM(8);

#pragma unroll
    for (int ch = 0; ch < NCH; ++ch) {
        const int pgu = 9 + 2 * ch, pdn = 10 + 2 * ch;
        if (IN(pgu)) {
            LAS int* TS = (LAS int*)(F.lds + MISC_OFF + 512);
            if (F.tid < 33) TS[F.tid] = ((const int*)(ws + WS_TSTART))[ch * 64 + F.tid];
            __syncthreads();
            const int ntile = TS[32];
            pg8::OrdGrp S{(const char*)(ws + WS_H2), (const char*)(ws + WS_WGU_T), TS, ntile, 8, F.G, cid, (size_t)0, (size_t)256 * DM, (size_t)2048 * DM};
            LAS unsigned short* gtab = (LAS unsigned short*)(F.lds + GTAB_OFF);
            { const unsigned* ROWTOK = (const unsigned*)(ws + WS_ROWTOK) + (size_t)ch * SLOTS_CH;
              static_assert(GTAB_UNITS == 40, "the fill below covers 2 x 20 units");
              const int u0 = (F.tid >> 8) * 20, rr = F.tid & 255; unsigned tv[20]; unsigned okm = 0;
#pragma unroll
              for (int j = 0; j < 20; ++j) { int pm, pn; const bool ok = pg8::tile_map((long)(u0 + j) * F.G + cid, ntile, 8, pm, pn); okm |= (ok ? 1u : 0u) << j; tv[j] = ROWTOK[(ok ? pm : 0) * 256 + rr]; }
#pragma unroll
              for (int j = 0; j < 20; ++j) if ((okm >> j) & 1u) gtab[(u0 + j) * 256 + rr] = (unsigned short)tv[j]; }
            __syncthreads();
            pg8::EpiGU E{(unsigned char*)(ws + WS_ACT), F.a->in[I_BGU], (const float*)(ws + WS_ROWRS) + (size_t)ch * SLOTS_CH, (const LAS float*)(F.lds + EPI_OFF)};
            pg8::gemm_phase<pg8::EpiGU, pg8::OrdGrp, true, true>(ring, DM / 2, 0, 128, S, E, gtab); if (REP9 > 1) pg8::gemm_phase<pg8::EpiGU, pg8::OrdGrp, true, true>(ring, DM / 2, 0, 128, S, E, gtab);
            if (ch > 0) p_combine(F, ch - 1);
        } SEAM(pgu);
        if (IN(pdn)) {
            LAS int* TS = (LAS int*)(F.lds + MISC_OFF + 512);
            if (F.tid < 33) TS[F.tid] = ((const int*)(ws + WS_TSTART))[ch * 64 + F.tid];
            __syncthreads();
            const int ntile = TS[32];
            pg8::OrdGrp S{(const char*)(ws + WS_ACT), (const char*)(ws + WS_WDN_T), TS, ntile, 4, F.G, cid, (size_t)256 * DFF, (size_t)256 * DFF, (size_t)DM * DFF, 1};
            pg8::EpiDN E{(unsigned char*)(ws + WS_YBUF), F.a->in[I_BDN], (const float*)(ws + WS_ROWW) + (size_t)ch * SLOTS_CH, (const LAS float*)(F.lds + EPI_OFF)};
            LAS unsigned short* gtab = (LAS unsigned short*)(F.lds + GTAB_OFF);
            for (int i = F.tid; i < GTAB_UNITS * 256; i += 512) gtab[i] = (unsigned short)(i & 255);
            __syncthreads();
            pg8::gemm_phase<pg8::EpiDN, pg8::OrdGrp, true, true>(ring, DFF / 2, DFF, 128, S, E, gtab); if (REP10 > 1) pg8::gemm_phase<pg8::EpiDN, pg8::OrdGrp, true, true>(ring, DFF / 2, DFF, 128, S, E, gtab);
        } SEAM(pdn);
    }
    if (IN(NPH - 1)) { p_combine(F, NCH - 1); }
#undef IN
#undef SEAM
}

extern "C" void kernel_launch(void* const* d_in, const int* in_sizes, int n_in, void* d_out, int out_size, void* d_ws, size_t ws_size, hipStream_t stream) {
    static int grid = 0;
    if (grid == 0) {
        if (n_in != 28 || out_size != T * DM || ws_size < WS_END) { fprintf(stderr, "kernel_launch: unexpected shapes (n_in %d, out %d, ws %zu)\n", n_in, out_size, ws_size); grid = -1; return; }
        int dev = 0, cus = 0;
        if (hipGetDevice(&dev) != hipSuccess || hipDeviceGetAttribute(&cus, hipDeviceAttributeMultiprocessorCount, dev) != hipSuccess) { grid = -1; return; }
        if (hipFuncSetAttribute((const void*)mk_fwd, hipFuncAttributeMaxDynamicSharedMemorySize, LDS_BYTES) != hipSuccess) { fprintf(stderr, "kernel_launch: hipFuncSetAttribute failed\n"); grid = -1; return; }
        int per_cu = 0;
        if (hipOccupancyMaxActiveBlocksPerMultiprocessor(&per_cu, (const void*)mk_fwd, 512, LDS_BYTES) != hipSuccess || per_cu < 1) fprintf(stderr, "kernel_launch: occupancy query says %d\n", per_cu);
        (void)hipGetLastError();
        grid = cus;
    }
    if (grid < 0) return;
    (void)hipMemsetAsync((char*)d_ws + WS_CTL, 0, CTL_ZERO_BYTES, stream);
    Args a{};
    for (int i = 0; i < 28; ++i) a.in[i] = (const float*)d_in[i];
    a.out = (float*)d_out; a.ws = (unsigned char*)d_ws;
#if MK_N_LAUNCHES == 1
    a.ph_lo = 0; a.ph_hi = NPH;
    hipLaunchKernelGGL(mk_fwd, dim3(grid), dim3(512), LDS_BYTES, stream, a);
#else
    for (int p = 0; p < NPH; ++p) { a.ph_lo = p; a.ph_hi = p + 1; hipLaunchKernelGGL(mk_fwd, dim3(grid), dim3(512), LDS_BYTES, stream, a); }
#endif
}
```
